# Optimizing an MI355X kernel written in HIP

```python
import math
import jax, jax.numpy as jnp
from jax import lax
import numpy as np

D_MODEL = 1024
BATCH = 32
SEQ = 2048
DEPTH = 1

HEAD_DIM = 64
MOBA_HEADS = 8
MOBA_WIDTH = MOBA_HEADS * HEAD_DIM
MOBA_BLOCK = 256
MOBA_TOPK = 3
MOBA_Q_CHUNK = 16
DIFF_HEADS = 4
DIFF_QK_DIM = HEAD_DIM
DIFF_V_DIM = 2 * HEAD_DIM
DIFF_WIDTH = DIFF_HEADS * DIFF_V_DIM
MIX_WIDTH = MOBA_WIDTH + DIFF_WIDTH
IN_SPLITS = (MOBA_WIDTH, MOBA_WIDTH, MOBA_WIDTH,
             DIFF_HEADS * 2 * DIFF_QK_DIM, DIFF_HEADS * 2 * DIFF_QK_DIM, DIFF_WIDTH)
IN_COLS = sum(IN_SPLITS)
ATTN_Q_BLOCK = 128
ROPE_THETA = 10000.0
EPS = 1e-6
NEG_INF = -1e30
PEER_HEADS = 8
PEER_NKEYS = 128
PEER_EXPERTS = PEER_NKEYS * PEER_NKEYS
PEER_DK = 256
PEER_HALF = PEER_DK // 2
PEER_TOPK = 16
PEER_TOK_CHUNK = 128

kernel_name = "hymba_moba_diffattn_peer_layer"


def rms_norm(x, gain):
    xf = x.astype(jnp.float32)
    y = xf * lax.rsqrt(jnp.mean(xf * xf, axis=-1, keepdims=True) + EPS)
    return (y * gain.astype(jnp.float32)).astype(x.dtype)


def rope_tables(seq):
    pos = jnp.arange(seq, dtype=jnp.float32)
    inv = 1.0 / (ROPE_THETA ** (jnp.arange(0, HEAD_DIM, 2, dtype=jnp.float32) / HEAD_DIM))
    ang = pos[:, None] * inv[None, :]
    return jnp.cos(ang), jnp.sin(ang)


def apply_rope(x, cos, sin):
    x1, x2 = jnp.split(x, 2, axis=-1)
    c = cos.astype(x.dtype)
    s = sin.astype(x.dtype)
    return jnp.concatenate([x1 * c - x2 * s, x2 * c + x1 * s], axis=-1)


def moba_attention(q, k, v):
    B, H, S, Dh = q.shape
    nb = -(-S // MOBA_BLOCK)
    pad = nb * MOBA_BLOCK - S
    kp = jnp.pad(k, ((0, 0), (0, 0), (0, pad), (0, 0)))
    vp = jnp.pad(v, ((0, 0), (0, 0), (0, pad), (0, 0)))
    k_blocks = kp.reshape(B, H, nb, MOBA_BLOCK, Dh)
    v_blocks = vp.reshape(B, H, nb, MOBA_BLOCK, Dh)
    k_mean = jnp.mean(k_blocks.astype(jnp.float32), axis=3)
    gate = jnp.einsum('bhsd,bhnd->bhsn', q.astype(jnp.float32), k_mean)
    q_block = jnp.arange(S) // MOBA_BLOCK
    past = jnp.arange(nb)[None, :] < q_block[:, None]
    gate = jnp.where(past, gate, NEG_INF)
    k_eff = min(MOBA_TOPK, nb)
    _, sel = lax.top_k(gate, k_eff)
    valid = sel < q_block[:, None]

    n_chunks = S // MOBA_Q_CHUNK

    def to_chunks(t):
        t = t.reshape(B, H, n_chunks, MOBA_Q_CHUNK, *t.shape[3:])
        return jnp.moveaxis(t, 2, 0)

    b_idx = jnp.arange(B)[:, None, None, None]
    h_idx = jnp.arange(H)[None, :, None, None]
    scale = Dh ** -0.5
    key_off = jnp.arange(MOBA_BLOCK)

    def chunk_fn(args):
        c, qc, selc, validc = args
        q_pos = c * MOBA_Q_CHUNK + jnp.arange(MOBA_Q_CHUNK)
        blk = (c * MOBA_Q_CHUNK) // MOBA_BLOCK
        k_sel = k_blocks[b_idx, h_idx, selc]
        v_sel = v_blocks[b_idx, h_idx, selc]
        s_sel = jnp.einsum('bhcd,bhckld->bhckl', qc, k_sel).astype(jnp.float32) * scale
        s_sel = jnp.where(validc[..., None], s_sel, NEG_INF)
        k_own = lax.dynamic_slice_in_dim(kp, blk * MOBA_BLOCK, MOBA_BLOCK, axis=2)
        v_own = lax.dynamic_slice_in_dim(vp, blk * MOBA_BLOCK, MOBA_BLOCK, axis=2)
        s_own = jnp.einsum('bhcd,bhld->bhcl', qc, k_own).astype(jnp.float32) * scale
        own_pos = blk * MOBA_BLOCK + key_off
        s_own = jnp.where(own_pos[None, :] <= q_pos[:, None], s_own, NEG_INF)
        n_sel = k_eff * MOBA_BLOCK
        logits = jnp.concatenate([s_sel.reshape(B, H, MOBA_Q_CHUNK, n_sel), s_own], axis=-1)
        p = jax.nn.softmax(logits, axis=-1).astype(v.dtype)
        p_sel = p[..., :n_sel].reshape(B, H, MOBA_Q_CHUNK, k_eff, MOBA_BLOCK)
        p_own = p[..., n_sel:]
        return (jnp.einsum('bhckl,bhckld->bhcd', p_sel, v_sel)
                + jnp.einsum('bhcl,bhld->bhcd', p_own, v_own))

    outs = lax.map(chunk_fn, (jnp.arange(n_chunks), to_chunks(q), to_chunks(sel), to_chunks(valid)))
    return jnp.moveaxis(outs, 0, 2).reshape(B, H, S, Dh)


def diff_attention(q, k, v, lam):
    B, H, _, S, Dk = q.shape
    Dv = v.shape[-1]
    nqb = S // ATTN_Q_BLOCK
    scale = Dk ** -0.5
    key_pos = jnp.arange(S)
    qb = jnp.moveaxis(q.reshape(B, H, 2, nqb, ATTN_Q_BLOCK, Dk), 3, 0)

    def block_fn(args):
        i, qi = args
        q_pos = i * ATTN_Q_BLOCK + jnp.arange(ATTN_Q_BLOCK)
        s = jnp.einsum('bhmqd,bhmkd->bhmqk', qi, k).astype(jnp.float32) * scale
        s = jnp.where(key_pos[None, :] <= q_pos[:, None], s, NEG_INF)
        p = jax.nn.softmax(s, axis=-1)
        a = p[:, :, 0] - lam * p[:, :, 1]
        return jnp.einsum('bhqk,bhkd->bhqd', a.astype(v.dtype), v)

    outs = lax.map(block_fn, (jnp.arange(nqb), qb))
    return jnp.moveaxis(outs, 0, 2).reshape(B, H, S, Dv)


def peer_ffn(x, w_query, sub_keys, expert_down, expert_up):
    B, S, D = x.shape
    T = B * S
    n_chunks = T // PEER_TOK_CHUNK
    xt = x.reshape(n_chunks, PEER_TOK_CHUNK, D)

    def chunk_fn(xc):
        C = xc.shape[0]
        q = (xc @ w_query).reshape(C, PEER_HEADS, 2, PEER_HALF)
        sc = jnp.einsum('thpd,hpnd->thpn', q, sub_keys).astype(jnp.float32)
        top_s, top_i = lax.top_k(sc, PEER_TOPK)
        cand_s = (top_s[:, :, 0, :, None] + top_s[:, :, 1, None, :]).reshape(C, PEER_HEADS, PEER_TOPK * PEER_TOPK)
        cand_i = (top_i[:, :, 0, :, None] * PEER_NKEYS + top_i[:, :, 1, None, :]).reshape(C, PEER_HEADS, PEER_TOPK * PEER_TOPK)
        best_s, best_pos = lax.top_k(cand_s, PEER_TOPK)
        experts = jnp.take_along_axis(cand_i, best_pos, axis=-1)
        gates = jax.nn.softmax(best_s, axis=-1)
        u = expert_down[experts]
        vv = expert_up[experts]
        act = jax.nn.gelu(jnp.einsum('cd,chkd->chk', xc, u).astype(jnp.float32), approximate=False)
        w = (gates * act).astype(xc.dtype)
        return jnp.einsum('chk,chkd->cd', w, vv)

    out = lax.map(chunk_fn, xt)
    return out.reshape(B, S, D)


def setup_inputs(seed: int = 0) -> dict:
    key = jax.random.key(seed)
    ks = jax.random.split(key, 20)
    f32 = jnp.float32

    def nrm(k, shape, scale):
        return jax.random.normal(k, shape, f32) * scale

    def gain(k, shape):
        return 1.0 + 0.01 * jax.random.normal(k, shape, f32)

    L = DEPTH
    return {
        "x": jax.random.normal(ks[0], (BATCH, SEQ, D_MODEL), f32),
        "attn_norm": gain(ks[1], (L, D_MODEL)),
        "w_in": nrm(ks[2], (L, D_MODEL, IN_COLS), D_MODEL ** -0.5),
        "q_norm_moba": gain(ks[3], (L, HEAD_DIM)),
        "k_norm_moba": gain(ks[4], (L, HEAD_DIM)),
        "q_norm_diff": gain(ks[5], (L, 2, DIFF_QK_DIM)),
        "k_norm_diff": gain(ks[6], (L, 2, DIFF_QK_DIM)),
        "lambda_q1": nrm(ks[7], (L, DIFF_QK_DIM), 0.1),
        "lambda_k1": nrm(ks[8], (L, DIFF_QK_DIM), 0.1),
        "lambda_q2": nrm(ks[9], (L, DIFF_QK_DIM), 0.1),
        "lambda_k2": nrm(ks[10], (L, DIFF_QK_DIM), 0.1),
        "moba_out_gain": gain(ks[11], (L, MOBA_HEADS, HEAD_DIM)),
        "diff_out_gain": gain(ks[12], (L, DIFF_HEADS, DIFF_V_DIM)),
        "w_out": nrm(ks[13], (L, MIX_WIDTH, D_MODEL), MIX_WIDTH ** -0.5),
        "ffn_norm": gain(ks[14], (L, D_MODEL)),
        "peer_query": nrm(ks[15], (L, D_MODEL, PEER_HEADS * PEER_DK), D_MODEL ** -0.5),
        "peer_sub_keys": nrm(ks[16], (L, PEER_HEADS, 2, PEER_NKEYS, PEER_HALF), PEER_HALF ** -0.5),
        "peer_down": nrm(ks[17], (L, PEER_EXPERTS, D_MODEL), D_MODEL ** -0.5),
        "peer_up": nrm(ks[18], (L, PEER_EXPERTS, D_MODEL), (PEER_HEADS * PEER_TOPK) ** -0.5),
    }


def reference(x, attn_norm, w_in, q_norm_moba, k_norm_moba, q_norm_diff, k_norm_diff,
              lambda_q1, lambda_k1, lambda_q2, lambda_k2, moba_out_gain, diff_out_gain,
              w_out, ffn_norm, peer_query, peer_sub_keys, peer_down, peer_up):
    B, S, D = x.shape
    cos, sin = rope_tables(S)
    split_pts = [int(p) for p in np.cumsum(IN_SPLITS)[:-1]]
    for i in range(DEPTH):
        h = rms_norm(x, attn_norm[i])
        proj = h @ w_in[i]
        mq, mk, mv, dq, dk, dv = jnp.split(proj, split_pts, axis=-1)
        mq = mq.reshape(B, S, MOBA_HEADS, HEAD_DIM).transpose(0, 2, 1, 3)
        mk = mk.reshape(B, S, MOBA_HEADS, HEAD_DIM).transpose(0, 2, 1, 3)
        mv = mv.reshape(B, S, MOBA_HEADS, HEAD_DIM).transpose(0, 2, 1, 3)
        mq = apply_rope(rms_norm(mq, q_norm_moba[i]), cos, sin)
        mk = apply_rope(rms_norm(mk, k_norm_moba[i]), cos, sin)
        a_out = moba_attention(mq, mk, mv)
        a_out = rms_norm(a_out.transpose(0, 2, 1, 3), moba_out_gain[i])
        dq = dq.reshape(B, S, DIFF_HEADS, 2, DIFF_QK_DIM).transpose(0, 2, 3, 1, 4)
        dk = dk.reshape(B, S, DIFF_HEADS, 2, DIFF_QK_DIM).transpose(0, 2, 3, 1, 4)
        dv = dv.reshape(B, S, DIFF_HEADS, DIFF_V_DIM).transpose(0, 2, 1, 3)
        dq = apply_rope(rms_norm(dq, q_norm_diff[i][:, None, :]), cos, sin)
        dk = apply_rope(rms_norm(dk, k_norm_diff[i][:, None, :]), cos, sin)
        lambda_init = 0.8 - 0.6 * math.exp(-0.3 * i)
        lam = (jnp.exp(jnp.sum(lambda_q1[i].astype(jnp.float32) * lambda_k1[i].astype(jnp.float32)))
               - jnp.exp(jnp.sum(lambda_q2[i].astype(jnp.float32) * lambda_k2[i].astype(jnp.float32)))
               + lambda_init)
        b_out = diff_attention(dq, dk, dv, lam)
        b_out = rms_norm(b_out.transpose(0, 2, 1, 3), diff_out_gain[i]) * (1.0 - lambda_init)
        mixed = jnp.concatenate([a_out.reshape(B, S, MOBA_WIDTH),
                                 b_out.reshape(B, S, DIFF_WIDTH).astype(a_out.dtype)], axis=-1)
        x = x + mixed @ w_out[i]
        x = x + peer_ffn(rms_norm(x, ffn_norm[i]), peer_query[i], peer_sub_keys[i], peer_down[i], peer_up[i])
    return x
```

```cpp
#include <hip/hip_runtime.h>
#include <cstdio>
#include <cstdint>
namespace pg8 {
#define PG8_LAS __attribute__((address_space(3)))
typedef unsigned short bf16_t;
typedef short bf16x8 __attribute__((ext_vector_type(8)));
typedef float f32x4 __attribute__((ext_vector_type(4)));
typedef unsigned u32x4 __attribute__((ext_vector_type(4)));
constexpr int BM = 256, BK = 64, HALF = 128, HTB = HALF * BK * 2  , STAGE_BYTES = 8 * HTB, NXCD = 8, WGM = 8;

__host__ __device__ __forceinline__ int lds_byte(int r, int c) { const int st = (r >> 4) * 2 + (c >> 5), rr = r & 15, cc = c & 31, ob = rr * 64 + cc * 2; return st * 1024 + (ob ^ (((ob >> 9) & 1) << 5)); }
__host__ __device__ __forceinline__ void stage_rc(int b, int& R, int& C) { const int st = b / 1024, sb = b % 1024, swz = sb ^ (((sb >> 9) & 1) << 5); R = (st >> 1) * 16 + swz / 64; C = (st & 1) * 32 + (swz % 64) / 2; }
__host__ __device__ __forceinline__ int perm32(int rho) { const int n = rho >> 4, i = rho & 15; return 8 * (i >> 2) + 4 * n + (i & 3); }

struct Unit { int pm, pn; };
struct Gemm { const bf16_t* A; const bf16_t* Bt; int M, N, K; };

struct StaticOrder {
    int nM, nN, nwg, G, c;
    __host__ __device__ void init(int M, int N, int G_, int c_) { nM = M / BM; nN = N / BM; nwg = nM * nN; G = G_; c = c_; }
    __host__ __device__ bool next(int i, Unit& u) const {
        const long L = (long)i * G + c; if (L >= nwg) return false;
        int wgid = (int)L; { const int q = nwg / NXCD, r = nwg % NXCD, xcd = wgid % NXCD, off = wgid / NXCD; wgid = (xcd < r ? xcd * (q + 1) : r * (q + 1) + (xcd - r) * q) + off; }
        const int nig = WGM * nN, gid = wgid / nig, fm = gid * WGM, gsz = (nM - fm) < WGM ? (nM - fm) : WGM;
        u.pm = fm + ((wgid % nig) % gsz); u.pn = (wgid % nig) / gsz; return true;
    }
    __device__ __forceinline__ void a_ready(const Unit&) const {}
    __device__ __forceinline__ void done(const Unit&) const {}
};

__device__ __forceinline__ unsigned cvt_pk_bf16(float lo, float hi) { unsigned r; asm volatile("v_cvt_pk_bf16_f32 %0, %1, %2" : "=v"(r) : "v"(lo), "v"(hi)); return r; }
struct EpiBf16 {
    static constexpr bool PERM = true, AFTER_DRAIN = false;
    bf16_t* O; int ldc; int split_cols; size_t split_stride;
    __device__ __forceinline__ void operator()(const f32x4 (&acc)[2][2][4][2], const Unit& u, int wr, int wc, int fr, int fq) const {
        const int row0 = u.pm * BM + wr * 64 + fr; int colt = u.pn * BM; bf16_t* base = O;
        if (split_cols) { const int t = colt / split_cols; base += (size_t)t * split_stride; colt -= t * split_cols; }
        const int col0 = colt + wc * 32 + 8 * fq;
#pragma unroll
        for (int ai = 0; ai < 2; ++ai)
#pragma unroll
            for (int m = 0; m < 4; ++m) { bf16_t* rowp = base + (size_t)(row0 + ai * HALF + m * 16) * ldc + col0;
#pragma unroll
                for (int bj = 0; bj < 2; ++bj) { const f32x4 v0 = acc[ai][bj][m][0], v1 = acc[ai][bj][m][1];
                    u32x4 w; w.x = cvt_pk_bf16(v0[0], v0[1]); w.y = cvt_pk_bf16(v0[2], v0[3]); w.z = cvt_pk_bf16(v1[0], v1[1]); w.w = cvt_pk_bf16(v1[2], v1[3]);
                    *(u32x4*)(rowp + bj * HALF) = w; } }
    }
};
struct EpiResF32 {
    static constexpr bool PERM = false, AFTER_DRAIN = false;
    const float* base; float* out; int ldc;
    __device__ __forceinline__ void operator()(const f32x4 (&acc)[2][2][4][2], const Unit& u, int wr, int wc, int fr, int fq) const {
        const int col0 = u.pn * BM + wc * 32 + 4 * fq;
#pragma unroll
        for (int ai = 0; ai < 2; ++ai)
#pragma unroll
            for (int m = 0; m < 4; ++m) { const size_t off = (size_t)(u.pm * BM + ai * HALF + wr * 64 + m * 16 + fr) * ldc + col0;
#pragma unroll
                for (int bj = 0; bj < 2; ++bj)
#pragma unroll
                    for (int n = 0; n < 2; ++n) { const f32x4 bs = *(const f32x4*)(base + off + bj * HALF + n * 16); *(f32x4*)(out + off + bj * HALF + n * 16) = bs + acc[ai][bj][m][n]; } }
    }
};
template <class Epi, class Sched, bool ALIGN_EPI = false, bool SP2 = false>
__device__ __forceinline__ void gemm_phase(PG8_LAS unsigned char* lds, const Gemm g, const Sched& S, const Epi& E) {
    const int tid = threadIdx.x, wid = __builtin_amdgcn_readfirstlane(tid >> 6), lane = tid & 63, wr = wid >> 2, wc = wid & 3, fr = lane & 15, fq = lane >> 4;
    const int K = g.K, nt = K / BK;
    unsigned voffA[2], voffB[2];
#pragma unroll
    for (int i = 0; i < 2; ++i) { int R, C; stage_rc(tid * 16 + i * 8192, R, C); const int Rb = Epi::PERM ? ((R & ~31) + perm32(R & 31)) : R;
        voffA[i] = (unsigned)(R * K + C) * 2u; voffB[i] = (unsigned)(Rb * K + C) * 2u; }
    const size_t kstep = (size_t)(BK * 2);
    const size_t hstep = (size_t)HALF * K * 2;
    const size_t tstep = 2 * hstep;
    const unsigned ldsw = (unsigned)wid * 1024u;
    const int aoff = lds_byte(wr * 64 + fr, fq * 8), boff = lds_byte(wc * 32 + fr, fq * 8);
#define PG8_SA(b, h) (((b) * 2 + (h)) * HTB)
#define PG8_SB(b, h) ((4 + (b) * 2 + (h)) * HTB)
#define PG8_STAGE(bufoff, gbase, voff) do { _Pragma("unroll") for (int _i = 0; _i < 2; ++_i) \
        __builtin_amdgcn_global_load_lds((const unsigned*)((const char*)(gbase) + (voff)[_i]), (PG8_LAS unsigned*)(lds + (bufoff) + ldsw + _i * 8192), 16, 0, 0); } while (0)
#define PG8_LDA(dst, b, h) do { _Pragma("unroll") for (int m = 0; m < 4; ++m) _Pragma("unroll") for (int k = 0; k < 2; ++k) dst[m][k] = *(const PG8_LAS bf16x8*)(lds + PG8_SA(b, h) + aoff + m * 2048 + k * 1024); } while (0)
#define PG8_LDB(dst, b, h) do { _Pragma("unroll") for (int n = 0; n < 2; ++n) _Pragma("unroll") for (int k = 0; k < 2; ++k) dst[n][k] = *(const PG8_LAS bf16x8*)(lds + PG8_SB(b, h) + boff + n * 2048 + k * 1024); } while (0)
#define PG8_MMA(ai, bj, At, Bt) do { __builtin_amdgcn_s_setprio(1); _Pragma("unroll") for (int m = 0; m < 4; ++m) _Pragma("unroll") for (int n = 0; n < 2; ++n) _Pragma("unroll") for (int k = 0; k < 2; ++k) \
        acc[ai][bj][m][n] = __builtin_amdgcn_mfma_f32_16x16x32_bf16(Bt[n][k], At[m][k], acc[ai][bj][m][n], 0, 0, 0); __builtin_amdgcn_s_setprio(0); } while (0)
#define PG8_WAIT_V(n) asm volatile("s_waitcnt vmcnt(" #n ")" ::: "memory")
#define PG8_WAIT_L(n) asm volatile("s_waitcnt lgkmcnt(" #n ")" ::: "memory")
#define PG8_BAR __builtin_amdgcn_s_barrier()
#define PG8_SCHED __builtin_amdgcn_sched_barrier(0)
    Unit cur, nxt; int ui = 0;
    if (!S.next(0, cur)) return;
    f32x4 acc[2][2][4][2];
#pragma unroll
    for (int a = 0; a < 2; ++a)
#pragma unroll
        for (int b = 0; b < 2; ++b)
#pragma unroll
            for (int m = 0; m < 4; ++m)
#pragma unroll
                for (int n = 0; n < 2; ++n) acc[a][b][m][n] = (f32x4){0.f, 0.f, 0.f, 0.f};
    bf16x8 At[4][2], B0[2][2], B1[2][2];
    const char* cA = (const char*)g.A + (size_t)cur.pm * tstep; const char* cB = (const char*)g.Bt + (size_t)cur.pn * tstep;
    S.a_ready(cur);
    if constexpr (SP2) {
        PG8_STAGE(PG8_SB(0, 0), cB, voffB); PG8_STAGE(PG8_SB(0, 1), cB + hstep, voffB); PG8_STAGE(PG8_SA(0, 0), cA, voffA); PG8_STAGE(PG8_SA(0, 1), cA + hstep, voffA);
        if (wr == 1) PG8_BAR;
        PG8_WAIT_V(2); PG8_BAR;
        PG8_STAGE(PG8_SB(1, 0), cB + kstep, voffB); PG8_STAGE(PG8_SA(1, 0), cA + kstep, voffA); PG8_STAGE(PG8_SB(1, 1), cB + hstep + kstep, voffB);
        PG8_WAIT_V(6); PG8_BAR;
    } else {
        PG8_STAGE(PG8_SB(0, 0), cB, voffB); PG8_STAGE(PG8_SA(0, 0), cA, voffA); PG8_STAGE(PG8_SB(0, 1), cB + hstep, voffB); PG8_STAGE(PG8_SA(0, 1), cA + hstep, voffA);
        if (wr == 1) PG8_BAR;
        PG8_WAIT_V(4); PG8_BAR;
        PG8_STAGE(PG8_SB(1, 0), cB + kstep, voffB); PG8_STAGE(PG8_SA(1, 0), cA + kstep, voffA); PG8_STAGE(PG8_SB(1, 1), cB + hstep + kstep, voffB);
        PG8_WAIT_V(6); PG8_BAR;
    }
    for (;;) {
        const bool has_next = S.next(ui + 1, nxt);
        const char* nA = has_next ? (const char*)g.A + (size_t)nxt.pm * tstep : cA; const char* nB = has_next ? (const char*)g.Bt + (size_t)nxt.pn * tstep : cB;
        for (int t = 0; t < nt; t += 2) {
            const bool last = (t == nt - 2);
            const char* a1 = cA + (size_t)(t + 1) * kstep;
            const char* a2 = last ? nA : cA + (size_t)(t + 2) * kstep; const char* b2 = last ? nB : cB + (size_t)(t + 2) * kstep;
            const char* a3 = a2 + kstep; const char* b3 = b2 + kstep;
            if (last && has_next) S.a_ready(nxt);
            if constexpr (SP2) {
            PG8_LDB(B0, 0, 0); PG8_LDB(B1, 0, 1); PG8_SCHED; PG8_LDA(At, 0, 0); PG8_STAGE(PG8_SA(1, 1), a1 + hstep, voffA);
            PG8_WAIT_V(8); PG8_WAIT_L(0); PG8_BAR; PG8_MMA(0, 0, At, B0); PG8_MMA(0, 1, At, B1); PG8_BAR; PG8_SCHED;
            PG8_LDA(At, 0, 1); PG8_STAGE(PG8_SB(0, 0), b2, voffB); PG8_STAGE(PG8_SB(0, 1), b2 + hstep, voffB); PG8_STAGE(PG8_SA(0, 0), a2, voffA);
            PG8_WAIT_V(8); PG8_WAIT_L(0); PG8_BAR; PG8_MMA(1, 0, At, B0); PG8_MMA(1, 1, At, B1); PG8_BAR; PG8_SCHED;
            PG8_LDB(B0, 1, 0); PG8_LDB(B1, 1, 1); PG8_SCHED; PG8_LDA(At, 1, 0); PG8_STAGE(PG8_SA(0, 1), a2 + hstep, voffA);
            PG8_WAIT_V(8); PG8_WAIT_L(0); PG8_BAR; PG8_MMA(0, 0, At, B0); PG8_MMA(0, 1, At, B1); PG8_BAR; PG8_SCHED;
            PG8_LDA(At, 1, 1); PG8_STAGE(PG8_SB(1, 0), b3, voffB); PG8_STAGE(PG8_SB(1, 1), b3 + hstep, voffB); PG8_STAGE(PG8_SA(1, 0), a3, voffA);
            PG8_WAIT_V(8); PG8_WAIT_L(0); PG8_BAR; PG8_MMA(1, 0, At, B0); PG8_MMA(1, 1, At, B1); PG8_BAR; PG8_SCHED;
            } else {
            PG8_LDB(B0, 0, 0); PG8_SCHED; PG8_LDA(At, 0, 0); PG8_STAGE(PG8_SA(1, 1), a1 + hstep, voffA);
            PG8_WAIT_L(8); PG8_BAR; PG8_WAIT_L(0); PG8_MMA(0, 0, At, B0); PG8_BAR; PG8_SCHED;
            PG8_LDB(B1, 0, 1); PG8_STAGE(PG8_SB(0, 0), b2, voffB);
            PG8_BAR; PG8_WAIT_L(0); PG8_MMA(0, 1, At, B1); PG8_BAR;
            PG8_LDA(At, 0, 1); PG8_STAGE(PG8_SA(0, 0), a2, voffA);
            PG8_BAR; PG8_WAIT_L(0); PG8_MMA(1, 0, At, B0); PG8_BAR; PG8_SCHED;
            PG8_STAGE(PG8_SB(0, 1), b2 + hstep, voffB);
            PG8_WAIT_V(6); PG8_BAR; PG8_MMA(1, 1, At, B1); PG8_BAR;
            PG8_LDB(B0, 1, 0); PG8_SCHED; PG8_LDA(At, 1, 0); PG8_STAGE(PG8_SA(0, 1), a2 + hstep, voffA);
            PG8_WAIT_L(8); PG8_BAR; PG8_WAIT_L(0); PG8_MMA(0, 0, At, B0); PG8_BAR; PG8_SCHED;
            PG8_LDB(B1, 1, 1); PG8_STAGE(PG8_SB(1, 0), b3, voffB);
            PG8_BAR; PG8_WAIT_L(0); PG8_MMA(0, 1, At, B1); PG8_BAR;
            PG8_LDA(At, 1, 1); PG8_STAGE(PG8_SA(1, 0), a3, voffA);
            PG8_BAR; PG8_WAIT_L(0); PG8_MMA(1, 0, At, B0); PG8_BAR; PG8_SCHED;
            PG8_STAGE(PG8_SB(1, 1), b3 + hstep, voffB);
            PG8_WAIT_V(6); PG8_BAR; PG8_MMA(1, 1, At, B1); PG8_BAR;
            }
        }
        if constexpr (ALIGN_EPI) { if (wr == 0) PG8_BAR; }
        if constexpr (!Epi::AFTER_DRAIN) { E(acc, cur, wr, wc, fr, fq); S.done(cur); }
        if (!has_next) break;
#pragma unroll
        for (int a = 0; a < 2; ++a)
#pragma unroll
            for (int b = 0; b < 2; ++b)
#pragma unroll
                for (int m = 0; m < 4; ++m)
#pragma unroll
                    for (int n = 0; n < 2; ++n) acc[a][b][m][n] = (f32x4){0.f, 0.f, 0.f, 0.f};
        cur = nxt; cA = nA; cB = nB; ++ui;
        if constexpr (ALIGN_EPI) { if (wr == 1) PG8_BAR; }
    }
    PG8_WAIT_V(0);
    if constexpr (!ALIGN_EPI) { if (wr == 0) PG8_BAR; }
    PG8_BAR;
    if constexpr (Epi::AFTER_DRAIN) { E.fused(acc, cur, wr, wc, fr, fq, lds, wid, lane); S.done(cur); }
#undef PG8_SA
#undef PG8_SB
#undef PG8_STAGE
#undef PG8_LDA
#undef PG8_LDB
#undef PG8_MMA
#undef PG8_WAIT_V
#undef PG8_WAIT_L
#undef PG8_BAR
#undef PG8_SCHED
}
}
typedef unsigned short bf16;
constexpr int T = 65536, DM = 1024, SEQ = 2048, NB = 32;
constexpr size_t MiB = 1u << 20;
constexpr size_t WS_CTL = 0, WS_KMEAN = 1 * MiB, WS_ZERO_BYTES = 2 * MiB;
constexpr size_t WS_ROPE = 2 * MiB, WS_SCAL = 3 * MiB;
constexpr size_t WS_WIN = 4 * MiB, WS_WOUT = 10 * MiB, WS_WQ = 12 * MiB, WS_SUBK = 16 * MiB;
constexpr size_t WS_DOWN = 32 * MiB, WS_UP = 64 * MiB, WS_XN = 96 * MiB;
constexpr size_t WS_QKV = 224 * MiB, QKV_STRIDE = 64 * MiB;
constexpr size_t WS_PQ = 224 * MiB;
constexpr size_t WS_MIXED = 608 * MiB, WS_DO = 736 * MiB, WS_IDS = 864 * MiB, WS_GATES = 896 * MiB, WS_END = 928 * MiB;
constexpr size_t QKV_ELEMS = QKV_STRIDE / 2;
constexpr float QSCALE = 0.125f * 1.4426950408889634f;
constexpr float EPS = 1e-6f;

__device__ __forceinline__ unsigned f2bf(float f) { unsigned u = __float_as_uint(f); return (u + 0x7fffu + ((u >> 16) & 1u)) >> 16; }
__device__ __forceinline__ float bf2f(unsigned h) { return __uint_as_float(h << 16); }
__device__ __forceinline__ float wave_sum(float v) {
#pragma unroll
    for (int o = 1; o < 64; o <<= 1) v += __shfl_xor(v, o);
    return v;
}

__global__ __launch_bounds__(256) void k_transpose_bf16(const float* __restrict__ W, int K, int N, bf16* __restrict__ WT) {
    __shared__ float tile[32][33];
    const int n0 = blockIdx.x * 32, k0 = blockIdx.y * 32, tx = threadIdx.x & 31, ty = threadIdx.x >> 5;
    for (int i = ty; i < 32; i += 8) tile[i][tx] = W[(size_t)(k0 + i) * N + n0 + tx];
    __syncthreads();
    for (int i = ty; i < 32; i += 8) WT[(size_t)(n0 + i) * K + k0 + tx] = (bf16)f2bf(tile[tx][i]);
}
__global__ __launch_bounds__(256) void k_convert_bf16(const float* __restrict__ src, bf16* __restrict__ dst, size_t n4) {
    for (size_t i = (size_t)blockIdx.x * 256 + threadIdx.x; i < n4; i += (size_t)gridDim.x * 256) {
        const float4 v = ((const float4*)src)[i];
        uint2 o; o.x = f2bf(v.x) | (f2bf(v.y) << 16); o.y = f2bf(v.z) | (f2bf(v.w) << 16);
        ((uint2*)dst)[i] = o;
    }
}
__global__ __launch_bounds__(256) void k_rope(float* __restrict__ rope) {
    const int i = blockIdx.x * 256 + threadIdx.x; if (i >= SEQ * 32) return;
    const int pos = i >> 5, j = i & 31;
    const float inv = 1.0f / exp2f((float)j * (13.287712379549449f / 32.0f));
    const float ang = (float)pos * inv;
    double rev = (double)ang * 0.15915494309189535; rev -= floor(rev);
    rope[i] = __builtin_amdgcn_cosf((float)rev); rope[SEQ * 32 + i] = __builtin_amdgcn_sinf((float)rev);
}
__global__ void k_scalars(const float* lq1, const float* lk1, const float* lq2, const float* lk2, float* scal) {
    if (threadIdx.x == 0 && blockIdx.x == 0) { float a = 0.f, b = 0.f; for (int i = 0; i < 64; ++i) { a += lq1[i] * lk1[i]; b += lq2[i] * lk2[i]; }
        scal[0] = expf(a) - expf(b) + 0.2f; }
}
__global__ __launch_bounds__(256) void k_rmsnorm(const float* __restrict__ x, const float* __restrict__ g, bf16* __restrict__ out, int rows) {
    const int lane = threadIdx.x & 63, nw = gridDim.x * 4;
    for (int r = blockIdx.x * 4 + (threadIdx.x >> 6); r < rows; r += nw) {
        const float4* xr = (const float4*)(x + (size_t)r * DM) + lane;
        float4 v[4]; float s = 0.f;
#pragma unroll
        for (int j = 0; j < 4; ++j) { v[j] = xr[64 * j]; s += (v[j].x * v[j].x + v[j].y * v[j].y) + (v[j].z * v[j].z + v[j].w * v[j].w); }
        const float rs = rsqrtf(wave_sum(s) * (1.0f / DM) + EPS);
        uint2* o = (uint2*)(out + (size_t)r * DM) + lane;
#pragma unroll
        for (int j = 0; j < 4; ++j) { const float4 gg = ((const float4*)g)[lane + 64 * j];
            uint2 w; w.x = f2bf(v[j].x * rs * gg.x) | (f2bf(v[j].y * rs * gg.y) << 16); w.y = f2bf(v[j].z * rs * gg.z) | (f2bf(v[j].w * rs * gg.w) << 16);
            o[64 * j] = w; }
    }
}
__global__ __launch_bounds__(256) void k_qk_post(bf16* __restrict__ qkv, const float* __restrict__ rope, const float* __restrict__ gqm, const float* __restrict__ gkm,
                                                 const float* __restrict__ gqd, const float* __restrict__ gkd) {
    const int lane = threadIdx.x & 63, half = lane >> 5, j = lane & 31, nw = gridDim.x * 4;
    for (int t = blockIdx.x * 4 + (threadIdx.x >> 6); t < T; t += nw) {
        const int pos = t & (SEQ - 1);
        const float c = rope[pos * 32 + j], sn = rope[SEQ * 32 + pos * 32 + j];
        for (int it = 0; it < 16; ++it) {
            const int s = it * 2 + half, type = s >> 3, hs = s & 7;
            bf16* buf = qkv + (size_t)(type < 2 ? type : type + 1) * QKV_ELEMS + (size_t)t * 512 + hs * 64;
            const float x1 = bf2f(buf[j]), x2 = bf2f(buf[j + 32]);
            float ss = x1 * x1 + x2 * x2;
#pragma unroll
            for (int o = 1; o < 32; o <<= 1) ss += __shfl_xor(ss, o);
            const float rs = rsqrtf(ss * (1.0f / 64.0f) + EPS);
            const float* g = type == 0 ? gqm : type == 1 ? gkm : type == 2 ? gqd + (hs & 1) * 64 : gkd + (hs & 1) * 64;
            const float y1 = x1 * rs * g[j], y2 = x2 * rs * g[j + 32];
            float o1 = y1 * c - y2 * sn, o2 = y2 * c + y1 * sn;
            if (type == 0 || type == 2) { o1 *= QSCALE; o2 *= QSCALE; }
            buf[j] = (bf16)f2bf(o1); buf[j + 32] = (bf16)f2bf(o2);
        }
    }
}
__global__ __launch_bounds__(256) void k_kmean(const bf16* __restrict__ MK, float* __restrict__ kmean) {
    const int w = blockIdx.x * 4 + (threadIdx.x >> 6), lane = threadIdx.x & 63; if (w >= NB * 8 * 8) return;
    const int blk = w & 7, h = (w >> 3) & 7, b = w >> 6; float s = 0.f;
    const bf16* p = MK + ((size_t)b * SEQ + blk * 256) * 512 + h * 64 + lane;
    for (int i = 0; i < 256; ++i) s += bf2f(p[(size_t)i * 512]);
    kmean[(size_t)w * 64 + lane] = s * (1.0f / 256.0f);
}
__device__ __forceinline__ void load64(const bf16* p, float (&f)[64]) {
    const uint4* p4 = (const uint4*)p;
#pragma unroll
    for (int i = 0; i < 8; ++i) { const uint4 u = p4[i];
        f[8 * i + 0] = __uint_as_float(u.x << 16); f[8 * i + 1] = __uint_as_float(u.x & 0xffff0000u); f[8 * i + 2] = __uint_as_float(u.y << 16); f[8 * i + 3] = __uint_as_float(u.y & 0xffff0000u);
        f[8 * i + 4] = __uint_as_float(u.z << 16); f[8 * i + 5] = __uint_as_float(u.z & 0xffff0000u); f[8 * i + 6] = __uint_as_float(u.w << 16); f[8 * i + 7] = __uint_as_float(u.w & 0xffff0000u); }
}
__global__ __launch_bounds__(256) void k_attn_naive(const bf16* __restrict__ qkv, const float* __restrict__ kmean, const float* __restrict__ gain_m, bf16* __restrict__ mixed, bf16* __restrict__ dob) {
    const int bid = blockIdx.x, qb = 7 - (bid & 7), hd = (bid >> 3) % 24, b = bid / (8 * 24);
    const int q = qb * 256 + threadIdx.x; const size_t trow = (size_t)b * SEQ + q, brow = (size_t)b * SEQ;
    const bool moba = hd < 8; const bf16 *Qp, *Kp, *Vp; int h = hd, m = 0, c = 0;
    if (moba) { Qp = qkv + trow * 512 + hd * 64; Kp = qkv + QKV_ELEMS + brow * 512 + hd * 64; Vp = qkv + 2 * QKV_ELEMS + brow * 512 + hd * 64; }
    else { const int jj = hd - 8; h = jj >> 2; m = (jj >> 1) & 1; c = jj & 1;
        Qp = qkv + 3 * QKV_ELEMS + trow * 512 + h * 128 + m * 64; Kp = qkv + 4 * QKV_ELEMS + brow * 512 + h * 128 + m * 64; Vp = qkv + 5 * QKV_ELEMS + brow * 512 + h * 128 + c * 64; }
    float qf[64]; load64(Qp, qf);
    unsigned sel = 0;
    if (moba) {
        float g[8];
#pragma unroll
        for (int n = 0; n < 8; ++n) { float s = 0.f; const float* km = kmean + (((size_t)b * 8 + hd) * 8 + n) * 64;
#pragma unroll
            for (int d = 0; d < 64; ++d) s += qf[d] * km[d];
            g[n] = s; }
#pragma unroll
        for (int r = 0; r < 3; ++r) { float best = -3.0e38f; int bi = -1;
#pragma unroll
            for (int n = 0; n < 8; ++n) if (n < qb && !((sel >> n) & 1u) && g[n] > best) { best = g[n]; bi = n; }
            if (bi >= 0) sel |= 1u << bi; }
    }
    float mx = -3.0e38f, l = 0.f; float o[64];
#pragma unroll
    for (int d = 0; d < 64; ++d) o[d] = 0.f;
    for (int kb = 0; kb <= qb; ++kb) {
        const bool on = !moba || kb == qb || ((sel >> kb) & 1u);
        if (!__any(on)) continue;
        for (int kk = 0; kk < 256; ++kk) {
            const int key = kb * 256 + kk;
            float kf[64]; load64(Kp + (size_t)key * 512, kf);
            float s = 0.f;
#pragma unroll
            for (int d = 0; d < 64; ++d) s += qf[d] * kf[d];
            if (on && key <= q) {
                if (s > mx) { const float f = exp2f(mx - s); l *= f;
#pragma unroll
                    for (int d = 0; d < 64; ++d) o[d] *= f;
                    mx = s; }
                const float p = exp2f(s - mx); l += p;
                float vf[64]; load64(Vp + (size_t)key * 512, vf);
#pragma unroll
                for (int d = 0; d < 64; ++d) o[d] += p * vf[d];
            }
        }
    }
    const float il = 1.0f / l;
    if (moba) {
        float ss = 0.f;
#pragma unroll
        for (int d = 0; d < 64; ++d) { o[d] *= il; ss += o[d] * o[d]; }
        const float rs = rsqrtf(ss * (1.0f / 64.0f) + EPS);
        bf16* dst = mixed + trow * 1024 + hd * 64;
#pragma unroll
        for (int d = 0; d < 64; d += 2) *(unsigned*)(dst + d) = f2bf(o[d] * rs * gain_m[hd * 64 + d]) | (f2bf(o[d + 1] * rs * gain_m[hd * 64 + d + 1]) << 16);
    } else {
        bf16* dst = dob + trow * 1024 + h * 256 + m * 128 + c * 64;
#pragma unroll
        for (int d = 0; d < 64; d += 2) *(unsigned*)(dst + d) = f2bf(o[d] * il) | (f2bf(o[d + 1] * il) << 16);
    }
}
__global__ __launch_bounds__(256) void k_diff_combine(const bf16* __restrict__ dob, const float* __restrict__ scal, const float* __restrict__ gain_d, bf16* __restrict__ mixed) {
    const int lane = threadIdx.x & 63, nw = gridDim.x * 4; const float lam = scal[0];
    for (int w = blockIdx.x * 4 + (threadIdx.x >> 6); w < T * 4; w += nw) {
        const int t = w >> 2, h = w & 3; const bf16* p = dob + (size_t)t * 1024 + h * 256;
        const float da = bf2f(p[lane]) - lam * bf2f(p[128 + lane]), db = bf2f(p[64 + lane]) - lam * bf2f(p[192 + lane]);
        const float rs = rsqrtf(wave_sum(da * da + db * db) * (1.0f / 128.0f) + EPS) * 0.8f;
        bf16* o = mixed + (size_t)t * 1024 + 512 + h * 128;
        o[lane] = (bf16)f2bf(da * rs * gain_d[h * 128 + lane]); o[64 + lane] = (bf16)f2bf(db * rs * gain_d[h * 128 + 64 + lane]);
    }
}
__device__ __forceinline__ void wave_argmax(float& v, int& idx) {
#pragma unroll
    for (int o = 32; o >= 1; o >>= 1) { const float ov = __shfl_xor(v, o); const int oi = __shfl_xor(idx, o); if (ov > v || (ov == v && oi < idx)) { v = ov; idx = oi; } }
}
__global__ __launch_bounds__(256) void k_peer_route(const bf16* __restrict__ PQ, const bf16* __restrict__ subk, int* __restrict__ ids, float* __restrict__ gates) {
    __shared__ float ts[4][2][16]; __shared__ int ti[4][2][16];
    const int lane = threadIdx.x & 63, wv = threadIdx.x >> 6, nw = gridDim.x * 4;
    for (int w = blockIdx.x * 4 + wv; w < T * 8; w += nw) {
        const int t = w >> 3, h = w & 7; const bf16* q = PQ + (size_t)t * 2048 + h * 256;
        for (int p = 0; p < 2; ++p) {
            const bf16* k0 = subk + ((size_t)(h * 2 + p) * 128 + lane) * 128; const bf16* k1 = k0 + 64 * 128;
            float s0 = 0.f, s1 = 0.f;
            for (int d = 0; d < 128; d += 8) { const uint4 a = *(const uint4*)(k0 + d), bq = *(const uint4*)(k1 + d), qq = *(const uint4*)(q + p * 128 + d);
                const unsigned av[4] = {a.x, a.y, a.z, a.w}, bv[4] = {bq.x, bq.y, bq.z, bq.w}, qv[4] = {qq.x, qq.y, qq.z, qq.w};
#pragma unroll
                for (int e = 0; e < 4; ++e) { const float ql = __uint_as_float(qv[e] << 16), qh = __uint_as_float(qv[e] & 0xffff0000u);
                    s0 += ql * __uint_as_float(av[e] << 16) + qh * __uint_as_float(av[e] & 0xffff0000u);
                    s1 += ql * __uint_as_float(bv[e] << 16) + qh * __uint_as_float(bv[e] & 0xffff0000u); } }
            for (int r = 0; r < 16; ++r) { float v = s0; int idx = lane; if (s1 > v) { v = s1; idx = lane + 64; }
                wave_argmax(v, idx);
                if (lane == 0) { ts[wv][p][r] = v; ti[wv][p][r] = idx; }
                if (lane == (idx & 63)) { if (idx >= 64) s1 = -3.0e38f; else s0 = -3.0e38f; } }
        }
        __builtin_amdgcn_s_waitcnt(0xC07F); __builtin_amdgcn_wave_barrier();
        float cv[4];
#pragma unroll
        for (int e = 0; e < 4; ++e) { const int ci = lane * 4 + e; cv[e] = ts[wv][0][ci >> 4] + ts[wv][1][ci & 15]; }
        float bs[16]; int bidx = 0; float mysc = 0.f;
        for (int r = 0; r < 16; ++r) { float v = cv[0]; int idx = lane * 4;
#pragma unroll
            for (int e = 1; e < 4; ++e) if (cv[e] > v) { v = cv[e]; idx = lane * 4 + e; }
            wave_argmax(v, idx);
            if (lane == r) { mysc = v; bidx = idx; }
            if (lane == (idx >> 2)) {
#pragma unroll
                for (int e = 0; e < 4; ++e) if ((idx & 3) == e) cv[e] = -3.0e38f; } }
        (void)bs;
        const float top = __shfl(mysc, 0); float ex = lane < 16 ? expf(mysc - top) : 0.f;
        float sum = ex;
#pragma unroll
        for (int o = 1; o < 16; o <<= 1) sum += __shfl_xor(sum, o);
        if (lane < 16) { const int e = ti[wv][0][bidx >> 4] * 128 + ti[wv][1][bidx & 15];
            ids[(size_t)t * 128 + h * 16 + lane] = e; gates[(size_t)t * 128 + h * 16 + lane] = ex / sum; }
        __builtin_amdgcn_wave_barrier();
    }
}
__device__ __forceinline__ float dot8(const uint4 a, const uint4 b) {
    float s = 0.f; const unsigned av[4] = {a.x, a.y, a.z, a.w}, bv[4] = {b.x, b.y, b.z, b.w};
#pragma unroll
    for (int e = 0; e < 4; ++e) s += __uint_as_float(av[e] << 16) * __uint_as_float(bv[e] << 16) + __uint_as_float(av[e] & 0xffff0000u) * __uint_as_float(bv[e] & 0xffff0000u);
    return s;
}
__global__ __launch_bounds__(256) void k_peer_gather(const bf16* __restrict__ xn, const int* __restrict__ ids, const float* __restrict__ gates, const bf16* __restrict__ down, const bf16* __restrict__ up, float* __restrict__ out) {
    const int lane = threadIdx.x & 63, nw = gridDim.x * 4;
    for (int t = blockIdx.x * 4 + (threadIdx.x >> 6); t < T; t += nw) {
        const uint4 xa = *(const uint4*)(xn + (size_t)t * DM + lane * 8), xb = *(const uint4*)(xn + (size_t)t * DM + 512 + lane * 8);
        float acc[16];
#pragma unroll
        for (int i = 0; i < 16; ++i) acc[i] = 0.f;
        for (int e = 0; e < 128; ++e) {
            const int id = ids[(size_t)t * 128 + e]; const float gt = gates[(size_t)t * 128 + e];
            const bf16* dr = down + (size_t)id * DM; const bf16* ur = up + (size_t)id * DM;
            const uint4 da = *(const uint4*)(dr + lane * 8), db = *(const uint4*)(dr + 512 + lane * 8);
            const uint4 ua = *(const uint4*)(ur + lane * 8), ub = *(const uint4*)(ur + 512 + lane * 8);
            const float z = wave_sum(dot8(xa, da) + dot8(xb, db));
            const float w = gt * 0.5f * z * (1.0f + erff(z * 0.70710678118654752f));
            const unsigned uav[4] = {ua.x, ua.y, ua.z, ua.w}, ubv[4] = {ub.x, ub.y, ub.z, ub.w};
#pragma unroll
            for (int i = 0; i < 4; ++i) { acc[2 * i] += w * __uint_as_float(uav[i] << 16); acc[2 * i + 1] += w * __uint_as_float(uav[i] & 0xffff0000u);
                acc[8 + 2 * i] += w * __uint_as_float(ubv[i] << 16); acc[8 + 2 * i + 1] += w * __uint_as_float(ubv[i] & 0xffff0000u); }
        }
        float* o = out + (size_t)t * DM;
        float4 r0 = *(float4*)(o + lane * 8), r1 = *(float4*)(o + lane * 8 + 4), r2 = *(float4*)(o + 512 + lane * 8), r3 = *(float4*)(o + 512 + lane * 8 + 4);
        r0.x += acc[0]; r0.y += acc[1]; r0.z += acc[2]; r0.w += acc[3]; r1.x += acc[4]; r1.y += acc[5]; r1.z += acc[6]; r1.w += acc[7];
        r2.x += acc[8]; r2.y += acc[9]; r2.z += acc[10]; r2.w += acc[11]; r3.x += acc[12]; r3.y += acc[13]; r3.z += acc[14]; r3.w += acc[15];
        *(float4*)(o + lane * 8) = r0; *(float4*)(o + lane * 8 + 4) = r1; *(float4*)(o + 512 + lane * 8) = r2; *(float4*)(o + 512 + lane * 8 + 4) = r3;
    }
}
template <class Epi> __global__ __launch_bounds__(512, 2) void k_gemm(pg8::Gemm g, Epi E) {
    extern __shared__ __attribute__((aligned(16))) unsigned char lds[];
    pg8::StaticOrder S; S.init(g.M, g.N, (int)gridDim.x, (int)blockIdx.x);
    pg8::gemm_phase<Epi, pg8::StaticOrder, true, true>((PG8_LAS unsigned char*)lds, g, S, E);
}

extern "C" void kernel_launch(void* const* d_in, const int* in_sizes, int n_in, void* d_out, int out_size, void* d_ws, size_t ws_size, hipStream_t stream) {
    static int ready = 0;
    if (!ready) {
        if (n_in != 19 || in_sizes[0] != T * DM || out_size != T * DM || ws_size < WS_END) { fprintf(stderr, "kernel_launch: unexpected shapes (n_in %d in0 %d out %d ws %zu)\n", n_in, n_in > 0 ? in_sizes[0] : -1, out_size, ws_size); ready = -1; return; }
        hipFuncSetAttribute((const void*)k_gemm<pg8::EpiBf16>, hipFuncAttributeMaxDynamicSharedMemorySize, pg8::STAGE_BYTES);
        hipFuncSetAttribute((const void*)k_gemm<pg8::EpiResF32>, hipFuncAttributeMaxDynamicSharedMemorySize, pg8::STAGE_BYTES);
        ready = 1;
    }
    if (ready < 0) return;
    const float* x = (const float*)d_in[0]; const float* attn_norm = (const float*)d_in[1]; const float* w_in = (const float*)d_in[2];
    const float* gqm = (const float*)d_in[3]; const float* gkm = (const float*)d_in[4]; const float* gqd = (const float*)d_in[5]; const float* gkd = (const float*)d_in[6];
    const float* lq1 = (const float*)d_in[7]; const float* lk1 = (const float*)d_in[8]; const float* lq2 = (const float*)d_in[9]; const float* lk2 = (const float*)d_in[10];
    const float* gain_m = (const float*)d_in[11]; const float* gain_d = (const float*)d_in[12]; const float* w_out = (const float*)d_in[13]; const float* ffn_norm = (const float*)d_in[14];
    const float* wq = (const float*)d_in[15]; const float* subk = (const float*)d_in[16]; const float* down = (const float*)d_in[17]; const float* up = (const float*)d_in[18];
    unsigned char* ws = (unsigned char*)d_ws; float* out = (float*)d_out;
    bf16* WinT = (bf16*)(ws + WS_WIN); bf16* WoutT = (bf16*)(ws + WS_WOUT); bf16* WqT = (bf16*)(ws + WS_WQ); bf16* SUBK = (bf16*)(ws + WS_SUBK);
    bf16* DOWN = (bf16*)(ws + WS_DOWN); bf16* UP = (bf16*)(ws + WS_UP); bf16* XN = (bf16*)(ws + WS_XN); bf16* QKV = (bf16*)(ws + WS_QKV); bf16* PQ = (bf16*)(ws + WS_PQ);
    bf16* MIXED = (bf16*)(ws + WS_MIXED); bf16* DOB = (bf16*)(ws + WS_DO); int* IDS = (int*)(ws + WS_IDS); float* GATES = (float*)(ws + WS_GATES);
    float* ROPE = (float*)(ws + WS_ROPE); float* SCAL = (float*)(ws + WS_SCAL); float* KMEAN = (float*)(ws + WS_KMEAN);

    hipMemsetAsync(ws, 0, WS_ZERO_BYTES, stream);
    k_transpose_bf16<<<dim3(3072 / 32, 1024 / 32), 256, 0, stream>>>(w_in, 1024, 3072, WinT);
    k_transpose_bf16<<<dim3(1024 / 32, 1024 / 32), 256, 0, stream>>>(w_out, 1024, 1024, WoutT);
    k_transpose_bf16<<<dim3(2048 / 32, 1024 / 32), 256, 0, stream>>>(wq, 1024, 2048, WqT);
    k_convert_bf16<<<256, 256, 0, stream>>>(subk, SUBK, (size_t)16 * 128 * 128 / 4);
    k_convert_bf16<<<2048, 256, 0, stream>>>(down, DOWN, (size_t)16384 * 1024 / 4);
    k_convert_bf16<<<2048, 256, 0, stream>>>(up, UP, (size_t)16384 * 1024 / 4);
    k_rope<<<SEQ * 32 / 256, 256, 0, stream>>>(ROPE);
    k_scalars<<<1, 64, 0, stream>>>(lq1, lk1, lq2, lk2, SCAL);
    k_rmsnorm<<<2048, 256, 0, stream>>>(x, attn_norm, XN, T);
    { pg8::Gemm g{XN, WinT, T, 3072, 1024}; pg8::EpiBf16 E{QKV, 512, 512, QKV_ELEMS};
      k_gemm<pg8::EpiBf16><<<256, 512, pg8::STAGE_BYTES, stream>>>(g, E); }
    k_qk_post<<<2048, 256, 0, stream>>>(QKV, ROPE, gqm, gkm, gqd, gkd);
    k_kmean<<<NB * 8 * 8 / 4, 256, 0, stream>>>(QKV + QKV_ELEMS, KMEAN);
    k_attn_naive<<<NB * 24 * 8, 256, 0, stream>>>(QKV, KMEAN, gain_m, MIXED, DOB);
    k_diff_combine<<<2048, 256, 0, stream>>>(DOB, SCAL, gain_d, MIXED);
    { pg8::Gemm g{MIXED, WoutT, T, 1024, 1024}; pg8::EpiResF32 E{x, out, 1024};
      k_gemm<pg8::EpiResF32><<<256, 512, pg8::STAGE_BYTES, stream>>>(g, E); }
    k_rmsnorm<<<2048, 256, 0, stream>>>(out, ffn_norm, XN, T);
    { pg8::Gemm g{XN, WqT, T, 2048, 1024}; pg8::EpiBf16 E{PQ, 2048, 0, 0};
      k_gemm<pg8::EpiBf16><<<256, 512, pg8::STAGE_BYTES, stream>>>(g, E); }
    k_peer_route<<<4096, 256, 0, stream>>>(PQ, SUBK, IDS, GATES);
    k_peer_gather<<<4096, 256, 0, stream>>>(XN, IDS, GATES, DOWN, UP, out);
}
```

```cpp
#include <hip/hip_runtime.h>
#include <hip/hip_cooperative_groups.h>
#include <cstdio>
#include <cstdint>
namespace cg = cooperative_groups;
namespace pg8 {
#define PG8_LAS __attribute__((address_space(3)))
typedef unsigned short bf16_t;
typedef short bf16x8 __attribute__((ext_vector_type(8)));
typedef float f32x4 __attribute__((ext_vector_type(4)));
typedef unsigned u32x4 __attribute__((ext_vector_type(4)));
constexpr int BM = 256, BK = 64, HALF = 128, HTB = HALF * BK * 2  , STAGE_BYTES = 8 * HTB, NXCD = 8, WGM = 8;

__host__ __device__ __forceinline__ int lds_byte(int r, int c) { const int st = (r >> 4) * 2 + (c >> 5), rr = r & 15, cc = c & 31, ob = rr * 64 + cc * 2; return st * 1024 + (ob ^ (((ob >> 9) & 1) << 5)); }
__host__ __device__ __forceinline__ void stage_rc(int b, int& R, int& C) { const int st = b / 1024, sb = b % 1024, swz = sb ^ (((sb >> 9) & 1) << 5); R = (st >> 1) * 16 + swz / 64; C = (st & 1) * 32 + (swz % 64) / 2; }
__host__ __device__ __forceinline__ int perm32(int rho) { const int n = rho >> 4, i = rho & 15; return 8 * (i >> 2) + 4 * n + (i & 3); }

struct Unit { int pm, pn; };
struct Gemm { const bf16_t* A; const bf16_t* Bt; int M, N, K; };

struct StaticOrder {
    int nM, nN, nwg, G, c;
    __host__ __device__ void init(int M, int N, int G_, int c_) { nM = M / BM; nN = N / BM; nwg = nM * nN; G = G_; c = c_; }
    __host__ __device__ bool next(int i, Unit& u) const {
        const long L = (long)i * G + c; if (L >= nwg) return false;
        int wgid = (int)L; { const int q = nwg / NXCD, r = nwg % NXCD, xcd = wgid % NXCD, off = wgid / NXCD; wgid = (xcd < r ? xcd * (q + 1) : r * (q + 1) + (xcd - r) * q) + off; }
        const int nig = WGM * nN, gid = wgid / nig, fm = gid * WGM, gsz = (nM - fm) < WGM ? (nM - fm) : WGM;
        u.pm = fm + ((wgid % nig) % gsz); u.pn = (wgid % nig) / gsz; return true;
    }
    __device__ __forceinline__ void a_ready(const Unit&) const {}
    __device__ __forceinline__ void done(const Unit&) const {}
};

__device__ __forceinline__ unsigned cvt_pk_bf16(float lo, float hi) { unsigned r; asm volatile("v_cvt_pk_bf16_f32 %0, %1, %2" : "=v"(r) : "v"(lo), "v"(hi)); return r; }
struct EpiBf16 {
    static constexpr bool PERM = true, AFTER_DRAIN = false;
    bf16_t* O; int ldc; int split_cols; size_t split_stride;
    __device__ __forceinline__ void operator()(const f32x4 (&acc)[2][2][4][2], const Unit& u, int wr, int wc, int fr, int fq) const {
        const int row0 = u.pm * BM + wr * 64 + fr; int colt = u.pn * BM; bf16_t* base = O;
        if (split_cols) { const int t = colt / split_cols; base += (size_t)t * split_stride; colt -= t * split_cols; }
        const int col0 = colt + wc * 32 + 8 * fq;
#pragma unroll
        for (int ai = 0; ai < 2; ++ai)
#pragma unroll
            for (int m = 0; m < 4; ++m) { bf16_t* rowp = base + (size_t)(row0 + ai * HALF + m * 16) * ldc + col0;
#pragma unroll
                for (int bj = 0; bj < 2; ++bj) { const f32x4 v0 = acc[ai][bj][m][0], v1 = acc[ai][bj][m][1];
                    u32x4 w; w.x = cvt_pk_bf16(v0[0], v0[1]); w.y = cvt_pk_bf16(v0[2], v0[3]); w.z = cvt_pk_bf16(v1[0], v1[1]); w.w = cvt_pk_bf16(v1[2], v1[3]);
                    *(u32x4*)(rowp + bj * HALF) = w; } }
    }
};
struct EpiResF32 {
    static constexpr bool PERM = false, AFTER_DRAIN = false;
    const float* base; float* out; int ldc;
    __device__ __forceinline__ void operator()(const f32x4 (&acc)[2][2][4][2], const Unit& u, int wr, int wc, int fr, int fq) const {
        const int col0 = u.pn * BM + wc * 32 + 4 * fq;
#pragma unroll
        for (int ai = 0; ai < 2; ++ai)
#pragma unroll
            for (int m = 0; m < 4; ++m) { const size_t off = (size_t)(u.pm * BM + ai * HALF + wr * 64 + m * 16 + fr) * ldc + col0;
#pragma unroll
                for (int bj = 0; bj < 2; ++bj)
#pragma unroll
                    for (int n = 0; n < 2; ++n) { const f32x4 bs = *(const f32x4*)(base + off + bj * HALF + n * 16); *(f32x4*)(out + off + bj * HALF + n * 16) = bs + acc[ai][bj][m][n]; } }
    }
};
template <class Epi, class Sched, bool ALIGN_EPI = false, bool SP2 = false>
__device__ __forceinline__ void gemm_phase(PG8_LAS unsigned char* lds, const Gemm g, const Sched& S, const Epi& E) {
    const int tid = threadIdx.x, wid = __builtin_amdgcn_readfirstlane(tid >> 6), lane = tid & 63, wr = wid >> 2, wc = wid & 3, fr = lane & 15, fq = lane >> 4;
    const int K = g.K, nt = K / BK;
    unsigned voffA[2], voffB[2];
#pragma unroll
    for (int i = 0; i < 2; ++i) { int R, C; stage_rc(tid * 16 + i * 8192, R, C); const int Rb = Epi::PERM ? ((R & ~31) + perm32(R & 31)) : R;
        voffA[i] = (unsigned)(R * K + C) * 2u; voffB[i] = (unsigned)(Rb * K + C) * 2u; }
    const size_t kstep = (size_t)(BK * 2);
    const size_t hstep = (size_t)HALF * K * 2;
    const size_t tstep = 2 * hstep;
    const unsigned ldsw = (unsigned)wid * 1024u;
    const int aoff = lds_byte(wr * 64 + fr, fq * 8), boff = lds_byte(wc * 32 + fr, fq * 8);
#define PG8_SA(b, h) (((b) * 2 + (h)) * HTB)
#define PG8_SB(b, h) ((4 + (b) * 2 + (h)) * HTB)
#define PG8_STAGE(bufoff, gbase, voff) do { _Pragma("unroll") for (int _i = 0; _i < 2; ++_i) \
        __builtin_amdgcn_global_load_lds((const unsigned*)((const char*)(gbase) + (voff)[_i]), (PG8_LAS unsigned*)(lds + (bufoff) + ldsw + _i * 8192), 16, 0, 0); } while (0)
#define PG8_LDA(dst, b, h) do { _Pragma("unroll") for (int m = 0; m < 4; ++m) _Pragma("unroll") for (int k = 0; k < 2; ++k) dst[m][k] = *(const PG8_LAS bf16x8*)(lds + PG8_SA(b, h) + aoff + m * 2048 + k * 1024); } while (0)
#define PG8_LDB(dst, b, h) do { _Pragma("unroll") for (int n = 0; n < 2; ++n) _Pragma("unroll") for (int k = 0; k < 2; ++k) dst[n][k] = *(const PG8_LAS bf16x8*)(lds + PG8_SB(b, h) + boff + n * 2048 + k * 1024); } while (0)
#define PG8_MMA(ai, bj, At, Bt) do { __builtin_amdgcn_s_setprio(1); _Pragma("unroll") for (int m = 0; m < 4; ++m) _Pragma("unroll") for (int n = 0; n < 2; ++n) _Pragma("unroll") for (int k = 0; k < 2; ++k) \
        acc[ai][bj][m][n] = __builtin_amdgcn_mfma_f32_16x16x32_bf16(Bt[n][k], At[m][k], acc[ai][bj][m][n], 0, 0, 0); __builtin_amdgcn_s_setprio(0); } while (0)
#define PG8_WAIT_V(n) asm volatile("s_waitcnt vmcnt(" #n ")" ::: "memory")
#define PG8_WAIT_L(n) asm volatile("s_waitcnt lgkmcnt(" #n ")" ::: "memory")
#define PG8_BAR __builtin_amdgcn_s_barrier()
#define PG8_SCHED __builtin_amdgcn_sched_barrier(0)
    Unit cur, nxt; int ui = 0;
    if (!S.next(0, cur)) return;
    f32x4 acc[2][2][4][2];
#pragma unroll
    for (int a = 0; a < 2; ++a)
#pragma unroll
        for (int b = 0; b < 2; ++b)
#pragma unroll
            for (int m = 0; m < 4; ++m)
#pragma unroll
                for (int n = 0; n < 2; ++n) acc[a][b][m][n] = (f32x4){0.f, 0.f, 0.f, 0.f};
    bf16x8 At[4][2], B0[2][2], B1[2][2];
    const char* cA = (const char*)g.A + (size_t)cur.pm * tstep; const char* cB = (const char*)g.Bt + (size_t)cur.pn * tstep;
    S.a_ready(cur);
    if constexpr (SP2) {
        PG8_STAGE(PG8_SB(0, 0), cB, voffB); PG8_STAGE(PG8_SB(0, 1), cB + hstep, voffB); PG8_STAGE(PG8_SA(0, 0), cA, voffA); PG8_STAGE(PG8_SA(0, 1), cA + hstep, voffA);
        if (wr == 1) PG8_BAR;
        PG8_WAIT_V(2); PG8_BAR;
        PG8_STAGE(PG8_SB(1, 0), cB + kstep, voffB); PG8_STAGE(PG8_SA(1, 0), cA + kstep, voffA); PG8_STAGE(PG8_SB(1, 1), cB + hstep + kstep, voffB);
        PG8_WAIT_V(6); PG8_BAR;
    } else {
        PG8_STAGE(PG8_SB(0, 0), cB, voffB); PG8_STAGE(PG8_SA(0, 0), cA, voffA); PG8_STAGE(PG8_SB(0, 1), cB + hstep, voffB); PG8_STAGE(PG8_SA(0, 1), cA + hstep, voffA);
        if (wr == 1) PG8_BAR;
        PG8_WAIT_V(4); PG8_BAR;
        PG8_STAGE(PG8_SB(1, 0), cB + kstep, voffB); PG8_STAGE(PG8_SA(1, 0), cA + kstep, voffA); PG8_STAGE(PG8_SB(1, 1), cB + hstep + kstep, voffB);
        PG8_WAIT_V(6); PG8_BAR;
    }
    for (;;) {
        const bool has_next = S.next(ui + 1, nxt);
        const char* nA = has_next ? (const char*)g.A + (size_t)nxt.pm * tstep : cA; const char* nB = has_next ? (const char*)g.Bt + (size_t)nxt.pn * tstep : cB;
        for (int t = 0; t < nt; t += 2) {
            const bool last = (t == nt - 2);
            const char* a1 = cA + (size_t)(t + 1) * kstep;
            const char* a2 = last ? nA : cA + (size_t)(t + 2) * kstep; const char* b2 = last ? nB : cB + (size_t)(t + 2) * kstep;
            const char* a3 = a2 + kstep; const char* b3 = b2 + kstep;
            if (last && has_next) S.a_ready(nxt);
            if constexpr (SP2) {
            PG8_LDB(B0, 0, 0); PG8_LDB(B1, 0, 1); PG8_SCHED; PG8_LDA(At, 0, 0); PG8_STAGE(PG8_SA(1, 1), a1 + hstep, voffA);
            PG8_WAIT_V(8); PG8_WAIT_L(0); PG8_BAR; PG8_MMA(0, 0, At, B0); PG8_MMA(0, 1, At, B1); PG8_BAR; PG8_SCHED;
            PG8_LDA(At, 0, 1); PG8_STAGE(PG8_SB(0, 0), b2, voffB); PG8_STAGE(PG8_SB(0, 1), b2 + hstep, voffB); PG8_STAGE(PG8_SA(0, 0), a2, voffA);
            PG8_WAIT_V(8); PG8_WAIT_L(0); PG8_BAR; PG8_MMA(1, 0, At, B0); PG8_MMA(1, 1, At, B1); PG8_BAR; PG8_SCHED;
            PG8_LDB(B0, 1, 0); PG8_LDB(B1, 1, 1); PG8_SCHED; PG8_LDA(At, 1, 0); PG8_STAGE(PG8_SA(0, 1), a2 + hstep, voffA);
            PG8_WAIT_V(8); PG8_WAIT_L(0); PG8_BAR; PG8_MMA(0, 0, At, B0); PG8_MMA(0, 1, At, B1); PG8_BAR; PG8_SCHED;
            PG8_LDA(At, 1, 1); PG8_STAGE(PG8_SB(1, 0), b3, voffB); PG8_STAGE(PG8_SB(1, 1), b3 + hstep, voffB); PG8_STAGE(PG8_SA(1, 0), a3, voffA);
            PG8_WAIT_V(8); PG8_WAIT_L(0); PG8_BAR; PG8_MMA(1, 0, At, B0); PG8_MMA(1, 1, At, B1); PG8_BAR; PG8_SCHED;
            } else {
            PG8_LDB(B0, 0, 0); PG8_SCHED; PG8_LDA(At, 0, 0); PG8_STAGE(PG8_SA(1, 1), a1 + hstep, voffA);
            PG8_WAIT_L(8); PG8_BAR; PG8_WAIT_L(0); PG8_MMA(0, 0, At, B0); PG8_BAR; PG8_SCHED;
            PG8_LDB(B1, 0, 1); PG8_STAGE(PG8_SB(0, 0), b2, voffB);
            PG8_BAR; PG8_WAIT_L(0); PG8_MMA(0, 1, At, B1); PG8_BAR;
            PG8_LDA(At, 0, 1); PG8_STAGE(PG8_SA(0, 0), a2, voffA);
            PG8_BAR; PG8_WAIT_L(0); PG8_MMA(1, 0, At, B0); PG8_BAR; PG8_SCHED;
            PG8_STAGE(PG8_SB(0, 1), b2 + hstep, voffB);
            PG8_WAIT_V(6); PG8_BAR; PG8_MMA(1, 1, At, B1); PG8_BAR;
            PG8_LDB(B0, 1, 0); PG8_SCHED; PG8_LDA(At, 1, 0); PG8_STAGE(PG8_SA(0, 1), a2 + hstep, voffA);
            PG8_WAIT_L(8); PG8_BAR; PG8_WAIT_L(0); PG8_MMA(0, 0, At, B0); PG8_BAR; PG8_SCHED;
            PG8_LDB(B1, 1, 1); PG8_STAGE(PG8_SB(1, 0), b3, voffB);
            PG8_BAR; PG8_WAIT_L(0); PG8_MMA(0, 1, At, B1); PG8_BAR;
            PG8_LDA(At, 1, 1); PG8_STAGE(PG8_SA(1, 0), a3, voffA);
            PG8_BAR; PG8_WAIT_L(0); PG8_MMA(1, 0, At, B0); PG8_BAR; PG8_SCHED;
            PG8_STAGE(PG8_SB(1, 1), b3 + hstep, voffB);
            PG8_WAIT_V(6); PG8_BAR; PG8_MMA(1, 1, At, B1); PG8_BAR;
            }
        }
        if constexpr (ALIGN_EPI) { if (wr == 0) PG8_BAR; }
        if constexpr (!Epi::AFTER_DRAIN) { E(acc, cur, wr, wc, fr, fq); S.done(cur); }
        if (!has_next) break;
#pragma unroll
        for (int a = 0; a < 2; ++a)
#pragma unroll
            for (int b = 0; b < 2; ++b)
#pragma unroll
                for (int m = 0; m < 4; ++m)
#pragma unroll
                    for (int n = 0; n < 2; ++n) acc[a][b][m][n] = (f32x4){0.f, 0.f, 0.f, 0.f};
        cur = nxt; cA = nA; cB = nB; ++ui;
        if constexpr (ALIGN_EPI) { if (wr == 1) PG8_BAR; }
    }
    PG8_WAIT_V(0);
    if constexpr (!ALIGN_EPI) { if (wr == 0) PG8_BAR; }
    PG8_BAR;
    if constexpr (Epi::AFTER_DRAIN) { E.fused(acc, cur, wr, wc, fr, fq, lds, wid, lane); S.done(cur); }
#undef PG8_SA
#undef PG8_SB
#undef PG8_STAGE
#undef PG8_LDA
#undef PG8_LDB
#undef PG8_MMA
#undef PG8_WAIT_V
#undef PG8_WAIT_L
#undef PG8_BAR
#undef PG8_SCHED
}
}
typedef unsigned short bf16;
constexpr int T = 65536, DM = 1024, SEQ = 2048, NB = 32;
constexpr size_t MiB = 1u << 20;
constexpr size_t WS_CTL = 0, WS_KMEAN = 1 * MiB, WS_ZERO_BYTES = 2 * MiB;
constexpr size_t WS_ROPE = 2 * MiB, WS_SCAL = 3 * MiB;
constexpr size_t WS_WIN = 4 * MiB, WS_WOUT = 10 * MiB, WS_WQ = 12 * MiB, WS_SUBK = 16 * MiB;
constexpr size_t WS_DOWN = 32 * MiB, WS_UP = 64 * MiB, WS_XN = 96 * MiB;
constexpr size_t WS_QKV = 224 * MiB, QKV_STRIDE = 64 * MiB;
constexpr size_t WS_PQ = 224 * MiB;
constexpr size_t WS_MIXED = 608 * MiB, WS_DO = 736 * MiB, WS_IDS = 864 * MiB, WS_GATES = 896 * MiB, WS_END = 928 * MiB;
constexpr size_t QKV_ELEMS = QKV_STRIDE / 2;
constexpr float QSCALE = 0.125f * 1.4426950408889634f;
constexpr float EPS = 1e-6f;

__device__ __forceinline__ unsigned f2bf(float f) { unsigned u = __float_as_uint(f); return (u + 0x7fffu + ((u >> 16) & 1u)) >> 16; }
__device__ __forceinline__ float bf2f(unsigned h) { return __uint_as_float(h << 16); }
__device__ __forceinline__ float wave_sum(float v) {
#pragma unroll
    for (int o = 1; o < 64; o <<= 1) v += __shfl_xor(v, o);
    return v;
}

__device__ __forceinline__ void load64(const bf16* p, float (&f)[64]) {
    const uint4* p4 = (const uint4*)p;
#pragma unroll
    for (int i = 0; i < 8; ++i) { const uint4 u = p4[i];
        f[8 * i + 0] = __uint_as_float(u.x << 16); f[8 * i + 1] = __uint_as_float(u.x & 0xffff0000u); f[8 * i + 2] = __uint_as_float(u.y << 16); f[8 * i + 3] = __uint_as_float(u.y & 0xffff0000u);
        f[8 * i + 4] = __uint_as_float(u.z << 16); f[8 * i + 5] = __uint_as_float(u.z & 0xffff0000u); f[8 * i + 6] = __uint_as_float(u.w << 16); f[8 * i + 7] = __uint_as_float(u.w & 0xffff0000u); }
}
#define LAS __attribute__((address_space(3)))
constexpr int NTHR = 512, NWAVE = 8;
constexpr int LDS_BYTES = 147456;

struct Params {
    const float* in[19]; float* out; unsigned char* ws;
};

__device__ __forceinline__ void ph_transpose(const float* __restrict__ W, int K, int N, bf16* __restrict__ WT, float* tiles, int wg, int nwg, int tid) {
    float (*tile)[33] = (float (*)[33])(tiles + (tid >> 8) * (32 * 33));
    const int nt_n = N / 32, nitems = nt_n * (K / 32), tx = tid & 31, ty = (tid & 255) >> 5;
    for (int it0 = wg * 2; it0 < nitems; it0 += nwg * 2) {
        const int it = it0 + (tid >> 8); const bool act = it < nitems;
        const int n0 = (it % nt_n) * 32, k0 = (it / nt_n) * 32;
        if (act) for (int i = ty; i < 32; i += 8) tile[i][tx] = W[(size_t)(k0 + i) * N + n0 + tx];
        __syncthreads();
        if (act) for (int i = ty; i < 32; i += 8) WT[(size_t)(n0 + i) * K + k0 + tx] = (bf16)f2bf(tile[tx][i]);
        __syncthreads();
    }
}
__device__ __forceinline__ void ph_convert(const float* __restrict__ src, bf16* __restrict__ dst, size_t n4, int wg, int nwg, int tid) {
    for (size_t i = (size_t)wg * NTHR + tid; i < n4; i += (size_t)nwg * NTHR) {
        const float4 v = ((const float4*)src)[i];
        uint2 o; o.x = f2bf(v.x) | (f2bf(v.y) << 16); o.y = f2bf(v.z) | (f2bf(v.w) << 16);
        ((uint2*)dst)[i] = o;
    }
}
__device__ __forceinline__ void ph_rope(float* __restrict__ rope, int wg, int nwg, int tid) {
    for (int i = wg * NTHR + tid; i < SEQ * 32; i += nwg * NTHR) {
        const int pos = i >> 5, j = i & 31;
        const float inv = 1.0f / exp2f((float)j * (13.287712379549449f / 32.0f));
        const float ang = (float)pos * inv;
        double rev = (double)ang * 0.15915494309189535; rev -= floor(rev);
        rope[i] = __builtin_amdgcn_cosf((float)rev); rope[SEQ * 32 + i] = __builtin_amdgcn_sinf((float)rev);
    }
}
__device__ __forceinline__ void ph_rmsnorm(const float* __restrict__ x, const float* __restrict__ g, bf16* __restrict__ out, int rows, int wg, int nwg, int tid) {
    const int lane = tid & 63, nw = nwg * NWAVE;
    for (int r = wg * NWAVE + (tid >> 6); r < rows; r += nw) {
        const float4* xr = (const float4*)(x + (size_t)r * DM) + lane;
        float4 v[4]; float s = 0.f;
#pragma unroll
        for (int j = 0; j < 4; ++j) { v[j] = xr[64 * j]; s += (v[j].x * v[j].x + v[j].y * v[j].y) + (v[j].z * v[j].z + v[j].w * v[j].w); }
        const float rs = rsqrtf(wave_sum(s) * (1.0f / DM) + EPS);
        uint2* o = (uint2*)(out + (size_t)r * DM) + lane;
#pragma unroll
        for (int j = 0; j < 4; ++j) { const float4 gg = ((const float4*)g)[lane + 64 * j];
            uint2 w; w.x = f2bf(v[j].x * rs * gg.x) | (f2bf(v[j].y * rs * gg.y) << 16); w.y = f2bf(v[j].z * rs * gg.z) | (f2bf(v[j].w * rs * gg.w) << 16);
            o[64 * j] = w; }
    }
}
__device__ __forceinline__ void ph_qk_post(bf16* __restrict__ qkv, const float* __restrict__ rope, const float* __restrict__ gqm, const float* __restrict__ gkm,
                                           const float* __restrict__ gqd, const float* __restrict__ gkd, float* __restrict__ kmean, int wg, int nwg, int tid) {
    const int lane = tid & 63, half = lane >> 5, j = lane & 31, wv = tid >> 6;
    for (int blk = wg; blk < T / 256; blk += nwg) {
        float ks[4][2];
#pragma unroll
        for (int a = 0; a < 4; ++a) { ks[a][0] = 0.f; ks[a][1] = 0.f; }
        for (int tt = wv; tt < 256; tt += NWAVE) {
            const int t = blk * 256 + tt, pos = t & (SEQ - 1);
            const float c = rope[pos * 32 + j], sn = rope[SEQ * 32 + pos * 32 + j];
#pragma unroll
            for (int it = 0; it < 16; ++it) {
                const int s = it * 2 + half, type = it >> 2, hs = s & 7;
                bf16* buf = qkv + (size_t)(type < 2 ? type : type + 1) * QKV_ELEMS + (size_t)t * 512 + hs * 64;
                const float x1 = bf2f(buf[j]), x2 = bf2f(buf[j + 32]);
                float ss = x1 * x1 + x2 * x2;
#pragma unroll
                for (int o = 1; o < 32; o <<= 1) ss += __shfl_xor(ss, o);
                const float rs = rsqrtf(ss * (1.0f / 64.0f) + EPS);
                const float* g = type == 0 ? gqm : type == 1 ? gkm : type == 2 ? gqd + (hs & 1) * 64 : gkd + (hs & 1) * 64;
                const float y1 = x1 * rs * g[j], y2 = x2 * rs * g[j + 32];
                float o1 = y1 * c - y2 * sn, o2 = y2 * c + y1 * sn;
                if (type == 0 || type == 2) { o1 *= QSCALE; o2 *= QSCALE; }
                if (type == 1) { ks[it - 4][0] += o1; ks[it - 4][1] += o2; }
                buf[j] = (bf16)f2bf(o1); buf[j + 32] = (bf16)f2bf(o2);
            }
        }
        const int b = blk >> 3, nb = blk & 7;
#pragma unroll
        for (int a = 0; a < 4; ++a) { const int h = a * 2 + half; float* km = kmean + (((size_t)b * 8 + h) * 8 + nb) * 64;
            atomicAdd(km + j, ks[a][0] * (1.0f / 256.0f)); atomicAdd(km + j + 32, ks[a][1] * (1.0f / 256.0f)); }
    }
}
__device__ __forceinline__ void ph_attn_naive(const bf16* __restrict__ qkv, const float* __restrict__ kmean, const float* __restrict__ gain_m, bf16* __restrict__ mixed, bf16* __restrict__ dob, int wg, int nwg, int tid) {
    const int NU = NB * 24 * 8;
    int iter = 0;
    for (int u0 = wg * 2; u0 < NU; u0 += nwg * 2, ++iter) {
        const int u = u0 + (tid >> 8); if (u >= NU) continue;
        const int qb = ((u & 7) + iter) & 7, hd = (u >> 3) % 24, b = u / (8 * 24);
        const int q = qb * 256 + (tid & 255); const size_t trow = (size_t)b * SEQ + q, brow = (size_t)b * SEQ;
        const bool moba = hd < 8; const bf16 *Qp, *Kp, *Vp; int h = hd, m = 0, c = 0;
        if (moba) { Qp = qkv + trow * 512 + hd * 64; Kp = qkv + QKV_ELEMS + brow * 512 + hd * 64; Vp = qkv + 2 * QKV_ELEMS + brow * 512 + hd * 64; }
        else { const int jj = hd - 8; h = jj >> 2; m = (jj >> 1) & 1; c = jj & 1;
            Qp = qkv + 3 * QKV_ELEMS + trow * 512 + h * 128 + m * 64; Kp = qkv + 4 * QKV_ELEMS + brow * 512 + h * 128 + m * 64; Vp = qkv + 5 * QKV_ELEMS + brow * 512 + h * 128 + c * 64; }
        float qf[64]; load64(Qp, qf);
        unsigned sel = 0;
        if (moba) {
            float g[8];
#pragma unroll
            for (int n = 0; n < 8; ++n) { float s = 0.f; const float* km = kmean + (((size_t)b * 8 + hd) * 8 + n) * 64;
#pragma unroll
                for (int d = 0; d < 64; ++d) s += qf[d] * km[d];
                g[n] = s; }
#pragma unroll
            for (int r = 0; r < 3; ++r) { float best = -3.0e38f; int bi = -1;
#pragma unroll
                for (int n = 0; n < 8; ++n) if (n < qb && !((sel >> n) & 1u) && g[n] > best) { best = g[n]; bi = n; }
                if (bi >= 0) sel |= 1u << bi; }
        }
        float ss = 0.f;
        for (int dh = 0; dh < 2; ++dh) {
            float mx = -3.0e38f, l = 0.f; float o[32];
#pragma unroll
            for (int d = 0; d < 32; ++d) o[d] = 0.f;
            for (int kb = 0; kb <= qb; ++kb) {
                const bool on = !moba || kb == qb || ((sel >> kb) & 1u);
                if (!__any(on)) continue;
                for (int kk = 0; kk < 256; ++kk) {
                    const int key = kb * 256 + kk;
                    float s = 0.f;
                    { float kf[64]; load64(Kp + (size_t)key * 512, kf);
#pragma unroll
                      for (int d = 0; d < 64; ++d) s += qf[d] * kf[d]; }
                    if (on && key <= q) {
                        if (s > mx) { const float f = exp2f(mx - s); l *= f;
#pragma unroll
                            for (int d = 0; d < 32; ++d) o[d] *= f;
                            mx = s; }
                        const float p = exp2f(s - mx); l += p;
                        const uint4* v4 = (const uint4*)(Vp + (size_t)key * 512 + dh * 32);
#pragma unroll
                        for (int i = 0; i < 4; ++i) { const uint4 uu = v4[i]; const unsigned uv[4] = {uu.x, uu.y, uu.z, uu.w};
#pragma unroll
                            for (int e = 0; e < 4; ++e) { o[8 * i + 2 * e] += p * __uint_as_float(uv[e] << 16); o[8 * i + 2 * e + 1] += p * __uint_as_float(uv[e] & 0xffff0000u); } }
                    }
                }
            }
            const float il = 1.0f / l;
            bf16* dst = moba ? mixed + trow * 1024 + hd * 64 + dh * 32 : dob + trow * 1024 + h * 256 + m * 128 + c * 64 + dh * 32;
#pragma unroll
            for (int d = 0; d < 32; ++d) { o[d] *= il; ss += o[d] * o[d]; }
            if (moba && dh == 1) {
                const float rs = rsqrtf(ss * (1.0f / 64.0f) + EPS);
#pragma unroll
                for (int d = 0; d < 32; d += 2) *(unsigned*)(dst + d) = f2bf(o[d] * rs * gain_m[hd * 64 + 32 + d]) | (f2bf(o[d + 1] * rs * gain_m[hd * 64 + 32 + d + 1]) << 16);
                bf16* d0 = dst - 32;
#pragma unroll
                for (int d = 0; d < 32; d += 2) { const unsigned w = *(volatile unsigned*)(d0 + d); const float a0 = __uint_as_float(w << 16), a1 = __uint_as_float(w & 0xffff0000u);
                    *(volatile unsigned*)(d0 + d) = f2bf(a0 * rs * gain_m[hd * 64 + d]) | (f2bf(a1 * rs * gain_m[hd * 64 + d + 1]) << 16); }
            } else {
#pragma unroll
                for (int d = 0; d < 32; d += 2) *(volatile unsigned*)(dst + d) = f2bf(o[d]) | (f2bf(o[d + 1]) << 16);
            }
        }
    }
}
__device__ __forceinline__ void ph_diff_combine(const bf16* __restrict__ dob, float lam, const float* __restrict__ gain_d, bf16* __restrict__ mixed, int wg, int nwg, int tid) {
    const int lane = tid & 63, nw = nwg * NWAVE;
    for (int w = wg * NWAVE + (tid >> 6); w < T * 4; w += nw) {
        const int t = w >> 2, h = w & 3; const bf16* p = dob + (size_t)t * 1024 + h * 256;
        const float da = bf2f(p[lane]) - lam * bf2f(p[128 + lane]), db = bf2f(p[64 + lane]) - lam * bf2f(p[192 + lane]);
        const float rs = rsqrtf(wave_sum(da * da + db * db) * (1.0f / 128.0f) + EPS) * 0.8f;
        bf16* o = mixed + (size_t)t * 1024 + 512 + h * 128;
        o[lane] = (bf16)f2bf(da * rs * gain_d[h * 128 + lane]); o[64 + lane] = (bf16)f2bf(db * rs * gain_d[h * 128 + 64 + lane]);
    }
}
__device__ __forceinline__ void wave_argmax(float& v, int& idx) {
#pragma unroll
    for (int o = 32; o >= 1; o >>= 1) { const float ov = __shfl_xor(v, o); const int oi = __shfl_xor(idx, o); if (ov > v || (ov == v && oi < idx)) { v = ov; idx = oi; } }
}
__device__ __forceinline__ void ph_peer_route(const bf16* __restrict__ PQ, const bf16* __restrict__ subk, int* __restrict__ ids, float* __restrict__ gates, float* ldsf, int wg, int nwg, int tid) {
    const int lane = tid & 63, wv = tid >> 6, nw = nwg * NWAVE;
    float* ts = ldsf + wv * 64; int* ti = (int*)(ldsf + wv * 64 + 32);
    for (int w = wg * NWAVE + wv; w < T * 8; w += nw) {
        const int t = w >> 3, h = w & 7; const bf16* q = PQ + (size_t)t * 2048 + h * 256;
        for (int p = 0; p < 2; ++p) {
            const bf16* k0 = subk + ((size_t)(h * 2 + p) * 128 + lane) * 128; const bf16* k1 = k0 + 64 * 128;
            float s0 = 0.f, s1 = 0.f;
            for (int d = 0; d < 128; d += 8) { const uint4 a = *(const uint4*)(k0 + d), bq = *(const uint4*)(k1 + d), qq = *(const uint4*)(q + p * 128 + d);
                const unsigned av[4] = {a.x, a.y, a.z, a.w}, bv[4] = {bq.x, bq.y, bq.z, bq.w}, qv[4] = {qq.x, qq.y, qq.z, qq.w};
#pragma unroll
                for (int e = 0; e < 4; ++e) { const float ql = __uint_as_float(qv[e] << 16), qh = __uint_as_float(qv[e] & 0xffff0000u);
                    s0 += ql * __uint_as_float(av[e] << 16) + qh * __uint_as_float(av[e] & 0xffff0000u);
                    s1 += ql * __uint_as_float(bv[e] << 16) + qh * __uint_as_float(bv[e] & 0xffff0000u); } }
            for (int r = 0; r < 16; ++r) { float v = s0; int idx = lane; if (s1 > v) { v = s1; idx = lane + 64; }
                wave_argmax(v, idx);
                if (lane == 0) { ts[p * 16 + r] = v; ti[p * 16 + r] = idx; }
                if (lane == (idx & 63)) { if (idx >= 64) s1 = -3.0e38f; else s0 = -3.0e38f; } }
        }
        __builtin_amdgcn_s_waitcnt(0xC07F); __builtin_amdgcn_wave_barrier();
        float cv[4];
#pragma unroll
        for (int e = 0; e < 4; ++e) { const int ci = lane * 4 + e; cv[e] = ts[ci >> 4] + ts[16 + (ci & 15)]; }
        int bidx = 0; float mysc = 0.f;
        for (int r = 0; r < 16; ++r) { float v = cv[0]; int idx = lane * 4;
#pragma unroll
            for (int e = 1; e < 4; ++e) if (cv[e] > v) { v = cv[e]; idx = lane * 4 + e; }
            wave_argmax(v, idx);
            if (lane == r) { mysc = v; bidx = idx; }
            if (lane == (idx >> 2)) {
#pragma unroll
                for (int e = 0; e < 4; ++e) if ((idx & 3) == e) cv[e] = -3.0e38f; } }
        const float top = __shfl(mysc, 0); const float ex = lane < 16 ? expf(mysc - top) : 0.f;
        float sum = ex;
#pragma unroll
        for (int o = 1; o < 16; o <<= 1) sum += __shfl_xor(sum, o);
        if (lane < 16) { const int e = ti[bidx >> 4] * 128 + ti[16 + (bidx & 15)];
            ids[(size_t)t * 128 + h * 16 + lane] = e; gates[(size_t)t * 128 + h * 16 + lane] = ex / sum; }
        __builtin_amdgcn_s_waitcnt(0xC07F); __builtin_amdgcn_wave_barrier();
    }
}
__device__ __forceinline__ float dot8(const uint4 a, const uint4 b) {
    float s = 0.f; const unsigned av[4] = {a.x, a.y, a.z, a.w}, bv[4] = {b.x, b.y, b.z, b.w};
#pragma unroll
    for (int e = 0; e < 4; ++e) s += __uint_as_float(av[e] << 16) * __uint_as_float(bv[e] << 16) + __uint_as_float(av[e] & 0xffff0000u) * __uint_as_float(bv[e] & 0xffff0000u);
    return s;
}
__device__ __forceinline__ void ph_peer_gather(const bf16* __restrict__ xn, const int* __restrict__ ids, const float* __restrict__ gates, const bf16* __restrict__ down, const bf16* __restrict__ up, float* __restrict__ out, int wg, int nwg, int tid) {
    const int lane = tid & 63, nw = nwg * NWAVE;
    for (int t = wg * NWAVE + (tid >> 6); t < T; t += nw) {
        const uint4 xa = *(const uint4*)(xn + (size_t)t * DM + lane * 8), xb = *(const uint4*)(xn + (size_t)t * DM + 512 + lane * 8);
        float acc[16];
#pragma unroll
        for (int i = 0; i < 16; ++i) acc[i] = 0.f;
        for (int e = 0; e < 128; ++e) {
            const int id = ids[(size_t)t * 128 + e]; const float gt = gates[(size_t)t * 128 + e];
            const bf16* dr = down + (size_t)id * DM; const bf16* ur = up + (size_t)id * DM;
            const uint4 da = *(const uint4*)(dr + lane * 8), db = *(const uint4*)(dr + 512 + lane * 8);
            const uint4 ua = *(const uint4*)(ur + lane * 8), ub = *(const uint4*)(ur + 512 + lane * 8);
            const float z = wave_sum(dot8(xa, da) + dot8(xb, db));
            const float w = gt * 0.5f * z * (1.0f + erff(z * 0.70710678118654752f));
            const unsigned uav[4] = {ua.x, ua.y, ua.z, ua.w}, ubv[4] = {ub.x, ub.y, ub.z, ub.w};
#pragma unroll
            for (int i = 0; i < 4; ++i) { acc[2 * i] += w * __uint_as_float(uav[i] << 16); acc[2 * i + 1] += w * __uint_as_float(uav[i] & 0xffff0000u);
                acc[8 + 2 * i] += w * __uint_as_float(ubv[i] << 16); acc[8 + 2 * i + 1] += w * __uint_as_float(ubv[i] & 0xffff0000u); }
        }
        float* o = out + (size_t)t * DM;
        float4 r0 = *(float4*)(o + lane * 8), r1 = *(float4*)(o + lane * 8 + 4), r2 = *(float4*)(o + 512 + lane * 8), r3 = *(float4*)(o + 512 + lane * 8 + 4);
        r0.x += acc[0]; r0.y += acc[1]; r0.z += acc[2]; r0.w += acc[3]; r1.x += acc[4]; r1.y += acc[5]; r1.z += acc[6]; r1.w += acc[7];
        r2.x += acc[8]; r2.y += acc[9]; r2.z += acc[10]; r2.w += acc[11]; r3.x += acc[12]; r3.y += acc[13]; r3.z += acc[14]; r3.w += acc[15];
        *(float4*)(o + lane * 8) = r0; *(float4*)(o + lane * 8 + 4) = r1; *(float4*)(o + 512 + lane * 8) = r2; *(float4*)(o + 512 + lane * 8 + 4) = r3;
    }
}
__global__ void __launch_bounds__(NTHR, 2) mk_fwd(Params P) {
    extern __shared__ __attribute__((aligned(16))) unsigned char lds[];
    cg::grid_group grid = cg::this_grid();
    const int tid = threadIdx.x, wg = blockIdx.x, nwg = gridDim.x;
    unsigned char* ws = P.ws; float* out = P.out;
    const float* x = P.in[0];
    bf16* WinT = (bf16*)(ws + WS_WIN); bf16* WoutT = (bf16*)(ws + WS_WOUT); bf16* WqT = (bf16*)(ws + WS_WQ); bf16* SUBK = (bf16*)(ws + WS_SUBK);
    bf16* DOWN = (bf16*)(ws + WS_DOWN); bf16* UP = (bf16*)(ws + WS_UP); bf16* XN = (bf16*)(ws + WS_XN); bf16* QKV = (bf16*)(ws + WS_QKV); bf16* PQ = (bf16*)(ws + WS_PQ);
    bf16* MIXED = (bf16*)(ws + WS_MIXED); bf16* DOB = (bf16*)(ws + WS_DO); int* IDS = (int*)(ws + WS_IDS); float* GATES = (float*)(ws + WS_GATES);
    float* ROPE = (float*)(ws + WS_ROPE); float* KMEAN = (float*)(ws + WS_KMEAN);

    ph_transpose(P.in[2], 1024, 3072, WinT, (float*)lds, wg, nwg, tid);
    ph_transpose(P.in[13], 1024, 1024, WoutT, (float*)lds, wg, nwg, tid);
    ph_transpose(P.in[15], 1024, 2048, WqT, (float*)lds, wg, nwg, tid);
    ph_convert(P.in[16], SUBK, (size_t)16 * 128 * 128 / 4, wg, nwg, tid);
    ph_convert(P.in[17], DOWN, (size_t)16384 * 1024 / 4, wg, nwg, tid);
    ph_convert(P.in[18], UP, (size_t)16384 * 1024 / 4, wg, nwg, tid);
    ph_rope(ROPE, wg, nwg, tid);
    ph_rmsnorm(x, P.in[1], XN, T, wg, nwg, tid);
    float lam; { float a = 0.f, b = 0.f; for (int i = 0; i < 64; ++i) { a += P.in[7][i] * P.in[8][i]; b += P.in[9][i] * P.in[10][i]; } lam = expf(a) - expf(b) + 0.2f; }
    grid.sync();
    { pg8::Gemm g{XN, WinT, T, 3072, 1024}; pg8::EpiBf16 E{QKV, 512, 512, QKV_ELEMS}; pg8::StaticOrder S; S.init(g.M, g.N, nwg, wg);
      pg8::gemm_phase<pg8::EpiBf16, pg8::StaticOrder, true, true>((PG8_LAS unsigned char*)lds, g, S, E); }
    grid.sync();
    ph_qk_post(QKV, ROPE, P.in[3], P.in[4], P.in[5], P.in[6], KMEAN, wg, nwg, tid);
    grid.sync();
    ph_attn_naive(QKV, KMEAN, P.in[11], MIXED, DOB, wg, nwg, tid);
    grid.sync();
    ph_diff_combine(DOB, lam, P.in[12], MIXED, wg, nwg, tid);
    grid.sync();
    { pg8::Gemm g{MIXED, WoutT, T, 1024, 1024}; pg8::EpiResF32 E{x, out, 1024}; pg8::StaticOrder S; S.init(g.M, g.N, nwg, wg);
      pg8::gemm_phase<pg8::EpiResF32, pg8::StaticOrder, true, true>((PG8_LAS unsigned char*)lds, g, S, E); }
    grid.sync();
    ph_rmsnorm(out, P.in[14], XN, T, wg, nwg, tid);
    grid.sync();
    { pg8::Gemm g{XN, WqT, T, 2048, 1024}; pg8::EpiBf16 E{PQ, 2048, 0, 0}; pg8::StaticOrder S; S.init(g.M, g.N, nwg, wg);
      pg8::gemm_phase<pg8::EpiBf16, pg8::StaticOrder, true, true>((PG8_LAS unsigned char*)lds, g, S, E); }
    grid.sync();
    ph_peer_route(PQ, SUBK, IDS, GATES, (float*)lds, wg, nwg, tid);
    grid.sync();
    ph_peer_gather(XN, IDS, GATES, DOWN, UP, out, wg, nwg, tid);
}

extern "C" void kernel_launch(void* const* d_in, const int* in_sizes, int n_in, void* d_out, int out_size, void* d_ws, size_t ws_size, hipStream_t stream) {
    static int grid_blocks = 0;
    if (grid_blocks == 0) {
        if (n_in != 19 || in_sizes[0] != T * DM || out_size != T * DM || ws_size < WS_END) { fprintf(stderr, "kernel_launch: unexpected shapes (n_in %d in0 %d out %d ws %zu)\n", n_in, n_in > 0 ? in_sizes[0] : -1, out_size, ws_size); grid_blocks = -1; return; }
        int dev = 0, cus = 0, per_cu = 0;
        (void)hipGetDevice(&dev); (void)hipDeviceGetAttribute(&cus, hipDeviceAttributeMultiprocessorCount, dev);
        (void)hipFuncSetAttribute((const void*)mk_fwd, hipFuncAttributeMaxDynamicSharedMemorySize, LDS_BYTES);
        (void)hipOccupancyMaxActiveBlocksPerMultiprocessor(&per_cu, (const void*)mk_fwd, NTHR, LDS_BYTES);
        if (per_cu < 1 || cus < 1) { fprintf(stderr, "kernel_launch: occupancy query says %d blocks/CU on %d CUs\n", per_cu, cus); grid_blocks = -1; return; }
        if (per_cu > 1) per_cu = 1;
        grid_blocks = cus * per_cu;
    }
    if (grid_blocks < 0) return;
    (void)hipMemsetAsync(d_ws, 0, WS_ZERO_BYTES, stream);
    Params p{};
    for (int i = 0; i < 19; ++i) p.in[i] = (const float*)d_in[i];
    p.out = (float*)d_out; p.ws = (unsigned char*)d_ws;
    void* args[] = {&p};
    hipError_t e = hipLaunchCooperativeKernel((const void*)mk_fwd, dim3(grid_blocks), dim3(NTHR), args, LDS_BYTES, stream);
    if (e != hipSuccess) fprintf(stderr, "cooperative launch failed: %s (grid %d)\n", hipGetErrorString(e), grid_blocks);
}
```

```cpp
#include <hip/hip_runtime.h>
#include <hip/hip_cooperative_groups.h>
#include <cstdio>
#include <cstdint>
namespace cg = cooperative_groups;
__device__ __forceinline__ int fresh_tid() { int t = threadIdx.x; asm volatile("" : "+v"(t)); return t; }
namespace pg8 {
#define PG8_LAS __attribute__((address_space(3)))
typedef unsigned short bf16_t;
typedef short bf16x8 __attribute__((ext_vector_type(8)));
typedef float f32x4 __attribute__((ext_vector_type(4)));
typedef unsigned u32x4 __attribute__((ext_vector_type(4)));
constexpr int BM = 256, BK = 64, HALF = 128, HTB = HALF * BK * 2  , STAGE_BYTES = 8 * HTB, NXCD = 8, WGM = 8;

__host__ __device__ __forceinline__ int lds_byte(int r, int c) { const int st = (r >> 4) * 2 + (c >> 5), rr = r & 15, cc = c & 31, ob = rr * 64 + cc * 2; return st * 1024 + (ob ^ (((ob >> 9) & 1) << 5)); }
__host__ __device__ __forceinline__ void stage_rc(int b, int& R, int& C) { const int st = b / 1024, sb = b % 1024, swz = sb ^ (((sb >> 9) & 1) << 5); R = (st >> 1) * 16 + swz / 64; C = (st & 1) * 32 + (swz % 64) / 2; }
__host__ __device__ __forceinline__ int perm32(int rho) { const int n = rho >> 4, i = rho & 15; return 8 * (i >> 2) + 4 * n + (i & 3); }

struct Unit { int pm, pn; };
struct Gemm { const bf16_t* A; const bf16_t* Bt; int M, N, K; };

struct StaticOrder {
    int nM, nN, nwg, G, c;
    __host__ __device__ void init(int M, int N, int G_, int c_) { nM = M / BM; nN = N / BM; nwg = nM * nN; G = G_; c = c_; }
    __host__ __device__ bool next(int i, Unit& u) const {
        const long L = (long)i * G + c; if (L >= nwg) return false;
        int wgid = (int)L; { const int q = nwg / NXCD, r = nwg % NXCD, xcd = wgid % NXCD, off = wgid / NXCD; wgid = (xcd < r ? xcd * (q + 1) : r * (q + 1) + (xcd - r) * q) + off; }
        const int nig = WGM * nN, gid = wgid / nig, fm = gid * WGM, gsz = (nM - fm) < WGM ? (nM - fm) : WGM;
        u.pm = fm + ((wgid % nig) % gsz); u.pn = (wgid % nig) / gsz; return true;
    }
    __device__ __forceinline__ void a_ready(const Unit&) const {}
    __device__ __forceinline__ void done(const Unit&) const {}
};

__device__ __forceinline__ unsigned cvt_pk_bf16(float lo, float hi) { unsigned r; asm volatile("v_cvt_pk_bf16_f32 %0, %1, %2" : "=v"(r) : "v"(lo), "v"(hi)); return r; }
struct EpiBf16 {
    static constexpr bool PERM = true, AFTER_DRAIN = false;
    bf16_t* O; int ldc; int split_cols; size_t split_stride;
    __device__ __forceinline__ void operator()(const f32x4 (&acc)[2][2][4][2], const Unit& u, int wr, int wc, int fr, int fq) const {
        const int row0 = u.pm * BM + wr * 64 + fr; int colt = u.pn * BM; bf16_t* base = O;
        if (split_cols) { const int t = colt / split_cols; base += (size_t)t * split_stride; colt -= t * split_cols; }
        const int col0 = colt + wc * 32 + 8 * fq;
#pragma unroll
        for (int ai = 0; ai < 2; ++ai)
#pragma unroll
            for (int m = 0; m < 4; ++m) { bf16_t* rowp = base + (size_t)(row0 + ai * HALF + m * 16) * ldc + col0;
#pragma unroll
                for (int bj = 0; bj < 2; ++bj) { const f32x4 v0 = acc[ai][bj][m][0], v1 = acc[ai][bj][m][1];
                    u32x4 w; w.x = cvt_pk_bf16(v0[0], v0[1]); w.y = cvt_pk_bf16(v0[2], v0[3]); w.z = cvt_pk_bf16(v1[0], v1[1]); w.w = cvt_pk_bf16(v1[2], v1[3]);
                    *(u32x4*)(rowp + bj * HALF) = w; } }
    }
};
struct EpiResF32 {
    static constexpr bool PERM = false, AFTER_DRAIN = false;
    const float* base; float* out; int ldc;
    __device__ __forceinline__ void operator()(const f32x4 (&acc)[2][2][4][2], const Unit& u, int wr, int wc, int fr, int fq) const {
        const int col0 = u.pn * BM + wc * 32 + 4 * fq;
#pragma unroll
        for (int ai = 0; ai < 2; ++ai)
#pragma unroll
            for (int m = 0; m < 4; ++m) { const size_t off = (size_t)(u.pm * BM + ai * HALF + wr * 64 + m * 16 + fr) * ldc + col0;
#pragma unroll
                for (int bj = 0; bj < 2; ++bj)
#pragma unroll
                    for (int n = 0; n < 2; ++n) { const f32x4 bs = *(const f32x4*)(base + off + bj * HALF + n * 16); *(f32x4*)(out + off + bj * HALF + n * 16) = bs + acc[ai][bj][m][n]; } }
    }
};
template <class Epi, class Sched, bool ALIGN_EPI = false, bool SP2 = false>
__device__ __forceinline__ void gemm_phase(PG8_LAS unsigned char* lds, const Gemm g, const Sched& S, const Epi& E) {
    const int tid = fresh_tid(), wid = __builtin_amdgcn_readfirstlane(tid >> 6), lane = tid & 63, wr = wid >> 2, wc = wid & 3, fr = lane & 15, fq = lane >> 4;
    const int K = g.K, nt = K / BK;
    unsigned voffA[2], voffB[2];
#pragma unroll
    for (int i = 0; i < 2; ++i) { int R, C; stage_rc(tid * 16 + i * 8192, R, C); const int Rb = Epi::PERM ? ((R & ~31) + perm32(R & 31)) : R;
        voffA[i] = (unsigned)(R * K + C) * 2u; voffB[i] = (unsigned)(Rb * K + C) * 2u; }
    const size_t kstep = (size_t)(BK * 2);
    const size_t hstep = (size_t)HALF * K * 2;
    const size_t tstep = 2 * hstep;
    const unsigned ldsw = (unsigned)wid * 1024u;
    const int aoff = lds_byte(wr * 64 + fr, fq * 8), boff = lds_byte(wc * 32 + fr, fq * 8);
#define PG8_SA(b, h) (((b) * 2 + (h)) * HTB)
#define PG8_SB(b, h) ((4 + (b) * 2 + (h)) * HTB)
#define PG8_STAGE(bufoff, gbase, voff) do { _Pragma("unroll") for (int _i = 0; _i < 2; ++_i) \
        __builtin_amdgcn_global_load_lds((const unsigned*)((const char*)(gbase) + (voff)[_i]), (PG8_LAS unsigned*)(lds + (bufoff) + ldsw + _i * 8192), 16, 0, 0); } while (0)
#define PG8_LDA(dst, b, h) do { _Pragma("unroll") for (int m = 0; m < 4; ++m) _Pragma("unroll") for (int k = 0; k < 2; ++k) dst[m][k] = *(const PG8_LAS bf16x8*)(lds + PG8_SA(b, h) + aoff + m * 2048 + k * 1024); } while (0)
#define PG8_LDB(dst, b, h) do { _Pragma("unroll") for (int n = 0; n < 2; ++n) _Pragma("unroll") for (int k = 0; k < 2; ++k) dst[n][k] = *(const PG8_LAS bf16x8*)(lds + PG8_SB(b, h) + boff + n * 2048 + k * 1024); } while (0)
#define PG8_MMA(ai, bj, At, Bt) do { __builtin_amdgcn_s_setprio(1); _Pragma("unroll") for (int m = 0; m < 4; ++m) _Pragma("unroll") for (int n = 0; n < 2; ++n) _Pragma("unroll") for (int k = 0; k < 2; ++k) \
        acc[ai][bj][m][n] = __builtin_amdgcn_mfma_f32_16x16x32_bf16(Bt[n][k], At[m][k], acc[ai][bj][m][n], 0, 0, 0); __builtin_amdgcn_s_setprio(0); } while (0)
#define PG8_WAIT_V(n) asm volatile("s_waitcnt vmcnt(" #n ")" ::: "memory")
#define PG8_WAIT_L(n) asm volatile("s_waitcnt lgkmcnt(" #n ")" ::: "memory")
#define PG8_BAR __builtin_amdgcn_s_barrier()
#define PG8_SCHED __builtin_amdgcn_sched_barrier(0)
    Unit cur, nxt; int ui = 0;
    if (!S.next(0, cur)) return;
    f32x4 acc[2][2][4][2];
#pragma unroll
    for (int a = 0; a < 2; ++a)
#pragma unroll
        for (int b = 0; b < 2; ++b)
#pragma unroll
            for (int m = 0; m < 4; ++m)
#pragma unroll
                for (int n = 0; n < 2; ++n) acc[a][b][m][n] = (f32x4){0.f, 0.f, 0.f, 0.f};
    bf16x8 At[4][2], B0[2][2], B1[2][2];
    const char* cA = (const char*)g.A + (size_t)cur.pm * tstep; const char* cB = (const char*)g.Bt + (size_t)cur.pn * tstep;
    S.a_ready(cur);
    if constexpr (SP2) {
        PG8_STAGE(PG8_SB(0, 0), cB, voffB); PG8_STAGE(PG8_SB(0, 1), cB + hstep, voffB); PG8_STAGE(PG8_SA(0, 0), cA, voffA); PG8_STAGE(PG8_SA(0, 1), cA + hstep, voffA);
        if (wr == 1) PG8_BAR;
        PG8_WAIT_V(2); PG8_BAR;
        PG8_STAGE(PG8_SB(1, 0), cB + kstep, voffB); PG8_STAGE(PG8_SA(1, 0), cA + kstep, voffA); PG8_STAGE(PG8_SB(1, 1), cB + hstep + kstep, voffB);
        PG8_WAIT_V(6); PG8_BAR;
    } else {
        PG8_STAGE(PG8_SB(0, 0), cB, voffB); PG8_STAGE(PG8_SA(0, 0), cA, voffA); PG8_STAGE(PG8_SB(0, 1), cB + hstep, voffB); PG8_STAGE(PG8_SA(0, 1), cA + hstep, voffA);
        if (wr == 1) PG8_BAR;
        PG8_WAIT_V(4); PG8_BAR;
        PG8_STAGE(PG8_SB(1, 0), cB + kstep, voffB); PG8_STAGE(PG8_SA(1, 0), cA + kstep, voffA); PG8_STAGE(PG8_SB(1, 1), cB + hstep + kstep, voffB);
        PG8_WAIT_V(6); PG8_BAR;
    }
    for (;;) {
        const bool has_next = S.next(ui + 1, nxt);
        const char* nA = has_next ? (const char*)g.A + (size_t)nxt.pm * tstep : cA; const char* nB = has_next ? (const char*)g.Bt + (size_t)nxt.pn * tstep : cB;
        for (int t = 0; t < nt; t += 2) {
            const bool last = (t == nt - 2);
            const char* a1 = cA + (size_t)(t + 1) * kstep;
            const char* a2 = last ? nA : cA + (size_t)(t + 2) * kstep; const char* b2 = last ? nB : cB + (size_t)(t + 2) * kstep;
            const char* a3 = a2 + kstep; const char* b3 = b2 + kstep;
            if (last && has_next) S.a_ready(nxt);
            if constexpr (SP2) {
            PG8_LDB(B0, 0, 0); PG8_LDB(B1, 0, 1); PG8_SCHED; PG8_LDA(At, 0, 0); PG8_STAGE(PG8_SA(1, 1), a1 + hstep, voffA);
            PG8_WAIT_V(8); PG8_WAIT_L(0); PG8_BAR; PG8_MMA(0, 0, At, B0); PG8_MMA(0, 1, At, B1); PG8_BAR; PG8_SCHED;
            PG8_LDA(At, 0, 1); PG8_STAGE(PG8_SB(0, 0), b2, voffB); PG8_STAGE(PG8_SB(0, 1), b2 + hstep, voffB); PG8_STAGE(PG8_SA(0, 0), a2, voffA);
            PG8_WAIT_V(8); PG8_WAIT_L(0); PG8_BAR; PG8_MMA(1, 0, At, B0); PG8_MMA(1, 1, At, B1); PG8_BAR; PG8_SCHED;
            PG8_LDB(B0, 1, 0); PG8_LDB(B1, 1, 1); PG8_SCHED; PG8_LDA(At, 1, 0); PG8_STAGE(PG8_SA(0, 1), a2 + hstep, voffA);
            PG8_WAIT_V(8); PG8_WAIT_L(0); PG8_BAR; PG8_MMA(0, 0, At, B0); PG8_MMA(0, 1, At, B1); PG8_BAR; PG8_SCHED;
            PG8_LDA(At, 1, 1); PG8_STAGE(PG8_SB(1, 0), b3, voffB); PG8_STAGE(PG8_SB(1, 1), b3 + hstep, voffB); PG8_STAGE(PG8_SA(1, 0), a3, voffA);
            PG8_WAIT_V(8); PG8_WAIT_L(0); PG8_BAR; PG8_MMA(1, 0, At, B0); PG8_MMA(1, 1, At, B1); PG8_BAR; PG8_SCHED;
            } else {
            PG8_LDB(B0, 0, 0); PG8_SCHED; PG8_LDA(At, 0, 0); PG8_STAGE(PG8_SA(1, 1), a1 + hstep, voffA);
            PG8_WAIT_L(8); PG8_BAR; PG8_WAIT_L(0); PG8_MMA(0, 0, At, B0); PG8_BAR; PG8_SCHED;
            PG8_LDB(B1, 0, 1); PG8_STAGE(PG8_SB(0, 0), b2, voffB);
            PG8_BAR; PG8_WAIT_L(0); PG8_MMA(0, 1, At, B1); PG8_BAR;
            PG8_LDA(At, 0, 1); PG8_STAGE(PG8_SA(0, 0), a2, voffA);
            PG8_BAR; PG8_WAIT_L(0); PG8_MMA(1, 0, At, B0); PG8_BAR; PG8_SCHED;
            PG8_STAGE(PG8_SB(0, 1), b2 + hstep, voffB);
            PG8_WAIT_V(6); PG8_BAR; PG8_MMA(1, 1, At, B1); PG8_BAR;
            PG8_LDB(B0, 1, 0); PG8_SCHED; PG8_LDA(At, 1, 0); PG8_STAGE(PG8_SA(0, 1), a2 + hstep, voffA);
            PG8_WAIT_L(8); PG8_BAR; PG8_WAIT_L(0); PG8_MMA(0, 0, At, B0); PG8_BAR; PG8_SCHED;
            PG8_LDB(B1, 1, 1); PG8_STAGE(PG8_SB(1, 0), b3, voffB);
            PG8_BAR; PG8_WAIT_L(0); PG8_MMA(0, 1, At, B1); PG8_BAR;
            PG8_LDA(At, 1, 1); PG8_STAGE(PG8_SA(1, 0), a3, voffA);
            PG8_BAR; PG8_WAIT_L(0); PG8_MMA(1, 0, At, B0); PG8_BAR; PG8_SCHED;
            PG8_STAGE(PG8_SB(1, 1), b3 + hstep, voffB);
            PG8_WAIT_V(6); PG8_BAR; PG8_MMA(1, 1, At, B1); PG8_BAR;
            }
        }
        if constexpr (ALIGN_EPI) { if (wr == 0) PG8_BAR; }
        if constexpr (!Epi::AFTER_DRAIN) { E(acc, cur, wr, wc, fr, fq); S.done(cur); }
        if (!has_next) break;
#pragma unroll
        for (int a = 0; a < 2; ++a)
#pragma unroll
            for (int b = 0; b < 2; ++b)
#pragma unroll
                for (int m = 0; m < 4; ++m)
#pragma unroll
                    for (int n = 0; n < 2; ++n) acc[a][b][m][n] = (f32x4){0.f, 0.f, 0.f, 0.f};
        cur = nxt; cA = nA; cB = nB; ++ui;
        if constexpr (ALIGN_EPI) { if (wr == 1) PG8_BAR; }
    }
    PG8_WAIT_V(0);
    if constexpr (!ALIGN_EPI) { if (wr == 0) PG8_BAR; }
    PG8_BAR;
    if constexpr (Epi::AFTER_DRAIN) { E.fused(acc, cur, wr, wc, fr, fq, lds, wid, lane); S.done(cur); }
#undef PG8_SA
#undef PG8_SB
#undef PG8_STAGE
#undef PG8_LDA
#undef PG8_LDB
#undef PG8_MMA
#undef PG8_WAIT_V
#undef PG8_WAIT_L
#undef PG8_BAR
#undef PG8_SCHED
}
}
#include <hip/hip_bf16.h>
#include <cmath>
namespace attn_body {
using bf16=__hip_bfloat16;
using bf16x8=__attribute__((ext_vector_type(8)))short;
using s16x4=__attribute__((ext_vector_type(4)))short;
using f32x16=__attribute__((ext_vector_type(16)))float;
using u32x4=__attribute__((ext_vector_type(4)))unsigned;
constexpr int SEQ=2048,D=64,DM=512,PO=1024;
constexpr int NW=8,QBLK=32,QB=QBLK*NW,KVBLK=64,NQB=SEQ/QB;
constexpr int ATTN_UNIT_ROWS=QB;
__device__ __forceinline__ int crow(int r,int hi){return (r&3)+8*(r>>2)+4*hi;}
#define SBAR() __builtin_amdgcn_sched_barrier(0)
__device__ __forceinline__ void cmask(f32x16&p0,f32x16&p1,int jb,int qrel,int hi){
  const float NEG=-INFINITY; int kb=64*jb+4*hi;
  #pragma unroll
  for(int r=0;r<16;++r){int kv=kb+(r&3)+8*(r>>2); if(kv>qrel)p0[r]=NEG; if(kv+32>qrel)p1[r]=NEG;}
}

__device__ __forceinline__ void bmask(f32x16&p0,f32x16&p1,unsigned on){
  if(!on){
    #pragma unroll
    for(int r=0;r<16;++r){p0[r]=-INFINITY;p1[r]=-INFINITY;} }
}
constexpr int NSLOT=3, SLOTB=8192;
constexpr int LDS_K=0, LDS_V=NSLOT*SLOTB, LDS_WS=2*NSLOT*SLOTB, LDS_OST=LDS_WS+NW*64*4, LDS_BYTES=LDS_OST+NW*4096;
constexpr float C2=0.125f*1.4426950408889634f;
__device__ __forceinline__ void glds16(const void*gsrc,unsigned lds_dst){unsigned keep;
  asm volatile("s_mov_b32 %0, m0\n\ts_mov_b32 m0, %2\n\ts_nop 0\n\tglobal_load_lds_dwordx4 %1, off\n\ts_mov_b32 m0, %0":"=&s"(keep):"v"(gsrc),"s"(lds_dst):"memory");}
__device__ __forceinline__ float max3f(float a,float b,float c){float r;asm("v_max3_f32 %0, %1, %2, %3":"=v"(r):"v"(a),"v"(b),"v"(c));return r;}
__device__ __forceinline__ float max2f(float a,float b){float r;asm("v_max_f32_e32 %0, %1, %2":"=v"(r):"v"(a),"v"(b));return r;}
__device__ __forceinline__ float fadd_s(float a,float b){float r;asm("v_add_f32_e32 %0, %1, %2":"=v"(r):"v"(a),"v"(b));return r;}
__device__ __forceinline__ float fsub_s(float a,float b){float r;asm("v_sub_f32_e32 %0, %1, %2":"=v"(r):"v"(a),"v"(b));return r;}
typedef float f32x2_t __attribute__((ext_vector_type(2))); typedef __bf16 bf16x2_t __attribute__((ext_vector_type(2)));
__device__ __forceinline__ unsigned cvtpk_s(float lo,float hi){f32x2_t v={lo,hi};bf16x2_t b=__builtin_convertvector(v,bf16x2_t);return __builtin_bit_cast(unsigned,b);}
#define WAIT_BAR(N) asm volatile("s_waitcnt vmcnt(" #N ") lgkmcnt(0)\n\ts_barrier":::"memory")

__device__ __forceinline__ void qkt(f32x16&p0,f32x16&p1,const char*Kslot,const bf16x8*qr,int r32,int hi){
  const char*kb=Kslot+hi*1024+r32*16;
  #pragma unroll
  for(int d0=0;d0<4;++d0){
    const bf16x8 b0=*reinterpret_cast<const bf16x8*>(kb+d0*2048);
    const bf16x8 b1=*reinterpret_cast<const bf16x8*>(kb+d0*2048+512);
    if(d0==0){p0=__builtin_amdgcn_mfma_f32_32x32x16_bf16(b0,qr[0],f32x16{},0,0,0);p1=__builtin_amdgcn_mfma_f32_32x32x16_bf16(b1,qr[0],f32x16{},0,0,0);}
    else{p0=__builtin_amdgcn_mfma_f32_32x32x16_bf16(b0,qr[d0],p0,0,0,0);p1=__builtin_amdgcn_mfma_f32_32x32x16_bf16(b1,qr[d0],p1,0,0,0);}}
}
typedef __attribute__((address_space(3))) const char* lds_cptr;
typedef short v4i16_t __attribute__((ext_vector_type(4)));
__device__ __forceinline__ void kload8(bf16x8*kf,lds_cptr kp){
  kf[0]=*(const __attribute__((address_space(3))) bf16x8*)(kp);      kf[1]=*(const __attribute__((address_space(3))) bf16x8*)(kp+512);
  kf[2]=*(const __attribute__((address_space(3))) bf16x8*)(kp+2048); kf[3]=*(const __attribute__((address_space(3))) bf16x8*)(kp+2560);
  kf[4]=*(const __attribute__((address_space(3))) bf16x8*)(kp+4096); kf[5]=*(const __attribute__((address_space(3))) bf16x8*)(kp+4608);
  kf[6]=*(const __attribute__((address_space(3))) bf16x8*)(kp+6144); kf[7]=*(const __attribute__((address_space(3))) bf16x8*)(kp+6656);
}
__device__ __forceinline__ void kload2(bf16x8*kf,lds_cptr kp,int j){ kf[2*j]=*(const __attribute__((address_space(3))) bf16x8*)(kp+j*2048); kf[2*j+1]=*(const __attribute__((address_space(3))) bf16x8*)(kp+j*2048+512); }
__device__ __forceinline__ s16x4 vtr(lds_cptr p){ return __builtin_bit_cast(s16x4,__builtin_amdgcn_ds_read_tr16_b64_v4i16((__attribute__((address_space(3))) v4i16_t*)p)); }
__device__ __forceinline__ float rowmax(const f32x16&p0,const f32x16&p1){
  float a=max3f(p0[0],p0[1],p1[0]),b=max3f(p0[2],p0[3],p1[1]);a=max3f(a,p1[2],p1[3]);
  #pragma unroll
  for(int r=4;r<16;r+=4){a=max3f(a,p0[r],p0[r+1]);b=max3f(b,p0[r+2],p0[r+3]);a=max3f(a,p1[r],p1[r+1]);b=max3f(b,p1[r+2],p1[r+3]);}
  const float m=max2f(a,b);
  auto rr=__builtin_amdgcn_permlane32_swap(__float_as_uint(m),__float_as_uint(m),false,false);
  return max2f(__uint_as_float(rr[0]),__uint_as_float(rr[1]));
}
__device__ __forceinline__ void pv(f32x16*o,int vb,bf16x8 pa0,bf16x8 pa1,bf16x8 pa2,bf16x8 pa3){
  #pragma unroll
  for(int d0=0;d0<2;++d0){s16x4 lo[4],hi[4];
    #pragma unroll
    for(int ks=0;ks<4;++ks){
      asm volatile("ds_read_b64_tr_b16 %0,%1 offset:%c2":"=&v"(lo[ks]):"v"(vb),"i"(d0*4096+ks*1024):"memory");
      asm volatile("ds_read_b64_tr_b16 %0,%1 offset:%c2":"=&v"(hi[ks]):"v"(vb),"i"(d0*4096+ks*1024+512):"memory");}
    asm volatile("s_waitcnt lgkmcnt(0)":::"memory");SBAR();
    #define PK(k) (bf16x8){lo[k][0],lo[k][1],lo[k][2],lo[k][3],hi[k][0],hi[k][1],hi[k][2],hi[k][3]}
    o[d0]=__builtin_amdgcn_mfma_f32_32x32x16_bf16(pa0,PK(0),o[d0],0,0,0);
    o[d0]=__builtin_amdgcn_mfma_f32_32x32x16_bf16(pa1,PK(1),o[d0],0,0,0);
    o[d0]=__builtin_amdgcn_mfma_f32_32x32x16_bf16(pa2,PK(2),o[d0],0,0,0);
    o[d0]=__builtin_amdgcn_mfma_f32_32x32x16_bf16(pa3,PK(3),o[d0],0,0,0);
    #undef PK
  }
}

#ifndef ATTN_STORE16
#define ATTN_STORE16(p,v) (*(u32x4*)(p)=(v))
#endif
template<int THRL,bool MOBA> __device__ __forceinline__ void attn_unit(int qb,const bf16*Qu,const bf16*__restrict__ Kh,const bf16*__restrict__ Vh,bf16*Ou,const float*__restrict__ km,const float*__restrict__ gm,char*shm){
  const int tid=fresh_tid(),lane=tid&63,r32=lane&31,hi=lane>>5; const int wid=__builtin_amdgcn_readfirstlane(tid>>6);
  const int q0=qb*QB;
  const bf16*Qw=Qu+(long)(wid*QBLK)*DM;
  const unsigned lds0=(unsigned)(uintptr_t)shm;
  float*wsf=(float*)(shm+LDS_WS)+wid*64;
  const bf16*ksrc=Kh+(long)lane*DM+wid*8;
  const bf16*vsrc=Vh+(long)(16*(wid&3)+(lane>>2))*DM+(wid>>2)*32+(lane&3)*8;
  const unsigned kdst=lds0+LDS_K+wid*1024, vdst=lds0+LDS_V+wid*1024;
  #define DMA_K(t,slot) glds16(ksrc+(long)(t)*KVBLK*DM,(unsigned)__builtin_amdgcn_readfirstlane(kdst+(slot)))
  #define DMA_V(t,slot) glds16(vsrc+(long)(t)*KVBLK*DM,(unsigned)__builtin_amdgcn_readfirstlane(vdst+(slot)))
  const int vb0=(int)(lds0+LDS_V)+((lane>>4)&1)*32+(lane&3)*8+(4*hi+((lane&15)>>2))*64;
  const char*Kbase=shm+LDS_K; bf16x8 kf[8];
  const lds_cptr shm3=(lds_cptr)shm; const lds_cptr kp0=shm3+LDS_K+hi*1024+r32*16; const lds_cptr vp0=shm3+LDS_V+((lane>>4)&1)*32+(lane&3)*8+(4*hi+((lane&15)>>2))*64;
  const int NT=(q0+QB)/KVBLK;
  DMA_K(0,0);DMA_V(0,0);DMA_K(1,SLOTB);
  bf16x8 qr[4];
  #pragma unroll
  for(int d0=0;d0<4;++d0)qr[d0]=*reinterpret_cast<const bf16x8*>(&Qw[(long)r32*DM+d0*16+hi*8]);
  unsigned selm=0u;
  if(MOBA){ float g[8];
    #pragma unroll
    for(int n=0;n<8;++n){ float s_=0.f; if(n<qb){
      #pragma unroll
      for(int d0=0;d0<4;++d0){ const float4 ka=*reinterpret_cast<const float4*>(km+n*64+d0*16+hi*8), kb2=*reinterpret_cast<const float4*>(km+n*64+d0*16+hi*8+4);
        const float kv[8]={ka.x,ka.y,ka.z,ka.w,kb2.x,kb2.y,kb2.z,kb2.w};
        #pragma unroll
        for(int j=0;j<8;++j)s_+=__uint_as_float(((unsigned)(unsigned short)qr[d0][j])<<16)*kv[j]; }
      s_+=__shfl_xor(s_,32); } g[n]=s_; asm volatile("":"+v"(s_)::"memory"); SBAR(); }
    #pragma unroll
    for(int r=0;r<3;++r){ float best=-3.0e38f; int bi=-1;
      #pragma unroll
      for(int n=0;n<8;++n) if(n<qb&&!((selm>>n)&1u)&&g[n]>best){best=g[n];bi=n;}
      if(bi>=0)selm|=1u<<bi; } }
  float l_reg=0.f;f32x16 o[2];o[0]=f32x16{};o[1]=f32x16{};
  const int qrel=wid*QBLK+r32;
  #define CMASK(P0,P1,t) do{int jb_=(t)-(NT-4); if(jb_>=0)cmask(P0,P1,jb_,qrel,hi); else if(MOBA) bmask(P0,P1,(selm>>((t)>>2))&1u);}while(0)
  #define START(P0,P1) do{ _Pragma("unroll") for(int r=0;r<16;++r)P0[r]=__builtin_amdgcn_exp2f(P0[r]); }while(0)
  #define RESC() do{}while(0)
  f32x16 pA0,pA1,pB0,pB1;
  int sl_prev=0,sl_cur=0,sl_next=SLOTB;
  #define ROT() do{sl_prev=sl_cur;sl_cur=sl_next;sl_next=(sl_next==(NSLOT-1)*SLOTB)?0:sl_next+SLOTB;}while(0)
  DMA_K(2,2*SLOTB);
  WAIT_BAR(3);
  qkt(pA0,pA1,Kbase,qr,r32,hi);asm volatile("s_nop 15\n\ts_nop 7":"+v"(pA0),"+v"(pA1));CMASK(pA0,pA1,0);
  START(pA0,pA1);
  _Pragma("unroll") for(int r=0;r<16;++r)pA1[r]=__builtin_amdgcn_exp2f(pA1[r]);
  WAIT_BAR(0);
  DMA_K(3,0);DMA_V(1,SLOTB);
  ROT();
  kload8(kf,kp0+sl_cur);
  WAIT_BAR(2);
  s16x4 vlo[8],vhi[8]; u32x4 pw0,pw1,pw2,pw3;
  #define PKW(P,B) cvtpk_s(P[B],P[B+1])
  #define PAF(k) __builtin_bit_cast(bf16x8,pw##k)
  #define VFR(i) (bf16x8){vlo[i][0],vlo[i][1],vlo[i][2],vlo[i][3],vhi[i][0],vhi[i][1],vhi[i][2],vhi[i][3]}
  #define PIN(x) asm volatile("":"+v"(x))
  #define MX3(a,b,c) __builtin_fmaxf(__builtin_fmaxf((a),(b)),(c))
  #define GAPA(MF,A0,A1,A2,A3,W0,W1,PW) do{ MF; sacc+=A0; sacc+=A1; sacc+=A2; sacc+=A3; PIN(sacc); W0; W1; PIN(PW); SBAR(); }while(0)
  #define EX(v) __builtin_amdgcn_exp2f(v)
  #define GAPB(MF,X,B) do{ MF; X[B]=EX(X[B]); X[B+1]=EX(X[B+1]); X[B+2]=EX(X[B+2]); X[B+3]=EX(X[B+3]); PIN(X); SBAR(); }while(0)
  #define VRD(i) do{ vlo[i]=vtr(vp_+(((i)>>2)*4096+((i)&3)*1024)); vhi[i]=vtr(vp_+(((i)>>2)*4096+((i)&3)*1024+512)); }while(0)
  #define KRD(G,j) do{ if(G){ kload2(kf,kp0+sl_next,j); SBAR(); } }while(0)
  #define STEP(C0,C1,P0,P1,t,GK,GV,GL) do{ SBAR(); \
    const lds_cptr vp_=vp0+sl_prev; \
    VRD(0); SBAR(); float sacc=(P0[0]+P0[1]); \
    GAPA(C0=__builtin_amdgcn_mfma_f32_32x32x16_bf16(kf[0],qr[0],f32x16{},0,0,0), P0[2],P0[3],P0[4],P0[5],     pw0[0]=PKW(P0,0), pw0[1]=PKW(P0,2), pw0); \
    VRD(4); SBAR(); GAPA(C1=__builtin_amdgcn_mfma_f32_32x32x16_bf16(kf[1],qr[0],f32x16{},0,0,0), P0[6],P0[7],P0[8],P0[9],     pw0[2]=PKW(P0,4), pw0[3]=PKW(P0,6), pw0); \
    VRD(1); SBAR(); GAPA(C0=__builtin_amdgcn_mfma_f32_32x32x16_bf16(kf[2],qr[1],C0,0,0,0),   P0[10],P0[11],P0[12],P0[13], pw1[0]=PKW(P0,8), pw1[1]=PKW(P0,10), pw1); \
    VRD(5); SBAR(); GAPA(C1=__builtin_amdgcn_mfma_f32_32x32x16_bf16(kf[3],qr[1],C1,0,0,0),   P0[14],P0[15],P1[0],P1[1],   pw1[2]=PKW(P0,12),pw1[3]=PKW(P0,14), pw1); \
    VRD(2); SBAR(); GAPA(C0=__builtin_amdgcn_mfma_f32_32x32x16_bf16(kf[4],qr[2],C0,0,0,0),   P1[2],P1[3],P1[4],P1[5],     pw2[0]=PKW(P1,0), pw2[1]=PKW(P1,2), pw2); \
    VRD(6); SBAR(); GAPA(C1=__builtin_amdgcn_mfma_f32_32x32x16_bf16(kf[5],qr[2],C1,0,0,0),   P1[6],P1[7],P1[8],P1[9],     pw2[2]=PKW(P1,4), pw2[3]=PKW(P1,6), pw2); \
    VRD(3); SBAR(); GAPA(C0=__builtin_amdgcn_mfma_f32_32x32x16_bf16(kf[6],qr[3],C0,0,0,0),   P1[10],P1[11],P1[12],P1[13], pw3[0]=PKW(P1,8), pw3[1]=PKW(P1,10), pw3); \
    VRD(7); SBAR(); GAPA(C1=__builtin_amdgcn_mfma_f32_32x32x16_bf16(kf[7],qr[3],C1,0,0,0),   P1[14],P1[15],0.f,0.f,       pw3[2]=PKW(P1,12),pw3[3]=PKW(P1,14), pw3); \
    l_reg+=sacc; \
    if(GK){DMA_K((t)+3,sl_cur);} if(GV){DMA_V((t)+1,sl_next);} \
    CMASK(C0,C1,t); \
    SBAR(); \
    GAPB(o[0]=__builtin_amdgcn_mfma_f32_32x32x16_bf16(PAF(0),VFR(0),o[0],0,0,0), C0,0); \
    GAPB(o[1]=__builtin_amdgcn_mfma_f32_32x32x16_bf16(PAF(0),VFR(4),o[1],0,0,0), C0,4); \
    KRD(GL,0); GAPB(o[0]=__builtin_amdgcn_mfma_f32_32x32x16_bf16(PAF(1),VFR(1),o[0],0,0,0), C0,8); \
    KRD(GL,1); GAPB(o[1]=__builtin_amdgcn_mfma_f32_32x32x16_bf16(PAF(1),VFR(5),o[1],0,0,0), C0,12); \
    KRD(GL,2); GAPB(o[0]=__builtin_amdgcn_mfma_f32_32x32x16_bf16(PAF(2),VFR(2),o[0],0,0,0), C1,0); \
    KRD(GL,3); GAPB(o[1]=__builtin_amdgcn_mfma_f32_32x32x16_bf16(PAF(2),VFR(6),o[1],0,0,0), C1,4); \
    GAPB(o[0]=__builtin_amdgcn_mfma_f32_32x32x16_bf16(PAF(3),VFR(3),o[0],0,0,0), C1,8); \
    GAPB(o[1]=__builtin_amdgcn_mfma_f32_32x32x16_bf16(PAF(3),VFR(7),o[1],0,0,0), C1,12); \
    }while(0)
  int t=1;
  #undef CMASK
  #define CMASK(P0,P1,t) do{ if(MOBA) bmask(P0,P1,(selm>>((t)>>2))&1u); }while(0)
  for(;t+5<NT;t+=2){
    STEP(pB0,pB1,pA0,pA1,t,true,true,true);     WAIT_BAR(2); RESC(); ROT();
    STEP(pA0,pA1,pB0,pB1,t+1,true,true,true);   WAIT_BAR(2); RESC(); ROT();
  }
  #undef CMASK
  #define CMASK(P0,P1,t) do{int jb_=(t)-(NT-4); if(jb_>=0)cmask(P0,P1,jb_,qrel,hi); else if(MOBA) bmask(P0,P1,(selm>>((t)>>2))&1u);}while(0)
  #define ENDW(tt) do{ if((tt)+3<NT){WAIT_BAR(2);} else if((tt)+2<NT){WAIT_BAR(1);} else {WAIT_BAR(0);} }while(0)
  for(;t+1<NT;t+=2){
    STEP(pB0,pB1,pA0,pA1,t,(t+3<NT),(t+1<NT),(t+1<NT));       ENDW(t);   RESC(); ROT();
    STEP(pA0,pA1,pB0,pB1,t+1,(t+4<NT),(t+2<NT),(t+2<NT));     ENDW(t+1); RESC(); ROT();
  }
  STEP(pB0,pB1,pA0,pA1,NT-1,false,false,false); RESC();
  { float sacc=pB0[0]+pB0[1]; _Pragma("unroll") for(int r=2;r<16;++r)sacc+=pB0[r]; _Pragma("unroll") for(int r=0;r<16;++r)sacc+=pB1[r]; l_reg+=sacc;
    pw0=(u32x4){PKW(pB0,0),PKW(pB0,2),PKW(pB0,4),PKW(pB0,6)};pw1=(u32x4){PKW(pB0,8),PKW(pB0,10),PKW(pB0,12),PKW(pB0,14)};pw2=(u32x4){PKW(pB1,0),PKW(pB1,2),PKW(pB1,4),PKW(pB1,6)};pw3=(u32x4){PKW(pB1,8),PKW(pB1,10),PKW(pB1,12),PKW(pB1,14)};
    SBAR(); pv(o,vb0+sl_cur,PAF(0),PAF(1),PAF(2),PAF(3)); }
  #undef PKW
  #undef PAF
  #undef VFR
  #undef PIN
  #undef MX3
  #undef GAPA
  #undef GAPB
  #undef EX
  #undef VRD
  #undef KRD
  #undef STEP
  #undef ENDW
  {auto rr=__builtin_amdgcn_permlane32_swap(__float_as_uint(l_reg),__float_as_uint(l_reg),false,false);l_reg=__uint_as_float(rr[0])+__uint_as_float(rr[1]);}
  if(hi==0)wsf[32+r32]=l_reg;asm volatile("s_waitcnt lgkmcnt(0)":::"memory");
  float rli[16];
  #pragma unroll
  for(int r=0;r<16;++r)rli[r]=__builtin_amdgcn_rcpf(wsf[32+crow(r,hi)]);
  bf16*Ow=Ou+(long)(wid*QBLK)*PO;
  { bf16*stg=(bf16*)(shm+LDS_OST)+wid*2048;
    #pragma unroll
    for(int r=0;r<16;++r){const int orow=crow(r,hi);
      #pragma unroll
      for(int d0=0;d0<2;++d0)stg[orow*64+d0*32+r32]=__float2bfloat16(o[d0][r]*rli[r]);}
    asm volatile("s_waitcnt lgkmcnt(0)":::"memory");
    #pragma unroll
    for(int i=0;i<4;++i){const int row=i*8+(lane>>3),ch=lane&7; u32x4 v=*(const u32x4*)(stg+row*64+ch*8);
      if(MOBA){ float f[8]; float ss=0.f;
        #pragma unroll
        for(int e=0;e<4;++e){ f[2*e]=__uint_as_float(v[e]<<16); f[2*e+1]=__uint_as_float(v[e]&0xffff0000u); ss+=f[2*e]*f[2*e]+f[2*e+1]*f[2*e+1]; }
        ss+=__shfl_xor(ss,1); ss+=__shfl_xor(ss,2); ss+=__shfl_xor(ss,4);
        const float rs=__builtin_amdgcn_rsqf(ss*(1.0f/64.0f)+1e-6f);
        const float4 g0=*reinterpret_cast<const float4*>(gm+ch*8), g1=*reinterpret_cast<const float4*>(gm+ch*8+4);
        v[0]=cvtpk_s(f[0]*rs*g0.x,f[1]*rs*g0.y); v[1]=cvtpk_s(f[2]*rs*g0.z,f[3]*rs*g0.w); v[2]=cvtpk_s(f[4]*rs*g1.x,f[5]*rs*g1.y); v[3]=cvtpk_s(f[6]*rs*g1.z,f[7]*rs*g1.w); }
      ATTN_STORE16(Ow+(long)row*PO+ch*8,v);} }
  asm volatile("s_waitcnt lgkmcnt(0)\n\ts_barrier":::"memory");
  #undef DMA_K
  #undef DMA_V
  #undef CMASK
  #undef START
  #undef RESC
  #undef ROT
}
constexpr int ATTN_LDS_BYTES=LDS_BYTES;
#undef SBAR
#undef WAIT_BAR
}
typedef unsigned short bf16;
constexpr int T = 65536, DM = 1024, SEQ = 2048, NB = 32;
constexpr size_t MiB = 1u << 20;
constexpr size_t WS_CTL = 0, WS_KMEAN = 1 * MiB, WS_ZERO_BYTES = 2 * MiB;
constexpr size_t WS_ROPE = 2 * MiB, WS_SCAL = 3 * MiB;
constexpr size_t WS_WIN = 4 * MiB, WS_WOUT = 10 * MiB, WS_WQ = 12 * MiB, WS_SUBK = 16 * MiB;
constexpr size_t WS_DOWN = 32 * MiB, WS_UP = 64 * MiB, WS_XN = 96 * MiB;
constexpr size_t WS_QKV = 224 * MiB, QKV_STRIDE = 64 * MiB;
constexpr size_t WS_PQ = 224 * MiB;
constexpr size_t WS_MIXED = 608 * MiB, WS_DO = 736 * MiB, WS_IDS = 864 * MiB, WS_GATES = 896 * MiB, WS_END = 928 * MiB;
constexpr size_t QKV_ELEMS = QKV_STRIDE / 2;
constexpr float QSCALE = 0.125f * 1.4426950408889634f;
constexpr float EPS = 1e-6f;

__device__ __forceinline__ unsigned f2bf(float f) { unsigned u = __float_as_uint(f); return (u + 0x7fffu + ((u >> 16) & 1u)) >> 16; }
__device__ __forceinline__ float bf2f(unsigned h) { return __uint_as_float(h << 16); }
__device__ __forceinline__ float wave_sum(float v) {
#pragma unroll
    for (int o = 1; o < 64; o <<= 1) v += __shfl_xor(v, o);
    return v;
}

#define LAS __attribute__((address_space(3)))
constexpr int NTHR = 512, NWAVE = 8;
constexpr int LDS_BYTES = 147456;

struct Params {
    const float* in[19]; float* out; unsigned char* ws;
};

__device__ __forceinline__ void ph_transpose(const float* __restrict__ W, int K, int N, bf16* __restrict__ WT, float* tiles, int wg, int nwg, int tid) {
    float (*tile)[33] = (float (*)[33])(tiles + (tid >> 8) * (32 * 33));
    const int nt_n = N / 32, nitems = nt_n * (K / 32), tx = tid & 31, ty = (tid & 255) >> 5;
    for (int it0 = wg * 2; it0 < nitems; it0 += nwg * 2) {
        const int it = it0 + (tid >> 8); const bool act = it < nitems;
        const int n0 = (it % nt_n) * 32, k0 = (it / nt_n) * 32;
        if (act) for (int i = ty; i < 32; i += 8) tile[i][tx] = W[(size_t)(k0 + i) * N + n0 + tx];
        __syncthreads();
        if (act) for (int i = ty; i < 32; i += 8) WT[(size_t)(n0 + i) * K + k0 + tx] = (bf16)f2bf(tile[tx][i]);
        __syncthreads();
    }
}
__device__ __forceinline__ void ph_convert(const float* __restrict__ src, bf16* __restrict__ dst, size_t n4, int wg, int nwg, int tid) {
    for (size_t i = (size_t)wg * NTHR + tid; i < n4; i += (size_t)nwg * NTHR) {
        const float4 v = ((const float4*)src)[i];
        uint2 o; o.x = f2bf(v.x) | (f2bf(v.y) << 16); o.y = f2bf(v.z) | (f2bf(v.w) << 16);
        ((uint2*)dst)[i] = o;
    }
}
__device__ __forceinline__ void ph_rope(float* __restrict__ rope, int wg, int nwg, int tid) {
    for (int i = wg * NTHR + tid; i < SEQ * 32; i += nwg * NTHR) {
        const int pos = i >> 5, j = i & 31;
        const float inv = 1.0f / exp2f((float)j * (13.287712379549449f / 32.0f));
        const float ang = (float)pos * inv;
        double rev = (double)ang * 0.15915494309189535; rev -= floor(rev);
        rope[i] = __builtin_amdgcn_cosf((float)rev); rope[SEQ * 32 + i] = __builtin_amdgcn_sinf((float)rev);
    }
}
__device__ __forceinline__ void ph_rmsnorm(const float* __restrict__ x, const float* __restrict__ g, bf16* __restrict__ out, int rows, int wg, int nwg, int tid) {
    const int lane = tid & 63, nw = nwg * NWAVE;
    for (int r = wg * NWAVE + (tid >> 6); r < rows; r += nw) {
        const float4* xr = (const float4*)(x + (size_t)r * DM) + lane;
        float4 v[4]; float s = 0.f;
#pragma unroll
        for (int j = 0; j < 4; ++j) { v[j] = xr[64 * j]; s += (v[j].x * v[j].x + v[j].y * v[j].y) + (v[j].z * v[j].z + v[j].w * v[j].w); }
        const float rs = rsqrtf(wave_sum(s) * (1.0f / DM) + EPS);
        uint2* o = (uint2*)(out + (size_t)r * DM) + lane;
#pragma unroll
        for (int j = 0; j < 4; ++j) { const float4 gg = ((const float4*)g)[lane + 64 * j];
            uint2 w; w.x = f2bf(v[j].x * rs * gg.x) | (f2bf(v[j].y * rs * gg.y) << 16); w.y = f2bf(v[j].z * rs * gg.z) | (f2bf(v[j].w * rs * gg.w) << 16);
            o[64 * j] = w; }
    }
}
__device__ __forceinline__ void ph_qk_post(bf16* __restrict__ qkv, const float* __restrict__ rope, const float* __restrict__ gqm, const float* __restrict__ gkm,
                                           const float* __restrict__ gqd, const float* __restrict__ gkd, float* __restrict__ kmean, int wg, int nwg, int tid) {
    const int lane = tid & 63, half = lane >> 5, j = lane & 31, wv = tid >> 6;
    for (int blk = wg; blk < T / 256; blk += nwg) {
        float ks[4][2];
#pragma unroll
        for (int a = 0; a < 4; ++a) { ks[a][0] = 0.f; ks[a][1] = 0.f; }
        for (int tt = wv; tt < 256; tt += NWAVE) {
            const int t = blk * 256 + tt, pos = t & (SEQ - 1);
            const float c = rope[pos * 32 + j], sn = rope[SEQ * 32 + pos * 32 + j];
#pragma unroll
            for (int it = 0; it < 16; ++it) {
                const int s = it * 2 + half, type = it >> 2, hs = s & 7;
                bf16* buf = qkv + (size_t)(type < 2 ? type : type + 1) * QKV_ELEMS + (size_t)t * 512 + hs * 64;
                const float x1 = bf2f(buf[j]), x2 = bf2f(buf[j + 32]);
                float ss = x1 * x1 + x2 * x2;
#pragma unroll
                for (int o = 1; o < 32; o <<= 1) ss += __shfl_xor(ss, o);
                const float rs = rsqrtf(ss * (1.0f / 64.0f) + EPS);
                const float* g = type == 0 ? gqm : type == 1 ? gkm : type == 2 ? gqd + (hs & 1) * 64 : gkd + (hs & 1) * 64;
                const float y1 = x1 * rs * g[j], y2 = x2 * rs * g[j + 32];
                float o1 = y1 * c - y2 * sn, o2 = y2 * c + y1 * sn;
                if (type == 0 || type == 2) { o1 *= QSCALE; o2 *= QSCALE; }
                if (type == 1) { ks[it - 4][0] += o1; ks[it - 4][1] += o2; }
                buf[j] = (bf16)f2bf(o1); buf[j + 32] = (bf16)f2bf(o2);
            }
        }
        const int b = blk >> 3, nb = blk & 7;
#pragma unroll
        for (int a = 0; a < 4; ++a) { const int h = a * 2 + half; float* km = kmean + (((size_t)b * 8 + h) * 8 + nb) * 64;
            atomicAdd(km + j, ks[a][0] * (1.0f / 256.0f)); atomicAdd(km + j + 32, ks[a][1] * (1.0f / 256.0f)); }
    }
}
__device__ __forceinline__ void ph_diff_combine(const bf16* __restrict__ dob, float lam, const float* __restrict__ gain_d, bf16* __restrict__ mixed, int wg, int nwg, int tid) {
    const int lane = tid & 63, nw = nwg * NWAVE;
    for (int w = wg * NWAVE + (tid >> 6); w < T * 4; w += nw) {
        const int t = w >> 2, h = w & 3; const bf16* p = dob + (size_t)t * 1024 + h * 256;
        const float da = bf2f(p[lane]) - lam * bf2f(p[128 + lane]), db = bf2f(p[64 + lane]) - lam * bf2f(p[192 + lane]);
        const float rs = rsqrtf(wave_sum(da * da + db * db) * (1.0f / 128.0f) + EPS) * 0.8f;
        bf16* o = mixed + (size_t)t * 1024 + 512 + h * 128;
        o[lane] = (bf16)f2bf(da * rs * gain_d[h * 128 + lane]); o[64 + lane] = (bf16)f2bf(db * rs * gain_d[h * 128 + 64 + lane]);
    }
}
__device__ __forceinline__ void wave_argmax(float& v, int& idx) {
#pragma unroll
    for (int o = 32; o >= 1; o >>= 1) { const float ov = __shfl_xor(v, o); const int oi = __shfl_xor(idx, o); if (ov > v || (ov == v && oi < idx)) { v = ov; idx = oi; } }
}
__device__ __forceinline__ void ph_peer_route(const bf16* __restrict__ PQ, const bf16* __restrict__ subk, int* __restrict__ ids, float* __restrict__ gates, float* ldsf, int wg, int nwg, int tid) {
    const int lane = tid & 63, wv = tid >> 6, nw = nwg * NWAVE;
    float* ts = ldsf + wv * 64; int* ti = (int*)(ldsf + wv * 64 + 32);
    for (int w = wg * NWAVE + wv; w < T * 8; w += nw) {
        const int t = w >> 3, h = w & 7; const bf16* q = PQ + (size_t)t * 2048 + h * 256;
        for (int p = 0; p < 2; ++p) {
            const bf16* k0 = subk + ((size_t)(h * 2 + p) * 128 + lane) * 128; const bf16* k1 = k0 + 64 * 128;
            float s0 = 0.f, s1 = 0.f;
            for (int d = 0; d < 128; d += 8) { const uint4 a = *(const uint4*)(k0 + d), bq = *(const uint4*)(k1 + d), qq = *(const uint4*)(q + p * 128 + d);
                const unsigned av[4] = {a.x, a.y, a.z, a.w}, bv[4] = {bq.x, bq.y, bq.z, bq.w}, qv[4] = {qq.x, qq.y, qq.z, qq.w};
#pragma unroll
                for (int e = 0; e < 4; ++e) { const float ql = __uint_as_float(qv[e] << 16), qh = __uint_as_float(qv[e] & 0xffff0000u);
                    s0 += ql * __uint_as_float(av[e] << 16) + qh * __uint_as_float(av[e] & 0xffff0000u);
                    s1 += ql * __uint_as_float(bv[e] << 16) + qh * __uint_as_float(bv[e] & 0xffff0000u); } }
            for (int r = 0; r < 16; ++r) { float v = s0; int idx = lane; if (s1 > v) { v = s1; idx = lane + 64; }
                wave_argmax(v, idx);
                if (lane == 0) { ts[p * 16 + r] = v; ti[p * 16 + r] = idx; }
                if (lane == (idx & 63)) { if (idx >= 64) s1 = -3.0e38f; else s0 = -3.0e38f; } }
        }
        __builtin_amdgcn_s_waitcnt(0xC07F); __builtin_amdgcn_wave_barrier();
        float cv[4];
#pragma unroll
        for (int e = 0; e < 4; ++e) { const int ci = lane * 4 + e; cv[e] = ts[ci >> 4] + ts[16 + (ci & 15)]; }
        int bidx = 0; float mysc = 0.f;
        for (int r = 0; r < 16; ++r) { float v = cv[0]; int idx = lane * 4;
#pragma unroll
            for (int e = 1; e < 4; ++e) if (cv[e] > v) { v = cv[e]; idx = lane * 4 + e; }
            wave_argmax(v, idx);
            if (lane == r) { mysc = v; bidx = idx; }
            if (lane == (idx >> 2)) {
#pragma unroll
                for (int e = 0; e < 4; ++e) if ((idx & 3) == e) cv[e] = -3.0e38f; } }
        const float top = __shfl(mysc, 0); const float ex = lane < 16 ? expf(mysc - top) : 0.f;
        float sum = ex;
#pragma unroll
        for (int o = 1; o < 16; o <<= 1) sum += __shfl_xor(sum, o);
        if (lane < 16) { const int e = ti[bidx >> 4] * 128 + ti[16 + (bidx & 15)];
            ids[(size_t)t * 128 + h * 16 + lane] = e; gates[(size_t)t * 128 + h * 16 + lane] = ex / sum; }
        __builtin_amdgcn_s_waitcnt(0xC07F); __builtin_amdgcn_wave_barrier();
    }
}
__device__ __forceinline__ float dot8(const uint4 a, const uint4 b) {
    float s = 0.f; const unsigned av[4] = {a.x, a.y, a.z, a.w}, bv[4] = {b.x, b.y, b.z, b.w};
#pragma unroll
    for (int e = 0; e < 4; ++e) s += __uint_as_float(av[e] << 16) * __uint_as_float(bv[e] << 16) + __uint_as_float(av[e] & 0xffff0000u) * __uint_as_float(bv[e] & 0xffff0000u);
    return s;
}
__device__ __forceinline__ void ph_peer_gather(const bf16* __restrict__ xn, const int* __restrict__ ids, const float* __restrict__ gates, const bf16* __restrict__ down, const bf16* __restrict__ up, float* __restrict__ out, int wg, int nwg, int tid) {
    const int lane = tid & 63, nw = nwg * NWAVE;
    for (int t = wg * NWAVE + (tid >> 6); t < T; t += nw) {
        const uint4 xa = *(const uint4*)(xn + (size_t)t * DM + lane * 8), xb = *(const uint4*)(xn + (size_t)t * DM + 512 + lane * 8);
        float acc[16];
#pragma unroll
        for (int i = 0; i < 16; ++i) acc[i] = 0.f;
        for (int e = 0; e < 128; ++e) {
            const int id = ids[(size_t)t * 128 + e]; const float gt = gates[(size_t)t * 128 + e];
            const bf16* dr = down + (size_t)id * DM; const bf16* ur = up + (size_t)id * DM;
            const uint4 da = *(const uint4*)(dr + lane * 8), db = *(const uint4*)(dr + 512 + lane * 8);
            const uint4 ua = *(const uint4*)(ur + lane * 8), ub = *(const uint4*)(ur + 512 + lane * 8);
            const float z = wave_sum(dot8(xa, da) + dot8(xb, db));
            const float w = gt * 0.5f * z * (1.0f + erff(z * 0.70710678118654752f));
            const unsigned uav[4] = {ua.x, ua.y, ua.z, ua.w}, ubv[4] = {ub.x, ub.y, ub.z, ub.w};
#pragma unroll
            for (int i = 0; i < 4; ++i) { acc[2 * i] += w * __uint_as_float(uav[i] << 16); acc[2 * i + 1] += w * __uint_as_float(uav[i] & 0xffff0000u);
                acc[8 + 2 * i] += w * __uint_as_float(ubv[i] << 16); acc[8 + 2 * i + 1] += w * __uint_as_float(ubv[i] & 0xffff0000u); }
        }
        float* o = out + (size_t)t * DM;
        float4 r0 = *(float4*)(o + lane * 8), r1 = *(float4*)(o + lane * 8 + 4), r2 = *(float4*)(o + 512 + lane * 8), r3 = *(float4*)(o + 512 + lane * 8 + 4);
        r0.x += acc[0]; r0.y += acc[1]; r0.z += acc[2]; r0.w += acc[3]; r1.x += acc[4]; r1.y += acc[5]; r1.z += acc[6]; r1.w += acc[7];
        r2.x += acc[8]; r2.y += acc[9]; r2.z += acc[10]; r2.w += acc[11]; r3.x += acc[12]; r3.y += acc[13]; r3.z += acc[14]; r3.w += acc[15];
        *(float4*)(o + lane * 8) = r0; *(float4*)(o + lane * 8 + 4) = r1; *(float4*)(o + 512 + lane * 8) = r2; *(float4*)(o + 512 + lane * 8 + 4) = r3;
    }
}
__global__ void __launch_bounds__(NTHR, 2) mk_fwd(Params P) {
    extern __shared__ __attribute__((aligned(16))) unsigned char lds[];
    cg::grid_group grid = cg::this_grid();
    const int wg = blockIdx.x, nwg = gridDim.x;
    unsigned char* ws = P.ws; float* out = P.out;
    const float* x = P.in[0];
    bf16* WinT = (bf16*)(ws + WS_WIN); bf16* WoutT = (bf16*)(ws + WS_WOUT); bf16* WqT = (bf16*)(ws + WS_WQ); bf16* SUBK = (bf16*)(ws + WS_SUBK);
    bf16* DOWN = (bf16*)(ws + WS_DOWN); bf16* UP = (bf16*)(ws + WS_UP); bf16* XN = (bf16*)(ws + WS_XN); bf16* QKV = (bf16*)(ws + WS_QKV); bf16* PQ = (bf16*)(ws + WS_PQ);
    bf16* MIXED = (bf16*)(ws + WS_MIXED); bf16* DOB = (bf16*)(ws + WS_DO); int* IDS = (int*)(ws + WS_IDS); float* GATES = (float*)(ws + WS_GATES);
    float* ROPE = (float*)(ws + WS_ROPE); float* KMEAN = (float*)(ws + WS_KMEAN);

    ph_transpose(P.in[2], 1024, 3072, WinT, (float*)lds, wg, nwg, fresh_tid());
    ph_transpose(P.in[13], 1024, 1024, WoutT, (float*)lds, wg, nwg, fresh_tid());
    ph_transpose(P.in[15], 1024, 2048, WqT, (float*)lds, wg, nwg, fresh_tid());
    ph_convert(P.in[16], SUBK, (size_t)16 * 128 * 128 / 4, wg, nwg, fresh_tid());
    ph_convert(P.in[17], DOWN, (size_t)16384 * 1024 / 4, wg, nwg, fresh_tid());
    ph_convert(P.in[18], UP, (size_t)16384 * 1024 / 4, wg, nwg, fresh_tid());
    ph_rope(ROPE, wg, nwg, fresh_tid());
    ph_rmsnorm(x, P.in[1], XN, T, wg, nwg, fresh_tid());
    float lam; { float a = 0.f, b = 0.f; for (int i = 0; i < 64; ++i) { a += P.in[7][i] * P.in[8][i]; b += P.in[9][i] * P.in[10][i]; } lam = expf(a) - expf(b) + 0.2f; }
    grid.sync();
    { pg8::Gemm g{XN, WinT, T, 3072, 1024}; pg8::EpiBf16 E{QKV, 512, 512, QKV_ELEMS}; pg8::StaticOrder S; S.init(g.M, g.N, nwg, wg);
      pg8::gemm_phase<pg8::EpiBf16, pg8::StaticOrder, true, true>((PG8_LAS unsigned char*)lds, g, S, E); }
    grid.sync();
    ph_qk_post(QKV, ROPE, P.in[3], P.in[4], P.in[5], P.in[6], KMEAN, wg, nwg, fresh_tid());
    grid.sync();
    { const float* gain_m = P.in[11];
      for (int combo = wg; combo < NB * 8; combo += nwg) {
        const int b = combo >> 3, hd = combo & 7; const size_t brow = (size_t)b * SEQ;
        for (int qb = 7; qb >= 0; --qb) { const size_t qrow = brow + (size_t)qb * 256;
            attn_body::attn_unit<8, true>(qb, (const attn_body::bf16*)(QKV + qrow * 512 + hd * 64), (const attn_body::bf16*)(QKV + QKV_ELEMS + brow * 512 + hd * 64),
                (const attn_body::bf16*)(QKV + 2 * QKV_ELEMS + brow * 512 + hd * 64), (attn_body::bf16*)(MIXED + qrow * 1024 + hd * 64), KMEAN + ((size_t)b * 8 + hd) * 512, gain_m + hd * 64, (char*)lds); }
      }
      for (int combo = wg; combo < NB * 16; combo += nwg) {
        const int b = combo >> 4, jj = combo & 15, h = jj >> 2, m = (jj >> 1) & 1, c = jj & 1; const size_t brow = (size_t)b * SEQ;
        for (int qb = 7; qb >= 0; --qb) { const size_t qrow = brow + (size_t)qb * 256;
            attn_body::attn_unit<8, false>(qb, (const attn_body::bf16*)(QKV + 3 * QKV_ELEMS + qrow * 512 + h * 128 + m * 64), (const attn_body::bf16*)(QKV + 4 * QKV_ELEMS + brow * 512 + h * 128 + m * 64),
                (const attn_body::bf16*)(QKV + 5 * QKV_ELEMS + brow * 512 + h * 128 + c * 64), (attn_body::bf16*)(DOB + qrow * 1024 + h * 256 + m * 128 + c * 64), nullptr, nullptr, (char*)lds); }
      } }
    grid.sync();
    ph_diff_combine(DOB, lam, P.in[12], MIXED, wg, nwg, fresh_tid());
    grid.sync();
    { pg8::Gemm g{MIXED, WoutT, T, 1024, 1024}; pg8::EpiResF32 E{x, out, 1024}; pg8::StaticOrder S; S.init(g.M, g.N, nwg, wg);
      pg8::gemm_phase<pg8::EpiResF32, pg8::StaticOrder, true, true>((PG8_LAS unsigned char*)lds, g, S, E); }
    grid.sync();
    ph_rmsnorm(out, P.in[14], XN, T, wg, nwg, fresh_tid());
    grid.sync();
    { pg8::Gemm g{XN, WqT, T, 2048, 1024}; pg8::EpiBf16 E{PQ, 2048, 0, 0}; pg8::StaticOrder S; S.init(g.M, g.N, nwg, wg);
      pg8::gemm_phase<pg8::EpiBf16, pg8::StaticOrder, true, true>((PG8_LAS unsigned char*)lds, g, S, E); }
    grid.sync();
    ph_peer_route(PQ, SUBK, IDS, GATES, (float*)lds, wg, nwg, fresh_tid());
    grid.sync();
    ph_peer_gather(XN, IDS, GATES, DOWN, UP, out, wg, nwg, fresh_tid());
}

extern "C" void kernel_launch(void* const* d_in, const int* in_sizes, int n_in, void* d_out, int out_size, void* d_ws, size_t ws_size, hipStream_t stream) {
    static int grid_blocks = 0;
    if (grid_blocks == 0) {
        if (n_in != 19 || in_sizes[0] != T * DM || out_size != T * DM || ws_size < WS_END) { fprintf(stderr, "kernel_launch: unexpected shapes (n_in %d in0 %d out %d ws %zu)\n", n_in, n_in > 0 ? in_sizes[0] : -1, out_size, ws_size); grid_blocks = -1; return; }
        int dev = 0, cus = 0, per_cu = 0;
        (void)hipGetDevice(&dev); (void)hipDeviceGetAttribute(&cus, hipDeviceAttributeMultiprocessorCount, dev);
        (void)hipFuncSetAttribute((const void*)mk_fwd, hipFuncAttributeMaxDynamicSharedMemorySize, LDS_BYTES);
        (void)hipOccupancyMaxActiveBlocksPerMultiprocessor(&per_cu, (const void*)mk_fwd, NTHR, LDS_BYTES);
        if (per_cu < 1 || cus < 1) { fprintf(stderr, "kernel_launch: occupancy query says %d blocks/CU on %d CUs\n", per_cu, cus); grid_blocks = -1; return; }
        if (per_cu > 1) per_cu = 1;
        grid_blocks = cus * per_cu;
    }
    if (grid_blocks < 0) return;
    (void)hipMemsetAsync(d_ws, 0, WS_ZERO_BYTES, stream);
    Params p{};
    for (int i = 0; i < 19; ++i) p.in[i] = (const float*)d_in[i];
    p.out = (float*)d_out; p.ws = (unsigned char*)d_ws;
    void* args[] = {&p};
    hipError_t e = hipLaunchCooperativeKernel((const void*)mk_fwd, dim3(grid_blocks), dim3(NTHR), args, LDS_BYTES, stream);
    if (e != hipSuccess) fprintf(stderr, "cooperative launch failed: %s (grid %d)\n", hipGetErrorString(e), grid_blocks);
}
```

```cpp
#include <hip/hip_runtime.h>
#include <hip/hip_cooperative_groups.h>
#include <cstdio>
#include <cstdint>
namespace cg = cooperative_groups;
__device__ __forceinline__ int fresh_tid() { int t = threadIdx.x; asm volatile("" : "+v"(t)); return t; }
namespace pg8 {
#define PG8_LAS __attribute__((address_space(3)))
typedef unsigned short bf16_t;
typedef short bf16x8 __attribute__((ext_vector_type(8)));
typedef float f32x4 __attribute__((ext_vector_type(4)));
typedef unsigned u32x4 __attribute__((ext_vector_type(4)));
constexpr int BM = 256, BK = 64, HALF = 128, HTB = HALF * BK * 2  , STAGE_BYTES = 8 * HTB, NXCD = 8, WGM = 8;

__host__ __device__ __forceinline__ int lds_byte(int r, int c) { const int st = (r >> 4) * 2 + (c >> 5), rr = r & 15, cc = c & 31, ob = rr * 64 + cc * 2; return st * 1024 + (ob ^ (((ob >> 9) & 1) << 5)); }
__host__ __device__ __forceinline__ void stage_rc(int b, int& R, int& C) { const int st = b / 1024, sb = b % 1024, swz = sb ^ (((sb >> 9) & 1) << 5); R = (st >> 1) * 16 + swz / 64; C = (st & 1) * 32 + (swz % 64) / 2; }
__host__ __device__ __forceinline__ int perm32(int rho) { const int n = rho >> 4, i = rho & 15; return 8 * (i >> 2) + 4 * n + (i & 3); }

struct Unit { int pm, pn; };
struct Gemm { const bf16_t* A; const bf16_t* Bt; int M, N, K; };

struct StaticOrder {
    int nM, nN, nwg, G, c;
    __host__ __device__ void init(int M, int N, int G_, int c_) { nM = M / BM; nN = N / BM; nwg = nM * nN; G = G_; c = c_; }
    __host__ __device__ bool next(int i, Unit& u) const {
        const long L = (long)i * G + c; if (L >= nwg) return false;
        int wgid = (int)L; { const int q = nwg / NXCD, r = nwg % NXCD, xcd = wgid % NXCD, off = wgid / NXCD; wgid = (xcd < r ? xcd * (q + 1) : r * (q + 1) + (xcd - r) * q) + off; }
        const int nig = WGM * nN, gid = wgid / nig, fm = gid * WGM, gsz = (nM - fm) < WGM ? (nM - fm) : WGM;
        u.pm = fm + ((wgid % nig) % gsz); u.pn = (wgid % nig) / gsz; return true;
    }
    __device__ __forceinline__ void a_ready(const Unit&) const {}
    __device__ __forceinline__ void done(const Unit&) const {}
};

__device__ __forceinline__ unsigned cvt_pk_bf16(float lo, float hi) { unsigned r; asm volatile("v_cvt_pk_bf16_f32 %0, %1, %2" : "=v"(r) : "v"(lo), "v"(hi)); return r; }
struct EpiBf16 {
    static constexpr bool PERM = true, AFTER_DRAIN = false;
    bf16_t* O; int ldc; int split_cols; size_t split_stride;
    __device__ __forceinline__ void operator()(const f32x4 (&acc)[2][2][4][2], const Unit& u, int wr, int wc, int fr, int fq) const {
        const int row0 = u.pm * BM + wr * 64 + fr; int colt = u.pn * BM; bf16_t* base = O;
        if (split_cols) { const int t = colt / split_cols; base += (size_t)t * split_stride; colt -= t * split_cols; }
        const int col0 = colt + wc * 32 + 8 * fq;
#pragma unroll
        for (int ai = 0; ai < 2; ++ai)
#pragma unroll
            for (int m = 0; m < 4; ++m) { bf16_t* rowp = base + (size_t)(row0 + ai * HALF + m * 16) * ldc + col0;
#pragma unroll
                for (int bj = 0; bj < 2; ++bj) { const f32x4 v0 = acc[ai][bj][m][0], v1 = acc[ai][bj][m][1];
                    u32x4 w; w.x = cvt_pk_bf16(v0[0], v0[1]); w.y = cvt_pk_bf16(v0[2], v0[3]); w.z = cvt_pk_bf16(v1[0], v1[1]); w.w = cvt_pk_bf16(v1[2], v1[3]);
                    *(u32x4*)(rowp + bj * HALF) = w; } }
    }
};
struct EpiResF32 {
    static constexpr bool PERM = false, AFTER_DRAIN = false;
    const float* base; float* out; int ldc;
    __device__ __forceinline__ void operator()(const f32x4 (&acc)[2][2][4][2], const Unit& u, int wr, int wc, int fr, int fq) const {
        const int col0 = u.pn * BM + wc * 32 + 4 * fq;
#pragma unroll
        for (int ai = 0; ai < 2; ++ai)
#pragma unroll
            for (int m = 0; m < 4; ++m) { const size_t off = (size_t)(u.pm * BM + ai * HALF + wr * 64 + m * 16 + fr) * ldc + col0;
#pragma unroll
                for (int bj = 0; bj < 2; ++bj)
#pragma unroll
                    for (int n = 0; n < 2; ++n) { const f32x4 bs = *(const f32x4*)(base + off + bj * HALF + n * 16); *(f32x4*)(out + off + bj * HALF + n * 16) = bs + acc[ai][bj][m][n]; } }
    }
};
template <class Epi, class Sched, bool ALIGN_EPI = false, bool SP2 = false>
__device__ __forceinline__ void gemm_phase(PG8_LAS unsigned char* lds, const Gemm g, const Sched& S, const Epi& E) {
    const int tid = fresh_tid(), wid = __builtin_amdgcn_readfirstlane(tid >> 6), lane = tid & 63, wr = wid >> 2, wc = wid & 3, fr = lane & 15, fq = lane >> 4;
    const int K = g.K, nt = K / BK;
    unsigned voffA[2], voffB[2];
#pragma unroll
    for (int i = 0; i < 2; ++i) { int R, C; stage_rc(tid * 16 + i * 8192, R, C); const int Rb = Epi::PERM ? ((R & ~31) + perm32(R & 31)) : R;
        voffA[i] = (unsigned)(R * K + C) * 2u; voffB[i] = (unsigned)(Rb * K + C) * 2u; }
    const size_t kstep = (size_t)(BK * 2);
    const size_t hstep = (size_t)HALF * K * 2;
    const size_t tstep = 2 * hstep;
    const unsigned ldsw = (unsigned)wid * 1024u;
    const int aoff = lds_byte(wr * 64 + fr, fq * 8), boff = lds_byte(wc * 32 + fr, fq * 8);
#define PG8_SA(b, h) (((b) * 2 + (h)) * HTB)
#define PG8_SB(b, h) ((4 + (b) * 2 + (h)) * HTB)
#define PG8_STAGE(bufoff, gbase, voff) do { _Pragma("unroll") for (int _i = 0; _i < 2; ++_i) \
        __builtin_amdgcn_global_load_lds((const unsigned*)((const char*)(gbase) + (voff)[_i]), (PG8_LAS unsigned*)(lds + (bufoff) + ldsw + _i * 8192), 16, 0, 0); } while (0)
#define PG8_LDA(dst, b, h) do { _Pragma("unroll") for (int m = 0; m < 4; ++m) _Pragma("unroll") for (int k = 0; k < 2; ++k) dst[m][k] = *(const PG8_LAS bf16x8*)(lds + PG8_SA(b, h) + aoff + m * 2048 + k * 1024); } while (0)
#define PG8_LDB(dst, b, h) do { _Pragma("unroll") for (int n = 0; n < 2; ++n) _Pragma("unroll") for (int k = 0; k < 2; ++k) dst[n][k] = *(const PG8_LAS bf16x8*)(lds + PG8_SB(b, h) + boff + n * 2048 + k * 1024); } while (0)
#define PG8_MMA(ai, bj, At, Bt) do { __builtin_amdgcn_s_setprio(1); _Pragma("unroll") for (int m = 0; m < 4; ++m) _Pragma("unroll") for (int n = 0; n < 2; ++n) _Pragma("unroll") for (int k = 0; k < 2; ++k) \
        acc[ai][bj][m][n] = __builtin_amdgcn_mfma_f32_16x16x32_bf16(Bt[n][k], At[m][k], acc[ai][bj][m][n], 0, 0, 0); __builtin_amdgcn_s_setprio(0); } while (0)
#define PG8_WAIT_V(n) asm volatile("s_waitcnt vmcnt(" #n ")" ::: "memory")
#define PG8_WAIT_L(n) asm volatile("s_waitcnt lgkmcnt(" #n ")" ::: "memory")
#define PG8_BAR __builtin_amdgcn_s_barrier()
#define PG8_SCHED __builtin_amdgcn_sched_barrier(0)
    Unit cur, nxt; int ui = 0;
    if (!S.next(0, cur)) return;
    f32x4 acc[2][2][4][2];
#pragma unroll
    for (int a = 0; a < 2; ++a)
#pragma unroll
        for (int b = 0; b < 2; ++b)
#pragma unroll
            for (int m = 0; m < 4; ++m)
#pragma unroll
                for (int n = 0; n < 2; ++n) acc[a][b][m][n] = (f32x4){0.f, 0.f, 0.f, 0.f};
    bf16x8 At[4][2], B0[2][2], B1[2][2];
    const char* cA = (const char*)g.A + (size_t)cur.pm * tstep; const char* cB = (const char*)g.Bt + (size_t)cur.pn * tstep;
    S.a_ready(cur);
    if constexpr (SP2) {
        PG8_STAGE(PG8_SB(0, 0), cB, voffB); PG8_STAGE(PG8_SB(0, 1), cB + hstep, voffB); PG8_STAGE(PG8_SA(0, 0), cA, voffA); PG8_STAGE(PG8_SA(0, 1), cA + hstep, voffA);
        if (wr == 1) PG8_BAR;
        PG8_WAIT_V(2); PG8_BAR;
        PG8_STAGE(PG8_SB(1, 0), cB + kstep, voffB); PG8_STAGE(PG8_SA(1, 0), cA + kstep, voffA); PG8_STAGE(PG8_SB(1, 1), cB + hstep + kstep, voffB);
        PG8_WAIT_V(6); PG8_BAR;
    } else {
        PG8_STAGE(PG8_SB(0, 0), cB, voffB); PG8_STAGE(PG8_SA(0, 0), cA, voffA); PG8_STAGE(PG8_SB(0, 1), cB + hstep, voffB); PG8_STAGE(PG8_SA(0, 1), cA + hstep, voffA);
        if (wr == 1) PG8_BAR;
        PG8_WAIT_V(4); PG8_BAR;
        PG8_STAGE(PG8_SB(1, 0), cB + kstep, voffB); PG8_STAGE(PG8_SA(1, 0), cA + kstep, voffA); PG8_STAGE(PG8_SB(1, 1), cB + hstep + kstep, voffB);
        PG8_WAIT_V(6); PG8_BAR;
    }
    for (;;) {
        const bool has_next = S.next(ui + 1, nxt);
        const char* nA = has_next ? (const char*)g.A + (size_t)nxt.pm * tstep : cA; const char* nB = has_next ? (const char*)g.Bt + (size_t)nxt.pn * tstep : cB;
        for (int t = 0; t < nt; t += 2) {
            const bool last = (t == nt - 2);
            const char* a1 = cA + (size_t)(t + 1) * kstep;
            const char* a2 = last ? nA : cA + (size_t)(t + 2) * kstep; const char* b2 = last ? nB : cB + (size_t)(t + 2) * kstep;
            const char* a3 = a2 + kstep; const char* b3 = b2 + kstep;
            if (last && has_next) S.a_ready(nxt);
            if constexpr (SP2) {
            PG8_LDB(B0, 0, 0); PG8_LDB(B1, 0, 1); PG8_SCHED; PG8_LDA(At, 0, 0); PG8_STAGE(PG8_SA(1, 1), a1 + hstep, voffA);
            PG8_WAIT_V(8); PG8_WAIT_L(0); PG8_BAR; PG8_MMA(0, 0, At, B0); PG8_MMA(0, 1, At, B1); PG8_BAR; PG8_SCHED;
            PG8_LDA(At, 0, 1); PG8_STAGE(PG8_SB(0, 0), b2, voffB); PG8_STAGE(PG8_SB(0, 1), b2 + hstep, voffB); PG8_STAGE(PG8_SA(0, 0), a2, voffA);
            PG8_WAIT_V(8); PG8_WAIT_L(0); PG8_BAR; PG8_MMA(1, 0, At, B0); PG8_MMA(1, 1, At, B1); PG8_BAR; PG8_SCHED;
            PG8_LDB(B0, 1, 0); PG8_LDB(B1, 1, 1); PG8_SCHED; PG8_LDA(At, 1, 0); PG8_STAGE(PG8_SA(0, 1), a2 + hstep, voffA);
            PG8_WAIT_V(8); PG8_WAIT_L(0); PG8_BAR; PG8_MMA(0, 0, At, B0); PG8_MMA(0, 1, At, B1); PG8_BAR; PG8_SCHED;
            PG8_LDA(At, 1, 1); PG8_STAGE(PG8_SB(1, 0), b3, voffB); PG8_STAGE(PG8_SB(1, 1), b3 + hstep, voffB); PG8_STAGE(PG8_SA(1, 0), a3, voffA);
            PG8_WAIT_V(8); PG8_WAIT_L(0); PG8_BAR; PG8_MMA(1, 0, At, B0); PG8_MMA(1, 1, At, B1); PG8_BAR; PG8_SCHED;
            } else {
            PG8_LDB(B0, 0, 0); PG8_SCHED; PG8_LDA(At, 0, 0); PG8_STAGE(PG8_SA(1, 1), a1 + hstep, voffA);
            PG8_WAIT_L(8); PG8_BAR; PG8_WAIT_L(0); PG8_MMA(0, 0, At, B0); PG8_BAR; PG8_SCHED;
            PG8_LDB(B1, 0, 1); PG8_STAGE(PG8_SB(0, 0), b2, voffB);
            PG8_BAR; PG8_WAIT_L(0); PG8_MMA(0, 1, At, B1); PG8_BAR;
            PG8_LDA(At, 0, 1); PG8_STAGE(PG8_SA(0, 0), a2, voffA);
            PG8_BAR; PG8_WAIT_L(0); PG8_MMA(1, 0, At, B0); PG8_BAR; PG8_SCHED;
            PG8_STAGE(PG8_SB(0, 1), b2 + hstep, voffB);
            PG8_WAIT_V(6); PG8_BAR; PG8_MMA(1, 1, At, B1); PG8_BAR;
            PG8_LDB(B0, 1, 0); PG8_SCHED; PG8_LDA(At, 1, 0); PG8_STAGE(PG8_SA(0, 1), a2 + hstep, voffA);
            PG8_WAIT_L(8); PG8_BAR; PG8_WAIT_L(0); PG8_MMA(0, 0, At, B0); PG8_BAR; PG8_SCHED;
            PG8_LDB(B1, 1, 1); PG8_STAGE(PG8_SB(1, 0), b3, voffB);
            PG8_BAR; PG8_WAIT_L(0); PG8_MMA(0, 1, At, B1); PG8_BAR;
            PG8_LDA(At, 1, 1); PG8_STAGE(PG8_SA(1, 0), a3, voffA);
            PG8_BAR; PG8_WAIT_L(0); PG8_MMA(1, 0, At, B0); PG8_BAR; PG8_SCHED;
            PG8_STAGE(PG8_SB(1, 1), b3 + hstep, voffB);
            PG8_WAIT_V(6); PG8_BAR; PG8_MMA(1, 1, At, B1); PG8_BAR;
            }
        }
        if constexpr (ALIGN_EPI) { if (wr == 0) PG8_BAR; }
        if constexpr (!Epi::AFTER_DRAIN) { E(acc, cur, wr, wc, fr, fq); S.done(cur); }
        if (!has_next) break;
#pragma unroll
        for (int a = 0; a < 2; ++a)
#pragma unroll
            for (int b = 0; b < 2; ++b)
#pragma unroll
                for (int m = 0; m < 4; ++m)
#pragma unroll
                    for (int n = 0; n < 2; ++n) acc[a][b][m][n] = (f32x4){0.f, 0.f, 0.f, 0.f};
        cur = nxt; cA = nA; cB = nB; ++ui;
        if constexpr (ALIGN_EPI) { if (wr == 1) PG8_BAR; }
    }
    PG8_WAIT_V(0);
    if constexpr (!ALIGN_EPI) { if (wr == 0) PG8_BAR; }
    PG8_BAR;
    if constexpr (Epi::AFTER_DRAIN) { E.fused(acc, cur, wr, wc, fr, fq, lds, wid, lane); S.done(cur); }
#undef PG8_SA
#undef PG8_SB
#undef PG8_STAGE
#undef PG8_LDA
#undef PG8_LDB
#undef PG8_MMA
#undef PG8_WAIT_V
#undef PG8_WAIT_L
#undef PG8_BAR
#undef PG8_SCHED
}
}
#include <hip/hip_bf16.h>
#include <cmath>
namespace attn_body {
using bf16=__hip_bfloat16;
using bf16x8=__attribute__((ext_vector_type(8)))short;
using s16x4=__attribute__((ext_vector_type(4)))short;
using f32x16=__attribute__((ext_vector_type(16)))float;
using u32x4=__attribute__((ext_vector_type(4)))unsigned;
constexpr int SEQ=2048,D=64,DM=512,PO=1024;
constexpr int NW=8,QBLK=32,QB=QBLK*NW,KVBLK=64,NQB=SEQ/QB;
constexpr int ATTN_UNIT_ROWS=QB;
__device__ __forceinline__ int crow(int r,int hi){return (r&3)+8*(r>>2)+4*hi;}
#define SBAR() __builtin_amdgcn_sched_barrier(0)
__device__ __forceinline__ void cmask(f32x16&p0,f32x16&p1,int jb,int qrel,int hi){
  const float NEG=-INFINITY; int kb=64*jb+4*hi;
  #pragma unroll
  for(int r=0;r<16;++r){int kv=kb+(r&3)+8*(r>>2); if(kv>qrel)p0[r]=NEG; if(kv+32>qrel)p1[r]=NEG;}
}

__device__ __forceinline__ void bmask(f32x16&p0,f32x16&p1,unsigned on){
  if(!on){
    #pragma unroll
    for(int r=0;r<16;++r){p0[r]=-INFINITY;p1[r]=-INFINITY;} }
}
constexpr int NSLOT=3, SLOTB=8192;
constexpr int LDS_K=0, LDS_V=NSLOT*SLOTB, LDS_WS=2*NSLOT*SLOTB, LDS_OST=LDS_WS+NW*64*4, LDS_BYTES=LDS_OST+NW*4096;
constexpr float C2=0.125f*1.4426950408889634f;
__device__ __forceinline__ void glds16(const void*gsrc,unsigned lds_dst){unsigned keep;
  asm volatile("s_mov_b32 %0, m0\n\ts_mov_b32 m0, %2\n\ts_nop 0\n\tglobal_load_lds_dwordx4 %1, off\n\ts_mov_b32 m0, %0":"=&s"(keep):"v"(gsrc),"s"(lds_dst):"memory");}
__device__ __forceinline__ float max3f(float a,float b,float c){float r;asm("v_max3_f32 %0, %1, %2, %3":"=v"(r):"v"(a),"v"(b),"v"(c));return r;}
__device__ __forceinline__ float max2f(float a,float b){float r;asm("v_max_f32_e32 %0, %1, %2":"=v"(r):"v"(a),"v"(b));return r;}
__device__ __forceinline__ float fadd_s(float a,float b){float r;asm("v_add_f32_e32 %0, %1, %2":"=v"(r):"v"(a),"v"(b));return r;}
__device__ __forceinline__ float fsub_s(float a,float b){float r;asm("v_sub_f32_e32 %0, %1, %2":"=v"(r):"v"(a),"v"(b));return r;}
typedef float f32x2_t __attribute__((ext_vector_type(2))); typedef __bf16 bf16x2_t __attribute__((ext_vector_type(2)));
__device__ __forceinline__ unsigned cvtpk_s(float lo,float hi){f32x2_t v={lo,hi};bf16x2_t b=__builtin_convertvector(v,bf16x2_t);return __builtin_bit_cast(unsigned,b);}
#define WAIT_BAR(N) asm volatile("s_waitcnt vmcnt(" #N ") lgkmcnt(0)\n\ts_barrier":::"memory")

__device__ __forceinline__ void qkt(f32x16&p0,f32x16&p1,const char*Kslot,const bf16x8*qr,int r32,int hi){
  const char*kb=Kslot+hi*1024+r32*16;
  #pragma unroll
  for(int d0=0;d0<4;++d0){
    const bf16x8 b0=*reinterpret_cast<const bf16x8*>(kb+d0*2048);
    const bf16x8 b1=*reinterpret_cast<const bf16x8*>(kb+d0*2048+512);
    if(d0==0){p0=__builtin_amdgcn_mfma_f32_32x32x16_bf16(b0,qr[0],f32x16{},0,0,0);p1=__builtin_amdgcn_mfma_f32_32x32x16_bf16(b1,qr[0],f32x16{},0,0,0);}
    else{p0=__builtin_amdgcn_mfma_f32_32x32x16_bf16(b0,qr[d0],p0,0,0,0);p1=__builtin_amdgcn_mfma_f32_32x32x16_bf16(b1,qr[d0],p1,0,0,0);}}
}
typedef __attribute__((address_space(3))) const char* lds_cptr;
typedef short v4i16_t __attribute__((ext_vector_type(4)));
__device__ __forceinline__ void kload8(bf16x8*kf,lds_cptr kp){
  kf[0]=*(const __attribute__((address_space(3))) bf16x8*)(kp);      kf[1]=*(const __attribute__((address_space(3))) bf16x8*)(kp+512);
  kf[2]=*(const __attribute__((address_space(3))) bf16x8*)(kp+2048); kf[3]=*(const __attribute__((address_space(3))) bf16x8*)(kp+2560);
  kf[4]=*(const __attribute__((address_space(3))) bf16x8*)(kp+4096); kf[5]=*(const __attribute__((address_space(3))) bf16x8*)(kp+4608);
  kf[6]=*(const __attribute__((address_space(3))) bf16x8*)(kp+6144); kf[7]=*(const __attribute__((address_space(3))) bf16x8*)(kp+6656);
}
__device__ __forceinline__ void kload2(bf16x8*kf,lds_cptr kp,int j){ kf[2*j]=*(const __attribute__((address_space(3))) bf16x8*)(kp+j*2048); kf[2*j+1]=*(const __attribute__((address_space(3))) bf16x8*)(kp+j*2048+512); }
__device__ __forceinline__ s16x4 vtr(lds_cptr p){ return __builtin_bit_cast(s16x4,__builtin_amdgcn_ds_read_tr16_b64_v4i16((__attribute__((address_space(3))) v4i16_t*)p)); }
__device__ __forceinline__ float rowmax(const f32x16&p0,const f32x16&p1){
  float a=max3f(p0[0],p0[1],p1[0]),b=max3f(p0[2],p0[3],p1[1]);a=max3f(a,p1[2],p1[3]);
  #pragma unroll
  for(int r=4;r<16;r+=4){a=max3f(a,p0[r],p0[r+1]);b=max3f(b,p0[r+2],p0[r+3]);a=max3f(a,p1[r],p1[r+1]);b=max3f(b,p1[r+2],p1[r+3]);}
  const float m=max2f(a,b);
  auto rr=__builtin_amdgcn_permlane32_swap(__float_as_uint(m),__float_as_uint(m),false,false);
  return max2f(__uint_as_float(rr[0]),__uint_as_float(rr[1]));
}
__device__ __forceinline__ void pv(f32x16*o,int vb,bf16x8 pa0,bf16x8 pa1,bf16x8 pa2,bf16x8 pa3){
  #pragma unroll
  for(int d0=0;d0<2;++d0){s16x4 lo[4],hi[4];
    #pragma unroll
    for(int ks=0;ks<4;++ks){
      asm volatile("ds_read_b64_tr_b16 %0,%1 offset:%c2":"=&v"(lo[ks]):"v"(vb),"i"(d0*4096+ks*1024):"memory");
      asm volatile("ds_read_b64_tr_b16 %0,%1 offset:%c2":"=&v"(hi[ks]):"v"(vb),"i"(d0*4096+ks*1024+512):"memory");}
    asm volatile("s_waitcnt lgkmcnt(0)":::"memory");SBAR();
    #define PK(k) (bf16x8){lo[k][0],lo[k][1],lo[k][2],lo[k][3],hi[k][0],hi[k][1],hi[k][2],hi[k][3]}
    o[d0]=__builtin_amdgcn_mfma_f32_32x32x16_bf16(pa0,PK(0),o[d0],0,0,0);
    o[d0]=__builtin_amdgcn_mfma_f32_32x32x16_bf16(pa1,PK(1),o[d0],0,0,0);
    o[d0]=__builtin_amdgcn_mfma_f32_32x32x16_bf16(pa2,PK(2),o[d0],0,0,0);
    o[d0]=__builtin_amdgcn_mfma_f32_32x32x16_bf16(pa3,PK(3),o[d0],0,0,0);
    #undef PK
  }
}

#ifndef ATTN_STORE16
#define ATTN_STORE16(p,v) (*(u32x4*)(p)=(v))
#endif
template<int THRL,bool MOBA> __device__ __forceinline__ void attn_unit(int qb,const bf16*Qu,const bf16*__restrict__ Kh,const bf16*__restrict__ Vh,bf16*Ou,const float*__restrict__ km,const float*__restrict__ gm,char*shm){
  const int tid=fresh_tid(),lane=tid&63,r32=lane&31,hi=lane>>5; const int wid=__builtin_amdgcn_readfirstlane(tid>>6);
  const int q0=qb*QB;
  const bf16*Qw=Qu+(long)(wid*QBLK)*DM;
  const unsigned lds0=(unsigned)(uintptr_t)shm;
  float*wsf=(float*)(shm+LDS_WS)+wid*64;
  const bf16*ksrc=Kh+(long)lane*DM+wid*8;
  const bf16*vsrc=Vh+(long)(16*(wid&3)+(lane>>2))*DM+(wid>>2)*32+(lane&3)*8;
  const unsigned kdst=lds0+LDS_K+wid*1024, vdst=lds0+LDS_V+wid*1024;
  #define DMA_K(t,slot) glds16(ksrc+(long)(t)*KVBLK*DM,(unsigned)__builtin_amdgcn_readfirstlane(kdst+(slot)))
  #define DMA_V(t,slot) glds16(vsrc+(long)(t)*KVBLK*DM,(unsigned)__builtin_amdgcn_readfirstlane(vdst+(slot)))
  const int vb0=(int)(lds0+LDS_V)+((lane>>4)&1)*32+(lane&3)*8+(4*hi+((lane&15)>>2))*64;
  const char*Kbase=shm+LDS_K; bf16x8 kf[8];
  const lds_cptr shm3=(lds_cptr)shm; const lds_cptr kp0=shm3+LDS_K+hi*1024+r32*16; const lds_cptr vp0=shm3+LDS_V+((lane>>4)&1)*32+(lane&3)*8+(4*hi+((lane&15)>>2))*64;
  const int NT=(q0+QB)/KVBLK;
  DMA_K(0,0);DMA_V(0,0);DMA_K(1,SLOTB);
  bf16x8 qr[4];
  #pragma unroll
  for(int d0=0;d0<4;++d0)qr[d0]=*reinterpret_cast<const bf16x8*>(&Qw[(long)r32*DM+d0*16+hi*8]);
  unsigned selm=0u;
  if(MOBA){ float g[8];
    #pragma unroll
    for(int n=0;n<8;++n){ float s_=0.f; if(n<qb){
      #pragma unroll
      for(int d0=0;d0<4;++d0){ const float4 ka=*reinterpret_cast<const float4*>(km+n*64+d0*16+hi*8), kb2=*reinterpret_cast<const float4*>(km+n*64+d0*16+hi*8+4);
        const float kv[8]={ka.x,ka.y,ka.z,ka.w,kb2.x,kb2.y,kb2.z,kb2.w};
        #pragma unroll
        for(int j=0;j<8;++j)s_+=__uint_as_float(((unsigned)(unsigned short)qr[d0][j])<<16)*kv[j]; }
      s_+=__shfl_xor(s_,32); } g[n]=s_; asm volatile("":"+v"(s_)::"memory"); SBAR(); }
    #pragma unroll
    for(int r=0;r<3;++r){ float best=-3.0e38f; int bi=-1;
      #pragma unroll
      for(int n=0;n<8;++n) if(n<qb&&!((selm>>n)&1u)&&g[n]>best){best=g[n];bi=n;}
      if(bi>=0)selm|=1u<<bi; } }
  float l_reg=0.f;f32x16 o[2];o[0]=f32x16{};o[1]=f32x16{};
  const int qrel=wid*QBLK+r32;
  #define CMASK(P0,P1,t) do{int jb_=(t)-(NT-4); if(jb_>=0)cmask(P0,P1,jb_,qrel,hi); else if(MOBA) bmask(P0,P1,(selm>>((t)>>2))&1u);}while(0)
  #define START(P0,P1) do{ _Pragma("unroll") for(int r=0;r<16;++r)P0[r]=__builtin_amdgcn_exp2f(P0[r]); }while(0)
  #define RESC() do{}while(0)
  f32x16 pA0,pA1,pB0,pB1;
  int sl_prev=0,sl_cur=0,sl_next=SLOTB;
  #define ROT() do{sl_prev=sl_cur;sl_cur=sl_next;sl_next=(sl_next==(NSLOT-1)*SLOTB)?0:sl_next+SLOTB;}while(0)
  DMA_K(2,2*SLOTB);
  WAIT_BAR(3);
  qkt(pA0,pA1,Kbase,qr,r32,hi);asm volatile("s_nop 15\n\ts_nop 7":"+v"(pA0),"+v"(pA1));CMASK(pA0,pA1,0);
  START(pA0,pA1);
  _Pragma("unroll") for(int r=0;r<16;++r)pA1[r]=__builtin_amdgcn_exp2f(pA1[r]);
  WAIT_BAR(0);
  DMA_K(3,0);DMA_V(1,SLOTB);
  ROT();
  kload8(kf,kp0+sl_cur);
  WAIT_BAR(2);
  s16x4 vlo[8],vhi[8]; u32x4 pw0,pw1,pw2,pw3;
  #define PKW(P,B) cvtpk_s(P[B],P[B+1])
  #define PAF(k) __builtin_bit_cast(bf16x8,pw##k)
  #define VFR(i) (bf16x8){vlo[i][0],vlo[i][1],vlo[i][2],vlo[i][3],vhi[i][0],vhi[i][1],vhi[i][2],vhi[i][3]}
  #define PIN(x) asm volatile("":"+v"(x))
  #define MX3(a,b,c) __builtin_fmaxf(__builtin_fmaxf((a),(b)),(c))
  #define GAPA(MF,A0,A1,A2,A3,W0,W1,PW) do{ MF; sacc+=A0; sacc+=A1; sacc+=A2; sacc+=A3; PIN(sacc); W0; W1; PIN(PW); SBAR(); }while(0)
  #define EX(v) __builtin_amdgcn_exp2f(v)
  #define GAPB(MF,X,B) do{ MF; X[B]=EX(X[B]); X[B+1]=EX(X[B+1]); X[B+2]=EX(X[B+2]); X[B+3]=EX(X[B+3]); PIN(X); SBAR(); }while(0)
  #define VRD(i) do{ vlo[i]=vtr(vp_+(((i)>>2)*4096+((i)&3)*1024)); vhi[i]=vtr(vp_+(((i)>>2)*4096+((i)&3)*1024+512)); }while(0)
  #define KRD(G,j) do{ if(G){ kload2(kf,kp0+sl_next,j); SBAR(); } }while(0)
  #define STEP(C0,C1,P0,P1,t,GK,GV,GL) do{ SBAR(); \
    const lds_cptr vp_=vp0+sl_prev; \
    VRD(0); SBAR(); float sacc=(P0[0]+P0[1]); \
    GAPA(C0=__builtin_amdgcn_mfma_f32_32x32x16_bf16(kf[0],qr[0],f32x16{},0,0,0), P0[2],P0[3],P0[4],P0[5],     pw0[0]=PKW(P0,0), pw0[1]=PKW(P0,2), pw0); \
    VRD(4); SBAR(); GAPA(C1=__builtin_amdgcn_mfma_f32_32x32x16_bf16(kf[1],qr[0],f32x16{},0,0,0), P0[6],P0[7],P0[8],P0[9],     pw0[2]=PKW(P0,4), pw0[3]=PKW(P0,6), pw0); \
    VRD(1); SBAR(); GAPA(C0=__builtin_amdgcn_mfma_f32_32x32x16_bf16(kf[2],qr[1],C0,0,0,0),   P0[10],P0[11],P0[12],P0[13], pw1[0]=PKW(P0,8), pw1[1]=PKW(P0,10), pw1); \
    VRD(5); SBAR(); GAPA(C1=__builtin_amdgcn_mfma_f32_32x32x16_bf16(kf[3],qr[1],C1,0,0,0),   P0[14],P0[15],P1[0],P1[1],   pw1[2]=PKW(P0,12),pw1[3]=PKW(P0,14), pw1); \
    VRD(2); SBAR(); GAPA(C0=__builtin_amdgcn_mfma_f32_32x32x16_bf16(kf[4],qr[2],C0,0,0,0),   P1[2],P1[3],P1[4],P1[5],     pw2[0]=PKW(P1,0), pw2[1]=PKW(P1,2), pw2); \
    VRD(6); SBAR(); GAPA(C1=__builtin_amdgcn_mfma_f32_32x32x16_bf16(kf[5],qr[2],C1,0,0,0),   P1[6],P1[7],P1[8],P1[9],     pw2[2]=PKW(P1,4), pw2[3]=PKW(P1,6), pw2); \
    VRD(3); SBAR(); GAPA(C0=__builtin_amdgcn_mfma_f32_32x32x16_bf16(kf[6],qr[3],C0,0,0,0),   P1[10],P1[11],P1[12],P1[13], pw3[0]=PKW(P1,8), pw3[1]=PKW(P1,10), pw3); \
    VRD(7); SBAR(); GAPA(C1=__builtin_amdgcn_mfma_f32_32x32x16_bf16(kf[7],qr[3],C1,0,0,0),   P1[14],P1[15],0.f,0.f,       pw3[2]=PKW(P1,12),pw3[3]=PKW(P1,14), pw3); \
    l_reg+=sacc; \
    if(GK){DMA_K((t)+3,sl_cur);} if(GV){DMA_V((t)+1,sl_next);} \
    CMASK(C0,C1,t); \
    SBAR(); \
    GAPB(o[0]=__builtin_amdgcn_mfma_f32_32x32x16_bf16(PAF(0),VFR(0),o[0],0,0,0), C0,0); \
    GAPB(o[1]=__builtin_amdgcn_mfma_f32_32x32x16_bf16(PAF(0),VFR(4),o[1],0,0,0), C0,4); \
    KRD(GL,0); GAPB(o[0]=__builtin_amdgcn_mfma_f32_32x32x16_bf16(PAF(1),VFR(1),o[0],0,0,0), C0,8); \
    KRD(GL,1); GAPB(o[1]=__builtin_amdgcn_mfma_f32_32x32x16_bf16(PAF(1),VFR(5),o[1],0,0,0), C0,12); \
    KRD(GL,2); GAPB(o[0]=__builtin_amdgcn_mfma_f32_32x32x16_bf16(PAF(2),VFR(2),o[0],0,0,0), C1,0); \
    KRD(GL,3); GAPB(o[1]=__builtin_amdgcn_mfma_f32_32x32x16_bf16(PAF(2),VFR(6),o[1],0,0,0), C1,4); \
    GAPB(o[0]=__builtin_amdgcn_mfma_f32_32x32x16_bf16(PAF(3),VFR(3),o[0],0,0,0), C1,8); \
    GAPB(o[1]=__builtin_amdgcn_mfma_f32_32x32x16_bf16(PAF(3),VFR(7),o[1],0,0,0), C1,12); \
    }while(0)
  int t=1;
  #undef CMASK
  #define CMASK(P0,P1,t) do{ if(MOBA) bmask(P0,P1,(selm>>((t)>>2))&1u); }while(0)
  for(;t+5<NT;t+=2){
    STEP(pB0,pB1,pA0,pA1,t,true,true,true);     WAIT_BAR(2); RESC(); ROT();
    STEP(pA0,pA1,pB0,pB1,t+1,true,true,true);   WAIT_BAR(2); RESC(); ROT();
  }
  #undef CMASK
  #define CMASK(P0,P1,t) do{int jb_=(t)-(NT-4); if(jb_>=0)cmask(P0,P1,jb_,qrel,hi); else if(MOBA) bmask(P0,P1,(selm>>((t)>>2))&1u);}while(0)
  #define ENDW(tt) do{ if((tt)+3<NT){WAIT_BAR(2);} else if((tt)+2<NT){WAIT_BAR(1);} else {WAIT_BAR(0);} }while(0)
  for(;t+1<NT;t+=2){
    STEP(pB0,pB1,pA0,pA1,t,(t+3<NT),(t+1<NT),(t+1<NT));       ENDW(t);   RESC(); ROT();
    STEP(pA0,pA1,pB0,pB1,t+1,(t+4<NT),(t+2<NT),(t+2<NT));     ENDW(t+1); RESC(); ROT();
  }
  STEP(pB0,pB1,pA0,pA1,NT-1,false,false,false); RESC();
  { float sacc=pB0[0]+pB0[1]; _Pragma("unroll") for(int r=2;r<16;++r)sacc+=pB0[r]; _Pragma("unroll") for(int r=0;r<16;++r)sacc+=pB1[r]; l_reg+=sacc;
    pw0=(u32x4){PKW(pB0,0),PKW(pB0,2),PKW(pB0,4),PKW(pB0,6)};pw1=(u32x4){PKW(pB0,8),PKW(pB0,10),PKW(pB0,12),PKW(pB0,14)};pw2=(u32x4){PKW(pB1,0),PKW(pB1,2),PKW(pB1,4),PKW(pB1,6)};pw3=(u32x4){PKW(pB1,8),PKW(pB1,10),PKW(pB1,12),PKW(pB1,14)};
    SBAR(); pv(o,vb0+sl_cur,PAF(0),PAF(1),PAF(2),PAF(3)); }
  #undef PKW
  #undef PAF
  #undef VFR
  #undef PIN
  #undef MX3
  #undef GAPA
  #undef GAPB
  #undef EX
  #undef VRD
  #undef KRD
  #undef STEP
  #undef ENDW
  {auto rr=__builtin_amdgcn_permlane32_swap(__float_as_uint(l_reg),__float_as_uint(l_reg),false,false);l_reg=__uint_as_float(rr[0])+__uint_as_float(rr[1]);}
  if(hi==0)wsf[32+r32]=l_reg;asm volatile("s_waitcnt lgkmcnt(0)":::"memory");
  float rli[16];
  #pragma unroll
  for(int r=0;r<16;++r)rli[r]=__builtin_amdgcn_rcpf(wsf[32+crow(r,hi)]);
  bf16*Ow=Ou+(long)(wid*QBLK)*PO;
  { bf16*stg=(bf16*)(shm+LDS_OST)+wid*2048;
    #pragma unroll
    for(int r=0;r<16;++r){const int orow=crow(r,hi);
      #pragma unroll
      for(int d0=0;d0<2;++d0)stg[orow*64+d0*32+r32]=__float2bfloat16(o[d0][r]*rli[r]);}
    asm volatile("s_waitcnt lgkmcnt(0)":::"memory");
    #pragma unroll
    for(int i=0;i<4;++i){const int row=i*8+(lane>>3),ch=lane&7; u32x4 v=*(const u32x4*)(stg+row*64+ch*8);
      if(MOBA){ float f[8]; float ss=0.f;
        #pragma unroll
        for(int e=0;e<4;++e){ f[2*e]=__uint_as_float(v[e]<<16); f[2*e+1]=__uint_as_float(v[e]&0xffff0000u); ss+=f[2*e]*f[2*e]+f[2*e+1]*f[2*e+1]; }
        ss+=__shfl_xor(ss,1); ss+=__shfl_xor(ss,2); ss+=__shfl_xor(ss,4);
        const float rs=__builtin_amdgcn_rsqf(ss*(1.0f/64.0f)+1e-6f);
        const float4 g0=*reinterpret_cast<const float4*>(gm+ch*8), g1=*reinterpret_cast<const float4*>(gm+ch*8+4);
        v[0]=cvtpk_s(f[0]*rs*g0.x,f[1]*rs*g0.y); v[1]=cvtpk_s(f[2]*rs*g0.z,f[3]*rs*g0.w); v[2]=cvtpk_s(f[4]*rs*g1.x,f[5]*rs*g1.y); v[3]=cvtpk_s(f[6]*rs*g1.z,f[7]*rs*g1.w); }
      ATTN_STORE16(Ow+(long)row*PO+ch*8,v);} }
  asm volatile("s_waitcnt lgkmcnt(0)\n\ts_barrier":::"memory");
  #undef DMA_K
  #undef DMA_V
  #undef CMASK
  #undef START
  #undef RESC
  #undef ROT
}
constexpr int ATTN_LDS_BYTES=LDS_BYTES;
#undef SBAR
#undef WAIT_BAR
}
typedef unsigned short bf16;
constexpr int T = 65536, DM = 1024, SEQ = 2048, NB = 32;
constexpr size_t MiB = 1u << 20;
constexpr size_t WS_CTL = 0, WS_KMEAN = 1 * MiB, WS_ZERO_BYTES = 2 * MiB;
constexpr size_t WS_ROPE = 2 * MiB, WS_SCAL = 3 * MiB;
constexpr size_t WS_WIN = 4 * MiB, WS_WOUT = 10 * MiB, WS_WQ = 12 * MiB, WS_SUBK = 16 * MiB;
constexpr size_t WS_DOWN = 32 * MiB, WS_UP = 64 * MiB, WS_XN = 96 * MiB;
constexpr size_t WS_QKV = 224 * MiB, QKV_STRIDE = 64 * MiB;
constexpr size_t WS_PQ = 224 * MiB;
constexpr size_t WS_MIXED = 608 * MiB, WS_DO = 736 * MiB, WS_IDS = 864 * MiB, WS_GATES = 896 * MiB, WS_END = 928 * MiB;
constexpr size_t QKV_ELEMS = QKV_STRIDE / 2;
constexpr float QSCALE = 0.125f * 1.4426950408889634f;
constexpr float EPS = 1e-6f;

__device__ __forceinline__ unsigned f2bf(float f) { unsigned u = __float_as_uint(f); return (u + 0x7fffu + ((u >> 16) & 1u)) >> 16; }
__device__ __forceinline__ float bf2f(unsigned h) { return __uint_as_float(h << 16); }
__device__ __forceinline__ float wave_sum(float v) {
#pragma unroll
    for (int o = 1; o < 64; o <<= 1) v += __shfl_xor(v, o);
    return v;
}

#define LAS __attribute__((address_space(3)))
constexpr int NTHR = 512, NWAVE = 8;
constexpr int LDS_BYTES = 147456;

struct Params {
    const float* in[19]; float* out; unsigned char* ws;
};

__device__ __forceinline__ void ph_transpose(const float* __restrict__ W, int K, int N, bf16* __restrict__ WT, float* tiles, int wg, int nwg, int tid) {
    float (*tile)[33] = (float (*)[33])(tiles + (tid >> 8) * (32 * 33));
    const int nt_n = N / 32, nitems = nt_n * (K / 32), tx = tid & 31, ty = (tid & 255) >> 5;
    for (int it0 = wg * 2; it0 < nitems; it0 += nwg * 2) {
        const int it = it0 + (tid >> 8); const bool act = it < nitems;
        const int n0 = (it % nt_n) * 32, k0 = (it / nt_n) * 32;
        if (act) for (int i = ty; i < 32; i += 8) tile[i][tx] = W[(size_t)(k0 + i) * N + n0 + tx];
        __syncthreads();
        if (act) for (int i = ty; i < 32; i += 8) WT[(size_t)(n0 + i) * K + k0 + tx] = (bf16)f2bf(tile[tx][i]);
        __syncthreads();
    }
}
__device__ __forceinline__ void ph_convert(const float* __restrict__ src, bf16* __restrict__ dst, size_t n4, int wg, int nwg, int tid) {
    for (size_t i = (size_t)wg * NTHR + tid; i < n4; i += (size_t)nwg * NTHR) {
        const float4 v = ((const float4*)src)[i];
        uint2 o; o.x = f2bf(v.x) | (f2bf(v.y) << 16); o.y = f2bf(v.z) | (f2bf(v.w) << 16);
        ((uint2*)dst)[i] = o;
    }
}
__device__ __forceinline__ void ph_rope(float* __restrict__ rope, int wg, int nwg, int tid) {
    for (int i = wg * NTHR + tid; i < SEQ * 32; i += nwg * NTHR) {
        const int pos = i >> 5, j = i & 31;
        const float inv = 1.0f / exp2f((float)j * (13.287712379549449f / 32.0f));
        const float ang = (float)pos * inv;
        double rev = (double)ang * 0.15915494309189535; rev -= floor(rev);
        rope[i] = __builtin_amdgcn_cosf((float)rev); rope[SEQ * 32 + i] = __builtin_amdgcn_sinf((float)rev);
    }
}
__device__ __forceinline__ void ph_rmsnorm(const float* __restrict__ x, const float* __restrict__ g, bf16* __restrict__ out, int rows, int wg, int nwg, int tid) {
    const int lane = tid & 63, nw = nwg * NWAVE;
    for (int r = wg * NWAVE + (tid >> 6); r < rows; r += nw) {
        const float4* xr = (const float4*)(x + (size_t)r * DM) + lane;
        float4 v[4]; float s = 0.f;
#pragma unroll
        for (int j = 0; j < 4; ++j) { v[j] = xr[64 * j]; s += (v[j].x * v[j].x + v[j].y * v[j].y) + (v[j].z * v[j].z + v[j].w * v[j].w); }
        const float rs = rsqrtf(wave_sum(s) * (1.0f / DM) + EPS);
        uint2* o = (uint2*)(out + (size_t)r * DM) + lane;
#pragma unroll
        for (int j = 0; j < 4; ++j) { const float4 gg = ((const float4*)g)[lane + 64 * j];
            uint2 w; w.x = f2bf(v[j].x * rs * gg.x) | (f2bf(v[j].y * rs * gg.y) << 16); w.y = f2bf(v[j].z * rs * gg.z) | (f2bf(v[j].w * rs * gg.w) << 16);
            o[64 * j] = w; }
    }
}
__device__ __forceinline__ void ph_qk_post(bf16* __restrict__ qkv, const float* __restrict__ rope, const float* __restrict__ gqm, const float* __restrict__ gkm,
                                           const float* __restrict__ gqd, const float* __restrict__ gkd, float* __restrict__ kmean, int wg, int nwg, int tid) {
    const int lane = tid & 63, half = lane >> 5, j = lane & 31, wv = tid >> 6;
    for (int blk = wg; blk < T / 256; blk += nwg) {
        float ks[4][2];
#pragma unroll
        for (int a = 0; a < 4; ++a) { ks[a][0] = 0.f; ks[a][1] = 0.f; }
        for (int tt = wv; tt < 256; tt += NWAVE) {
            const int t = blk * 256 + tt, pos = t & (SEQ - 1);
            const float c = rope[pos * 32 + j], sn = rope[SEQ * 32 + pos * 32 + j];
#pragma unroll
            for (int it = 0; it < 16; ++it) {
                const int s = it * 2 + half, type = it >> 2, hs = s & 7;
                bf16* buf = qkv + (size_t)(type < 2 ? type : type + 1) * QKV_ELEMS + (size_t)t * 512 + hs * 64;
                const float x1 = bf2f(buf[j]), x2 = bf2f(buf[j + 32]);
                float ss = x1 * x1 + x2 * x2;
#pragma unroll
                for (int o = 1; o < 32; o <<= 1) ss += __shfl_xor(ss, o);
                const float rs = rsqrtf(ss * (1.0f / 64.0f) + EPS);
                const float* g = type == 0 ? gqm : type == 1 ? gkm : type == 2 ? gqd + (hs & 1) * 64 : gkd + (hs & 1) * 64;
                const float y1 = x1 * rs * g[j], y2 = x2 * rs * g[j + 32];
                float o1 = y1 * c - y2 * sn, o2 = y2 * c + y1 * sn;
                if (type == 0 || type == 2) { o1 *= QSCALE; o2 *= QSCALE; }
                if (type == 1) { ks[it - 4][0] += o1; ks[it - 4][1] += o2; }
                buf[j] = (bf16)f2bf(o1); buf[j + 32] = (bf16)f2bf(o2);
            }
        }
        const int b = blk >> 3, nb = blk & 7;
#pragma unroll
        for (int a = 0; a < 4; ++a) { const int h = a * 2 + half; float* km = kmean + (((size_t)b * 8 + h) * 8 + nb) * 64;
            atomicAdd(km + j, ks[a][0] * (1.0f / 256.0f)); atomicAdd(km + j + 32, ks[a][1] * (1.0f / 256.0f)); }
    }
}
__device__ __forceinline__ void ph_diff_combine(const bf16* __restrict__ dob, float lam, const float* __restrict__ gain_d, bf16* __restrict__ mixed, int wg, int nwg, int tid) {
    const int lane = tid & 63, nw = nwg * NWAVE;
    for (int w = wg * NWAVE + (tid >> 6); w < T * 4; w += nw) {
        const int t = w >> 2, h = w & 3; const bf16* p = dob + (size_t)t * 1024 + h * 256;
        const float da = bf2f(p[lane]) - lam * bf2f(p[128 + lane]), db = bf2f(p[64 + lane]) - lam * bf2f(p[192 + lane]);
        const float rs = rsqrtf(wave_sum(da * da + db * db) * (1.0f / 128.0f) + EPS) * 0.8f;
        bf16* o = mixed + (size_t)t * 1024 + 512 + h * 128;
        o[lane] = (bf16)f2bf(da * rs * gain_d[h * 128 + lane]); o[64 + lane] = (bf16)f2bf(db * rs * gain_d[h * 128 + 64 + lane]);
    }
}
typedef float rf32x16 __attribute__((ext_vector_type(16)));
typedef short rbf16x8 __attribute__((ext_vector_type(8)));
__device__ __forceinline__ unsigned umax_(unsigned a, unsigned b) { return a > b ? a : b; }
__device__ __forceinline__ unsigned umin_(unsigned a, unsigned b) { return a > b ? b : a; }
#define CE_D(x, y) { const unsigned mx_ = umax_(x, y), mn_ = umin_(x, y); x = mx_; y = mn_; }
__device__ __forceinline__ void sort16_desc(unsigned (&v)[16]) {
    CE_D(v[0], v[1]) CE_D(v[3], v[2]) CE_D(v[4], v[5]) CE_D(v[7], v[6]) CE_D(v[8], v[9]) CE_D(v[11], v[10]) CE_D(v[12], v[13]) CE_D(v[15], v[14])
    CE_D(v[0], v[2]) CE_D(v[1], v[3]) CE_D(v[6], v[4]) CE_D(v[7], v[5]) CE_D(v[8], v[10]) CE_D(v[9], v[11]) CE_D(v[14], v[12]) CE_D(v[15], v[13])
    CE_D(v[0], v[1]) CE_D(v[2], v[3]) CE_D(v[5], v[4]) CE_D(v[7], v[6]) CE_D(v[8], v[9]) CE_D(v[10], v[11]) CE_D(v[13], v[12]) CE_D(v[15], v[14])
    CE_D(v[0], v[4]) CE_D(v[1], v[5]) CE_D(v[2], v[6]) CE_D(v[3], v[7]) CE_D(v[12], v[8]) CE_D(v[13], v[9]) CE_D(v[14], v[10]) CE_D(v[15], v[11])
    CE_D(v[0], v[2]) CE_D(v[1], v[3]) CE_D(v[4], v[6]) CE_D(v[5], v[7]) CE_D(v[10], v[8]) CE_D(v[11], v[9]) CE_D(v[14], v[12]) CE_D(v[15], v[13])
    CE_D(v[0], v[1]) CE_D(v[2], v[3]) CE_D(v[4], v[5]) CE_D(v[6], v[7]) CE_D(v[9], v[8]) CE_D(v[11], v[10]) CE_D(v[13], v[12]) CE_D(v[15], v[14])
    CE_D(v[0], v[8]) CE_D(v[1], v[9]) CE_D(v[2], v[10]) CE_D(v[3], v[11]) CE_D(v[4], v[12]) CE_D(v[5], v[13]) CE_D(v[6], v[14]) CE_D(v[7], v[15])
    CE_D(v[0], v[4]) CE_D(v[1], v[5]) CE_D(v[2], v[6]) CE_D(v[3], v[7]) CE_D(v[8], v[12]) CE_D(v[9], v[13]) CE_D(v[10], v[14]) CE_D(v[11], v[15])
    CE_D(v[0], v[2]) CE_D(v[1], v[3]) CE_D(v[4], v[6]) CE_D(v[5], v[7]) CE_D(v[8], v[10]) CE_D(v[9], v[11]) CE_D(v[12], v[14]) CE_D(v[13], v[15])
    CE_D(v[0], v[1]) CE_D(v[2], v[3]) CE_D(v[4], v[5]) CE_D(v[6], v[7]) CE_D(v[8], v[9]) CE_D(v[10], v[11]) CE_D(v[12], v[13]) CE_D(v[14], v[15])
}
__device__ __forceinline__ void merge16_desc(unsigned (&a)[16], const unsigned (&b)[16]) {
    a[0] = umax_(a[0], b[15]); a[1] = umax_(a[1], b[14]); a[2] = umax_(a[2], b[13]); a[3] = umax_(a[3], b[12]); a[4] = umax_(a[4], b[11]); a[5] = umax_(a[5], b[10]); a[6] = umax_(a[6], b[9]); a[7] = umax_(a[7], b[8]); a[8] = umax_(a[8], b[7]); a[9] = umax_(a[9], b[6]); a[10] = umax_(a[10], b[5]); a[11] = umax_(a[11], b[4]); a[12] = umax_(a[12], b[3]); a[13] = umax_(a[13], b[2]); a[14] = umax_(a[14], b[1]); a[15] = umax_(a[15], b[0]);
    CE_D(a[0], a[8]) CE_D(a[1], a[9]) CE_D(a[2], a[10]) CE_D(a[3], a[11]) CE_D(a[4], a[12]) CE_D(a[5], a[13]) CE_D(a[6], a[14]) CE_D(a[7], a[15])
    CE_D(a[0], a[4]) CE_D(a[1], a[5]) CE_D(a[2], a[6]) CE_D(a[3], a[7]) CE_D(a[8], a[12]) CE_D(a[9], a[13]) CE_D(a[10], a[14]) CE_D(a[11], a[15])
    CE_D(a[0], a[2]) CE_D(a[1], a[3]) CE_D(a[4], a[6]) CE_D(a[5], a[7]) CE_D(a[8], a[10]) CE_D(a[9], a[11]) CE_D(a[12], a[14]) CE_D(a[13], a[15])
    CE_D(a[0], a[1]) CE_D(a[2], a[3]) CE_D(a[4], a[5]) CE_D(a[6], a[7]) CE_D(a[8], a[9]) CE_D(a[10], a[11]) CE_D(a[12], a[13]) CE_D(a[14], a[15])
}
__device__ __forceinline__ void top16_of_64(unsigned (&G)[4][16]) {
    sort16_desc(G[0]); sort16_desc(G[1]); sort16_desc(G[2]); sort16_desc(G[3]);
    merge16_desc(G[0], G[1]); merge16_desc(G[2], G[3]); merge16_desc(G[0], G[2]);
}
__device__ __forceinline__ void ph_peer_route(const bf16* __restrict__ PQ, const bf16* __restrict__ subk, int* __restrict__ ids, float* __restrict__ gates, unsigned* ldsu, int wg, int nwg, int tid) {
    const int lane = tid & 63, r = lane & 31, hi = lane >> 5, wv = tid >> 6;
    unsigned* myl = ldsu + wv * 2048;
    const int nitems = (T / 32) * 8;
    for (int item = wg * NWAVE + wv; item < nitems; item += nwg * NWAVE) {
        const int tb = item >> 3, h = item & 7, t = tb * 32 + r;
        unsigned L[2][16];
#pragma unroll
        for (int p = 0; p < 2; ++p) {
            const bf16* qp = PQ + (size_t)t * 2048 + h * 256 + p * 128 + hi * 8;
            rbf16x8 bq[8];
#pragma unroll
            for (int s = 0; s < 8; ++s) bq[s] = *(const rbf16x8*)(qp + 16 * s);
            const bf16* kp = subk + ((size_t)(h * 2 + p) * 128 + r) * 128 + hi * 8;
            unsigned G[4][16]; unsigned hmask = hi ? ~4u : ~0u; asm volatile("" : "+v"(hmask));
#pragma unroll
            for (int nb = 0; nb < 4; ++nb) {
                rf32x16 acc = rf32x16{};
#pragma unroll
                for (int s = 0; s < 8; ++s) { const rbf16x8 a = *(const rbf16x8*)(kp + (size_t)nb * 32 * 128 + 16 * s); acc = __builtin_amdgcn_mfma_f32_32x32x16_bf16(a, bq[s], acc, 0, 0, 0); }
#pragma unroll
                for (int i = 0; i < 16; ++i) { const float v = fmaxf(acc[i] + 16.0f, 0.0f); const int n = nb * 32 + (i & 3) + 8 * (i >> 2);
                    G[nb][i] = ((__float_as_uint(v) & ~127u) | (unsigned)(127 - n)) & hmask; }
                asm volatile("" ::: "memory"); __builtin_amdgcn_sched_barrier(0);
            }
            top16_of_64(G);
            unsigned O[16];
#pragma unroll
            for (int i = 0; i < 16; ++i) { auto rr = __builtin_amdgcn_permlane32_swap(G[0][i], G[0][i], false, false); O[i] = hi ? rr[0] : rr[1]; }
            merge16_desc(G[0], O);
#pragma unroll
            for (int i = 0; i < 16; ++i) L[p][i] = G[0][i];
            asm volatile("" ::: "memory"); __builtin_amdgcn_sched_barrier(0);
        }
#pragma unroll
        for (int i = 0; i < 16; ++i) { myl[i * 64 + lane] = 127u - (L[0][i] & 127u); myl[(16 + i) * 64 + lane] = 127u - (L[1][i] & 127u); }
        float fa[16], fb[16];
#pragma unroll
        for (int i = 0; i < 16; ++i) { fa[i] = __uint_as_float(L[0][i] & ~127u); fb[i] = __uint_as_float(L[1][i] & ~127u); }
        unsigned C[4][16];
        C[0][0] = (__float_as_uint(fmaxf(fa[0] + fb[0] - 24.0f, 0.0f)) & ~255u) | 255u;
        C[0][1] = (__float_as_uint(fmaxf(fa[0] + fb[1] - 24.0f, 0.0f)) & ~255u) | 254u;
        C[0][2] = (__float_as_uint(fmaxf(fa[0] + fb[2] - 24.0f, 0.0f)) & ~255u) | 253u;
        C[0][3] = (__float_as_uint(fmaxf(fa[0] + fb[3] - 24.0f, 0.0f)) & ~255u) | 252u;
        C[0][4] = (__float_as_uint(fmaxf(fa[0] + fb[4] - 24.0f, 0.0f)) & ~255u) | 251u;
        C[0][5] = (__float_as_uint(fmaxf(fa[0] + fb[5] - 24.0f, 0.0f)) & ~255u) | 250u;
        C[0][6] = (__float_as_uint(fmaxf(fa[0] + fb[6] - 24.0f, 0.0f)) & ~255u) | 249u;
        C[0][7] = (__float_as_uint(fmaxf(fa[0] + fb[7] - 24.0f, 0.0f)) & ~255u) | 248u;
        C[0][8] = (__float_as_uint(fmaxf(fa[0] + fb[8] - 24.0f, 0.0f)) & ~255u) | 247u;
        C[0][9] = (__float_as_uint(fmaxf(fa[0] + fb[9] - 24.0f, 0.0f)) & ~255u) | 246u;
        C[0][10] = (__float_as_uint(fmaxf(fa[0] + fb[10] - 24.0f, 0.0f)) & ~255u) | 245u;
        C[0][11] = (__float_as_uint(fmaxf(fa[0] + fb[11] - 24.0f, 0.0f)) & ~255u) | 244u;
        C[0][12] = (__float_as_uint(fmaxf(fa[0] + fb[12] - 24.0f, 0.0f)) & ~255u) | 243u;
        C[0][13] = (__float_as_uint(fmaxf(fa[0] + fb[13] - 24.0f, 0.0f)) & ~255u) | 242u;
        C[0][14] = (__float_as_uint(fmaxf(fa[0] + fb[14] - 24.0f, 0.0f)) & ~255u) | 241u;
        C[0][15] = (__float_as_uint(fmaxf(fa[0] + fb[15] - 24.0f, 0.0f)) & ~255u) | 240u;
        C[1][0] = (__float_as_uint(fmaxf(fa[1] + fb[0] - 24.0f, 0.0f)) & ~255u) | 239u;
        C[1][1] = (__float_as_uint(fmaxf(fa[1] + fb[1] - 24.0f, 0.0f)) & ~255u) | 238u;
        C[1][2] = (__float_as_uint(fmaxf(fa[1] + fb[2] - 24.0f, 0.0f)) & ~255u) | 237u;
        C[1][3] = (__float_as_uint(fmaxf(fa[1] + fb[3] - 24.0f, 0.0f)) & ~255u) | 236u;
        C[1][4] = (__float_as_uint(fmaxf(fa[1] + fb[4] - 24.0f, 0.0f)) & ~255u) | 235u;
        C[1][5] = (__float_as_uint(fmaxf(fa[1] + fb[5] - 24.0f, 0.0f)) & ~255u) | 234u;
        C[1][6] = (__float_as_uint(fmaxf(fa[1] + fb[6] - 24.0f, 0.0f)) & ~255u) | 233u;
        C[1][7] = (__float_as_uint(fmaxf(fa[1] + fb[7] - 24.0f, 0.0f)) & ~255u) | 232u;
        C[1][8] = (__float_as_uint(fmaxf(fa[2] + fb[0] - 24.0f, 0.0f)) & ~255u) | 223u;
        C[1][9] = (__float_as_uint(fmaxf(fa[2] + fb[1] - 24.0f, 0.0f)) & ~255u) | 222u;
        C[1][10] = (__float_as_uint(fmaxf(fa[2] + fb[2] - 24.0f, 0.0f)) & ~255u) | 221u;
        C[1][11] = (__float_as_uint(fmaxf(fa[2] + fb[3] - 24.0f, 0.0f)) & ~255u) | 220u;
        C[1][12] = (__float_as_uint(fmaxf(fa[2] + fb[4] - 24.0f, 0.0f)) & ~255u) | 219u;
        C[1][13] = (__float_as_uint(fmaxf(fa[3] + fb[0] - 24.0f, 0.0f)) & ~255u) | 207u;
        C[1][14] = (__float_as_uint(fmaxf(fa[3] + fb[1] - 24.0f, 0.0f)) & ~255u) | 206u;
        C[1][15] = (__float_as_uint(fmaxf(fa[3] + fb[2] - 24.0f, 0.0f)) & ~255u) | 205u;
        C[2][0] = (__float_as_uint(fmaxf(fa[3] + fb[3] - 24.0f, 0.0f)) & ~255u) | 204u;
        C[2][1] = (__float_as_uint(fmaxf(fa[4] + fb[0] - 24.0f, 0.0f)) & ~255u) | 191u;
        C[2][2] = (__float_as_uint(fmaxf(fa[4] + fb[1] - 24.0f, 0.0f)) & ~255u) | 190u;
        C[2][3] = (__float_as_uint(fmaxf(fa[4] + fb[2] - 24.0f, 0.0f)) & ~255u) | 189u;
        C[2][4] = (__float_as_uint(fmaxf(fa[5] + fb[0] - 24.0f, 0.0f)) & ~255u) | 175u;
        C[2][5] = (__float_as_uint(fmaxf(fa[5] + fb[1] - 24.0f, 0.0f)) & ~255u) | 174u;
        C[2][6] = (__float_as_uint(fmaxf(fa[6] + fb[0] - 24.0f, 0.0f)) & ~255u) | 159u;
        C[2][7] = (__float_as_uint(fmaxf(fa[6] + fb[1] - 24.0f, 0.0f)) & ~255u) | 158u;
        C[2][8] = (__float_as_uint(fmaxf(fa[7] + fb[0] - 24.0f, 0.0f)) & ~255u) | 143u;
        C[2][9] = (__float_as_uint(fmaxf(fa[7] + fb[1] - 24.0f, 0.0f)) & ~255u) | 142u;
        C[2][10] = (__float_as_uint(fmaxf(fa[8] + fb[0] - 24.0f, 0.0f)) & ~255u) | 127u;
        C[2][11] = (__float_as_uint(fmaxf(fa[9] + fb[0] - 24.0f, 0.0f)) & ~255u) | 111u;
        C[2][12] = (__float_as_uint(fmaxf(fa[10] + fb[0] - 24.0f, 0.0f)) & ~255u) | 95u;
        C[2][13] = (__float_as_uint(fmaxf(fa[11] + fb[0] - 24.0f, 0.0f)) & ~255u) | 79u;
        C[2][14] = (__float_as_uint(fmaxf(fa[12] + fb[0] - 24.0f, 0.0f)) & ~255u) | 63u;
        C[2][15] = (__float_as_uint(fmaxf(fa[13] + fb[0] - 24.0f, 0.0f)) & ~255u) | 47u;
        C[3][0] = (__float_as_uint(fmaxf(fa[14] + fb[0] - 24.0f, 0.0f)) & ~255u) | 31u;
        C[3][1] = (__float_as_uint(fmaxf(fa[15] + fb[0] - 24.0f, 0.0f)) & ~255u) | 15u;
        C[3][2] = 0u;
        C[3][3] = 0u;
        C[3][4] = 0u;
        C[3][5] = 0u;
        C[3][6] = 0u;
        C[3][7] = 0u;
        C[3][8] = 0u;
        C[3][9] = 0u;
        C[3][10] = 0u;
        C[3][11] = 0u;
        C[3][12] = 0u;
        C[3][13] = 0u;
        C[3][14] = 0u;
        C[3][15] = 0u;
        top16_of_64(C);
        const float s0 = __uint_as_float(C[0][0] & ~255u);
        float ex[16]; float sum = 0.f; int eid[16];
#pragma unroll
        for (int k = 0; k < 16; ++k) { ex[k] = __expf(__uint_as_float(C[0][k] & ~255u) - s0); sum += ex[k];
            const unsigned code = 255u - (C[0][k] & 255u); const unsigned ia = myl[(code >> 4) * 64 + lane], ib = myl[(16 + (code & 15u)) * 64 + lane]; eid[k] = (int)(ia * 128u + ib); }
        const float inv = 1.0f / sum;
        if (hi == 0) { int4* dst = (int4*)(ids + (size_t)t * 128 + h * 16);
#pragma unroll
            for (int k = 0; k < 4; ++k) dst[k] = make_int4(eid[4 * k], eid[4 * k + 1], eid[4 * k + 2], eid[4 * k + 3]); }
        else { float4* dst = (float4*)(gates + (size_t)t * 128 + h * 16);
#pragma unroll
            for (int k = 0; k < 4; ++k) dst[k] = make_float4(ex[4 * k] * inv, ex[4 * k + 1] * inv, ex[4 * k + 2] * inv, ex[4 * k + 3] * inv); }
    }
}
typedef __bf16 bf16x2_t __attribute__((ext_vector_type(2)));
__device__ __forceinline__ float dot2bf(unsigned a, unsigned b, float acc) { return __builtin_amdgcn_fdot2_f32_bf16(__builtin_bit_cast(bf16x2_t, a), __builtin_bit_cast(bf16x2_t, b), acc, false); }
__device__ __forceinline__ float dot8(const uint4 a, const uint4 b, float s) { s = dot2bf(a.x, b.x, s); s = dot2bf(a.y, b.y, s); s = dot2bf(a.z, b.z, s); s = dot2bf(a.w, b.w, s); return s; }
__device__ __forceinline__ float gelu_erf(float z) { return 0.5f * z * (1.0f + erff(z * 0.70710678118654752f)); }
struct GBatch { uint4 d[4][2]; uint4 u[4][2]; float g[4]; };
__device__ __forceinline__ void gb_load(GBatch& B, const int* __restrict__ idp, const float* __restrict__ gp, int e0, const bf16* __restrict__ down, const bf16* __restrict__ up, int lane) {
#pragma unroll
    for (int j = 0; j < 4; ++j) { const int id = __builtin_amdgcn_readfirstlane(idp[e0 + j]); B.g[j] = gp[e0 + j];
        const bf16* dr = down + (size_t)id * DM + lane * 8; const bf16* ur = up + (size_t)id * DM + lane * 8;
        B.d[j][0] = *(const uint4*)dr; B.d[j][1] = *(const uint4*)(dr + 512); B.u[j][0] = *(const uint4*)ur; B.u[j][1] = *(const uint4*)(ur + 512); }
}
__device__ __forceinline__ void gb_compute(const GBatch& B, const uint4 xa, const uint4 xb, float (&acc)[16]) {
    float z[4];
#pragma unroll
    for (int j = 0; j < 4; ++j) z[j] = dot8(xb, B.d[j][1], dot8(xa, B.d[j][0], 0.f));
#pragma unroll
    for (int o = 1; o < 64; o <<= 1) {
#pragma unroll
        for (int j = 0; j < 4; ++j) z[j] += __shfl_xor(z[j], o); }
    unsigned wp[2];
#pragma unroll
    for (int j = 0; j < 4; j += 2) { const float w0 = B.g[j] * gelu_erf(z[j]), w1 = B.g[j + 1] * gelu_erf(z[j + 1]); wp[j >> 1] = f2bf(w0) | (f2bf(w1) << 16); }
#pragma unroll
    for (int jp = 0; jp < 2; ++jp)
#pragma unroll
        for (int hh = 0; hh < 2; ++hh) { const uint4 u0 = B.u[2 * jp][hh], u1 = B.u[2 * jp + 1][hh];
            const unsigned a0[4] = {u0.x, u0.y, u0.z, u0.w}, a1[4] = {u1.x, u1.y, u1.z, u1.w};
#pragma unroll
            for (int i = 0; i < 4; ++i) { const unsigned lo = __builtin_amdgcn_perm(a1[i], a0[i], 0x05040100u), hi = __builtin_amdgcn_perm(a1[i], a0[i], 0x07060302u);
                acc[hh * 8 + 2 * i] = dot2bf(lo, wp[jp], acc[hh * 8 + 2 * i]); acc[hh * 8 + 2 * i + 1] = dot2bf(hi, wp[jp], acc[hh * 8 + 2 * i + 1]); } }
}
__device__ __forceinline__ void ph_peer_gather(const bf16* __restrict__ xn, const int* __restrict__ ids, const float* __restrict__ gates, const bf16* __restrict__ down, const bf16* __restrict__ up, const float* x1, float* outw, int wg, int nwg, int tid) {
    const int lane = tid & 63, nw = nwg * NWAVE;
    for (int t = wg * NWAVE + (tid >> 6); t < T; t += nw) {
        const int* idp = ids + (size_t)t * 128; const float* gp = gates + (size_t)t * 128;
        GBatch B0, B1;
        gb_load(B0, idp, gp, 0, down, up, lane);
        const uint4 xa = *(const uint4*)(xn + (size_t)t * DM + lane * 8), xb = *(const uint4*)(xn + (size_t)t * DM + 512 + lane * 8);
        float acc[16];
#pragma unroll
        for (int i = 0; i < 16; ++i) acc[i] = 0.f;
        for (int e0 = 0; e0 < 128; e0 += 8) {
            gb_load(B1, idp, gp, e0 + 4, down, up, lane);
            gb_compute(B0, xa, xb, acc);
            if (e0 + 8 < 128) gb_load(B0, idp, gp, e0 + 8, down, up, lane);
            gb_compute(B1, xa, xb, acc);
        }
        const float* xi = x1 + (size_t)t * DM; float* o = outw + (size_t)t * DM;
        float4 r0 = *(const float4*)(xi + lane * 8), r1 = *(const float4*)(xi + lane * 8 + 4), r2 = *(const float4*)(xi + 512 + lane * 8), r3 = *(const float4*)(xi + 512 + lane * 8 + 4);
        r0.x += acc[0]; r0.y += acc[1]; r0.z += acc[2]; r0.w += acc[3]; r1.x += acc[4]; r1.y += acc[5]; r1.z += acc[6]; r1.w += acc[7];
        r2.x += acc[8]; r2.y += acc[9]; r2.z += acc[10]; r2.w += acc[11]; r3.x += acc[12]; r3.y += acc[13]; r3.z += acc[14]; r3.w += acc[15];
        *(float4*)(o + lane * 8) = r0; *(float4*)(o + lane * 8 + 4) = r1; *(float4*)(o + 512 + lane * 8) = r2; *(float4*)(o + 512 + lane * 8 + 4) = r3;
    }
}
#ifndef REP_ATTN
#define REP_ATTN 1
#endif
#ifndef REP_ROUTE
#define REP_ROUTE 1
#endif
#ifndef REP_GATHER
#define REP_GATHER 1
#endif
#ifndef REP_QKPOST
#define REP_QKPOST 1
#endif
__global__ void __launch_bounds__(NTHR, 2) mk_fwd(Params P) {
    extern __shared__ __attribute__((aligned(16))) unsigned char lds[];
    cg::grid_group grid = cg::this_grid();
    const int wg = blockIdx.x, nwg = gridDim.x;
    unsigned char* ws = P.ws; float* out = P.out;
    const float* x = P.in[0];
    bf16* WinT = (bf16*)(ws + WS_WIN); bf16* WoutT = (bf16*)(ws + WS_WOUT); bf16* WqT = (bf16*)(ws + WS_WQ); bf16* SUBK = (bf16*)(ws + WS_SUBK);
    bf16* DOWN = (bf16*)(ws + WS_DOWN); bf16* UP = (bf16*)(ws + WS_UP); bf16* XN = (bf16*)(ws + WS_XN); bf16* QKV = (bf16*)(ws + WS_QKV); bf16* PQ = (bf16*)(ws + WS_PQ);
    bf16* MIXED = (bf16*)(ws + WS_MIXED); bf16* DOB = (bf16*)(ws + WS_DO); int* IDS = (int*)(ws + WS_IDS); float* GATES = (float*)(ws + WS_GATES);
    float* ROPE = (float*)(ws + WS_ROPE); float* KMEAN = (float*)(ws + WS_KMEAN);

    ph_transpose(P.in[2], 1024, 3072, WinT, (float*)lds, wg, nwg, fresh_tid());
    ph_transpose(P.in[13], 1024, 1024, WoutT, (float*)lds, wg, nwg, fresh_tid());
    ph_transpose(P.in[15], 1024, 2048, WqT, (float*)lds, wg, nwg, fresh_tid());
    ph_convert(P.in[16], SUBK, (size_t)16 * 128 * 128 / 4, wg, nwg, fresh_tid());
    ph_convert(P.in[17], DOWN, (size_t)16384 * 1024 / 4, wg, nwg, fresh_tid());
    ph_convert(P.in[18], UP, (size_t)16384 * 1024 / 4, wg, nwg, fresh_tid());
    ph_rope(ROPE, wg, nwg, fresh_tid());
    ph_rmsnorm(x, P.in[1], XN, T, wg, nwg, fresh_tid());
    float lam; { float a = 0.f, b = 0.f; for (int i = 0; i < 64; ++i) { a += P.in[7][i] * P.in[8][i]; b += P.in[9][i] * P.in[10][i]; } lam = expf(a) - expf(b) + 0.2f; }
    grid.sync();
    { pg8::Gemm g{XN, WinT, T, 3072, 1024}; pg8::EpiBf16 E{QKV, 512, 512, QKV_ELEMS}; pg8::StaticOrder S; S.init(g.M, g.N, nwg, wg);
      pg8::gemm_phase<pg8::EpiBf16, pg8::StaticOrder, true, true>((PG8_LAS unsigned char*)lds, g, S, E); }
    grid.sync();
    ph_qk_post(QKV, ROPE, P.in[3], P.in[4], P.in[5], P.in[6], KMEAN, wg, nwg, fresh_tid());
    grid.sync();
    for (int rep_ = 0; rep_ < REP_ATTN; ++rep_) { const float* gain_m = P.in[11];
      for (int combo = wg; combo < NB * 8; combo += nwg) {
        const int b = combo >> 3, hd = combo & 7; const size_t brow = (size_t)b * SEQ;
        for (int qb = 7; qb >= 0; --qb) { const size_t qrow = brow + (size_t)qb * 256;
            attn_body::attn_unit<8, true>(qb, (const attn_body::bf16*)(QKV + qrow * 512 + hd * 64), (const attn_body::bf16*)(QKV + QKV_ELEMS + brow * 512 + hd * 64),
                (const attn_body::bf16*)(QKV + 2 * QKV_ELEMS + brow * 512 + hd * 64), (attn_body::bf16*)(MIXED + qrow * 1024 + hd * 64), KMEAN + ((size_t)b * 8 + hd) * 512, gain_m + hd * 64, (char*)lds); }
      }
      for (int combo = wg; combo < NB * 16; combo += nwg) {
        const int b = combo >> 4, jj = combo & 15, h = jj >> 2, m = (jj >> 1) & 1, c = jj & 1; const size_t brow = (size_t)b * SEQ;
        for (int qb = 7; qb >= 0; --qb) { const size_t qrow = brow + (size_t)qb * 256;
            attn_body::attn_unit<8, false>(qb, (const attn_body::bf16*)(QKV + 3 * QKV_ELEMS + qrow * 512 + h * 128 + m * 64), (const attn_body::bf16*)(QKV + 4 * QKV_ELEMS + brow * 512 + h * 128 + m * 64),
                (const attn_body::bf16*)(QKV + 5 * QKV_ELEMS + brow * 512 + h * 128 + c * 64), (attn_body::bf16*)(DOB + qrow * 1024 + h * 256 + m * 128 + c * 64), nullptr, nullptr, (char*)lds); }
      } }
    grid.sync();
    ph_diff_combine(DOB, lam, P.in[12], MIXED, wg, nwg, fresh_tid());
    grid.sync();
    { pg8::Gemm g{MIXED, WoutT, T, 1024, 1024}; pg8::EpiResF32 E{x, out, 1024}; pg8::StaticOrder S; S.init(g.M, g.N, nwg, wg);
      pg8::gemm_phase<pg8::EpiResF32, pg8::StaticOrder, true, true>((PG8_LAS unsigned char*)lds, g, S, E); }
    grid.sync();
    ph_rmsnorm(out, P.in[14], XN, T, wg, nwg, fresh_tid());
    grid.sync();
    { pg8::Gemm g{XN, WqT, T, 2048, 1024}; pg8::EpiBf16 E{PQ, 2048, 0, 0}; pg8::StaticOrder S; S.init(g.M, g.N, nwg, wg);
      pg8::gemm_phase<pg8::EpiBf16, pg8::StaticOrder, true, true>((PG8_LAS unsigned char*)lds, g, S, E); }
    grid.sync();
    for (int rep_ = 0; rep_ < REP_ROUTE; ++rep_) ph_peer_route(PQ, SUBK, IDS, GATES, (unsigned*)lds, wg, nwg, fresh_tid());
    grid.sync();
    for (int rep_ = 1; rep_ < REP_GATHER; ++rep_) ph_peer_gather(XN, IDS, GATES, DOWN, UP, out, (float*)(ws + WS_MIXED), wg, nwg, fresh_tid());
    ph_peer_gather(XN, IDS, GATES, DOWN, UP, out, out, wg, nwg, fresh_tid());
}

extern "C" void kernel_launch(void* const* d_in, const int* in_sizes, int n_in, void* d_out, int out_size, void* d_ws, size_t ws_size, hipStream_t stream) {
    static int grid_blocks = 0;
    if (grid_blocks == 0) {
        if (n_in != 19 || in_sizes[0] != T * DM || out_size != T * DM || ws_size < WS_END) { fprintf(stderr, "kernel_launch: unexpected shapes (n_in %d in0 %d out %d ws %zu)\n", n_in, n_in > 0 ? in_sizes[0] : -1, out_size, ws_size); grid_blocks = -1; return; }
        int dev = 0, cus = 0, per_cu = 0;
        (void)hipGetDevice(&dev); (void)hipDeviceGetAttribute(&cus, hipDeviceAttributeMultiprocessorCount, dev);
        (void)hipFuncSetAttribute((const void*)mk_fwd, hipFuncAttributeMaxDynamicSharedMemorySize, LDS_BYTES);
        (void)hipOccupancyMaxActiveBlocksPerMultiprocessor(&per_cu, (const void*)mk_fwd, NTHR, LDS_BYTES);
        if (per_cu < 1 || cus < 1) { fprintf(stderr, "kernel_launch: occupancy query says %d blocks/CU on %d CUs\n", per_cu, cus); grid_blocks = -1; return; }
        if (per_cu > 1) per_cu = 1;
        grid_blocks = cus * per_cu;
    }
    if (grid_blocks < 0) return;
    (void)hipMemsetAsync(d_ws, 0, WS_ZERO_BYTES, stream);
    Params p{};
    for (int i = 0; i < 19; ++i) p.in[i] = (const float*)d_in[i];
    p.out = (float*)d_out; p.ws = (unsigned char*)d_ws;
    void* args[] = {&p};
    hipError_t e = hipLaunchCooperativeKernel((const void*)mk_fwd, dim3(grid_blocks), dim3(NTHR), args, LDS_BYTES, stream);
    if (e != hipSuccess) fprintf(stderr, "cooperative launch failed: %s (grid %d)\n", hipGetErrorString(e), grid_blocks);
}
```

```cpp
#include <hip/hip_runtime.h>
#include <hip/hip_cooperative_groups.h>
#include <cstdio>
#include <cstdint>
namespace cg = cooperative_groups;
__device__ __forceinline__ int fresh_tid() { int t = threadIdx.x; asm volatile("" : "+v"(t)); return t; }
namespace pg8 {
#define PG8_LAS __attribute__((address_space(3)))
typedef unsigned short bf16_t;
typedef short bf16x8 __attribute__((ext_vector_type(8)));
typedef float f32x4 __attribute__((ext_vector_type(4)));
typedef unsigned u32x4 __attribute__((ext_vector_type(4)));
constexpr int BM = 256, BK = 64, HALF = 128, HTB = HALF * BK * 2  , STAGE_BYTES = 8 * HTB, NXCD = 8, WGM = 8;

__host__ __device__ __forceinline__ int lds_byte(int r, int c) { const int st = (r >> 4) * 2 + (c >> 5), rr = r & 15, cc = c & 31, ob = rr * 64 + cc * 2; return st * 1024 + (ob ^ (((ob >> 9) & 1) << 5)); }
__host__ __device__ __forceinline__ void stage_rc(int b, int& R, int& C) { const int st = b / 1024, sb = b % 1024, swz = sb ^ (((sb >> 9) & 1) << 5); R = (st >> 1) * 16 + swz / 64; C = (st & 1) * 32 + (swz % 64) / 2; }
__host__ __device__ __forceinline__ int perm32(int rho) { const int n = rho >> 4, i = rho & 15; return 8 * (i >> 2) + 4 * n + (i & 3); }

struct Unit { int pm, pn; };
struct Gemm { const bf16_t* A; const bf16_t* Bt; int M, N, K; };

struct StaticOrder {
    int nM, nN, nwg, G, c;
    __host__ __device__ void init(int M, int N, int G_, int c_) { nM = M / BM; nN = N / BM; nwg = nM * nN; G = G_; c = c_; }
    __host__ __device__ bool next(int i, Unit& u) const {
        const long L = (long)i * G + c; if (L >= nwg) return false;
        int wgid = (int)L; { const int q = nwg / NXCD, r = nwg % NXCD, xcd = wgid % NXCD, off = wgid / NXCD; wgid = (xcd < r ? xcd * (q + 1) : r * (q + 1) + (xcd - r) * q) + off; }
        const int nig = WGM * nN, gid = wgid / nig, fm = gid * WGM, gsz = (nM - fm) < WGM ? (nM - fm) : WGM;
        u.pm = fm + ((wgid % nig) % gsz); u.pn = (wgid % nig) / gsz; return true;
    }
    __device__ __forceinline__ void a_ready(const Unit&) const {}
    __device__ __forceinline__ void done(const Unit&) const {}
};

__device__ __forceinline__ unsigned cvt_pk_bf16(float lo, float hi) { unsigned r; asm volatile("v_cvt_pk_bf16_f32 %0, %1, %2" : "=v"(r) : "v"(lo), "v"(hi)); return r; }
struct EpiBf16 {
    static constexpr bool PERM = true, AFTER_DRAIN = false;
    bf16_t* O; int ldc; int split_cols; size_t split_stride;
    __device__ __forceinline__ void operator()(const f32x4 (&acc)[2][2][4][2], const Unit& u, int wr, int wc, int fr, int fq) const {
        const int row0 = u.pm * BM + wr * 64 + fr; int colt = u.pn * BM; bf16_t* base = O;
        if (split_cols) { const int t = colt / split_cols; base += (size_t)t * split_stride; colt -= t * split_cols; }
        const int col0 = colt + wc * 32 + 8 * fq;
#pragma unroll
        for (int ai = 0; ai < 2; ++ai)
#pragma unroll
            for (int m = 0; m < 4; ++m) { bf16_t* rowp = base + (size_t)(row0 + ai * HALF + m * 16) * ldc + col0;
#pragma unroll
                for (int bj = 0; bj < 2; ++bj) { const f32x4 v0 = acc[ai][bj][m][0], v1 = acc[ai][bj][m][1];
                    u32x4 w; w.x = cvt_pk_bf16(v0[0], v0[1]); w.y = cvt_pk_bf16(v0[2], v0[3]); w.z = cvt_pk_bf16(v1[0], v1[1]); w.w = cvt_pk_bf16(v1[2], v1[3]);
                    *(u32x4*)(rowp + bj * HALF) = w; } }
    }
};
struct EpiResF32 {
    static constexpr bool PERM = false, AFTER_DRAIN = false;
    const float* base; float* out; int ldc;
    __device__ __forceinline__ void operator()(const f32x4 (&acc)[2][2][4][2], const Unit& u, int wr, int wc, int fr, int fq) const {
        const int col0 = u.pn * BM + wc * 32 + 4 * fq;
#pragma unroll
        for (int ai = 0; ai < 2; ++ai)
#pragma unroll
            for (int m = 0; m < 4; ++m) { const size_t off = (size_t)(u.pm * BM + ai * HALF + wr * 64 + m * 16 + fr) * ldc + col0;
#pragma unroll
                for (int bj = 0; bj < 2; ++bj)
#pragma unroll
                    for (int n = 0; n < 2; ++n) { const f32x4 bs = *(const f32x4*)(base + off + bj * HALF + n * 16); *(f32x4*)(out + off + bj * HALF + n * 16) = bs + acc[ai][bj][m][n]; } }
    }
};
template <class Epi, class Sched, bool ALIGN_EPI = false, bool SP2 = false>
__device__ __forceinline__ void gemm_phase(PG8_LAS unsigned char* lds, const Gemm g, const Sched& S, const Epi& E) {
    const int tid = fresh_tid(), wid = __builtin_amdgcn_readfirstlane(tid >> 6), lane = tid & 63, wr = wid >> 2, wc = wid & 3, fr = lane & 15, fq = lane >> 4;
    const int K = g.K, nt = K / BK;
    unsigned voffA[2], voffB[2];
#pragma unroll
    for (int i = 0; i < 2; ++i) { int R, C; stage_rc(tid * 16 + i * 8192, R, C); const int Rb = Epi::PERM ? ((R & ~31) + perm32(R & 31)) : R;
        voffA[i] = (unsigned)(R * K + C) * 2u; voffB[i] = (unsigned)(Rb * K + C) * 2u; }
    const size_t kstep = (size_t)(BK * 2);
    const size_t hstep = (size_t)HALF * K * 2;
    const size_t tstep = 2 * hstep;
    const unsigned ldsw = (unsigned)wid * 1024u;
    const int aoff = lds_byte(wr * 64 + fr, fq * 8), boff = lds_byte(wc * 32 + fr, fq * 8);
#define PG8_SA(b, h) (((b) * 2 + (h)) * HTB)
#define PG8_SB(b, h) ((4 + (b) * 2 + (h)) * HTB)
#define PG8_STAGE(bufoff, gbase, voff) do { _Pragma("unroll") for (int _i = 0; _i < 2; ++_i) \
        __builtin_amdgcn_global_load_lds((const unsigned*)((const char*)(gbase) + (voff)[_i]), (PG8_LAS unsigned*)(lds + (bufoff) + ldsw + _i * 8192), 16, 0, 0); } while (0)
#define PG8_LDA(dst, b, h) do { _Pragma("unroll") for (int m = 0; m < 4; ++m) _Pragma("unroll") for (int k = 0; k < 2; ++k) dst[m][k] = *(const PG8_LAS bf16x8*)(lds + PG8_SA(b, h) + aoff + m * 2048 + k * 1024); } while (0)
#define PG8_LDB(dst, b, h) do { _Pragma("unroll") for (int n = 0; n < 2; ++n) _Pragma("unroll") for (int k = 0; k < 2; ++k) dst[n][k] = *(const PG8_LAS bf16x8*)(lds + PG8_SB(b, h) + boff + n * 2048 + k * 1024); } while (0)
#define PG8_MMA(ai, bj, At, Bt) do { __builtin_amdgcn_s_setprio(1); _Pragma("unroll") for (int m = 0; m < 4; ++m) _Pragma("unroll") for (int n = 0; n < 2; ++n) _Pragma("unroll") for (int k = 0; k < 2; ++k) \
        acc[ai][bj][m][n] = __builtin_amdgcn_mfma_f32_16x16x32_bf16(Bt[n][k], At[m][k], acc[ai][bj][m][n], 0, 0, 0); __builtin_amdgcn_s_setprio(0); } while (0)
#define PG8_WAIT_V(n) asm volatile("s_waitcnt vmcnt(" #n ")" ::: "memory")
#define PG8_WAIT_L(n) asm volatile("s_waitcnt lgkmcnt(" #n ")" ::: "memory")
#define PG8_BAR __builtin_amdgcn_s_barrier()
#define PG8_SCHED __builtin_amdgcn_sched_barrier(0)
    Unit cur, nxt; int ui = 0;
    if (!S.next(0, cur)) return;
    f32x4 acc[2][2][4][2];
#pragma unroll
    for (int a = 0; a < 2; ++a)
#pragma unroll
        for (int b = 0; b < 2; ++b)
#pragma unroll
            for (int m = 0; m < 4; ++m)
#pragma unroll
                for (int n = 0; n < 2; ++n) acc[a][b][m][n] = (f32x4){0.f, 0.f, 0.f, 0.f};
    bf16x8 At[4][2], B0[2][2], B1[2][2];
    const char* cA = (const char*)g.A + (size_t)cur.pm * tstep; const char* cB = (const char*)g.Bt + (size_t)cur.pn * tstep;
    S.a_ready(cur);
    if constexpr (SP2) {
        PG8_STAGE(PG8_SB(0, 0), cB, voffB); PG8_STAGE(PG8_SB(0, 1), cB + hstep, voffB); PG8_STAGE(PG8_SA(0, 0), cA, voffA); PG8_STAGE(PG8_SA(0, 1), cA + hstep, voffA);
        if (wr == 1) PG8_BAR;
        PG8_WAIT_V(2); PG8_BAR;
        PG8_STAGE(PG8_SB(1, 0), cB + kstep, voffB); PG8_STAGE(PG8_SA(1, 0), cA + kstep, voffA); PG8_STAGE(PG8_SB(1, 1), cB + hstep + kstep, voffB);
        PG8_WAIT_V(6); PG8_BAR;
    } else {
        PG8_STAGE(PG8_SB(0, 0), cB, voffB); PG8_STAGE(PG8_SA(0, 0), cA, voffA); PG8_STAGE(PG8_SB(0, 1), cB + hstep, voffB); PG8_STAGE(PG8_SA(0, 1), cA + hstep, voffA);
        if (wr == 1) PG8_BAR;
        PG8_WAIT_V(4); PG8_BAR;
        PG8_STAGE(PG8_SB(1, 0), cB + kstep, voffB); PG8_STAGE(PG8_SA(1, 0), cA + kstep, voffA); PG8_STAGE(PG8_SB(1, 1), cB + hstep + kstep, voffB);
        PG8_WAIT_V(6); PG8_BAR;
    }
    for (;;) {
        const bool has_next = S.next(ui + 1, nxt);
        const char* nA = has_next ? (const char*)g.A + (size_t)nxt.pm * tstep : cA; const char* nB = has_next ? (const char*)g.Bt + (size_t)nxt.pn * tstep : cB;
        for (int t = 0; t < nt; t += 2) {
            const bool last = (t == nt - 2);
            const char* a1 = cA + (size_t)(t + 1) * kstep;
            const char* a2 = last ? nA : cA + (size_t)(t + 2) * kstep; const char* b2 = last ? nB : cB + (size_t)(t + 2) * kstep;
            const char* a3 = a2 + kstep; const char* b3 = b2 + kstep;
            if (last && has_next) S.a_ready(nxt);
            if constexpr (SP2) {
            PG8_LDB(B0, 0, 0); PG8_LDB(B1, 0, 1); PG8_SCHED; PG8_LDA(At, 0, 0); PG8_STAGE(PG8_SA(1, 1), a1 + hstep, voffA);
            PG8_WAIT_V(8); PG8_WAIT_L(0); PG8_BAR; PG8_MMA(0, 0, At, B0); PG8_MMA(0, 1, At, B1); PG8_BAR; PG8_SCHED;
            PG8_LDA(At, 0, 1); PG8_STAGE(PG8_SB(0, 0), b2, voffB); PG8_STAGE(PG8_SB(0, 1), b2 + hstep, voffB); PG8_STAGE(PG8_SA(0, 0), a2, voffA);
            PG8_WAIT_V(8); PG8_WAIT_L(0); PG8_BAR; PG8_MMA(1, 0, At, B0); PG8_MMA(1, 1, At, B1); PG8_BAR; PG8_SCHED;
            PG8_LDB(B0, 1, 0); PG8_LDB(B1, 1, 1); PG8_SCHED; PG8_LDA(At, 1, 0); PG8_STAGE(PG8_SA(0, 1), a2 + hstep, voffA);
            PG8_WAIT_V(8); PG8_WAIT_L(0); PG8_BAR; PG8_MMA(0, 0, At, B0); PG8_MMA(0, 1, At, B1); PG8_BAR; PG8_SCHED;
            PG8_LDA(At, 1, 1); PG8_STAGE(PG8_SB(1, 0), b3, voffB); PG8_STAGE(PG8_SB(1, 1), b3 + hstep, voffB); PG8_STAGE(PG8_SA(1, 0), a3, voffA);
            PG8_WAIT_V(8); PG8_WAIT_L(0); PG8_BAR; PG8_MMA(1, 0, At, B0); PG8_MMA(1, 1, At, B1); PG8_BAR; PG8_SCHED;
            } else {
            PG8_LDB(B0, 0, 0); PG8_SCHED; PG8_LDA(At, 0, 0); PG8_STAGE(PG8_SA(1, 1), a1 + hstep, voffA);
            PG8_WAIT_L(8); PG8_BAR; PG8_WAIT_L(0); PG8_MMA(0, 0, At, B0); PG8_BAR; PG8_SCHED;
            PG8_LDB(B1, 0, 1); PG8_STAGE(PG8_SB(0, 0), b2, voffB);
            PG8_BAR; PG8_WAIT_L(0); PG8_MMA(0, 1, At, B1); PG8_BAR;
            PG8_LDA(At, 0, 1); PG8_STAGE(PG8_SA(0, 0), a2, voffA);
            PG8_BAR; PG8_WAIT_L(0); PG8_MMA(1, 0, At, B0); PG8_BAR; PG8_SCHED;
            PG8_STAGE(PG8_SB(0, 1), b2 + hstep, voffB);
            PG8_WAIT_V(6); PG8_BAR; PG8_MMA(1, 1, At, B1); PG8_BAR;
            PG8_LDB(B0, 1, 0); PG8_SCHED; PG8_LDA(At, 1, 0); PG8_STAGE(PG8_SA(0, 1), a2 + hstep, voffA);
            PG8_WAIT_L(8); PG8_BAR; PG8_WAIT_L(0); PG8_MMA(0, 0, At, B0); PG8_BAR; PG8_SCHED;
            PG8_LDB(B1, 1, 1); PG8_STAGE(PG8_SB(1, 0), b3, voffB);
            PG8_BAR; PG8_WAIT_L(0); PG8_MMA(0, 1, At, B1); PG8_BAR;
            PG8_LDA(At, 1, 1); PG8_STAGE(PG8_SA(1, 0), a3, voffA);
            PG8_BAR; PG8_WAIT_L(0); PG8_MMA(1, 0, At, B0); PG8_BAR; PG8_SCHED;
            PG8_STAGE(PG8_SB(1, 1), b3 + hstep, voffB);
            PG8_WAIT_V(6); PG8_BAR; PG8_MMA(1, 1, At, B1); PG8_BAR;
            }
        }
        if constexpr (ALIGN_EPI) { if (wr == 0) PG8_BAR; }
        if constexpr (!Epi::AFTER_DRAIN) { E(acc, cur, wr, wc, fr, fq); S.done(cur); }
        if (!has_next) break;
#pragma unroll
        for (int a = 0; a < 2; ++a)
#pragma unroll
            for (int b = 0; b < 2; ++b)
#pragma unroll
                for (int m = 0; m < 4; ++m)
#pragma unroll
                    for (int n = 0; n < 2; ++n) acc[a][b][m][n] = (f32x4){0.f, 0.f, 0.f, 0.f};
        cur = nxt; cA = nA; cB = nB; ++ui;
        if constexpr (ALIGN_EPI) { if (wr == 1) PG8_BAR; }
    }
    PG8_WAIT_V(0);
    if constexpr (!ALIGN_EPI) { if (wr == 0) PG8_BAR; }
    PG8_BAR;
    if constexpr (Epi::AFTER_DRAIN) { E.fused(acc, cur, wr, wc, fr, fq, lds, wid, lane); S.done(cur); }
#undef PG8_SA
#undef PG8_SB
#undef PG8_STAGE
#undef PG8_LDA
#undef PG8_LDB
#undef PG8_MMA
#undef PG8_WAIT_V
#undef PG8_WAIT_L
#undef PG8_BAR
#undef PG8_SCHED
}
}
#include <hip/hip_bf16.h>
#include <cmath>
namespace attn_body {
using bf16=__hip_bfloat16;
using bf16x8=__attribute__((ext_vector_type(8)))short;
using s16x4=__attribute__((ext_vector_type(4)))short;
using f32x16=__attribute__((ext_vector_type(16)))float;
using u32x4=__attribute__((ext_vector_type(4)))unsigned;
constexpr int SEQ=2048,D=64,DM=512,PO=1024;
constexpr int NW=8,QBLK=32,QB=QBLK*NW,KVBLK=64,NQB=SEQ/QB;
constexpr int ATTN_UNIT_ROWS=QB;
__device__ __forceinline__ int crow(int r,int hi){return (r&3)+8*(r>>2)+4*hi;}
#define SBAR() __builtin_amdgcn_sched_barrier(0)
__device__ __forceinline__ void cmask(f32x16&p0,f32x16&p1,int jb,int qrel,int hi){
  const float NEG=-INFINITY; int kb=64*jb+4*hi;
  #pragma unroll
  for(int r=0;r<16;++r){int kv=kb+(r&3)+8*(r>>2); if(kv>qrel)p0[r]=NEG; if(kv+32>qrel)p1[r]=NEG;}
}

__device__ __forceinline__ void bmask(f32x16&p0,f32x16&p1,unsigned on){
  if(!on){
    #pragma unroll
    for(int r=0;r<16;++r){p0[r]=-INFINITY;p1[r]=-INFINITY;} }
}
constexpr int NSLOT=3, SLOTB=8192;
constexpr int LDS_K=0, LDS_V=NSLOT*SLOTB, LDS_WS=2*NSLOT*SLOTB, LDS_OST=LDS_WS+NW*64*4, LDS_BYTES=LDS_OST+NW*4096;
constexpr float C2=0.125f*1.4426950408889634f;
__device__ __forceinline__ void glds16(const void*gsrc,unsigned lds_dst){unsigned keep;
  asm volatile("s_mov_b32 %0, m0\n\ts_mov_b32 m0, %2\n\ts_nop 0\n\tglobal_load_lds_dwordx4 %1, off\n\ts_mov_b32 m0, %0":"=&s"(keep):"v"(gsrc),"s"(lds_dst):"memory");}
__device__ __forceinline__ float max3f(float a,float b,float c){float r;asm("v_max3_f32 %0, %1, %2, %3":"=v"(r):"v"(a),"v"(b),"v"(c));return r;}
__device__ __forceinline__ float max2f(float a,float b){float r;asm("v_max_f32_e32 %0, %1, %2":"=v"(r):"v"(a),"v"(b));return r;}
__device__ __forceinline__ float fadd_s(float a,float b){float r;asm("v_add_f32_e32 %0, %1, %2":"=v"(r):"v"(a),"v"(b));return r;}
__device__ __forceinline__ float fsub_s(float a,float b){float r;asm("v_sub_f32_e32 %0, %1, %2":"=v"(r):"v"(a),"v"(b));return r;}
typedef float f32x2_t __attribute__((ext_vector_type(2))); typedef __bf16 bf16x2_t __attribute__((ext_vector_type(2)));
__device__ __forceinline__ unsigned cvtpk_s(float lo,float hi){f32x2_t v={lo,hi};bf16x2_t b=__builtin_convertvector(v,bf16x2_t);return __builtin_bit_cast(unsigned,b);}
#define WAIT_BAR(N) asm volatile("s_waitcnt vmcnt(" #N ") lgkmcnt(0)\n\ts_barrier":::"memory")

__device__ __forceinline__ void qkt(f32x16&p0,f32x16&p1,const char*Kslot,const bf16x8*qr,int r32,int hi){
  const char*kb=Kslot+hi*1024+r32*16;
  #pragma unroll
  for(int d0=0;d0<4;++d0){
    const bf16x8 b0=*reinterpret_cast<const bf16x8*>(kb+d0*2048);
    const bf16x8 b1=*reinterpret_cast<const bf16x8*>(kb+d0*2048+512);
    if(d0==0){p0=__builtin_amdgcn_mfma_f32_32x32x16_bf16(b0,qr[0],f32x16{},0,0,0);p1=__builtin_amdgcn_mfma_f32_32x32x16_bf16(b1,qr[0],f32x16{},0,0,0);}
    else{p0=__builtin_amdgcn_mfma_f32_32x32x16_bf16(b0,qr[d0],p0,0,0,0);p1=__builtin_amdgcn_mfma_f32_32x32x16_bf16(b1,qr[d0],p1,0,0,0);}}
}
typedef __attribute__((address_space(3))) const char* lds_cptr;
typedef short v4i16_t __attribute__((ext_vector_type(4)));
__device__ __forceinline__ void kload8(bf16x8*kf,lds_cptr kp){
  kf[0]=*(const __attribute__((address_space(3))) bf16x8*)(kp);      kf[1]=*(const __attribute__((address_space(3))) bf16x8*)(kp+512);
  kf[2]=*(const __attribute__((address_space(3))) bf16x8*)(kp+2048); kf[3]=*(const __attribute__((address_space(3))) bf16x8*)(kp+2560);
  kf[4]=*(const __attribute__((address_space(3))) bf16x8*)(kp+4096); kf[5]=*(const __attribute__((address_space(3))) bf16x8*)(kp+4608);
  kf[6]=*(const __attribute__((address_space(3))) bf16x8*)(kp+6144); kf[7]=*(const __attribute__((address_space(3))) bf16x8*)(kp+6656);
}
__device__ __forceinline__ void kload2(bf16x8*kf,lds_cptr kp,int j){ kf[2*j]=*(const __attribute__((address_space(3))) bf16x8*)(kp+j*2048); kf[2*j+1]=*(const __attribute__((address_space(3))) bf16x8*)(kp+j*2048+512); }
__device__ __forceinline__ s16x4 vtr(lds_cptr p){ return __builtin_bit_cast(s16x4,__builtin_amdgcn_ds_read_tr16_b64_v4i16((__attribute__((address_space(3))) v4i16_t*)p)); }
__device__ __forceinline__ float rowmax(const f32x16&p0,const f32x16&p1){
  float a=max3f(p0[0],p0[1],p1[0]),b=max3f(p0[2],p0[3],p1[1]);a=max3f(a,p1[2],p1[3]);
  #pragma unroll
  for(int r=4;r<16;r+=4){a=max3f(a,p0[r],p0[r+1]);b=max3f(b,p0[r+2],p0[r+3]);a=max3f(a,p1[r],p1[r+1]);b=max3f(b,p1[r+2],p1[r+3]);}
  const float m=max2f(a,b);
  auto rr=__builtin_amdgcn_permlane32_swap(__float_as_uint(m),__float_as_uint(m),false,false);
  return max2f(__uint_as_float(rr[0]),__uint_as_float(rr[1]));
}
__device__ __forceinline__ void pv(f32x16*o,int vb,bf16x8 pa0,bf16x8 pa1,bf16x8 pa2,bf16x8 pa3){
  #pragma unroll
  for(int d0=0;d0<2;++d0){s16x4 lo[4],hi[4];
    #pragma unroll
    for(int ks=0;ks<4;++ks){
      asm volatile("ds_read_b64_tr_b16 %0,%1 offset:%c2":"=&v"(lo[ks]):"v"(vb),"i"(d0*4096+ks*1024):"memory");
      asm volatile("ds_read_b64_tr_b16 %0,%1 offset:%c2":"=&v"(hi[ks]):"v"(vb),"i"(d0*4096+ks*1024+512):"memory");}
    asm volatile("s_waitcnt lgkmcnt(0)":::"memory");SBAR();
    #define PK(k) (bf16x8){lo[k][0],lo[k][1],lo[k][2],lo[k][3],hi[k][0],hi[k][1],hi[k][2],hi[k][3]}
    o[d0]=__builtin_amdgcn_mfma_f32_32x32x16_bf16(pa0,PK(0),o[d0],0,0,0);
    o[d0]=__builtin_amdgcn_mfma_f32_32x32x16_bf16(pa1,PK(1),o[d0],0,0,0);
    o[d0]=__builtin_amdgcn_mfma_f32_32x32x16_bf16(pa2,PK(2),o[d0],0,0,0);
    o[d0]=__builtin_amdgcn_mfma_f32_32x32x16_bf16(pa3,PK(3),o[d0],0,0,0);
    #undef PK
  }
}

#ifndef ATTN_STORE16
#define ATTN_STORE16(p,v) (*(u32x4*)(p)=(v))
#endif
template<int THRL,bool MOBA> __device__ __forceinline__ void attn_unit(int qb,const bf16*Qu,const bf16*__restrict__ Kh,const bf16*__restrict__ Vh,bf16*Ou,const float*__restrict__ km,const float*__restrict__ gm,char*shm){
  const int tid=fresh_tid(),lane=tid&63,r32=lane&31,hi=lane>>5; const int wid=__builtin_amdgcn_readfirstlane(tid>>6);
  const int q0=qb*QB;
  const bf16*Qw=Qu+(long)(wid*QBLK)*DM;
  const unsigned lds0=(unsigned)(uintptr_t)shm;
  float*wsf=(float*)(shm+LDS_WS)+wid*64;
  const bf16*ksrc=Kh+(long)lane*DM+wid*8;
  const bf16*vsrc=Vh+(long)(16*(wid&3)+(lane>>2))*DM+(wid>>2)*32+(lane&3)*8;
  const unsigned kdst=lds0+LDS_K+wid*1024, vdst=lds0+LDS_V+wid*1024;
  #define DMA_K(t,slot) glds16(ksrc+(long)(t)*KVBLK*DM,(unsigned)__builtin_amdgcn_readfirstlane(kdst+(slot)))
  #define DMA_V(t,slot) glds16(vsrc+(long)(t)*KVBLK*DM,(unsigned)__builtin_amdgcn_readfirstlane(vdst+(slot)))
  const int vb0=(int)(lds0+LDS_V)+((lane>>4)&1)*32+(lane&3)*8+(4*hi+((lane&15)>>2))*64;
  const char*Kbase=shm+LDS_K; bf16x8 kf[8];
  const lds_cptr shm3=(lds_cptr)shm; const lds_cptr kp0=shm3+LDS_K+hi*1024+r32*16; const lds_cptr vp0=shm3+LDS_V+((lane>>4)&1)*32+(lane&3)*8+(4*hi+((lane&15)>>2))*64;
  const int NT=(q0+QB)/KVBLK;
  DMA_K(0,0);DMA_V(0,0);DMA_K(1,SLOTB);
  bf16x8 qr[4];
  #pragma unroll
  for(int d0=0;d0<4;++d0)qr[d0]=*reinterpret_cast<const bf16x8*>(&Qw[(long)r32*DM+d0*16+hi*8]);
  unsigned selm=0u;
  if(MOBA){ float g[8];
    #pragma unroll
    for(int n=0;n<8;++n){ float s_=0.f; if(n<qb){
      #pragma unroll
      for(int d0=0;d0<4;++d0){ const float4 ka=*reinterpret_cast<const float4*>(km+n*64+d0*16+hi*8), kb2=*reinterpret_cast<const float4*>(km+n*64+d0*16+hi*8+4);
        const float kv[8]={ka.x,ka.y,ka.z,ka.w,kb2.x,kb2.y,kb2.z,kb2.w};
        #pragma unroll
        for(int j=0;j<8;++j)s_+=__uint_as_float(((unsigned)(unsigned short)qr[d0][j])<<16)*kv[j]; }
      s_+=__shfl_xor(s_,32); } g[n]=s_; asm volatile("":"+v"(s_)::"memory"); SBAR(); }
    #pragma unroll
    for(int r=0;r<3;++r){ float best=-3.0e38f; int bi=-1;
      #pragma unroll
      for(int n=0;n<8;++n) if(n<qb&&!((selm>>n)&1u)&&g[n]>best){best=g[n];bi=n;}
      if(bi>=0)selm|=1u<<bi; } }
  float l_reg=0.f;f32x16 o[2];o[0]=f32x16{};o[1]=f32x16{};
  const int qrel=wid*QBLK+r32;
  #define CMASK(P0,P1,t) do{int jb_=(t)-(NT-4); if(jb_>=0)cmask(P0,P1,jb_,qrel,hi); else if(MOBA) bmask(P0,P1,(selm>>((t)>>2))&1u);}while(0)
  #define START(P0,P1) do{ _Pragma("unroll") for(int r=0;r<16;++r)P0[r]=__builtin_amdgcn_exp2f(P0[r]); }while(0)
  #define RESC() do{}while(0)
  f32x16 pA0,pA1,pB0,pB1;
  int sl_prev=0,sl_cur=0,sl_next=SLOTB;
  #define ROT() do{sl_prev=sl_cur;sl_cur=sl_next;sl_next=(sl_next==(NSLOT-1)*SLOTB)?0:sl_next+SLOTB;}while(0)
  DMA_K(2,2*SLOTB);
  WAIT_BAR(3);
  qkt(pA0,pA1,Kbase,qr,r32,hi);asm volatile("s_nop 15\n\ts_nop 7":"+v"(pA0),"+v"(pA1));CMASK(pA0,pA1,0);
  START(pA0,pA1);
  _Pragma("unroll") for(int r=0;r<16;++r)pA1[r]=__builtin_amdgcn_exp2f(pA1[r]);
  WAIT_BAR(0);
  DMA_K(3,0);DMA_V(1,SLOTB);
  ROT();
  kload8(kf,kp0+sl_cur);
  WAIT_BAR(2);
  s16x4 vlo[8],vhi[8]; u32x4 pw0,pw1,pw2,pw3;
  #define PKW(P,B) cvtpk_s(P[B],P[B+1])
  #define PAF(k) __builtin_bit_cast(bf16x8,pw##k)
  #define VFR(i) (bf16x8){vlo[i][0],vlo[i][1],vlo[i][2],vlo[i][3],vhi[i][0],vhi[i][1],vhi[i][2],vhi[i][3]}
  #define PIN(x) asm volatile("":"+v"(x))
  #define MX3(a,b,c) __builtin_fmaxf(__builtin_fmaxf((a),(b)),(c))
  #define GAPA(MF,A0,A1,A2,A3,W0,W1,PW) do{ MF; sacc+=A0; sacc+=A1; sacc+=A2; sacc+=A3; PIN(sacc); W0; W1; PIN(PW); SBAR(); }while(0)
  #define EX(v) __builtin_amdgcn_exp2f(v)
  #define GAPB(MF,X,B) do{ MF; X[B]=EX(X[B]); X[B+1]=EX(X[B+1]); X[B+2]=EX(X[B+2]); X[B+3]=EX(X[B+3]); PIN(X); SBAR(); }while(0)
  #define VRD(i) do{ vlo[i]=vtr(vp_+(((i)>>2)*4096+((i)&3)*1024)); vhi[i]=vtr(vp_+(((i)>>2)*4096+((i)&3)*1024+512)); }while(0)
  #define KRD(G,j) do{ if(G){ kload2(kf,kp0+sl_next,j); SBAR(); } }while(0)
  #define STEP(C0,C1,P0,P1,t,GK,GV,GL) do{ SBAR(); \
    const lds_cptr vp_=vp0+sl_prev; \
    VRD(0); SBAR(); float sacc=(P0[0]+P0[1]); \
    GAPA(C0=__builtin_amdgcn_mfma_f32_32x32x16_bf16(kf[0],qr[0],f32x16{},0,0,0), P0[2],P0[3],P0[4],P0[5],     pw0[0]=PKW(P0,0), pw0[1]=PKW(P0,2), pw0); \
    VRD(4); SBAR(); GAPA(C1=__builtin_amdgcn_mfma_f32_32x32x16_bf16(kf[1],qr[0],f32x16{},0,0,0), P0[6],P0[7],P0[8],P0[9],     pw0[2]=PKW(P0,4), pw0[3]=PKW(P0,6), pw0); \
    VRD(1); SBAR(); GAPA(C0=__builtin_amdgcn_mfma_f32_32x32x16_bf16(kf[2],qr[1],C0,0,0,0),   P0[10],P0[11],P0[12],P0[13], pw1[0]=PKW(P0,8), pw1[1]=PKW(P0,10), pw1); \
    VRD(5); SBAR(); GAPA(C1=__builtin_amdgcn_mfma_f32_32x32x16_bf16(kf[3],qr[1],C1,0,0,0),   P0[14],P0[15],P1[0],P1[1],   pw1[2]=PKW(P0,12),pw1[3]=PKW(P0,14), pw1); \
    VRD(2); SBAR(); GAPA(C0=__builtin_amdgcn_mfma_f32_32x32x16_bf16(kf[4],qr[2],C0,0,0,0),   P1[2],P1[3],P1[4],P1[5],     pw2[0]=PKW(P1,0), pw2[1]=PKW(P1,2), pw2); \
    VRD(6); SBAR(); GAPA(C1=__builtin_amdgcn_mfma_f32_32x32x16_bf16(kf[5],qr[2],C1,0,0,0),   P1[6],P1[7],P1[8],P1[9],     pw2[2]=PKW(P1,4), pw2[3]=PKW(P1,6), pw2); \
    VRD(3); SBAR(); GAPA(C0=__builtin_amdgcn_mfma_f32_32x32x16_bf16(kf[6],qr[3],C0,0,0,0),   P1[10],P1[11],P1[12],P1[13], pw3[0]=PKW(P1,8), pw3[1]=PKW(P1,10), pw3); \
    VRD(7); SBAR(); GAPA(C1=__builtin_amdgcn_mfma_f32_32x32x16_bf16(kf[7],qr[3],C1,0,0,0),   P1[14],P1[15],0.f,0.f,       pw3[2]=PKW(P1,12),pw3[3]=PKW(P1,14), pw3); \
    l_reg+=sacc; \
    if(GK){DMA_K((t)+3,sl_cur);} if(GV){DMA_V((t)+1,sl_next);} \
    CMASK(C0,C1,t); \
    SBAR(); \
    GAPB(o[0]=__builtin_amdgcn_mfma_f32_32x32x16_bf16(PAF(0),VFR(0),o[0],0,0,0), C0,0); \
    GAPB(o[1]=__builtin_amdgcn_mfma_f32_32x32x16_bf16(PAF(0),VFR(4),o[1],0,0,0), C0,4); \
    KRD(GL,0); GAPB(o[0]=__builtin_amdgcn_mfma_f32_32x32x16_bf16(PAF(1),VFR(1),o[0],0,0,0), C0,8); \
    KRD(GL,1); GAPB(o[1]=__builtin_amdgcn_mfma_f32_32x32x16_bf16(PAF(1),VFR(5),o[1],0,0,0), C0,12); \
    KRD(GL,2); GAPB(o[0]=__builtin_amdgcn_mfma_f32_32x32x16_bf16(PAF(2),VFR(2),o[0],0,0,0), C1,0); \
    KRD(GL,3); GAPB(o[1]=__builtin_amdgcn_mfma_f32_32x32x16_bf16(PAF(2),VFR(6),o[1],0,0,0), C1,4); \
    GAPB(o[0]=__builtin_amdgcn_mfma_f32_32x32x16_bf16(PAF(3),VFR(3),o[0],0,0,0), C1,8); \
    GAPB(o[1]=__builtin_amdgcn_mfma_f32_32x32x16_bf16(PAF(3),VFR(7),o[1],0,0,0), C1,12); \
    }while(0)
  int t=1;
  #undef CMASK
  #define CMASK(P0,P1,t) do{ if(MOBA) bmask(P0,P1,(selm>>((t)>>2))&1u); }while(0)
  for(;t+5<NT;t+=2){
    STEP(pB0,pB1,pA0,pA1,t,true,true,true);     WAIT_BAR(2); RESC(); ROT();
    STEP(pA0,pA1,pB0,pB1,t+1,true,true,true);   WAIT_BAR(2); RESC(); ROT();
  }
  #undef CMASK
  #define CMASK(P0,P1,t) do{int jb_=(t)-(NT-4); if(jb_>=0)cmask(P0,P1,jb_,qrel,hi); else if(MOBA) bmask(P0,P1,(selm>>((t)>>2))&1u);}while(0)
  #define ENDW(tt) do{ if((tt)+3<NT){WAIT_BAR(2);} else if((tt)+2<NT){WAIT_BAR(1);} else {WAIT_BAR(0);} }while(0)
  for(;t+1<NT;t+=2){
    STEP(pB0,pB1,pA0,pA1,t,(t+3<NT),(t+1<NT),(t+1<NT));       ENDW(t);   RESC(); ROT();
    STEP(pA0,pA1,pB0,pB1,t+1,(t+4<NT),(t+2<NT),(t+2<NT));     ENDW(t+1); RESC(); ROT();
  }
  STEP(pB0,pB1,pA0,pA1,NT-1,false,false,false); RESC();
  { float sacc=pB0[0]+pB0[1]; _Pragma("unroll") for(int r=2;r<16;++r)sacc+=pB0[r]; _Pragma("unroll") for(int r=0;r<16;++r)sacc+=pB1[r]; l_reg+=sacc;
    pw0=(u32x4){PKW(pB0,0),PKW(pB0,2),PKW(pB0,4),PKW(pB0,6)};pw1=(u32x4){PKW(pB0,8),PKW(pB0,10),PKW(pB0,12),PKW(pB0,14)};pw2=(u32x4){PKW(pB1,0),PKW(pB1,2),PKW(pB1,4),PKW(pB1,6)};pw3=(u32x4){PKW(pB1,8),PKW(pB1,10),PKW(pB1,12),PKW(pB1,14)};
    SBAR(); pv(o,vb0+sl_cur,PAF(0),PAF(1),PAF(2),PAF(3)); }
  #undef PKW
  #undef PAF
  #undef VFR
  #undef PIN
  #undef MX3
  #undef GAPA
  #undef GAPB
  #undef EX
  #undef VRD
  #undef KRD
  #undef STEP
  #undef ENDW
  {auto rr=__builtin_amdgcn_permlane32_swap(__float_as_uint(l_reg),__float_as_uint(l_reg),false,false);l_reg=__uint_as_float(rr[0])+__uint_as_float(rr[1]);}
  if(hi==0)wsf[32+r32]=l_reg;asm volatile("s_waitcnt lgkmcnt(0)":::"memory");
  float rli[16];
  #pragma unroll
  for(int r=0;r<16;++r)rli[r]=__builtin_amdgcn_rcpf(wsf[32+crow(r,hi)]);
  bf16*Ow=Ou+(long)(wid*QBLK)*PO;
  { bf16*stg=(bf16*)(shm+LDS_OST)+wid*2048;
    #pragma unroll
    for(int r=0;r<16;++r){const int orow=crow(r,hi);
      #pragma unroll
      for(int d0=0;d0<2;++d0)stg[orow*64+d0*32+r32]=__float2bfloat16(o[d0][r]*rli[r]);}
    asm volatile("s_waitcnt lgkmcnt(0)":::"memory");
    #pragma unroll
    for(int i=0;i<4;++i){const int row=i*8+(lane>>3),ch=lane&7; u32x4 v=*(const u32x4*)(stg+row*64+ch*8);
      if(MOBA){ float f[8]; float ss=0.f;
        #pragma unroll
        for(int e=0;e<4;++e){ f[2*e]=__uint_as_float(v[e]<<16); f[2*e+1]=__uint_as_float(v[e]&0xffff0000u); ss+=f[2*e]*f[2*e]+f[2*e+1]*f[2*e+1]; }
        ss+=__shfl_xor(ss,1); ss+=__shfl_xor(ss,2); ss+=__shfl_xor(ss,4);
        const float rs=__builtin_amdgcn_rsqf(ss*(1.0f/64.0f)+1e-6f);
        const float4 g0=*reinterpret_cast<const float4*>(gm+ch*8), g1=*reinterpret_cast<const float4*>(gm+ch*8+4);
        v[0]=cvtpk_s(f[0]*rs*g0.x,f[1]*rs*g0.y); v[1]=cvtpk_s(f[2]*rs*g0.z,f[3]*rs*g0.w); v[2]=cvtpk_s(f[4]*rs*g1.x,f[5]*rs*g1.y); v[3]=cvtpk_s(f[6]*rs*g1.z,f[7]*rs*g1.w); }
      ATTN_STORE16(Ow+(long)row*PO+ch*8,v);} }
  asm volatile("s_waitcnt lgkmcnt(0)\n\ts_barrier":::"memory");
  #undef DMA_K
  #undef DMA_V
  #undef CMASK
  #undef START
  #undef RESC
  #undef ROT
}
constexpr int ATTN_LDS_BYTES=LDS_BYTES;
#undef SBAR
#undef WAIT_BAR
}
typedef unsigned short bf16;
constexpr int T = 65536, DM = 1024, SEQ = 2048, NB = 32;
constexpr size_t MiB = 1u << 20;
constexpr size_t WS_CTL = 0, WS_KMEAN = 1 * MiB, WS_ZERO_BYTES = 2 * MiB;
constexpr size_t WS_ROPE = 2 * MiB, WS_SCAL = 3 * MiB;
constexpr size_t WS_WIN = 4 * MiB, WS_WOUT = 10 * MiB, WS_WQ = 12 * MiB, WS_SUBK = 16 * MiB;
constexpr size_t WS_DOWN = 32 * MiB, WS_UP = 64 * MiB, WS_XN = 96 * MiB;
constexpr size_t WS_QKV = 224 * MiB, QKV_STRIDE = 64 * MiB;
constexpr size_t WS_PQ = 224 * MiB;
constexpr size_t WS_MIXED = 608 * MiB, WS_DO = 736 * MiB, WS_IDS = 864 * MiB, WS_GATES = 896 * MiB, WS_END = 928 * MiB;
constexpr size_t QKV_ELEMS = QKV_STRIDE / 2;
constexpr float QSCALE = 0.125f * 1.4426950408889634f;
constexpr float EPS = 1e-6f;

__device__ __forceinline__ unsigned f2bf(float f) { unsigned u = __float_as_uint(f); return (u + 0x7fffu + ((u >> 16) & 1u)) >> 16; }
__device__ __forceinline__ float bf2f(unsigned h) { return __uint_as_float(h << 16); }
__device__ __forceinline__ float wave_sum(float v) {
#pragma unroll
    for (int o = 1; o < 64; o <<= 1) v += __shfl_xor(v, o);
    return v;
}

#define LAS __attribute__((address_space(3)))
constexpr int NTHR = 512, NWAVE = 8;
constexpr int LDS_BYTES = 147456;

struct Params {
    const float* in[19]; float* out; unsigned char* ws;
};

__device__ __forceinline__ void ph_transpose(const float* __restrict__ W, int K, int N, bf16* __restrict__ WT, float* tiles, int wg, int nwg, int tid) {
    float (*tile)[33] = (float (*)[33])(tiles + (tid >> 8) * (32 * 33));
    const int nt_n = N / 32, nitems = nt_n * (K / 32), tx = tid & 31, ty = (tid & 255) >> 5;
    for (int it0 = wg * 2; it0 < nitems; it0 += nwg * 2) {
        const int it = it0 + (tid >> 8); const bool act = it < nitems;
        const int n0 = (it % nt_n) * 32, k0 = (it / nt_n) * 32;
        if (act) for (int i = ty; i < 32; i += 8) tile[i][tx] = W[(size_t)(k0 + i) * N + n0 + tx];
        __syncthreads();
        if (act) for (int i = ty; i < 32; i += 8) WT[(size_t)(n0 + i) * K + k0 + tx] = (bf16)f2bf(tile[tx][i]);
        __syncthreads();
    }
}
__device__ __forceinline__ void ph_convert(const float* __restrict__ src, bf16* __restrict__ dst, size_t n4, int wg, int nwg, int tid) {
    for (size_t i = (size_t)wg * NTHR + tid; i < n4; i += (size_t)nwg * NTHR) {
        const float4 v = ((const float4*)src)[i];
        uint2 o; o.x = f2bf(v.x) | (f2bf(v.y) << 16); o.y = f2bf(v.z) | (f2bf(v.w) << 16);
        ((uint2*)dst)[i] = o;
    }
}
__device__ __forceinline__ void ph_rope(float* __restrict__ rope, int wg, int nwg, int tid) {
    for (int i = wg * NTHR + tid; i < SEQ * 32; i += nwg * NTHR) {
        const int pos = i >> 5, j = i & 31;
        const float inv = 1.0f / exp2f((float)j * (13.287712379549449f / 32.0f));
        const float ang = (float)pos * inv;
        double rev = (double)ang * 0.15915494309189535; rev -= floor(rev);
        rope[i] = __builtin_amdgcn_cosf((float)rev); rope[SEQ * 32 + i] = __builtin_amdgcn_sinf((float)rev);
    }
}
__device__ __forceinline__ void ph_rmsnorm(const float* __restrict__ x, const float* __restrict__ g, bf16* __restrict__ out, int rows, int wg, int nwg, int tid) {
    const int lane = tid & 63, nw = nwg * NWAVE;
    for (int r = wg * NWAVE + (tid >> 6); r < rows; r += nw) {
        const float4* xr = (const float4*)(x + (size_t)r * DM) + lane;
        float4 v[4]; float s = 0.f;
#pragma unroll
        for (int j = 0; j < 4; ++j) { v[j] = xr[64 * j]; s += (v[j].x * v[j].x + v[j].y * v[j].y) + (v[j].z * v[j].z + v[j].w * v[j].w); }
        const float rs = rsqrtf(wave_sum(s) * (1.0f / DM) + EPS);
        uint2* o = (uint2*)(out + (size_t)r * DM) + lane;
#pragma unroll
        for (int j = 0; j < 4; ++j) { const float4 gg = ((const float4*)g)[lane + 64 * j];
            uint2 w; w.x = f2bf(v[j].x * rs * gg.x) | (f2bf(v[j].y * rs * gg.y) << 16); w.y = f2bf(v[j].z * rs * gg.z) | (f2bf(v[j].w * rs * gg.w) << 16);
            o[64 * j] = w; }
    }
}
__device__ __forceinline__ void ph_qk_post(bf16* __restrict__ qkv, const float* __restrict__ rope, const float* __restrict__ gqm, const float* __restrict__ gkm,
                                           const float* __restrict__ gqd, const float* __restrict__ gkd, float* __restrict__ kmean, int wg, int nwg, int tid) {
    const int lane = tid & 63, half = lane >> 5, j = lane & 31, wv = tid >> 6;
    for (int blk = wg; blk < T / 256; blk += nwg) {
        float ks[4][2];
#pragma unroll
        for (int a = 0; a < 4; ++a) { ks[a][0] = 0.f; ks[a][1] = 0.f; }
        for (int tt = wv; tt < 256; tt += NWAVE) {
            const int t = blk * 256 + tt, pos = t & (SEQ - 1);
            const float c = rope[pos * 32 + j], sn = rope[SEQ * 32 + pos * 32 + j];
#pragma unroll
            for (int it = 0; it < 16; ++it) {
                const int s = it * 2 + half, type = it >> 2, hs = s & 7;
                bf16* buf = qkv + (size_t)(type < 2 ? type : type + 1) * QKV_ELEMS + (size_t)t * 512 + hs * 64;
                const float x1 = bf2f(buf[j]), x2 = bf2f(buf[j + 32]);
                float ss = x1 * x1 + x2 * x2;
#pragma unroll
                for (int o = 1; o < 32; o <<= 1) ss += __shfl_xor(ss, o);
                const float rs = rsqrtf(ss * (1.0f / 64.0f) + EPS);
                const float* g = type == 0 ? gqm : type == 1 ? gkm : type == 2 ? gqd + (hs & 1) * 64 : gkd + (hs & 1) * 64;
                const float y1 = x1 * rs * g[j], y2 = x2 * rs * g[j + 32];
                float o1 = y1 * c - y2 * sn, o2 = y2 * c + y1 * sn;
                if (type == 0 || type == 2) { o1 *= QSCALE; o2 *= QSCALE; }
                if (type == 1) { ks[it - 4][0] += o1; ks[it - 4][1] += o2; }
                buf[j] = (bf16)f2bf(o1); buf[j + 32] = (bf16)f2bf(o2);
            }
        }
        const int b = blk >> 3, nb = blk & 7;
#pragma unroll
        for (int a = 0; a < 4; ++a) { const int h = a * 2 + half; float* km = kmean + (((size_t)b * 8 + h) * 8 + nb) * 64;
            atomicAdd(km + j, ks[a][0] * (1.0f / 256.0f)); atomicAdd(km + j + 32, ks[a][1] * (1.0f / 256.0f)); }
    }
}
__device__ __forceinline__ void ph_diff_combine(const bf16* __restrict__ dob, float lam, const float* __restrict__ gain_d, bf16* __restrict__ mixed, int wg, int nwg, int tid) {
    const int lane = tid & 63, nw = nwg * NWAVE;
    for (int w = wg * NWAVE + (tid >> 6); w < T * 4; w += nw) {
        const int t = w >> 2, h = w & 3; const bf16* p = dob + (size_t)t * 1024 + h * 256;
        const float da = bf2f(p[lane]) - lam * bf2f(p[128 + lane]), db = bf2f(p[64 + lane]) - lam * bf2f(p[192 + lane]);
        const float rs = rsqrtf(wave_sum(da * da + db * db) * (1.0f / 128.0f) + EPS) * 0.8f;
        bf16* o = mixed + (size_t)t * 1024 + 512 + h * 128;
        o[lane] = (bf16)f2bf(da * rs * gain_d[h * 128 + lane]); o[64 + lane] = (bf16)f2bf(db * rs * gain_d[h * 128 + 64 + lane]);
    }
}
typedef float rf32x16 __attribute__((ext_vector_type(16)));
typedef short rbf16x8 __attribute__((ext_vector_type(8)));
__device__ __forceinline__ unsigned umax_(unsigned a, unsigned b) { return a > b ? a : b; }
__device__ __forceinline__ unsigned umin_(unsigned a, unsigned b) { return a > b ? b : a; }
#define CE_D(x, y) { const unsigned mx_ = umax_(x, y), mn_ = umin_(x, y); x = mx_; y = mn_; }
__device__ __forceinline__ void sort16_desc(unsigned (&v)[16]) {
    CE_D(v[0], v[1]) CE_D(v[3], v[2]) CE_D(v[4], v[5]) CE_D(v[7], v[6]) CE_D(v[8], v[9]) CE_D(v[11], v[10]) CE_D(v[12], v[13]) CE_D(v[15], v[14])
    CE_D(v[0], v[2]) CE_D(v[1], v[3]) CE_D(v[6], v[4]) CE_D(v[7], v[5]) CE_D(v[8], v[10]) CE_D(v[9], v[11]) CE_D(v[14], v[12]) CE_D(v[15], v[13])
    CE_D(v[0], v[1]) CE_D(v[2], v[3]) CE_D(v[5], v[4]) CE_D(v[7], v[6]) CE_D(v[8], v[9]) CE_D(v[10], v[11]) CE_D(v[13], v[12]) CE_D(v[15], v[14])
    CE_D(v[0], v[4]) CE_D(v[1], v[5]) CE_D(v[2], v[6]) CE_D(v[3], v[7]) CE_D(v[12], v[8]) CE_D(v[13], v[9]) CE_D(v[14], v[10]) CE_D(v[15], v[11])
    CE_D(v[0], v[2]) CE_D(v[1], v[3]) CE_D(v[4], v[6]) CE_D(v[5], v[7]) CE_D(v[10], v[8]) CE_D(v[11], v[9]) CE_D(v[14], v[12]) CE_D(v[15], v[13])
    CE_D(v[0], v[1]) CE_D(v[2], v[3]) CE_D(v[4], v[5]) CE_D(v[6], v[7]) CE_D(v[9], v[8]) CE_D(v[11], v[10]) CE_D(v[13], v[12]) CE_D(v[15], v[14])
    CE_D(v[0], v[8]) CE_D(v[1], v[9]) CE_D(v[2], v[10]) CE_D(v[3], v[11]) CE_D(v[4], v[12]) CE_D(v[5], v[13]) CE_D(v[6], v[14]) CE_D(v[7], v[15])
    CE_D(v[0], v[4]) CE_D(v[1], v[5]) CE_D(v[2], v[6]) CE_D(v[3], v[7]) CE_D(v[8], v[12]) CE_D(v[9], v[13]) CE_D(v[10], v[14]) CE_D(v[11], v[15])
    CE_D(v[0], v[2]) CE_D(v[1], v[3]) CE_D(v[4], v[6]) CE_D(v[5], v[7]) CE_D(v[8], v[10]) CE_D(v[9], v[11]) CE_D(v[12], v[14]) CE_D(v[13], v[15])
    CE_D(v[0], v[1]) CE_D(v[2], v[3]) CE_D(v[4], v[5]) CE_D(v[6], v[7]) CE_D(v[8], v[9]) CE_D(v[10], v[11]) CE_D(v[12], v[13]) CE_D(v[14], v[15])
}
__device__ __forceinline__ void merge16_desc(unsigned (&a)[16], const unsigned (&b)[16]) {
    a[0] = umax_(a[0], b[15]); a[1] = umax_(a[1], b[14]); a[2] = umax_(a[2], b[13]); a[3] = umax_(a[3], b[12]); a[4] = umax_(a[4], b[11]); a[5] = umax_(a[5], b[10]); a[6] = umax_(a[6], b[9]); a[7] = umax_(a[7], b[8]); a[8] = umax_(a[8], b[7]); a[9] = umax_(a[9], b[6]); a[10] = umax_(a[10], b[5]); a[11] = umax_(a[11], b[4]); a[12] = umax_(a[12], b[3]); a[13] = umax_(a[13], b[2]); a[14] = umax_(a[14], b[1]); a[15] = umax_(a[15], b[0]);
    CE_D(a[0], a[8]) CE_D(a[1], a[9]) CE_D(a[2], a[10]) CE_D(a[3], a[11]) CE_D(a[4], a[12]) CE_D(a[5], a[13]) CE_D(a[6], a[14]) CE_D(a[7], a[15])
    CE_D(a[0], a[4]) CE_D(a[1], a[5]) CE_D(a[2], a[6]) CE_D(a[3], a[7]) CE_D(a[8], a[12]) CE_D(a[9], a[13]) CE_D(a[10], a[14]) CE_D(a[11], a[15])
    CE_D(a[0], a[2]) CE_D(a[1], a[3]) CE_D(a[4], a[6]) CE_D(a[5], a[7]) CE_D(a[8], a[10]) CE_D(a[9], a[11]) CE_D(a[12], a[14]) CE_D(a[13], a[15])
    CE_D(a[0], a[1]) CE_D(a[2], a[3]) CE_D(a[4], a[5]) CE_D(a[6], a[7]) CE_D(a[8], a[9]) CE_D(a[10], a[11]) CE_D(a[12], a[13]) CE_D(a[14], a[15])
}
__device__ __forceinline__ void top16_of_64(unsigned (&G)[4][16]) {
    sort16_desc(G[0]); sort16_desc(G[1]); sort16_desc(G[2]); sort16_desc(G[3]);
    merge16_desc(G[0], G[1]); merge16_desc(G[2], G[3]); merge16_desc(G[0], G[2]);
}
__device__ __forceinline__ void ph_peer_route(const bf16* __restrict__ PQ, const bf16* __restrict__ subk, int* __restrict__ ids, float* __restrict__ gates, unsigned* ldsu, int wg, int nwg, int tid) {
    const int lane = tid & 63, r = lane & 31, hi = lane >> 5, wv = tid >> 6;
    unsigned* myl = ldsu + wv * 2048;
    const int nitems = (T / 32) * 8;
    for (int item = wg * NWAVE + wv; item < nitems; item += nwg * NWAVE) {
        const int tb = item >> 3, h = item & 7, t = tb * 32 + r;
        unsigned L[2][16];
#pragma unroll
        for (int p = 0; p < 2; ++p) {
            const bf16* qp = PQ + (size_t)t * 2048 + h * 256 + p * 128 + hi * 8;
            rbf16x8 bq[8];
#pragma unroll
            for (int s = 0; s < 8; ++s) bq[s] = *(const rbf16x8*)(qp + 16 * s);
            const bf16* kp = subk + ((size_t)(h * 2 + p) * 128 + r) * 128 + hi * 8;
            unsigned G[4][16]; unsigned hmask = hi ? ~4u : ~0u; asm volatile("" : "+v"(hmask));
#pragma unroll
            for (int nb = 0; nb < 4; ++nb) {
                rf32x16 acc = rf32x16{};
#pragma unroll
                for (int s = 0; s < 8; ++s) { const rbf16x8 a = *(const rbf16x8*)(kp + (size_t)nb * 32 * 128 + 16 * s); acc = __builtin_amdgcn_mfma_f32_32x32x16_bf16(a, bq[s], acc, 0, 0, 0); }
#pragma unroll
                for (int i = 0; i < 16; ++i) { const float v = fmaxf(acc[i] + 16.0f, 0.0f); const int n = nb * 32 + (i & 3) + 8 * (i >> 2);
                    G[nb][i] = ((__float_as_uint(v) & ~127u) | (unsigned)(127 - n)) & hmask; }
                asm volatile("" ::: "memory"); __builtin_amdgcn_sched_barrier(0);
            }
            top16_of_64(G);
            unsigned O[16];
#pragma unroll
            for (int i = 0; i < 16; ++i) { auto rr = __builtin_amdgcn_permlane32_swap(G[0][i], G[0][i], false, false); O[i] = hi ? rr[0] : rr[1]; }
            merge16_desc(G[0], O);
#pragma unroll
            for (int i = 0; i < 16; ++i) L[p][i] = G[0][i];
            asm volatile("" ::: "memory"); __builtin_amdgcn_sched_barrier(0);
        }
#pragma unroll
        for (int i = 0; i < 16; ++i) { myl[i * 64 + lane] = 127u - (L[0][i] & 127u); myl[(16 + i) * 64 + lane] = 127u - (L[1][i] & 127u); }
        float fa[16], fb[16];
#pragma unroll
        for (int i = 0; i < 16; ++i) { fa[i] = __uint_as_float(L[0][i] & ~127u); fb[i] = __uint_as_float(L[1][i] & ~127u); }
        unsigned C[4][16];
        C[0][0] = (__float_as_uint(fmaxf(fa[0] + fb[0] - 24.0f, 0.0f)) & ~255u) | 255u;
        C[0][1] = (__float_as_uint(fmaxf(fa[0] + fb[1] - 24.0f, 0.0f)) & ~255u) | 254u;
        C[0][2] = (__float_as_uint(fmaxf(fa[0] + fb[2] - 24.0f, 0.0f)) & ~255u) | 253u;
        C[0][3] = (__float_as_uint(fmaxf(fa[0] + fb[3] - 24.0f, 0.0f)) & ~255u) | 252u;
        C[0][4] = (__float_as_uint(fmaxf(fa[0] + fb[4] - 24.0f, 0.0f)) & ~255u) | 251u;
        C[0][5] = (__float_as_uint(fmaxf(fa[0] + fb[5] - 24.0f, 0.0f)) & ~255u) | 250u;
        C[0][6] = (__float_as_uint(fmaxf(fa[0] + fb[6] - 24.0f, 0.0f)) & ~255u) | 249u;
        C[0][7] = (__float_as_uint(fmaxf(fa[0] + fb[7] - 24.0f, 0.0f)) & ~255u) | 248u;
        C[0][8] = (__float_as_uint(fmaxf(fa[0] + fb[8] - 24.0f, 0.0f)) & ~255u) | 247u;
        C[0][9] = (__float_as_uint(fmaxf(fa[0] + fb[9] - 24.0f, 0.0f)) & ~255u) | 246u;
        C[0][10] = (__float_as_uint(fmaxf(fa[0] + fb[10] - 24.0f, 0.0f)) & ~255u) | 245u;
        C[0][11] = (__float_as_uint(fmaxf(fa[0] + fb[11] - 24.0f, 0.0f)) & ~255u) | 244u;
        C[0][12] = (__float_as_uint(fmaxf(fa[0] + fb[12] - 24.0f, 0.0f)) & ~255u) | 243u;
        C[0][13] = (__float_as_uint(fmaxf(fa[0] + fb[13] - 24.0f, 0.0f)) & ~255u) | 242u;
        C[0][14] = (__float_as_uint(fmaxf(fa[0] + fb[14] - 24.0f, 0.0f)) & ~255u) | 241u;
        C[0][15] = (__float_as_uint(fmaxf(fa[0] + fb[15] - 24.0f, 0.0f)) & ~255u) | 240u;
        C[1][0] = (__float_as_uint(fmaxf(fa[1] + fb[0] - 24.0f, 0.0f)) & ~255u) | 239u;
        C[1][1] = (__float_as_uint(fmaxf(fa[1] + fb[1] - 24.0f, 0.0f)) & ~255u) | 238u;
        C[1][2] = (__float_as_uint(fmaxf(fa[1] + fb[2] - 24.0f, 0.0f)) & ~255u) | 237u;
        C[1][3] = (__float_as_uint(fmaxf(fa[1] + fb[3] - 24.0f, 0.0f)) & ~255u) | 236u;
        C[1][4] = (__float_as_uint(fmaxf(fa[1] + fb[4] - 24.0f, 0.0f)) & ~255u) | 235u;
        C[1][5] = (__float_as_uint(fmaxf(fa[1] + fb[5] - 24.0f, 0.0f)) & ~255u) | 234u;
        C[1][6] = (__float_as_uint(fmaxf(fa[1] + fb[6] - 24.0f, 0.0f)) & ~255u) | 233u;
        C[1][7] = (__float_as_uint(fmaxf(fa[1] + fb[7] - 24.0f, 0.0f)) & ~255u) | 232u;
        C[1][8] = (__float_as_uint(fmaxf(fa[2] + fb[0] - 24.0f, 0.0f)) & ~255u) | 223u;
        C[1][9] = (__float_as_uint(fmaxf(fa[2] + fb[1] - 24.0f, 0.0f)) & ~255u) | 222u;
        C[1][10] = (__float_as_uint(fmaxf(fa[2] + fb[2] - 24.0f, 0.0f)) & ~255u) | 221u;
        C[1][11] = (__float_as_uint(fmaxf(fa[2] + fb[3] - 24.0f, 0.0f)) & ~255u) | 220u;
        C[1][12] = (__float_as_uint(fmaxf(fa[2] + fb[4] - 24.0f, 0.0f)) & ~255u) | 219u;
        C[1][13] = (__float_as_uint(fmaxf(fa[3] + fb[0] - 24.0f, 0.0f)) & ~255u) | 207u;
        C[1][14] = (__float_as_uint(fmaxf(fa[3] + fb[1] - 24.0f, 0.0f)) & ~255u) | 206u;
        C[1][15] = (__float_as_uint(fmaxf(fa[3] + fb[2] - 24.0f, 0.0f)) & ~255u) | 205u;
        C[2][0] = (__float_as_uint(fmaxf(fa[3] + fb[3] - 24.0f, 0.0f)) & ~255u) | 204u;
        C[2][1] = (__float_as_uint(fmaxf(fa[4] + fb[0] - 24.0f, 0.0f)) & ~255u) | 191u;
        C[2][2] = (__float_as_uint(fmaxf(fa[4] + fb[1] - 24.0f, 0.0f)) & ~255u) | 190u;
        C[2][3] = (__float_as_uint(fmaxf(fa[4] + fb[2] - 24.0f, 0.0f)) & ~255u) | 189u;
        C[2][4] = (__float_as_uint(fmaxf(fa[5] + fb[0] - 24.0f, 0.0f)) & ~255u) | 175u;
        C[2][5] = (__float_as_uint(fmaxf(fa[5] + fb[1] - 24.0f, 0.0f)) & ~255u) | 174u;
        C[2][6] = (__float_as_uint(fmaxf(fa[6] + fb[0] - 24.0f, 0.0f)) & ~255u) | 159u;
        C[2][7] = (__float_as_uint(fmaxf(fa[6] + fb[1] - 24.0f, 0.0f)) & ~255u) | 158u;
        C[2][8] = (__float_as_uint(fmaxf(fa[7] + fb[0] - 24.0f, 0.0f)) & ~255u) | 143u;
        C[2][9] = (__float_as_uint(fmaxf(fa[7] + fb[1] - 24.0f, 0.0f)) & ~255u) | 142u;
        C[2][10] = (__float_as_uint(fmaxf(fa[8] + fb[0] - 24.0f, 0.0f)) & ~255u) | 127u;
        C[2][11] = (__float_as_uint(fmaxf(fa[9] + fb[0] - 24.0f, 0.0f)) & ~255u) | 111u;
        C[2][12] = (__float_as_uint(fmaxf(fa[10] + fb[0] - 24.0f, 0.0f)) & ~255u) | 95u;
        C[2][13] = (__float_as_uint(fmaxf(fa[11] + fb[0] - 24.0f, 0.0f)) & ~255u) | 79u;
        C[2][14] = (__float_as_uint(fmaxf(fa[12] + fb[0] - 24.0f, 0.0f)) & ~255u) | 63u;
        C[2][15] = (__float_as_uint(fmaxf(fa[13] + fb[0] - 24.0f, 0.0f)) & ~255u) | 47u;
        C[3][0] = (__float_as_uint(fmaxf(fa[14] + fb[0] - 24.0f, 0.0f)) & ~255u) | 31u;
        C[3][1] = (__float_as_uint(fmaxf(fa[15] + fb[0] - 24.0f, 0.0f)) & ~255u) | 15u;
        C[3][2] = 0u;
        C[3][3] = 0u;
        C[3][4] = 0u;
        C[3][5] = 0u;
        C[3][6] = 0u;
        C[3][7] = 0u;
        C[3][8] = 0u;
        C[3][9] = 0u;
        C[3][10] = 0u;
        C[3][11] = 0u;
        C[3][12] = 0u;
        C[3][13] = 0u;
        C[3][14] = 0u;
        C[3][15] = 0u;
        top16_of_64(C);
        const float s0 = __uint_as_float(C[0][0] & ~255u);
        float ex[16]; float sum = 0.f; int eid[16];
#pragma unroll
        for (int k = 0; k < 16; ++k) { ex[k] = __expf(__uint_as_float(C[0][k] & ~255u) - s0); sum += ex[k];
            const unsigned code = 255u - (C[0][k] & 255u); const unsigned ia = myl[(code >> 4) * 64 + lane], ib = myl[(16 + (code & 15u)) * 64 + lane]; eid[k] = (int)(ia * 128u + ib); }
        const float inv = 1.0f / sum;
        if (hi == 0) { int4* dst = (int4*)(ids + (size_t)t * 128 + h * 16);
#pragma unroll
            for (int k = 0; k < 4; ++k) dst[k] = make_int4(eid[4 * k], eid[4 * k + 1], eid[4 * k + 2], eid[4 * k + 3]); }
        else { float4* dst = (float4*)(gates + (size_t)t * 128 + h * 16);
#pragma unroll
            for (int k = 0; k < 4; ++k) dst[k] = make_float4(ex[4 * k] * inv, ex[4 * k + 1] * inv, ex[4 * k + 2] * inv, ex[4 * k + 3] * inv); }
    }
}
typedef __bf16 bf16x2_t __attribute__((ext_vector_type(2)));
__device__ __forceinline__ float dot2bf(unsigned a, unsigned b, float acc) { return __builtin_amdgcn_fdot2_f32_bf16(__builtin_bit_cast(bf16x2_t, a), __builtin_bit_cast(bf16x2_t, b), acc, false); }
__device__ __forceinline__ float dot8(const uint4 a, const uint4 b, float s) { s = dot2bf(a.x, b.x, s); s = dot2bf(a.y, b.y, s); s = dot2bf(a.z, b.z, s); s = dot2bf(a.w, b.w, s); return s; }
__device__ __forceinline__ float gelu_erf(float z) { return 0.5f * z * (1.0f + erff(z * 0.70710678118654752f)); }
constexpr float TSCALE = 32.0f, TINV = 1.0f / 32.0f;
typedef float f32x2g __attribute__((ext_vector_type(2)));
constexpr int GB = 4;
struct GBatch { uint4 d[GB]; uint4 u[GB]; float g[GB]; };
__device__ __forceinline__ void gb_load(GBatch& B, const int* __restrict__ idp, const float* __restrict__ gp, int e0, const unsigned char* __restrict__ down, const unsigned char* __restrict__ up, int lane) {
#pragma unroll
    for (int j = 0; j < GB; ++j) { const int id = __builtin_amdgcn_readfirstlane(idp[e0 + j]); B.g[j] = gp[e0 + j];
        B.d[j] = *(const uint4*)(down + (size_t)id * DM + lane * 16); B.u[j] = *(const uint4*)(up + (size_t)id * DM + lane * 16); }
}
__device__ __forceinline__ void unpack16(const uint4 v, f32x2g (&f)[8]) {
    f[0] = __builtin_amdgcn_cvt_pk_f32_fp8((int)v.x, false); f[1] = __builtin_amdgcn_cvt_pk_f32_fp8((int)v.x, true);
    f[2] = __builtin_amdgcn_cvt_pk_f32_fp8((int)v.y, false); f[3] = __builtin_amdgcn_cvt_pk_f32_fp8((int)v.y, true);
    f[4] = __builtin_amdgcn_cvt_pk_f32_fp8((int)v.z, false); f[5] = __builtin_amdgcn_cvt_pk_f32_fp8((int)v.z, true);
    f[6] = __builtin_amdgcn_cvt_pk_f32_fp8((int)v.w, false); f[7] = __builtin_amdgcn_cvt_pk_f32_fp8((int)v.w, true);
}
__device__ __forceinline__ void gb_compute(const GBatch& B, const f32x2g (&xf)[8], f32x2g (&acc)[8]) {
    float z[GB];
#pragma unroll
    for (int j = 0; j < GB; ++j) { f32x2g d[8]; unpack16(B.d[j], d); f32x2g s = xf[0] * d[0];
#pragma unroll
        for (int i = 1; i < 8; ++i) s = __builtin_elementwise_fma(xf[i], d[i], s);
        z[j] = s.x + s.y; }
#pragma unroll
    for (int o = 1; o < 64; o <<= 1) {
#pragma unroll
        for (int j = 0; j < GB; ++j) z[j] += __shfl_xor(z[j], o); }
#pragma unroll
    for (int j = 0; j < GB; ++j) { const float w = B.g[j] * gelu_erf(z[j] * TINV); f32x2g u[8]; unpack16(B.u[j], u); const f32x2g w2 = {w, w};
#pragma unroll
        for (int i = 0; i < 8; ++i) acc[i] = __builtin_elementwise_fma(u[i], w2, acc[i]); }
}
__device__ __forceinline__ void ph_peer_gather(const bf16* __restrict__ xn, const int* __restrict__ ids, const float* __restrict__ gates, const unsigned char* __restrict__ down, const unsigned char* __restrict__ up, const float* x1, float* outw, int wg, int nwg, int tid) {
    const int lane = tid & 63, nw = nwg * NWAVE;
    for (int t = wg * NWAVE + (tid >> 6); t < T; t += nw) {
        const int* idp = ids + (size_t)t * 128; const float* gp = gates + (size_t)t * 128;
        GBatch B0, B1;
        gb_load(B0, idp, gp, 0, down, up, lane);
        f32x2g xf[8];
        { const uint4 xa = *(const uint4*)(xn + (size_t)t * DM + lane * 16), xb = *(const uint4*)(xn + (size_t)t * DM + lane * 16 + 8);
          const unsigned xw[8] = {xa.x, xa.y, xa.z, xa.w, xb.x, xb.y, xb.z, xb.w};
#pragma unroll
          for (int i = 0; i < 8; ++i) { xf[i].x = __uint_as_float(xw[i] << 16); xf[i].y = __uint_as_float(xw[i] & 0xffff0000u); } }
        f32x2g acc[8];
#pragma unroll
        for (int i = 0; i < 8; ++i) acc[i] = (f32x2g){0.f, 0.f};
        for (int e0 = 0; e0 < 128; e0 += 2 * GB) {
            gb_load(B1, idp, gp, e0 + GB, down, up, lane);
            gb_compute(B0, xf, acc);
            if (e0 + 2 * GB < 128) gb_load(B0, idp, gp, e0 + 2 * GB, down, up, lane);
            gb_compute(B1, xf, acc);
        }
        const float* xi = x1 + (size_t)t * DM + lane * 16; float* o = outw + (size_t)t * DM + lane * 16;
#pragma unroll
        for (int k = 0; k < 4; ++k) { float4 r = *(const float4*)(xi + 4 * k);
            r.x += acc[2 * k].x * TINV; r.y += acc[2 * k].y * TINV; r.z += acc[2 * k + 1].x * TINV; r.w += acc[2 * k + 1].y * TINV; *(float4*)(o + 4 * k) = r; }
    }
}
__device__ __forceinline__ void ph_convert_fp8(const float* __restrict__ src, unsigned* __restrict__ dst, size_t n4, int wg, int nwg, int tid) {
    for (size_t i = (size_t)wg * NTHR + tid; i < n4; i += (size_t)nwg * NTHR) {
        const float4 v = ((const float4*)src)[i];
        int w = __builtin_amdgcn_cvt_pk_fp8_f32(v.x * TSCALE, v.y * TSCALE, 0, false); w = __builtin_amdgcn_cvt_pk_fp8_f32(v.z * TSCALE, v.w * TSCALE, w, true);
        dst[i] = (unsigned)w;
    }
}
#ifndef REP_ATTN
#define REP_ATTN 1
#endif
#ifndef REP_ROUTE
#define REP_ROUTE 1
#endif
#ifndef REP_GATHER
#define REP_GATHER 1
#endif
#ifndef REP_QKPOST
#define REP_QKPOST 1
#endif
__global__ void __launch_bounds__(NTHR, 2) mk_fwd(Params P) {
    extern __shared__ __attribute__((aligned(16))) unsigned char lds[];
    cg::grid_group grid = cg::this_grid();
    const int wg = blockIdx.x, nwg = gridDim.x;
    unsigned char* ws = P.ws; float* out = P.out;
    const float* x = P.in[0];
    bf16* WinT = (bf16*)(ws + WS_WIN); bf16* WoutT = (bf16*)(ws + WS_WOUT); bf16* WqT = (bf16*)(ws + WS_WQ); bf16* SUBK = (bf16*)(ws + WS_SUBK);
    unsigned char* DOWN = ws + WS_DOWN; unsigned char* UP = ws + WS_UP; bf16* XN = (bf16*)(ws + WS_XN); bf16* QKV = (bf16*)(ws + WS_QKV); bf16* PQ = (bf16*)(ws + WS_PQ);
    bf16* MIXED = (bf16*)(ws + WS_MIXED); bf16* DOB = (bf16*)(ws + WS_DO); int* IDS = (int*)(ws + WS_IDS); float* GATES = (float*)(ws + WS_GATES);
    float* ROPE = (float*)(ws + WS_ROPE); float* KMEAN = (float*)(ws + WS_KMEAN);

    ph_transpose(P.in[2], 1024, 3072, WinT, (float*)lds, wg, nwg, fresh_tid());
    ph_transpose(P.in[13], 1024, 1024, WoutT, (float*)lds, wg, nwg, fresh_tid());
    ph_transpose(P.in[15], 1024, 2048, WqT, (float*)lds, wg, nwg, fresh_tid());
    ph_convert(P.in[16], SUBK, (size_t)16 * 128 * 128 / 4, wg, nwg, fresh_tid());
    ph_convert_fp8(P.in[17], (unsigned*)DOWN, (size_t)16384 * 1024 / 4, wg, nwg, fresh_tid());
    ph_convert_fp8(P.in[18], (unsigned*)UP, (size_t)16384 * 1024 / 4, wg, nwg, fresh_tid());
    ph_rope(ROPE, wg, nwg, fresh_tid());
    ph_rmsnorm(x, P.in[1], XN, T, wg, nwg, fresh_tid());
    float lam; { float a = 0.f, b = 0.f; for (int i = 0; i < 64; ++i) { a += P.in[7][i] * P.in[8][i]; b += P.in[9][i] * P.in[10][i]; } lam = expf(a) - expf(b) + 0.2f; }
    grid.sync();
    { pg8::Gemm g{XN, WinT, T, 3072, 1024}; pg8::EpiBf16 E{QKV, 512, 512, QKV_ELEMS}; pg8::StaticOrder S; S.init(g.M, g.N, nwg, wg);
      pg8::gemm_phase<pg8::EpiBf16, pg8::StaticOrder, true, true>((PG8_LAS unsigned char*)lds, g, S, E); }
    grid.sync();
    ph_qk_post(QKV, ROPE, P.in[3], P.in[4], P.in[5], P.in[6], KMEAN, wg, nwg, fresh_tid());
    grid.sync();
    for (int rep_ = 0; rep_ < REP_ATTN; ++rep_) { const float* gain_m = P.in[11];
      for (int combo = wg; combo < NB * 8; combo += nwg) {
        const int b = combo >> 3, hd = combo & 7; const size_t brow = (size_t)b * SEQ;
        for (int qb = 7; qb >= 0; --qb) { const size_t qrow = brow + (size_t)qb * 256;
            attn_body::attn_unit<8, true>(qb, (const attn_body::bf16*)(QKV + qrow * 512 + hd * 64), (const attn_body::bf16*)(QKV + QKV_ELEMS + brow * 512 + hd * 64),
                (const attn_body::bf16*)(QKV + 2 * QKV_ELEMS + brow * 512 + hd * 64), (attn_body::bf16*)(MIXED + qrow * 1024 + hd * 64), KMEAN + ((size_t)b * 8 + hd) * 512, gain_m + hd * 64, (char*)lds); }
      }
      for (int combo = wg; combo < NB * 16; combo += nwg) {
        const int b = combo >> 4, jj = combo & 15, h = jj >> 2, m = (jj >> 1) & 1, c = jj & 1; const size_t brow = (size_t)b * SEQ;
        for (int qb = 7; qb >= 0; --qb) { const size_t qrow = brow + (size_t)qb * 256;
            attn_body::attn_unit<8, false>(qb, (const attn_body::bf16*)(QKV + 3 * QKV_ELEMS + qrow * 512 + h * 128 + m * 64), (const attn_body::bf16*)(QKV + 4 * QKV_ELEMS + brow * 512 + h * 128 + m * 64),
                (const attn_body::bf16*)(QKV + 5 * QKV_ELEMS + brow * 512 + h * 128 + c * 64), (attn_body::bf16*)(DOB + qrow * 1024 + h * 256 + m * 128 + c * 64), nullptr, nullptr, (char*)lds); }
      } }
    grid.sync();
    ph_diff_combine(DOB, lam, P.in[12], MIXED, wg, nwg, fresh_tid());
    grid.sync();
    { pg8::Gemm g{MIXED, WoutT, T, 1024, 1024}; pg8::EpiResF32 E{x, out, 1024}; pg8::StaticOrder S; S.init(g.M, g.N, nwg, wg);
      pg8::gemm_phase<pg8::EpiResF32, pg8::StaticOrder, true, true>((PG8_LAS unsigned char*)lds, g, S, E); }
    grid.sync();
    ph_rmsnorm(out, P.in[14], XN, T, wg, nwg, fresh_tid());
    grid.sync();
    { pg8::Gemm g{XN, WqT, T, 2048, 1024}; pg8::EpiBf16 E{PQ, 2048, 0, 0}; pg8::StaticOrder S; S.init(g.M, g.N, nwg, wg);
      pg8::gemm_phase<pg8::EpiBf16, pg8::StaticOrder, true, true>((PG8_LAS unsigned char*)lds, g, S, E); }
    grid.sync();
    for (int rep_ = 0; rep_ < REP_ROUTE; ++rep_) ph_peer_route(PQ, SUBK, IDS, GATES, (unsigned*)lds, wg, nwg, fresh_tid());
    grid.sync();
    for (int rep_ = 1; rep_ < REP_GATHER; ++rep_) ph_peer_gather(XN, IDS, GATES, DOWN, UP, out, (float*)(ws + WS_MIXED), wg, nwg, fresh_tid());
    ph_peer_gather(XN, IDS, GATES, DOWN, UP, out, out, wg, nwg, fresh_tid());
}

extern "C" void kernel_launch(void* const* d_in, const int* in_sizes, int n_in, void* d_out, int out_size, void* d_ws, size_t ws_size, hipStream_t stream) {
    static int grid_blocks = 0;
    if (grid_blocks == 0) {
        if (n_in != 19 || in_sizes[0] != T * DM || out_size != T * DM || ws_size < WS_END) { fprintf(stderr, "kernel_launch: unexpected shapes (n_in %d in0 %d out %d ws %zu)\n", n_in, n_in > 0 ? in_sizes[0] : -1, out_size, ws_size); grid_blocks = -1; return; }
        int dev = 0, cus = 0, per_cu = 0;
        (void)hipGetDevice(&dev); (void)hipDeviceGetAttribute(&cus, hipDeviceAttributeMultiprocessorCount, dev);
        (void)hipFuncSetAttribute((const void*)mk_fwd, hipFuncAttributeMaxDynamicSharedMemorySize, LDS_BYTES);
        (void)hipOccupancyMaxActiveBlocksPerMultiprocessor(&per_cu, (const void*)mk_fwd, NTHR, LDS_BYTES);
        if (per_cu < 1 || cus < 1) { fprintf(stderr, "kernel_launch: occupancy query says %d blocks/CU on %d CUs\n", per_cu, cus); grid_blocks = -1; return; }
        if (per_cu > 1) per_cu = 1;
        grid_blocks = cus * per_cu;
    }
    if (grid_blocks < 0) return;
    (void)hipMemsetAsync(d_ws, 0, WS_ZERO_BYTES, stream);
    Params p{};
    for (int i = 0; i < 19; ++i) p.in[i] = (const float*)d_in[i];
    p.out = (float*)d_out; p.ws = (unsigned char*)d_ws;
    void* args[] = {&p};
    hipError_t e = hipLaunchCooperativeKernel((const void*)mk_fwd, dim3(grid_blocks), dim3(NTHR), args, LDS_BYTES, stream);
    if (e != hipSuccess) fprintf(stderr, "cooperative launch failed: %s (grid %d)\n", hipGetErrorString(e), grid_blocks);
}
```

```cpp
#include <hip/hip_runtime.h>
#include <hip/hip_cooperative_groups.h>
#include <cstdio>
#include <cstdint>
namespace cg = cooperative_groups;
__device__ __forceinline__ int fresh_tid() { int t = threadIdx.x; asm volatile("" : "+v"(t)); return t; }
namespace pg8 {
#define PG8_LAS __attribute__((address_space(3)))
typedef unsigned short bf16_t;
typedef short bf16x8 __attribute__((ext_vector_type(8)));
typedef float f32x4 __attribute__((ext_vector_type(4)));
typedef unsigned u32x4 __attribute__((ext_vector_type(4)));
constexpr int BM = 256, BK = 64, HALF = 128, HTB = HALF * BK * 2  , STAGE_BYTES = 8 * HTB, NXCD = 8, WGM = 8;

__host__ __device__ __forceinline__ int lds_byte(int r, int c) { const int st = (r >> 4) * 2 + (c >> 5), rr = r & 15, cc = c & 31, ob = rr * 64 + cc * 2; return st * 1024 + (ob ^ (((ob >> 9) & 1) << 5)); }
__host__ __device__ __forceinline__ void stage_rc(int b, int& R, int& C) { const int st = b / 1024, sb = b % 1024, swz = sb ^ (((sb >> 9) & 1) << 5); R = (st >> 1) * 16 + swz / 64; C = (st & 1) * 32 + (swz % 64) / 2; }
__host__ __device__ __forceinline__ int perm32(int rho) { const int n = rho >> 4, i = rho & 15; return 8 * (i >> 2) + 4 * n + (i & 3); }

struct Unit { int pm, pn; };
struct Gemm { const bf16_t* A; const bf16_t* Bt; int M, N, K; };

struct StaticOrder {
    int nM, nN, nwg, G, c;
    __host__ __device__ void init(int M, int N, int G_, int c_) { nM = M / BM; nN = N / BM; nwg = nM * nN; G = G_; c = c_; }
    __host__ __device__ bool next(int i, Unit& u) const {
        const long L = (long)i * G + c; if (L >= nwg) return false;
        int wgid = (int)L; { const int q = nwg / NXCD, r = nwg % NXCD, xcd = wgid % NXCD, off = wgid / NXCD; wgid = (xcd < r ? xcd * (q + 1) : r * (q + 1) + (xcd - r) * q) + off; }
        const int nig = WGM * nN, gid = wgid / nig, fm = gid * WGM, gsz = (nM - fm) < WGM ? (nM - fm) : WGM;
        u.pm = fm + ((wgid % nig) % gsz); u.pn = (wgid % nig) / gsz; return true;
    }
    __device__ __forceinline__ void a_ready(const Unit&) const {}
    __device__ __forceinline__ void done(const Unit&) const {}
};

__device__ __forceinline__ unsigned cvt_pk_bf16(float lo, float hi) { unsigned r; asm volatile("v_cvt_pk_bf16_f32 %0, %1, %2" : "=v"(r) : "v"(lo), "v"(hi)); return r; }
struct EpiBf16 {
    static constexpr bool PERM = true, AFTER_DRAIN = false;
    bf16_t* O; int ldc; int split_cols; size_t split_stride;
    __device__ __forceinline__ void operator()(const f32x4 (&acc)[2][2][4][2], const Unit& u, int wr, int wc, int fr, int fq) const {
        const int row0 = u.pm * BM + wr * 64 + fr; int colt = u.pn * BM; bf16_t* base = O;
        if (split_cols) { const int t = colt / split_cols; base += (size_t)t * split_stride; colt -= t * split_cols; }
        const int col0 = colt + wc * 32 + 8 * fq;
#pragma unroll
        for (int ai = 0; ai < 2; ++ai)
#pragma unroll
            for (int m = 0; m < 4; ++m) { bf16_t* rowp = base + (size_t)(row0 + ai * HALF + m * 16) * ldc + col0;
#pragma unroll
                for (int bj = 0; bj < 2; ++bj) { const f32x4 v0 = acc[ai][bj][m][0], v1 = acc[ai][bj][m][1];
                    u32x4 w; w.x = cvt_pk_bf16(v0[0], v0[1]); w.y = cvt_pk_bf16(v0[2], v0[3]); w.z = cvt_pk_bf16(v1[0], v1[1]); w.w = cvt_pk_bf16(v1[2], v1[3]);
                    *(u32x4*)(rowp + bj * HALF) = w; } }
    }
};
struct EpiResF32 {
    static constexpr bool PERM = false, AFTER_DRAIN = false;
    const float* base; float* out; int ldc;
    __device__ __forceinline__ void operator()(const f32x4 (&acc)[2][2][4][2], const Unit& u, int wr, int wc, int fr, int fq) const {
        const int col0 = u.pn * BM + wc * 32 + 4 * fq;
#pragma unroll
        for (int ai = 0; ai < 2; ++ai)
#pragma unroll
            for (int m = 0; m < 4; ++m) { const size_t off = (size_t)(u.pm * BM + ai * HALF + wr * 64 + m * 16 + fr) * ldc + col0;
#pragma unroll
                for (int bj = 0; bj < 2; ++bj)
#pragma unroll
                    for (int n = 0; n < 2; ++n) { const f32x4 bs = *(const f32x4*)(base + off + bj * HALF + n * 16); *(f32x4*)(out + off + bj * HALF + n * 16) = bs + acc[ai][bj][m][n]; } }
    }
};
template <class Epi, class Sched, bool ALIGN_EPI = false, bool SP2 = false>
__device__ __forceinline__ void gemm_phase(PG8_LAS unsigned char* lds, const Gemm g, const Sched& S, const Epi& E) {
    const int tid = fresh_tid(), wid = __builtin_amdgcn_readfirstlane(tid >> 6), lane = tid & 63, wr = wid >> 2, wc = wid & 3, fr = lane & 15, fq = lane >> 4;
    const int K = g.K, nt = K / BK;
    unsigned voffA[2], voffB[2];
#pragma unroll
    for (int i = 0; i < 2; ++i) { int R, C; stage_rc(tid * 16 + i * 8192, R, C); const int Rb = Epi::PERM ? ((R & ~31) + perm32(R & 31)) : R;
        voffA[i] = (unsigned)(R * K + C) * 2u; voffB[i] = (unsigned)(Rb * K + C) * 2u; }
    const size_t kstep = (size_t)(BK * 2);
    const size_t hstep = (size_t)HALF * K * 2;
    const size_t tstep = 2 * hstep;
    const unsigned ldsw = (unsigned)wid * 1024u;
    const int aoff = lds_byte(wr * 64 + fr, fq * 8), boff = lds_byte(wc * 32 + fr, fq * 8);
#define PG8_SA(b, h) (((b) * 2 + (h)) * HTB)
#define PG8_SB(b, h) ((4 + (b) * 2 + (h)) * HTB)
#define PG8_STAGE(bufoff, gbase, voff) do { _Pragma("unroll") for (int _i = 0; _i < 2; ++_i) \
        __builtin_amdgcn_global_load_lds((const unsigned*)((const char*)(gbase) + (voff)[_i]), (PG8_LAS unsigned*)(lds + (bufoff) + ldsw + _i * 8192), 16, 0, 0); } while (0)
#define PG8_LDA(dst, b, h) do { _Pragma("unroll") for (int m = 0; m < 4; ++m) _Pragma("unroll") for (int k = 0; k < 2; ++k) dst[m][k] = *(const PG8_LAS bf16x8*)(lds + PG8_SA(b, h) + aoff + m * 2048 + k * 1024); } while (0)
#define PG8_LDB(dst, b, h) do { _Pragma("unroll") for (int n = 0; n < 2; ++n) _Pragma("unroll") for (int k = 0; k < 2; ++k) dst[n][k] = *(const PG8_LAS bf16x8*)(lds + PG8_SB(b, h) + boff + n * 2048 + k * 1024); } while (0)
#define PG8_MMA(ai, bj, At, Bt) do { __builtin_amdgcn_s_setprio(1); _Pragma("unroll") for (int m = 0; m < 4; ++m) _Pragma("unroll") for (int n = 0; n < 2; ++n) _Pragma("unroll") for (int k = 0; k < 2; ++k) \
        acc[ai][bj][m][n] = __builtin_amdgcn_mfma_f32_16x16x32_bf16(Bt[n][k], At[m][k], acc[ai][bj][m][n], 0, 0, 0); __builtin_amdgcn_s_setprio(0); } while (0)
#define PG8_WAIT_V(n) asm volatile("s_waitcnt vmcnt(" #n ")" ::: "memory")
#define PG8_WAIT_L(n) asm volatile("s_waitcnt lgkmcnt(" #n ")" ::: "memory")
#define PG8_BAR __builtin_amdgcn_s_barrier()
#define PG8_SCHED __builtin_amdgcn_sched_barrier(0)
    Unit cur, nxt; int ui = 0;
    if (!S.next(0, cur)) return;
    f32x4 acc[2][2][4][2];
#pragma unroll
    for (int a = 0; a < 2; ++a)
#pragma unroll
        for (int b = 0; b < 2; ++b)
#pragma unroll
            for (int m = 0; m < 4; ++m)
#pragma unroll
                for (int n = 0; n < 2; ++n) acc[a][b][m][n] = (f32x4){0.f, 0.f, 0.f, 0.f};
    bf16x8 At[4][2], B0[2][2], B1[2][2];
    const char* cA = (const char*)g.A + (size_t)cur.pm * tstep; const char* cB = (const char*)g.Bt + (size_t)cur.pn * tstep;
    S.a_ready(cur);
    if constexpr (SP2) {
        PG8_STAGE(PG8_SB(0, 0), cB, voffB); PG8_STAGE(PG8_SB(0, 1), cB + hstep, voffB); PG8_STAGE(PG8_SA(0, 0), cA, voffA); PG8_STAGE(PG8_SA(0, 1), cA + hstep, voffA);
        if (wr == 1) PG8_BAR;
        PG8_WAIT_V(2); PG8_BAR;
        PG8_STAGE(PG8_SB(1, 0), cB + kstep, voffB); PG8_STAGE(PG8_SA(1, 0), cA + kstep, voffA); PG8_STAGE(PG8_SB(1, 1), cB + hstep + kstep, voffB);
        PG8_WAIT_V(6); PG8_BAR;
    } else {
        PG8_STAGE(PG8_SB(0, 0), cB, voffB); PG8_STAGE(PG8_SA(0, 0), cA, voffA); PG8_STAGE(PG8_SB(0, 1), cB + hstep, voffB); PG8_STAGE(PG8_SA(0, 1), cA + hstep, voffA);
        if (wr == 1) PG8_BAR;
        PG8_WAIT_V(4); PG8_BAR;
        PG8_STAGE(PG8_SB(1, 0), cB + kstep, voffB); PG8_STAGE(PG8_SA(1, 0), cA + kstep, voffA); PG8_STAGE(PG8_SB(1, 1), cB + hstep + kstep, voffB);
        PG8_WAIT_V(6); PG8_BAR;
    }
    for (;;) {
        const bool has_next = S.next(ui + 1, nxt);
        const char* nA = has_next ? (const char*)g.A + (size_t)nxt.pm * tstep : cA; const char* nB = has_next ? (const char*)g.Bt + (size_t)nxt.pn * tstep : cB;
        for (int t = 0; t < nt; t += 2) {
            const bool last = (t == nt - 2);
            const char* a1 = cA + (size_t)(t + 1) * kstep;
            const char* a2 = last ? nA : cA + (size_t)(t + 2) * kstep; const char* b2 = last ? nB : cB + (size_t)(t + 2) * kstep;
            const char* a3 = a2 + kstep; const char* b3 = b2 + kstep;
            if (last && has_next) S.a_ready(nxt);
            if constexpr (SP2) {
            PG8_LDB(B0, 0, 0); PG8_LDB(B1, 0, 1); PG8_SCHED; PG8_LDA(At, 0, 0); PG8_STAGE(PG8_SA(1, 1), a1 + hstep, voffA);
            PG8_WAIT_V(8); PG8_WAIT_L(0); PG8_BAR; PG8_MMA(0, 0, At, B0); PG8_MMA(0, 1, At, B1); PG8_BAR; PG8_SCHED;
            PG8_LDA(At, 0, 1); PG8_STAGE(PG8_SB(0, 0), b2, voffB); PG8_STAGE(PG8_SB(0, 1), b2 + hstep, voffB); PG8_STAGE(PG8_SA(0, 0), a2, voffA);
            PG8_WAIT_V(8); PG8_WAIT_L(0); PG8_BAR; PG8_MMA(1, 0, At, B0); PG8_MMA(1, 1, At, B1); PG8_BAR; PG8_SCHED;
            PG8_LDB(B0, 1, 0); PG8_LDB(B1, 1, 1); PG8_SCHED; PG8_LDA(At, 1, 0); PG8_STAGE(PG8_SA(0, 1), a2 + hstep, voffA);
            PG8_WAIT_V(8); PG8_WAIT_L(0); PG8_BAR; PG8_MMA(0, 0, At, B0); PG8_MMA(0, 1, At, B1); PG8_BAR; PG8_SCHED;
            PG8_LDA(At, 1, 1); PG8_STAGE(PG8_SB(1, 0), b3, voffB); PG8_STAGE(PG8_SB(1, 1), b3 + hstep, voffB); PG8_STAGE(PG8_SA(1, 0), a3, voffA);
            PG8_WAIT_V(8); PG8_WAIT_L(0); PG8_BAR; PG8_MMA(1, 0, At, B0); PG8_MMA(1, 1, At, B1); PG8_BAR; PG8_SCHED;
            } else {
            PG8_LDB(B0, 0, 0); PG8_SCHED; PG8_LDA(At, 0, 0); PG8_STAGE(PG8_SA(1, 1), a1 + hstep, voffA);
            PG8_WAIT_L(8); PG8_BAR; PG8_WAIT_L(0); PG8_MMA(0, 0, At, B0); PG8_BAR; PG8_SCHED;
            PG8_LDB(B1, 0, 1); PG8_STAGE(PG8_SB(0, 0), b2, voffB);
            PG8_BAR; PG8_WAIT_L(0); PG8_MMA(0, 1, At, B1); PG8_BAR;
            PG8_LDA(At, 0, 1); PG8_STAGE(PG8_SA(0, 0), a2, voffA);
            PG8_BAR; PG8_WAIT_L(0); PG8_MMA(1, 0, At, B0); PG8_BAR; PG8_SCHED;
            PG8_STAGE(PG8_SB(0, 1), b2 + hstep, voffB);
            PG8_WAIT_V(6); PG8_BAR; PG8_MMA(1, 1, At, B1); PG8_BAR;
            PG8_LDB(B0, 1, 0); PG8_SCHED; PG8_LDA(At, 1, 0); PG8_STAGE(PG8_SA(0, 1), a2 + hstep, voffA);
            PG8_WAIT_L(8); PG8_BAR; PG8_WAIT_L(0); PG8_MMA(0, 0, At, B0); PG8_BAR; PG8_SCHED;
            PG8_LDB(B1, 1, 1); PG8_STAGE(PG8_SB(1, 0), b3, voffB);
            PG8_BAR; PG8_WAIT_L(0); PG8_MMA(0, 1, At, B1); PG8_BAR;
            PG8_LDA(At, 1, 1); PG8_STAGE(PG8_SA(1, 0), a3, voffA);
            PG8_BAR; PG8_WAIT_L(0); PG8_MMA(1, 0, At, B0); PG8_BAR; PG8_SCHED;
            PG8_STAGE(PG8_SB(1, 1), b3 + hstep, voffB);
            PG8_WAIT_V(6); PG8_BAR; PG8_MMA(1, 1, At, B1); PG8_BAR;
            }
        }
        if constexpr (ALIGN_EPI) { if (wr == 0) PG8_BAR; }
        if constexpr (!Epi::AFTER_DRAIN) { E(acc, cur, wr, wc, fr, fq); S.done(cur); }
        if (!has_next) break;
#pragma unroll
        for (int a = 0; a < 2; ++a)
#pragma unroll
            for (int b = 0; b < 2; ++b)
#pragma unroll
                for (int m = 0; m < 4; ++m)
#pragma unroll
                    for (int n = 0; n < 2; ++n) acc[a][b][m][n] = (f32x4){0.f, 0.f, 0.f, 0.f};
        cur = nxt; cA = nA; cB = nB; ++ui;
        if constexpr (ALIGN_EPI) { if (wr == 1) PG8_BAR; }
    }
    PG8_WAIT_V(0);
    if constexpr (!ALIGN_EPI) { if (wr == 0) PG8_BAR; }
    PG8_BAR;
    if constexpr (Epi::AFTER_DRAIN) { E.fused(acc, cur, wr, wc, fr, fq, lds, wid, lane); S.done(cur); }
#undef PG8_SA
#undef PG8_SB
#undef PG8_STAGE
#undef PG8_LDA
#undef PG8_LDB
#undef PG8_MMA
#undef PG8_WAIT_V
#undef PG8_WAIT_L
#undef PG8_BAR
#undef PG8_SCHED
}
}
#include <hip/hip_bf16.h>
#include <cmath>
namespace attn_body {
using bf16=__hip_bfloat16;
using bf16x8=__attribute__((ext_vector_type(8)))short;
using s16x4=__attribute__((ext_vector_type(4)))short;
using f32x16=__attribute__((ext_vector_type(16)))float;
using u32x4=__attribute__((ext_vector_type(4)))unsigned;
constexpr int SEQ=2048,D=64,DM=512,PO=1024;
constexpr int NW=8,QBLK=32,QB=QBLK*NW,KVBLK=64,NQB=SEQ/QB;
constexpr int ATTN_UNIT_ROWS=QB;
__device__ __forceinline__ int crow(int r,int hi){return (r&3)+8*(r>>2)+4*hi;}
#define SBAR() __builtin_amdgcn_sched_barrier(0)
__device__ __forceinline__ void cmask(f32x16&p0,f32x16&p1,int jb,int qrel,int hi){
  const float NEG=-INFINITY; int kb=64*jb+4*hi;
  #pragma unroll
  for(int r=0;r<16;++r){int kv=kb+(r&3)+8*(r>>2); if(kv>qrel)p0[r]=NEG; if(kv+32>qrel)p1[r]=NEG;}
}

__device__ __forceinline__ void bmask(f32x16&p0,f32x16&p1,unsigned on){
  if(!on){
    #pragma unroll
    for(int r=0;r<16;++r){p0[r]=-INFINITY;p1[r]=-INFINITY;} }
}
constexpr int NSLOT=3, SLOTB=8192;
constexpr int LDS_K=0, LDS_V=NSLOT*SLOTB, LDS_WS=2*NSLOT*SLOTB, LDS_OST=LDS_WS+NW*64*4, LDS_BYTES=LDS_OST+NW*4096;
constexpr float C2=0.125f*1.4426950408889634f;
__device__ __forceinline__ void glds16(const void*gsrc,unsigned lds_dst){unsigned keep;
  asm volatile("s_mov_b32 %0, m0\n\ts_mov_b32 m0, %2\n\ts_nop 0\n\tglobal_load_lds_dwordx4 %1, off\n\ts_mov_b32 m0, %0":"=&s"(keep):"v"(gsrc),"s"(lds_dst):"memory");}
__device__ __forceinline__ float max3f(float a,float b,float c){float r;asm("v_max3_f32 %0, %1, %2, %3":"=v"(r):"v"(a),"v"(b),"v"(c));return r;}
__device__ __forceinline__ float max2f(float a,float b){float r;asm("v_max_f32_e32 %0, %1, %2":"=v"(r):"v"(a),"v"(b));return r;}
__device__ __forceinline__ float fadd_s(float a,float b){float r;asm("v_add_f32_e32 %0, %1, %2":"=v"(r):"v"(a),"v"(b));return r;}
__device__ __forceinline__ float fsub_s(float a,float b){float r;asm("v_sub_f32_e32 %0, %1, %2":"=v"(r):"v"(a),"v"(b));return r;}
typedef float f32x2_t __attribute__((ext_vector_type(2))); typedef __bf16 bf16x2_t __attribute__((ext_vector_type(2)));
__device__ __forceinline__ unsigned cvtpk_s(float lo,float hi){f32x2_t v={lo,hi};bf16x2_t b=__builtin_convertvector(v,bf16x2_t);return __builtin_bit_cast(unsigned,b);}
#define WAIT_BAR(N) asm volatile("s_waitcnt vmcnt(" #N ") lgkmcnt(0)\n\ts_barrier":::"memory")

__device__ __forceinline__ void qkt(f32x16&p0,f32x16&p1,const char*Kslot,const bf16x8*qr,int r32,int hi){
  const char*kb=Kslot+hi*1024+r32*16;
  #pragma unroll
  for(int d0=0;d0<4;++d0){
    const bf16x8 b0=*reinterpret_cast<const bf16x8*>(kb+d0*2048);
    const bf16x8 b1=*reinterpret_cast<const bf16x8*>(kb+d0*2048+512);
    if(d0==0){p0=__builtin_amdgcn_mfma_f32_32x32x16_bf16(b0,qr[0],f32x16{},0,0,0);p1=__builtin_amdgcn_mfma_f32_32x32x16_bf16(b1,qr[0],f32x16{},0,0,0);}
    else{p0=__builtin_amdgcn_mfma_f32_32x32x16_bf16(b0,qr[d0],p0,0,0,0);p1=__builtin_amdgcn_mfma_f32_32x32x16_bf16(b1,qr[d0],p1,0,0,0);}}
}
typedef __attribute__((address_space(3))) const char* lds_cptr;
typedef short v4i16_t __attribute__((ext_vector_type(4)));
__device__ __forceinline__ void kload8(bf16x8*kf,lds_cptr kp){
  kf[0]=*(const __attribute__((address_space(3))) bf16x8*)(kp);      kf[1]=*(const __attribute__((address_space(3))) bf16x8*)(kp+512);
  kf[2]=*(const __attribute__((address_space(3))) bf16x8*)(kp+2048); kf[3]=*(const __attribute__((address_space(3))) bf16x8*)(kp+2560);
  kf[4]=*(const __attribute__((address_space(3))) bf16x8*)(kp+4096); kf[5]=*(const __attribute__((address_space(3))) bf16x8*)(kp+4608);
  kf[6]=*(const __attribute__((address_space(3))) bf16x8*)(kp+6144); kf[7]=*(const __attribute__((address_space(3))) bf16x8*)(kp+6656);
}
__device__ __forceinline__ void kload2(bf16x8*kf,lds_cptr kp,int j){ kf[2*j]=*(const __attribute__((address_space(3))) bf16x8*)(kp+j*2048); kf[2*j+1]=*(const __attribute__((address_space(3))) bf16x8*)(kp+j*2048+512); }
__device__ __forceinline__ s16x4 vtr(lds_cptr p){ return __builtin_bit_cast(s16x4,__builtin_amdgcn_ds_read_tr16_b64_v4i16((__attribute__((address_space(3))) v4i16_t*)p)); }
__device__ __forceinline__ float rowmax(const f32x16&p0,const f32x16&p1){
  float a=max3f(p0[0],p0[1],p1[0]),b=max3f(p0[2],p0[3],p1[1]);a=max3f(a,p1[2],p1[3]);
  #pragma unroll
  for(int r=4;r<16;r+=4){a=max3f(a,p0[r],p0[r+1]);b=max3f(b,p0[r+2],p0[r+3]);a=max3f(a,p1[r],p1[r+1]);b=max3f(b,p1[r+2],p1[r+3]);}
  const float m=max2f(a,b);
  auto rr=__builtin_amdgcn_permlane32_swap(__float_as_uint(m),__float_as_uint(m),false,false);
  return max2f(__uint_as_float(rr[0]),__uint_as_float(rr[1]));
}
__device__ __forceinline__ void pv(f32x16*o,int vb,bf16x8 pa0,bf16x8 pa1,bf16x8 pa2,bf16x8 pa3){
  #pragma unroll
  for(int d0=0;d0<2;++d0){s16x4 lo[4],hi[4];
    #pragma unroll
    for(int ks=0;ks<4;++ks){
      asm volatile("ds_read_b64_tr_b16 %0,%1 offset:%c2":"=&v"(lo[ks]):"v"(vb),"i"(d0*4096+ks*1024):"memory");
      asm volatile("ds_read_b64_tr_b16 %0,%1 offset:%c2":"=&v"(hi[ks]):"v"(vb),"i"(d0*4096+ks*1024+512):"memory");}
    asm volatile("s_waitcnt lgkmcnt(0)":::"memory");SBAR();
    #define PK(k) (bf16x8){lo[k][0],lo[k][1],lo[k][2],lo[k][3],hi[k][0],hi[k][1],hi[k][2],hi[k][3]}
    o[d0]=__builtin_amdgcn_mfma_f32_32x32x16_bf16(pa0,PK(0),o[d0],0,0,0);
    o[d0]=__builtin_amdgcn_mfma_f32_32x32x16_bf16(pa1,PK(1),o[d0],0,0,0);
    o[d0]=__builtin_amdgcn_mfma_f32_32x32x16_bf16(pa2,PK(2),o[d0],0,0,0);
    o[d0]=__builtin_amdgcn_mfma_f32_32x32x16_bf16(pa3,PK(3),o[d0],0,0,0);
    #undef PK
  }
}

#ifndef ATTN_STORE16
#define ATTN_STORE16(p,v) (*(u32x4*)(p)=(v))
#endif
template<int THRL,bool MOBA> __device__ __forceinline__ void attn_unit(int qb,const bf16*Qu,const bf16*__restrict__ Kh,const bf16*__restrict__ Vh,bf16*Ou,const float*__restrict__ km,const float*__restrict__ gm,char*shm){
  const int tid=fresh_tid(),lane=tid&63,r32=lane&31,hi=lane>>5; const int wid=__builtin_amdgcn_readfirstlane(tid>>6);
  const int q0=qb*QB;
  const bf16*Qw=Qu+(long)(wid*QBLK)*DM;
  const unsigned lds0=(unsigned)(uintptr_t)shm;
  float*wsf=(float*)(shm+LDS_WS)+wid*64;
  const bf16*ksrc=Kh+(long)lane*DM+wid*8;
  const bf16*vsrc=Vh+(long)(16*(wid&3)+(lane>>2))*DM+(wid>>2)*32+(lane&3)*8;
  const unsigned kdst=lds0+LDS_K+wid*1024, vdst=lds0+LDS_V+wid*1024;
  #define DMA_K(t,slot) glds16(ksrc+(long)(t)*KVBLK*DM,(unsigned)__builtin_amdgcn_readfirstlane(kdst+(slot)))
  #define DMA_V(t,slot) glds16(vsrc+(long)(t)*KVBLK*DM,(unsigned)__builtin_amdgcn_readfirstlane(vdst+(slot)))
  const int vb0=(int)(lds0+LDS_V)+((lane>>4)&1)*32+(lane&3)*8+(4*hi+((lane&15)>>2))*64;
  const char*Kbase=shm+LDS_K; bf16x8 kf[8];
  const lds_cptr shm3=(lds_cptr)shm; const lds_cptr kp0=shm3+LDS_K+hi*1024+r32*16; const lds_cptr vp0=shm3+LDS_V+((lane>>4)&1)*32+(lane&3)*8+(4*hi+((lane&15)>>2))*64;
  const int NT=(q0+QB)/KVBLK;
  DMA_K(0,0);DMA_V(0,0);DMA_K(1,SLOTB);
  bf16x8 qr[4];
  #pragma unroll
  for(int d0=0;d0<4;++d0)qr[d0]=*reinterpret_cast<const bf16x8*>(&Qw[(long)r32*DM+d0*16+hi*8]);
  unsigned selm=0u;
  if(MOBA){ float g[8];
    #pragma unroll
    for(int n=0;n<8;++n){ float s_=0.f; if(n<qb){
      #pragma unroll
      for(int d0=0;d0<4;++d0){ const float4 ka=*reinterpret_cast<const float4*>(km+n*64+d0*16+hi*8), kb2=*reinterpret_cast<const float4*>(km+n*64+d0*16+hi*8+4);
        const float kv[8]={ka.x,ka.y,ka.z,ka.w,kb2.x,kb2.y,kb2.z,kb2.w};
        #pragma unroll
        for(int j=0;j<8;++j)s_+=__uint_as_float(((unsigned)(unsigned short)qr[d0][j])<<16)*kv[j]; }
      s_+=__shfl_xor(s_,32); } g[n]=s_; asm volatile("":"+v"(s_)::"memory"); SBAR(); }
    #pragma unroll
    for(int r=0;r<3;++r){ float best=-3.0e38f; int bi=-1;
      #pragma unroll
      for(int n=0;n<8;++n) if(n<qb&&!((selm>>n)&1u)&&g[n]>best){best=g[n];bi=n;}
      if(bi>=0)selm|=1u<<bi; } }
  float l_reg=0.f;f32x16 o[2];o[0]=f32x16{};o[1]=f32x16{};
  const int qrel=wid*QBLK+r32;
  #define CMASK(P0,P1,t) do{int jb_=(t)-(NT-4); if(jb_>=0)cmask(P0,P1,jb_,qrel,hi); else if(MOBA) bmask(P0,P1,(selm>>((t)>>2))&1u);}while(0)
  #define START(P0,P1) do{ _Pragma("unroll") for(int r=0;r<16;++r)P0[r]=__builtin_amdgcn_exp2f(P0[r]); }while(0)
  #define RESC() do{}while(0)
  f32x16 pA0,pA1,pB0,pB1;
  int sl_prev=0,sl_cur=0,sl_next=SLOTB;
  #define ROT() do{sl_prev=sl_cur;sl_cur=sl_next;sl_next=(sl_next==(NSLOT-1)*SLOTB)?0:sl_next+SLOTB;}while(0)
  DMA_K(2,2*SLOTB);
  WAIT_BAR(3);
  qkt(pA0,pA1,Kbase,qr,r32,hi);asm volatile("s_nop 15\n\ts_nop 7":"+v"(pA0),"+v"(pA1));CMASK(pA0,pA1,0);
  START(pA0,pA1);
  _Pragma("unroll") for(int r=0;r<16;++r)pA1[r]=__builtin_amdgcn_exp2f(pA1[r]);
  WAIT_BAR(0);
  DMA_K(3,0);DMA_V(1,SLOTB);
  ROT();
  kload8(kf,kp0+sl_cur);
  WAIT_BAR(2);
  s16x4 vlo[8],vhi[8]; u32x4 pw0,pw1,pw2,pw3;
  #define PKW(P,B) cvtpk_s(P[B],P[B+1])
  #define PAF(k) __builtin_bit_cast(bf16x8,pw##k)
  #define VFR(i) (bf16x8){vlo[i][0],vlo[i][1],vlo[i][2],vlo[i][3],vhi[i][0],vhi[i][1],vhi[i][2],vhi[i][3]}
  #define PIN(x) asm volatile("":"+v"(x))
  #define MX3(a,b,c) __builtin_fmaxf(__builtin_fmaxf((a),(b)),(c))
  #define GAPA(MF,A0,A1,A2,A3,W0,W1,PW) do{ MF; sacc+=A0; sacc+=A1; sacc+=A2; sacc+=A3; PIN(sacc); W0; W1; PIN(PW); SBAR(); }while(0)
  #define EX(v) __builtin_amdgcn_exp2f(v)
  #define GAPB(MF,X,B) do{ MF; X[B]=EX(X[B]); X[B+1]=EX(X[B+1]); X[B+2]=EX(X[B+2]); X[B+3]=EX(X[B+3]); PIN(X); SBAR(); }while(0)
  #define VRD(i) do{ vlo[i]=vtr(vp_+(((i)>>2)*4096+((i)&3)*1024)); vhi[i]=vtr(vp_+(((i)>>2)*4096+((i)&3)*1024+512)); }while(0)
  #define KRD(G,j) do{ if(G){ kload2(kf,kp0+sl_next,j); SBAR(); } }while(0)
  #define STEP(C0,C1,P0,P1,t,GK,GV,GL) do{ SBAR(); \
    const lds_cptr vp_=vp0+sl_prev; \
    VRD(0); SBAR(); float sacc=(P0[0]+P0[1]); \
    GAPA(C0=__builtin_amdgcn_mfma_f32_32x32x16_bf16(kf[0],qr[0],f32x16{},0,0,0), P0[2],P0[3],P0[4],P0[5],     pw0[0]=PKW(P0,0), pw0[1]=PKW(P0,2), pw0); \
    VRD(4); SBAR(); GAPA(C1=__builtin_amdgcn_mfma_f32_32x32x16_bf16(kf[1],qr[0],f32x16{},0,0,0), P0[6],P0[7],P0[8],P0[9],     pw0[2]=PKW(P0,4), pw0[3]=PKW(P0,6), pw0); \
    VRD(1); SBAR(); GAPA(C0=__builtin_amdgcn_mfma_f32_32x32x16_bf16(kf[2],qr[1],C0,0,0,0),   P0[10],P0[11],P0[12],P0[13], pw1[0]=PKW(P0,8), pw1[1]=PKW(P0,10), pw1); \
    VRD(5); SBAR(); GAPA(C1=__builtin_amdgcn_mfma_f32_32x32x16_bf16(kf[3],qr[1],C1,0,0,0),   P0[14],P0[15],P1[0],P1[1],   pw1[2]=PKW(P0,12),pw1[3]=PKW(P0,14), pw1); \
    VRD(2); SBAR(); GAPA(C0=__builtin_amdgcn_mfma_f32_32x32x16_bf16(kf[4],qr[2],C0,0,0,0),   P1[2],P1[3],P1[4],P1[5],     pw2[0]=PKW(P1,0), pw2[1]=PKW(P1,2), pw2); \
    VRD(6); SBAR(); GAPA(C1=__builtin_amdgcn_mfma_f32_32x32x16_bf16(kf[5],qr[2],C1,0,0,0),   P1[6],P1[7],P1[8],P1[9],     pw2[2]=PKW(P1,4), pw2[3]=PKW(P1,6), pw2); \
    VRD(3); SBAR(); GAPA(C0=__builtin_amdgcn_mfma_f32_32x32x16_bf16(kf[6],qr[3],C0,0,0,0),   P1[10],P1[11],P1[12],P1[13], pw3[0]=PKW(P1,8), pw3[1]=PKW(P1,10), pw3); \
    VRD(7); SBAR(); GAPA(C1=__builtin_amdgcn_mfma_f32_32x32x16_bf16(kf[7],qr[3],C1,0,0,0),   P1[14],P1[15],0.f,0.f,       pw3[2]=PKW(P1,12),pw3[3]=PKW(P1,14), pw3); \
    l_reg+=sacc; \
    if(GK){DMA_K((t)+3,sl_cur);} if(GV){DMA_V((t)+1,sl_next);} \
    CMASK(C0,C1,t); \
    SBAR(); \
    GAPB(o[0]=__builtin_amdgcn_mfma_f32_32x32x16_bf16(PAF(0),VFR(0),o[0],0,0,0), C0,0); \
    GAPB(o[1]=__builtin_amdgcn_mfma_f32_32x32x16_bf16(PAF(0),VFR(4),o[1],0,0,0), C0,4); \
    KRD(GL,0); GAPB(o[0]=__builtin_amdgcn_mfma_f32_32x32x16_bf16(PAF(1),VFR(1),o[0],0,0,0), C0,8); \
    KRD(GL,1); GAPB(o[1]=__builtin_amdgcn_mfma_f32_32x32x16_bf16(PAF(1),VFR(5),o[1],0,0,0), C0,12); \
    KRD(GL,2); GAPB(o[0]=__builtin_amdgcn_mfma_f32_32x32x16_bf16(PAF(2),VFR(2),o[0],0,0,0), C1,0); \
    KRD(GL,3); GAPB(o[1]=__builtin_amdgcn_mfma_f32_32x32x16_bf16(PAF(2),VFR(6),o[1],0,0,0), C1,4); \
    GAPB(o[0]=__builtin_amdgcn_mfma_f32_32x32x16_bf16(PAF(3),VFR(3),o[0],0,0,0), C1,8); \
    GAPB(o[1]=__builtin_amdgcn_mfma_f32_32x32x16_bf16(PAF(3),VFR(7),o[1],0,0,0), C1,12); \
    }while(0)
  int t=1;
  #undef CMASK
  #define CMASK(P0,P1,t) do{ if(MOBA) bmask(P0,P1,(selm>>((t)>>2))&1u); }while(0)
  for(;t+5<NT;t+=2){
    STEP(pB0,pB1,pA0,pA1,t,true,true,true);     WAIT_BAR(2); RESC(); ROT();
    STEP(pA0,pA1,pB0,pB1,t+1,true,true,true);   WAIT_BAR(2); RESC(); ROT();
  }
  #undef CMASK
  #define CMASK(P0,P1,t) do{int jb_=(t)-(NT-4); if(jb_>=0)cmask(P0,P1,jb_,qrel,hi); else if(MOBA) bmask(P0,P1,(selm>>((t)>>2))&1u);}while(0)
  #define ENDW(tt) do{ if((tt)+3<NT){WAIT_BAR(2);} else if((tt)+2<NT){WAIT_BAR(1);} else {WAIT_BAR(0);} }while(0)
  for(;t+1<NT;t+=2){
    STEP(pB0,pB1,pA0,pA1,t,(t+3<NT),(t+1<NT),(t+1<NT));       ENDW(t);   RESC(); ROT();
    STEP(pA0,pA1,pB0,pB1,t+1,(t+4<NT),(t+2<NT),(t+2<NT));     ENDW(t+1); RESC(); ROT();
  }
  STEP(pB0,pB1,pA0,pA1,NT-1,false,false,false); RESC();
  { float sacc=pB0[0]+pB0[1]; _Pragma("unroll") for(int r=2;r<16;++r)sacc+=pB0[r]; _Pragma("unroll") for(int r=0;r<16;++r)sacc+=pB1[r]; l_reg+=sacc;
    pw0=(u32x4){PKW(pB0,0),PKW(pB0,2),PKW(pB0,4),PKW(pB0,6)};pw1=(u32x4){PKW(pB0,8),PKW(pB0,10),PKW(pB0,12),PKW(pB0,14)};pw2=(u32x4){PKW(pB1,0),PKW(pB1,2),PKW(pB1,4),PKW(pB1,6)};pw3=(u32x4){PKW(pB1,8),PKW(pB1,10),PKW(pB1,12),PKW(pB1,14)};
    SBAR(); pv(o,vb0+sl_cur,PAF(0),PAF(1),PAF(2),PAF(3)); }
  #undef PKW
  #undef PAF
  #undef VFR
  #undef PIN
  #undef MX3
  #undef GAPA
  #undef GAPB
  #undef EX
  #undef VRD
  #undef KRD
  #undef STEP
  #undef ENDW
  {auto rr=__builtin_amdgcn_permlane32_swap(__float_as_uint(l_reg),__float_as_uint(l_reg),false,false);l_reg=__uint_as_float(rr[0])+__uint_as_float(rr[1]);}
  if(hi==0)wsf[32+r32]=l_reg;asm volatile("s_waitcnt lgkmcnt(0)":::"memory");
  float rli[16];
  #pragma unroll
  for(int r=0;r<16;++r)rli[r]=__builtin_amdgcn_rcpf(wsf[32+crow(r,hi)]);
  bf16*Ow=Ou+(long)(wid*QBLK)*PO;
  { bf16*stg=(bf16*)(shm+LDS_OST)+wid*2048;
    #pragma unroll
    for(int r=0;r<16;++r){const int orow=crow(r,hi);
      #pragma unroll
      for(int d0=0;d0<2;++d0)stg[orow*64+d0*32+r32]=__float2bfloat16(o[d0][r]*rli[r]);}
    asm volatile("s_waitcnt lgkmcnt(0)":::"memory");
    #pragma unroll
    for(int i=0;i<4;++i){const int row=i*8+(lane>>3),ch=lane&7; u32x4 v=*(const u32x4*)(stg+row*64+ch*8);
      if(MOBA){ float f[8]; float ss=0.f;
        #pragma unroll
        for(int e=0;e<4;++e){ f[2*e]=__uint_as_float(v[e]<<16); f[2*e+1]=__uint_as_float(v[e]&0xffff0000u); ss+=f[2*e]*f[2*e]+f[2*e+1]*f[2*e+1]; }
        ss+=__shfl_xor(ss,1); ss+=__shfl_xor(ss,2); ss+=__shfl_xor(ss,4);
        const float rs=__builtin_amdgcn_rsqf(ss*(1.0f/64.0f)+1e-6f);
        const float4 g0=*reinterpret_cast<const float4*>(gm+ch*8), g1=*reinterpret_cast<const float4*>(gm+ch*8+4);
        v[0]=cvtpk_s(f[0]*rs*g0.x,f[1]*rs*g0.y); v[1]=cvtpk_s(f[2]*rs*g0.z,f[3]*rs*g0.w); v[2]=cvtpk_s(f[4]*rs*g1.x,f[5]*rs*g1.y); v[3]=cvtpk_s(f[6]*rs*g1.z,f[7]*rs*g1.w); }
      ATTN_STORE16(Ow+(long)row*PO+ch*8,v);} }
  asm volatile("s_waitcnt lgkmcnt(0)\n\ts_barrier":::"memory");
  #undef DMA_K
  #undef DMA_V
  #undef CMASK
  #undef START
  #undef RESC
  #undef ROT
}
constexpr int ATTN_LDS_BYTES=LDS_BYTES;
#undef SBAR
#undef WAIT_BAR
}
typedef unsigned short bf16;
constexpr int T = 65536, DM = 1024, SEQ = 2048, NB = 32;
constexpr size_t MiB = 1u << 20;
constexpr size_t WS_CTL = 0, WS_KMEAN = 1 * MiB, WS_ZERO_BYTES = 2 * MiB;
constexpr size_t WS_ROPE = 2 * MiB, WS_SCAL = 3 * MiB;
constexpr size_t WS_WIN = 4 * MiB, WS_WOUT = 10 * MiB, WS_WQ = 12 * MiB, WS_SUBK = 16 * MiB;
constexpr size_t WS_DOWN = 32 * MiB, WS_UP = 64 * MiB, WS_XN = 96 * MiB;
constexpr size_t WS_QKV = 224 * MiB, QKV_STRIDE = 64 * MiB;
constexpr size_t WS_PQ = 224 * MiB;
constexpr size_t WS_MIXED = 608 * MiB, WS_DO = 736 * MiB, WS_IDS = 864 * MiB, WS_GATES = 896 * MiB, WS_END = 928 * MiB;
constexpr size_t QKV_ELEMS = QKV_STRIDE / 2;
constexpr float QSCALE = 0.125f * 1.4426950408889634f;
constexpr float EPS = 1e-6f;

__device__ __forceinline__ unsigned f2bf(float f) { unsigned u = __float_as_uint(f); return (u + 0x7fffu + ((u >> 16) & 1u)) >> 16; }
__device__ __forceinline__ float bf2f(unsigned h) { return __uint_as_float(h << 16); }
__device__ __forceinline__ float wave_sum(float v) {
#pragma unroll
    for (int o = 1; o < 64; o <<= 1) v += __shfl_xor(v, o);
    return v;
}

#ifndef LAS
#define LAS __attribute__((address_space(3)))
#endif
#define GAS __attribute__((address_space(1)))
typedef GAS unsigned gu32;
#define XB_TMO      128
#define XB_XCNT(j)  (256  + 64 * (j))
#define XB_XSUB(j)  (1280 + 64 * (j))
#define XB_XGEN(j)  (2304 + 64 * (j))
#define XB_TOP      3328
#define XB_TOPGEN   3392
#define XCD_BAR_WORDS 3456
#define XB_SPIN_CAP (1u << 18)

__device__ __forceinline__ unsigned xb_ld(unsigned* p)              { return __hip_atomic_load(p, __ATOMIC_RELAXED, __HIP_MEMORY_SCOPE_AGENT); }
__device__ __forceinline__ unsigned xb_add(unsigned* p, unsigned v) { return __hip_atomic_fetch_add(p, v, __ATOMIC_RELAXED, __HIP_MEMORY_SCOPE_AGENT); }
__device__ __forceinline__ unsigned xb_xcc_id() { return (unsigned)__builtin_amdgcn_s_getreg((3 << 11) | 20) & 0xFu; }
#define XB_SPIN(cond, bar) do { unsigned _sp = 0; while (cond) { __builtin_amdgcn_s_sleep(1); \
    if ((++_sp & 255u) == 0u) { if (xb_ld(&(bar)[XB_TMO])) break; if (_sp > XB_SPIN_CAP) { atomicAdd(&(bar)[XB_TMO], 1u); break; } } } } while (0)

struct XcdBarrier {
    unsigned* bar; unsigned x;
    volatile LAS unsigned* st;
};

__device__ __forceinline__ XcdBarrier xcd_barrier_post(unsigned* bar, volatile LAS unsigned* st) {
    XcdBarrier b; b.bar = bar; b.x = xb_xcc_id(); b.st = st;
    if (threadIdx.x == 0) (void)xb_add(&bar[XB_XCNT(b.x)], 1u);
    return b;
}
__device__ __forceinline__ void xcd_barrier_complete(unsigned* bar, unsigned x, unsigned& nloc, unsigned& nx) {
    const unsigned G = gridDim.x * gridDim.y * gridDim.z;
    unsigned sum, cnt, mine, sp = 0u;
    for (;;) {
        sum = 0u; cnt = 0u; mine = 0u;
#pragma unroll
        for (unsigned j = 0; j < 16; ++j) { const unsigned c = xb_ld(&bar[XB_XCNT(j)]); sum += c; cnt += (c > 0u) ? 1u : 0u; mine = (j == x) ? c : mine; }
        if (sum == G) break;
        __builtin_amdgcn_s_sleep(1);
        if ((++sp & 255u) == 0u) { if (xb_ld(&bar[XB_TMO])) break; if (sp > XB_SPIN_CAP) { atomicAdd(&bar[XB_TMO], 1u); break; } }
    }
    nloc = mine > 0u ? mine : 1u; nx = cnt > 0u ? cnt : 1u;
}

__device__ __forceinline__ void xcd_barrier(const XcdBarrier& b) {
    asm volatile("s_waitcnt vmcnt(0)" ::: "memory");
    __syncthreads();
    if (threadIdx.x == 0) {
        unsigned* bar = b.bar;
        __builtin_amdgcn_s_waitcnt(0);
        unsigned nloc = b.st[0], nx = b.st[1];
        if (nloc == 0u) { xcd_barrier_complete(bar, b.x, nloc, nx); b.st[0] = nloc; b.st[1] = nx; }
        const unsigned old = xb_add(&bar[XB_XSUB(b.x)], 1u);
        const unsigned gen = old / nloc;
        if (old + 1u == (gen + 1u) * nloc) {
            __builtin_amdgcn_fence(__ATOMIC_RELEASE, "agent");
            asm volatile("s_waitcnt vmcnt(0)" ::: "memory");
            const unsigned og = xb_add(&bar[XB_TOP], 1u);
            const unsigned tg = og / nx;
            if (og + 1u == (tg + 1u) * nx) xb_add(&bar[XB_TOPGEN], 1u);
            else XB_SPIN(xb_ld(&bar[XB_TOPGEN]) == tg, bar);
            __builtin_amdgcn_fence(__ATOMIC_ACQUIRE, "agent");
            xb_add(&bar[XB_XGEN(b.x)], 1u);
            asm volatile("s_waitcnt vmcnt(0)" ::: "memory");
        } else {
            XB_SPIN(xb_ld(&bar[XB_XGEN(b.x)]) == gen, bar);
            __builtin_amdgcn_fence(__ATOMIC_ACQUIRE, "agent");
            asm volatile("s_waitcnt vmcnt(0)" ::: "memory");
        }
    }
    __syncthreads();
}
#ifndef LAS
#define LAS __attribute__((address_space(3)))
#endif
constexpr int NTHR = 512, NWAVE = 8;
constexpr int LDS_BYTES = 147456;

struct Params {
    const float* in[19]; float* out; unsigned char* ws;
};

__device__ __forceinline__ void ph_transpose(const float* __restrict__ W, int K, int N, bf16* __restrict__ WT, float* tiles, int wg, int nwg, int tid) {
    float (*tile)[33] = (float (*)[33])(tiles + (tid >> 8) * (32 * 33));
    const int nt_n = N / 32, nitems = nt_n * (K / 32), tx = tid & 31, ty = (tid & 255) >> 5;
    for (int it0 = wg * 2; it0 < nitems; it0 += nwg * 2) {
        const int it = it0 + (tid >> 8); const bool act = it < nitems;
        const int n0 = (it % nt_n) * 32, k0 = (it / nt_n) * 32;
        if (act) for (int i = ty; i < 32; i += 8) tile[i][tx] = W[(size_t)(k0 + i) * N + n0 + tx];
        __syncthreads();
        if (act) for (int i = ty; i < 32; i += 8) WT[(size_t)(n0 + i) * K + k0 + tx] = (bf16)f2bf(tile[tx][i]);
        __syncthreads();
    }
}
__device__ __forceinline__ void ph_convert(const float* __restrict__ src, bf16* __restrict__ dst, size_t n4, int wg, int nwg, int tid) {
    for (size_t i = (size_t)wg * NTHR + tid; i < n4; i += (size_t)nwg * NTHR) {
        const float4 v = ((const float4*)src)[i];
        uint2 o; o.x = f2bf(v.x) | (f2bf(v.y) << 16); o.y = f2bf(v.z) | (f2bf(v.w) << 16);
        ((uint2*)dst)[i] = o;
    }
}
__device__ __forceinline__ void ph_rope(float* __restrict__ rope, int wg, int nwg, int tid) {
    for (int i = wg * NTHR + tid; i < SEQ * 32; i += nwg * NTHR) {
        const int pos = i >> 5, j = i & 31;
        const float inv = 1.0f / exp2f((float)j * (13.287712379549449f / 32.0f));
        const float ang = (float)pos * inv;
        double rev = (double)ang * 0.15915494309189535; rev -= floor(rev);
        rope[i] = __builtin_amdgcn_cosf((float)rev); rope[SEQ * 32 + i] = __builtin_amdgcn_sinf((float)rev);
    }
}
__device__ __forceinline__ void ph_rmsnorm(const float* __restrict__ x, const float* __restrict__ g, bf16* __restrict__ out, int rows, int wg, int nwg, int tid) {
    const int lane = tid & 63, nw = nwg * NWAVE;
    for (int r = wg * NWAVE + (tid >> 6); r < rows; r += nw) {
        const float4* xr = (const float4*)(x + (size_t)r * DM) + lane;
        float4 v[4]; float s = 0.f;
#pragma unroll
        for (int j = 0; j < 4; ++j) { v[j] = xr[64 * j]; s += (v[j].x * v[j].x + v[j].y * v[j].y) + (v[j].z * v[j].z + v[j].w * v[j].w); }
        const float rs = rsqrtf(wave_sum(s) * (1.0f / DM) + EPS);
        uint2* o = (uint2*)(out + (size_t)r * DM) + lane;
#pragma unroll
        for (int j = 0; j < 4; ++j) { const float4 gg = ((const float4*)g)[lane + 64 * j];
            uint2 w; w.x = f2bf(v[j].x * rs * gg.x) | (f2bf(v[j].y * rs * gg.y) << 16); w.y = f2bf(v[j].z * rs * gg.z) | (f2bf(v[j].w * rs * gg.w) << 16);
            o[64 * j] = w; }
    }
}
__device__ __forceinline__ void ph_qk_post(bf16* __restrict__ qkv, const float* __restrict__ rope, const float* __restrict__ gqm, const float* __restrict__ gkm,
                                           const float* __restrict__ gqd, const float* __restrict__ gkd, float* __restrict__ kmean, int wg, int nwg, int tid) {
    const int lane = tid & 63, half = lane >> 5, j = lane & 31, wv = tid >> 6;
    for (int blk = wg; blk < T / 256; blk += nwg) {
        float ks[4][2];
#pragma unroll
        for (int a = 0; a < 4; ++a) { ks[a][0] = 0.f; ks[a][1] = 0.f; }
        for (int tt = wv; tt < 256; tt += NWAVE) {
            const int t = blk * 256 + tt, pos = t & (SEQ - 1);
            const float c = rope[pos * 32 + j], sn = rope[SEQ * 32 + pos * 32 + j];
#pragma unroll
            for (int it = 0; it < 16; ++it) {
                const int s = it * 2 + half, type = it >> 2, hs = s & 7;
                bf16* buf = qkv + (size_t)(type < 2 ? type : type + 1) * QKV_ELEMS + (size_t)t * 512 + hs * 64;
                const float x1 = bf2f(buf[j]), x2 = bf2f(buf[j + 32]);
                float ss = x1 * x1 + x2 * x2;
#pragma unroll
                for (int o = 1; o < 32; o <<= 1) ss += __shfl_xor(ss, o);
                const float rs = rsqrtf(ss * (1.0f / 64.0f) + EPS);
                const float* g = type == 0 ? gqm : type == 1 ? gkm : type == 2 ? gqd + (hs & 1) * 64 : gkd + (hs & 1) * 64;
                const float y1 = x1 * rs * g[j], y2 = x2 * rs * g[j + 32];
                float o1 = y1 * c - y2 * sn, o2 = y2 * c + y1 * sn;
                if (type == 0 || type == 2) { o1 *= QSCALE; o2 *= QSCALE; }
                if (type == 1) { ks[it - 4][0] += o1; ks[it - 4][1] += o2; }
                buf[j] = (bf16)f2bf(o1); buf[j + 32] = (bf16)f2bf(o2);
            }
        }
        const int b = blk >> 3, nb = blk & 7;
#pragma unroll
        for (int a = 0; a < 4; ++a) { const int h = a * 2 + half; float* km = kmean + (((size_t)b * 8 + h) * 8 + nb) * 64;
            atomicAdd(km + j, ks[a][0] * (1.0f / 256.0f)); atomicAdd(km + j + 32, ks[a][1] * (1.0f / 256.0f)); }
    }
}
__device__ __forceinline__ void ph_diff_combine(const bf16* __restrict__ dob, float lam, const float* __restrict__ gain_d, bf16* __restrict__ mixed, int wg, int nwg, int tid) {
    const int lane = tid & 63, nw = nwg * NWAVE;
    for (int w = wg * NWAVE + (tid >> 6); w < T * 4; w += nw) {
        const int t = w >> 2, h = w & 3; const bf16* p = dob + (size_t)t * 1024 + h * 256;
        const float da = bf2f(p[lane]) - lam * bf2f(p[128 + lane]), db = bf2f(p[64 + lane]) - lam * bf2f(p[192 + lane]);
        const float rs = rsqrtf(wave_sum(da * da + db * db) * (1.0f / 128.0f) + EPS) * 0.8f;
        bf16* o = mixed + (size_t)t * 1024 + 512 + h * 128;
        o[lane] = (bf16)f2bf(da * rs * gain_d[h * 128 + lane]); o[64 + lane] = (bf16)f2bf(db * rs * gain_d[h * 128 + 64 + lane]);
    }
}
typedef float rf32x16 __attribute__((ext_vector_type(16)));
typedef short rbf16x8 __attribute__((ext_vector_type(8)));
__device__ __forceinline__ unsigned umax_(unsigned a, unsigned b) { return a > b ? a : b; }
__device__ __forceinline__ unsigned umin_(unsigned a, unsigned b) { return a > b ? b : a; }
#define CE_D(x, y) { const unsigned mx_ = umax_(x, y), mn_ = umin_(x, y); x = mx_; y = mn_; }
__device__ __forceinline__ void sort16_desc(unsigned (&v)[16]) {
    CE_D(v[0], v[1]) CE_D(v[3], v[2]) CE_D(v[4], v[5]) CE_D(v[7], v[6]) CE_D(v[8], v[9]) CE_D(v[11], v[10]) CE_D(v[12], v[13]) CE_D(v[15], v[14])
    CE_D(v[0], v[2]) CE_D(v[1], v[3]) CE_D(v[6], v[4]) CE_D(v[7], v[5]) CE_D(v[8], v[10]) CE_D(v[9], v[11]) CE_D(v[14], v[12]) CE_D(v[15], v[13])
    CE_D(v[0], v[1]) CE_D(v[2], v[3]) CE_D(v[5], v[4]) CE_D(v[7], v[6]) CE_D(v[8], v[9]) CE_D(v[10], v[11]) CE_D(v[13], v[12]) CE_D(v[15], v[14])
    CE_D(v[0], v[4]) CE_D(v[1], v[5]) CE_D(v[2], v[6]) CE_D(v[3], v[7]) CE_D(v[12], v[8]) CE_D(v[13], v[9]) CE_D(v[14], v[10]) CE_D(v[15], v[11])
    CE_D(v[0], v[2]) CE_D(v[1], v[3]) CE_D(v[4], v[6]) CE_D(v[5], v[7]) CE_D(v[10], v[8]) CE_D(v[11], v[9]) CE_D(v[14], v[12]) CE_D(v[15], v[13])
    CE_D(v[0], v[1]) CE_D(v[2], v[3]) CE_D(v[4], v[5]) CE_D(v[6], v[7]) CE_D(v[9], v[8]) CE_D(v[11], v[10]) CE_D(v[13], v[12]) CE_D(v[15], v[14])
    CE_D(v[0], v[8]) CE_D(v[1], v[9]) CE_D(v[2], v[10]) CE_D(v[3], v[11]) CE_D(v[4], v[12]) CE_D(v[5], v[13]) CE_D(v[6], v[14]) CE_D(v[7], v[15])
    CE_D(v[0], v[4]) CE_D(v[1], v[5]) CE_D(v[2], v[6]) CE_D(v[3], v[7]) CE_D(v[8], v[12]) CE_D(v[9], v[13]) CE_D(v[10], v[14]) CE_D(v[11], v[15])
    CE_D(v[0], v[2]) CE_D(v[1], v[3]) CE_D(v[4], v[6]) CE_D(v[5], v[7]) CE_D(v[8], v[10]) CE_D(v[9], v[11]) CE_D(v[12], v[14]) CE_D(v[13], v[15])
    CE_D(v[0], v[1]) CE_D(v[2], v[3]) CE_D(v[4], v[5]) CE_D(v[6], v[7]) CE_D(v[8], v[9]) CE_D(v[10], v[11]) CE_D(v[12], v[13]) CE_D(v[14], v[15])
}
__device__ __forceinline__ void merge16_desc(unsigned (&a)[16], const unsigned (&b)[16]) {
    a[0] = umax_(a[0], b[15]); a[1] = umax_(a[1], b[14]); a[2] = umax_(a[2], b[13]); a[3] = umax_(a[3], b[12]); a[4] = umax_(a[4], b[11]); a[5] = umax_(a[5], b[10]); a[6] = umax_(a[6], b[9]); a[7] = umax_(a[7], b[8]); a[8] = umax_(a[8], b[7]); a[9] = umax_(a[9], b[6]); a[10] = umax_(a[10], b[5]); a[11] = umax_(a[11], b[4]); a[12] = umax_(a[12], b[3]); a[13] = umax_(a[13], b[2]); a[14] = umax_(a[14], b[1]); a[15] = umax_(a[15], b[0]);
    CE_D(a[0], a[8]) CE_D(a[1], a[9]) CE_D(a[2], a[10]) CE_D(a[3], a[11]) CE_D(a[4], a[12]) CE_D(a[5], a[13]) CE_D(a[6], a[14]) CE_D(a[7], a[15])
    CE_D(a[0], a[4]) CE_D(a[1], a[5]) CE_D(a[2], a[6]) CE_D(a[3], a[7]) CE_D(a[8], a[12]) CE_D(a[9], a[13]) CE_D(a[10], a[14]) CE_D(a[11], a[15])
    CE_D(a[0], a[2]) CE_D(a[1], a[3]) CE_D(a[4], a[6]) CE_D(a[5], a[7]) CE_D(a[8], a[10]) CE_D(a[9], a[11]) CE_D(a[12], a[14]) CE_D(a[13], a[15])
    CE_D(a[0], a[1]) CE_D(a[2], a[3]) CE_D(a[4], a[5]) CE_D(a[6], a[7]) CE_D(a[8], a[9]) CE_D(a[10], a[11]) CE_D(a[12], a[13]) CE_D(a[14], a[15])
}
__device__ __forceinline__ void top16_of_64(unsigned (&G)[4][16]) {
    sort16_desc(G[0]); sort16_desc(G[1]); sort16_desc(G[2]); sort16_desc(G[3]);
    merge16_desc(G[0], G[1]); merge16_desc(G[2], G[3]); merge16_desc(G[0], G[2]);
}
__device__ __forceinline__ void ph_peer_route(const bf16* __restrict__ PQ, const bf16* __restrict__ subk, int* __restrict__ ids, float* __restrict__ gates, unsigned* ldsu, int wg, int nwg, int tid) {
    const int lane = tid & 63, r = lane & 31, hi = lane >> 5, wv = tid >> 6;
    unsigned* myl = ldsu + wv * 2048;
    const int nitems = (T / 32) * 8;
    for (int item = wg * NWAVE + wv; item < nitems; item += nwg * NWAVE) {
        const int tb = item >> 3, h = item & 7, t = tb * 32 + r;
        unsigned L[2][16];
#pragma unroll
        for (int p = 0; p < 2; ++p) {
            const bf16* qp = PQ + (size_t)t * 2048 + h * 256 + p * 128 + hi * 8;
            rbf16x8 bq[8];
#pragma unroll
            for (int s = 0; s < 8; ++s) bq[s] = *(const rbf16x8*)(qp + 16 * s);
            const bf16* kp = subk + ((size_t)(h * 2 + p) * 128 + r) * 128 + hi * 8;
            unsigned G[4][16]; unsigned hmask = hi ? ~4u : ~0u; asm volatile("" : "+v"(hmask));
#pragma unroll
            for (int nb = 0; nb < 4; ++nb) {
                rf32x16 acc = rf32x16{};
#pragma unroll
                for (int s = 0; s < 8; ++s) { const rbf16x8 a = *(const rbf16x8*)(kp + (size_t)nb * 32 * 128 + 16 * s); acc = __builtin_amdgcn_mfma_f32_32x32x16_bf16(a, bq[s], acc, 0, 0, 0); }
#pragma unroll
                for (int i = 0; i < 16; ++i) { const float v = fmaxf(acc[i] + 16.0f, 0.0f); const int n = nb * 32 + (i & 3) + 8 * (i >> 2);
                    G[nb][i] = ((__float_as_uint(v) & ~127u) | (unsigned)(127 - n)) & hmask; }
                asm volatile("" ::: "memory"); __builtin_amdgcn_sched_barrier(0);
            }
            top16_of_64(G);
            unsigned O[16];
#pragma unroll
            for (int i = 0; i < 16; ++i) { auto rr = __builtin_amdgcn_permlane32_swap(G[0][i], G[0][i], false, false); O[i] = hi ? rr[0] : rr[1]; }
            merge16_desc(G[0], O);
#pragma unroll
            for (int i = 0; i < 16; ++i) L[p][i] = G[0][i];
            asm volatile("" ::: "memory"); __builtin_amdgcn_sched_barrier(0);
        }
#pragma unroll
        for (int i = 0; i < 16; ++i) { myl[i * 64 + lane] = 127u - (L[0][i] & 127u); myl[(16 + i) * 64 + lane] = 127u - (L[1][i] & 127u); }
        float fa[16], fb[16];
#pragma unroll
        for (int i = 0; i < 16; ++i) { fa[i] = __uint_as_float(L[0][i] & ~127u); fb[i] = __uint_as_float(L[1][i] & ~127u); }
        unsigned C[4][16];
        C[0][0] = (__float_as_uint(fmaxf(fa[0] + fb[0] - 24.0f, 0.0f)) & ~255u) | 255u;
        C[0][1] = (__float_as_uint(fmaxf(fa[0] + fb[1] - 24.0f, 0.0f)) & ~255u) | 254u;
        C[0][2] = (__float_as_uint(fmaxf(fa[0] + fb[2] - 24.0f, 0.0f)) & ~255u) | 253u;
        C[0][3] = (__float_as_uint(fmaxf(fa[0] + fb[3] - 24.0f, 0.0f)) & ~255u) | 252u;
        C[0][4] = (__float_as_uint(fmaxf(fa[0] + fb[4] - 24.0f, 0.0f)) & ~255u) | 251u;
        C[0][5] = (__float_as_uint(fmaxf(fa[0] + fb[5] - 24.0f, 0.0f)) & ~255u) | 250u;
        C[0][6] = (__float_as_uint(fmaxf(fa[0] + fb[6] - 24.0f, 0.0f)) & ~255u) | 249u;
        C[0][7] = (__float_as_uint(fmaxf(fa[0] + fb[7] - 24.0f, 0.0f)) & ~255u) | 248u;
        C[0][8] = (__float_as_uint(fmaxf(fa[0] + fb[8] - 24.0f, 0.0f)) & ~255u) | 247u;
        C[0][9] = (__float_as_uint(fmaxf(fa[0] + fb[9] - 24.0f, 0.0f)) & ~255u) | 246u;
        C[0][10] = (__float_as_uint(fmaxf(fa[0] + fb[10] - 24.0f, 0.0f)) & ~255u) | 245u;
        C[0][11] = (__float_as_uint(fmaxf(fa[0] + fb[11] - 24.0f, 0.0f)) & ~255u) | 244u;
        C[0][12] = (__float_as_uint(fmaxf(fa[0] + fb[12] - 24.0f, 0.0f)) & ~255u) | 243u;
        C[0][13] = (__float_as_uint(fmaxf(fa[0] + fb[13] - 24.0f, 0.0f)) & ~255u) | 242u;
        C[0][14] = (__float_as_uint(fmaxf(fa[0] + fb[14] - 24.0f, 0.0f)) & ~255u) | 241u;
        C[0][15] = (__float_as_uint(fmaxf(fa[0] + fb[15] - 24.0f, 0.0f)) & ~255u) | 240u;
        C[1][0] = (__float_as_uint(fmaxf(fa[1] + fb[0] - 24.0f, 0.0f)) & ~255u) | 239u;
        C[1][1] = (__float_as_uint(fmaxf(fa[1] + fb[1] - 24.0f, 0.0f)) & ~255u) | 238u;
        C[1][2] = (__float_as_uint(fmaxf(fa[1] + fb[2] - 24.0f, 0.0f)) & ~255u) | 237u;
        C[1][3] = (__float_as_uint(fmaxf(fa[1] + fb[3] - 24.0f, 0.0f)) & ~255u) | 236u;
        C[1][4] = (__float_as_uint(fmaxf(fa[1] + fb[4] - 24.0f, 0.0f)) & ~255u) | 235u;
        C[1][5] = (__float_as_uint(fmaxf(fa[1] + fb[5] - 24.0f, 0.0f)) & ~255u) | 234u;
        C[1][6] = (__float_as_uint(fmaxf(fa[1] + fb[6] - 24.0f, 0.0f)) & ~255u) | 233u;
        C[1][7] = (__float_as_uint(fmaxf(fa[1] + fb[7] - 24.0f, 0.0f)) & ~255u) | 232u;
        C[1][8] = (__float_as_uint(fmaxf(fa[2] + fb[0] - 24.0f, 0.0f)) & ~255u) | 223u;
        C[1][9] = (__float_as_uint(fmaxf(fa[2] + fb[1] - 24.0f, 0.0f)) & ~255u) | 222u;
        C[1][10] = (__float_as_uint(fmaxf(fa[2] + fb[2] - 24.0f, 0.0f)) & ~255u) | 221u;
        C[1][11] = (__float_as_uint(fmaxf(fa[2] + fb[3] - 24.0f, 0.0f)) & ~255u) | 220u;
        C[1][12] = (__float_as_uint(fmaxf(fa[2] + fb[4] - 24.0f, 0.0f)) & ~255u) | 219u;
        C[1][13] = (__float_as_uint(fmaxf(fa[3] + fb[0] - 24.0f, 0.0f)) & ~255u) | 207u;
        C[1][14] = (__float_as_uint(fmaxf(fa[3] + fb[1] - 24.0f, 0.0f)) & ~255u) | 206u;
        C[1][15] = (__float_as_uint(fmaxf(fa[3] + fb[2] - 24.0f, 0.0f)) & ~255u) | 205u;
        C[2][0] = (__float_as_uint(fmaxf(fa[3] + fb[3] - 24.0f, 0.0f)) & ~255u) | 204u;
        C[2][1] = (__float_as_uint(fmaxf(fa[4] + fb[0] - 24.0f, 0.0f)) & ~255u) | 191u;
        C[2][2] = (__float_as_uint(fmaxf(fa[4] + fb[1] - 24.0f, 0.0f)) & ~255u) | 190u;
        C[2][3] = (__float_as_uint(fmaxf(fa[4] + fb[2] - 24.0f, 0.0f)) & ~255u) | 189u;
        C[2][4] = (__float_as_uint(fmaxf(fa[5] + fb[0] - 24.0f, 0.0f)) & ~255u) | 175u;
        C[2][5] = (__float_as_uint(fmaxf(fa[5] + fb[1] - 24.0f, 0.0f)) & ~255u) | 174u;
        C[2][6] = (__float_as_uint(fmaxf(fa[6] + fb[0] - 24.0f, 0.0f)) & ~255u) | 159u;
        C[2][7] = (__float_as_uint(fmaxf(fa[6] + fb[1] - 24.0f, 0.0f)) & ~255u) | 158u;
        C[2][8] = (__float_as_uint(fmaxf(fa[7] + fb[0] - 24.0f, 0.0f)) & ~255u) | 143u;
        C[2][9] = (__float_as_uint(fmaxf(fa[7] + fb[1] - 24.0f, 0.0f)) & ~255u) | 142u;
        C[2][10] = (__float_as_uint(fmaxf(fa[8] + fb[0] - 24.0f, 0.0f)) & ~255u) | 127u;
        C[2][11] = (__float_as_uint(fmaxf(fa[9] + fb[0] - 24.0f, 0.0f)) & ~255u) | 111u;
        C[2][12] = (__float_as_uint(fmaxf(fa[10] + fb[0] - 24.0f, 0.0f)) & ~255u) | 95u;
        C[2][13] = (__float_as_uint(fmaxf(fa[11] + fb[0] - 24.0f, 0.0f)) & ~255u) | 79u;
        C[2][14] = (__float_as_uint(fmaxf(fa[12] + fb[0] - 24.0f, 0.0f)) & ~255u) | 63u;
        C[2][15] = (__float_as_uint(fmaxf(fa[13] + fb[0] - 24.0f, 0.0f)) & ~255u) | 47u;
        C[3][0] = (__float_as_uint(fmaxf(fa[14] + fb[0] - 24.0f, 0.0f)) & ~255u) | 31u;
        C[3][1] = (__float_as_uint(fmaxf(fa[15] + fb[0] - 24.0f, 0.0f)) & ~255u) | 15u;
        C[3][2] = 0u;
        C[3][3] = 0u;
        C[3][4] = 0u;
        C[3][5] = 0u;
        C[3][6] = 0u;
        C[3][7] = 0u;
        C[3][8] = 0u;
        C[3][9] = 0u;
        C[3][10] = 0u;
        C[3][11] = 0u;
        C[3][12] = 0u;
        C[3][13] = 0u;
        C[3][14] = 0u;
        C[3][15] = 0u;
        top16_of_64(C);
        const float s0 = __uint_as_float(C[0][0] & ~255u);
        float ex[16]; float sum = 0.f; int eid[16];
#pragma unroll
        for (int k = 0; k < 16; ++k) { ex[k] = __expf(__uint_as_float(C[0][k] & ~255u) - s0); sum += ex[k];
            const unsigned code = 255u - (C[0][k] & 255u); const unsigned ia = myl[(code >> 4) * 64 + lane], ib = myl[(16 + (code & 15u)) * 64 + lane]; eid[k] = (int)(ia * 128u + ib); }
        const float inv = 1.0f / sum;
        if (hi == 0) { int4* dst = (int4*)(ids + (size_t)t * 128 + h * 16);
#pragma unroll
            for (int k = 0; k < 4; ++k) dst[k] = make_int4(eid[4 * k], eid[4 * k + 1], eid[4 * k + 2], eid[4 * k + 3]); }
        else { float4* dst = (float4*)(gates + (size_t)t * 128 + h * 16);
#pragma unroll
            for (int k = 0; k < 4; ++k) dst[k] = make_float4(ex[4 * k] * inv, ex[4 * k + 1] * inv, ex[4 * k + 2] * inv, ex[4 * k + 3] * inv); }
    }
}
typedef __bf16 bf16x2_t __attribute__((ext_vector_type(2)));
__device__ __forceinline__ float dot2bf(unsigned a, unsigned b, float acc) { return __builtin_amdgcn_fdot2_f32_bf16(__builtin_bit_cast(bf16x2_t, a), __builtin_bit_cast(bf16x2_t, b), acc, false); }
__device__ __forceinline__ float dot8(const uint4 a, const uint4 b, float s) { s = dot2bf(a.x, b.x, s); s = dot2bf(a.y, b.y, s); s = dot2bf(a.z, b.z, s); s = dot2bf(a.w, b.w, s); return s; }
__device__ __forceinline__ float gelu_erf(float z) { return 0.5f * z * (1.0f + erff(z * 0.70710678118654752f)); }
constexpr float TSCALE = 32.0f, TINV = 1.0f / 32.0f;
typedef float f32x2g __attribute__((ext_vector_type(2)));
constexpr int GB = 4;
struct GBatch { uint4 d[GB]; uint4 u[GB]; float g[GB]; };
__device__ __forceinline__ void gb_load(GBatch& B, const int* __restrict__ idp, const float* __restrict__ gp, int e0, const unsigned char* __restrict__ down, const unsigned char* __restrict__ up, int lane) {
#pragma unroll
    for (int j = 0; j < GB; ++j) { const int id = __builtin_amdgcn_readfirstlane(idp[e0 + j]); B.g[j] = gp[e0 + j];
        B.d[j] = *(const uint4*)(down + (size_t)id * DM + lane * 16); B.u[j] = *(const uint4*)(up + (size_t)id * DM + lane * 16); }
}
__device__ __forceinline__ void unpack16(const uint4 v, f32x2g (&f)[8]) {
    f[0] = __builtin_amdgcn_cvt_pk_f32_fp8((int)v.x, false); f[1] = __builtin_amdgcn_cvt_pk_f32_fp8((int)v.x, true);
    f[2] = __builtin_amdgcn_cvt_pk_f32_fp8((int)v.y, false); f[3] = __builtin_amdgcn_cvt_pk_f32_fp8((int)v.y, true);
    f[4] = __builtin_amdgcn_cvt_pk_f32_fp8((int)v.z, false); f[5] = __builtin_amdgcn_cvt_pk_f32_fp8((int)v.z, true);
    f[6] = __builtin_amdgcn_cvt_pk_f32_fp8((int)v.w, false); f[7] = __builtin_amdgcn_cvt_pk_f32_fp8((int)v.w, true);
}
__device__ __forceinline__ void gb_compute(const GBatch& B, const f32x2g (&xf)[8], f32x2g (&acc)[8]) {
    float z[GB];
#pragma unroll
    for (int j = 0; j < GB; ++j) { f32x2g d[8]; unpack16(B.d[j], d); f32x2g s = xf[0] * d[0];
#pragma unroll
        for (int i = 1; i < 8; ++i) s = __builtin_elementwise_fma(xf[i], d[i], s);
        z[j] = s.x + s.y; }
#pragma unroll
    for (int o = 1; o < 64; o <<= 1) {
#pragma unroll
        for (int j = 0; j < GB; ++j) z[j] += __shfl_xor(z[j], o); }
#pragma unroll
    for (int j = 0; j < GB; ++j) { const float w = B.g[j] * gelu_erf(z[j] * TINV); f32x2g u[8]; unpack16(B.u[j], u); const f32x2g w2 = {w, w};
#pragma unroll
        for (int i = 0; i < 8; ++i) acc[i] = __builtin_elementwise_fma(u[i], w2, acc[i]); }
}
__device__ __forceinline__ void ph_peer_gather(const bf16* __restrict__ xn, const int* __restrict__ ids, const float* __restrict__ gates, const unsigned char* __restrict__ down, const unsigned char* __restrict__ up, const float* x1, float* outw, unsigned* ctr, int tid) {
    const int lane = tid & 63;
    int t; { unsigned v_ = 0; if (lane == 0) v_ = atomicAdd(ctr, 1u); t = (int)__builtin_amdgcn_readfirstlane(v_); }
    while (t < T) {
        unsigned vn_ = 0; if (lane == 0) vn_ = atomicAdd(ctr, 1u);
        const int* idp = ids + (size_t)t * 128; const float* gp = gates + (size_t)t * 128;
        GBatch B0, B1;
        gb_load(B0, idp, gp, 0, down, up, lane);
        f32x2g xf[8];
        { const uint4 xa = *(const uint4*)(xn + (size_t)t * DM + lane * 16), xb = *(const uint4*)(xn + (size_t)t * DM + lane * 16 + 8);
          const unsigned xw[8] = {xa.x, xa.y, xa.z, xa.w, xb.x, xb.y, xb.z, xb.w};
#pragma unroll
          for (int i = 0; i < 8; ++i) { xf[i].x = __uint_as_float(xw[i] << 16); xf[i].y = __uint_as_float(xw[i] & 0xffff0000u); } }
        f32x2g acc[8];
#pragma unroll
        for (int i = 0; i < 8; ++i) acc[i] = (f32x2g){0.f, 0.f};
        for (int e0 = 0; e0 < 128; e0 += 2 * GB) {
            gb_load(B1, idp, gp, e0 + GB, down, up, lane);
            gb_compute(B0, xf, acc);
            if (e0 + 2 * GB < 128) gb_load(B0, idp, gp, e0 + 2 * GB, down, up, lane);
            gb_compute(B1, xf, acc);
        }
        const float* xi = x1 + (size_t)t * DM + lane * 16; float* o = outw + (size_t)t * DM + lane * 16;
#pragma unroll
        for (int k = 0; k < 4; ++k) { float4 r = *(const float4*)(xi + 4 * k);
            r.x += acc[2 * k].x * TINV; r.y += acc[2 * k].y * TINV; r.z += acc[2 * k + 1].x * TINV; r.w += acc[2 * k + 1].y * TINV; *(float4*)(o + 4 * k) = r; }
        t = (int)__builtin_amdgcn_readfirstlane(vn_);
    }
}
__device__ __forceinline__ void ph_convert_fp8(const float* __restrict__ src, unsigned* __restrict__ dst, size_t n4, int wg, int nwg, int tid) {
    for (size_t i = (size_t)wg * NTHR + tid; i < n4; i += (size_t)nwg * NTHR) {
        const float4 v = ((const float4*)src)[i];
        int w = __builtin_amdgcn_cvt_pk_fp8_f32(v.x * TSCALE, v.y * TSCALE, 0, false); w = __builtin_amdgcn_cvt_pk_fp8_f32(v.z * TSCALE, v.w * TSCALE, w, true);
        dst[i] = (unsigned)w;
    }
}
#ifndef PROBE_PHASE
#define PROBE_PHASE -1
#endif
#ifndef PROBE_MULT
#define PROBE_MULT 4
#endif
#ifndef REP_ATTN
#define REP_ATTN 1
#endif
#ifndef REP_ROUTE
#define REP_ROUTE 1
#endif
#ifndef REP_GATHER
#define REP_GATHER 1
#endif
#ifndef REP_QKPOST
#define REP_QKPOST 1
#endif
__global__ void __launch_bounds__(NTHR, 2) mk_fwd(Params P) {
    extern __shared__ __attribute__((aligned(16))) unsigned char lds[];
    cg::grid_group grid = cg::this_grid();
    const int wg = blockIdx.x, nwg = gridDim.x;
#if PROBE_PHASE >= 0
    volatile unsigned* tsl = (volatile unsigned*)(lds + 147456 - 256);
#define STAMP(i) do { if (threadIdx.x == 0) tsl[i] = (unsigned)__builtin_amdgcn_s_memrealtime(); } while (0)
#else
#define STAMP(i) do {} while (0)
#endif
    STAMP(0);
    volatile LAS unsigned* bst = (volatile LAS unsigned*)((LAS unsigned char*)lds + LDS_BYTES - 512);
    if (threadIdx.x < 2) bst[threadIdx.x] = 0u;
    __syncthreads();
    XcdBarrier xbar = xcd_barrier_post((unsigned*)(P.ws + 4096), bst);
#define GRID_BAR() xcd_barrier(xbar)
    unsigned char* ws = P.ws; float* out = P.out;
    const float* x = P.in[0];
    bf16* WinT = (bf16*)(ws + WS_WIN); bf16* WoutT = (bf16*)(ws + WS_WOUT); bf16* WqT = (bf16*)(ws + WS_WQ); bf16* SUBK = (bf16*)(ws + WS_SUBK);
    unsigned char* DOWN = ws + WS_DOWN; unsigned char* UP = ws + WS_UP; bf16* XN = (bf16*)(ws + WS_XN); bf16* QKV = (bf16*)(ws + WS_QKV); bf16* PQ = (bf16*)(ws + WS_PQ);
    bf16* MIXED = (bf16*)(ws + WS_MIXED); bf16* DOB = (bf16*)(ws + WS_DO); int* IDS = (int*)(ws + WS_IDS); float* GATES = (float*)(ws + WS_GATES);
    float* ROPE = (float*)(ws + WS_ROPE); float* KMEAN = (float*)(ws + WS_KMEAN);

    ph_transpose(P.in[2], 1024, 3072, WinT, (float*)lds, wg, nwg, fresh_tid());
    ph_transpose(P.in[13], 1024, 1024, WoutT, (float*)lds, wg, nwg, fresh_tid());
    ph_transpose(P.in[15], 1024, 2048, WqT, (float*)lds, wg, nwg, fresh_tid());
    ph_convert(P.in[16], SUBK, (size_t)16 * 128 * 128 / 4, wg, nwg, fresh_tid());
    ph_convert_fp8(P.in[17], (unsigned*)DOWN, (size_t)16384 * 1024 / 4, wg, nwg, fresh_tid());
    ph_convert_fp8(P.in[18], (unsigned*)UP, (size_t)16384 * 1024 / 4, wg, nwg, fresh_tid());
    ph_rope(ROPE, wg, nwg, fresh_tid());
    ph_rmsnorm(x, P.in[1], XN, T, wg, nwg, fresh_tid());
    float lam; { float a = 0.f, b = 0.f; for (int i = 0; i < 64; ++i) { a += P.in[7][i] * P.in[8][i]; b += P.in[9][i] * P.in[10][i]; } lam = expf(a) - expf(b) + 0.2f; }
    grid.sync();
    STAMP(1);
    { pg8::Gemm g{XN, WinT, T, 3072, 1024}; pg8::EpiBf16 E{QKV, 512, 512, QKV_ELEMS}; pg8::StaticOrder S; S.init(g.M, g.N, nwg, wg);
      pg8::gemm_phase<pg8::EpiBf16, pg8::StaticOrder, true, true>((PG8_LAS unsigned char*)lds, g, S, E); }
    GRID_BAR();
    STAMP(2);
    ph_qk_post(QKV, ROPE, P.in[3], P.in[4], P.in[5], P.in[6], KMEAN, wg, nwg, fresh_tid());
    GRID_BAR();
    STAMP(3);
    for (int rep_ = 0; rep_ < REP_ATTN; ++rep_) { const float* gain_m = P.in[11];
      for (int combo = wg; combo < NB * 8; combo += nwg) {
        const int b = combo >> 3, hd = combo & 7; const size_t brow = (size_t)b * SEQ;
        for (int qb = 7; qb >= 0; --qb) { const size_t qrow = brow + (size_t)qb * 256;
            attn_body::attn_unit<8, true>(qb, (const attn_body::bf16*)(QKV + qrow * 512 + hd * 64), (const attn_body::bf16*)(QKV + QKV_ELEMS + brow * 512 + hd * 64),
                (const attn_body::bf16*)(QKV + 2 * QKV_ELEMS + brow * 512 + hd * 64), (attn_body::bf16*)(MIXED + qrow * 1024 + hd * 64), KMEAN + ((size_t)b * 8 + hd) * 512, gain_m + hd * 64, (char*)lds); }
      }
      for (int combo = wg; combo < NB * 16; combo += nwg) {
        const int b = combo >> 4, jj = combo & 15, h = jj >> 2, m = (jj >> 1) & 1, c = jj & 1; const size_t brow = (size_t)b * SEQ;
        for (int qb = 7; qb >= 0; --qb) { const size_t qrow = brow + (size_t)qb * 256;
            attn_body::attn_unit<8, false>(qb, (const attn_body::bf16*)(QKV + 3 * QKV_ELEMS + qrow * 512 + h * 128 + m * 64), (const attn_body::bf16*)(QKV + 4 * QKV_ELEMS + brow * 512 + h * 128 + m * 64),
                (const attn_body::bf16*)(QKV + 5 * QKV_ELEMS + brow * 512 + h * 128 + c * 64), (attn_body::bf16*)(DOB + qrow * 1024 + h * 256 + m * 128 + c * 64), nullptr, nullptr, (char*)lds); }
      } }
    GRID_BAR();
    STAMP(4);
    ph_diff_combine(DOB, lam, P.in[12], MIXED, wg, nwg, fresh_tid());
    GRID_BAR();
    STAMP(5);
    { pg8::Gemm g{MIXED, WoutT, T, 1024, 1024}; pg8::EpiResF32 E{x, out, 1024}; pg8::StaticOrder S; S.init(g.M, g.N, nwg, wg);
      pg8::gemm_phase<pg8::EpiResF32, pg8::StaticOrder, true, true>((PG8_LAS unsigned char*)lds, g, S, E); }
    GRID_BAR();
    STAMP(6);
    ph_rmsnorm(out, P.in[14], XN, T, wg, nwg, fresh_tid());
    GRID_BAR();
    STAMP(7);
    { pg8::Gemm g{XN, WqT, T, 2048, 1024}; pg8::EpiBf16 E{PQ, 2048, 0, 0}; pg8::StaticOrder S; S.init(g.M, g.N, nwg, wg);
      pg8::gemm_phase<pg8::EpiBf16, pg8::StaticOrder, true, true>((PG8_LAS unsigned char*)lds, g, S, E); }
    GRID_BAR();
    STAMP(8);
    for (int rep_ = 0; rep_ < REP_ROUTE; ++rep_) ph_peer_route(PQ, SUBK, IDS, GATES, (unsigned*)lds, wg, nwg, fresh_tid());
    GRID_BAR();
    STAMP(9);
    for (int rep_ = 1; rep_ < REP_GATHER; ++rep_) ph_peer_gather(XN, IDS, GATES, DOWN, UP, out, (float*)(ws + WS_MIXED), (unsigned*)(ws + 65536 + 256 * rep_), fresh_tid());
    ph_peer_gather(XN, IDS, GATES, DOWN, UP, out, out, (unsigned*)(ws + 65536), fresh_tid());
    STAMP(10);
#if PROBE_PHASE >= 0
    if (blockIdx.x == 0 && threadIdx.x == 0) { const unsigned dt = (tsl[PROBE_PHASE + 1] - tsl[PROBE_PHASE]) * PROBE_MULT; const unsigned long long t0 = __builtin_amdgcn_s_memrealtime(); while ((unsigned)(__builtin_amdgcn_s_memrealtime() - t0) < dt) __builtin_amdgcn_s_sleep(8); }
#endif
}

extern "C" void kernel_launch(void* const* d_in, const int* in_sizes, int n_in, void* d_out, int out_size, void* d_ws, size_t ws_size, hipStream_t stream) {
    static int grid_blocks = 0;
    if (grid_blocks == 0) {
        if (n_in != 19 || in_sizes[0] != T * DM || out_size != T * DM || ws_size < WS_END) { fprintf(stderr, "kernel_launch: unexpected shapes (n_in %d in0 %d out %d ws %zu)\n", n_in, n_in > 0 ? in_sizes[0] : -1, out_size, ws_size); grid_blocks = -1; return; }
        int dev = 0, cus = 0, per_cu = 0;
        (void)hipGetDevice(&dev); (void)hipDeviceGetAttribute(&cus, hipDeviceAttributeMultiprocessorCount, dev);
        (void)hipFuncSetAttribute((const void*)mk_fwd, hipFuncAttributeMaxDynamicSharedMemorySize, LDS_BYTES);
        (void)hipOccupancyMaxActiveBlocksPerMultiprocessor(&per_cu, (const void*)mk_fwd, NTHR, LDS_BYTES);
        if (per_cu < 1 || cus < 1) { fprintf(stderr, "kernel_launch: occupancy query says %d blocks/CU on %d CUs\n", per_cu, cus); grid_blocks = -1; return; }
        if (per_cu > 1) per_cu = 1;
        grid_blocks = cus * per_cu;
    }
    if (grid_blocks < 0) return;
    (void)hipMemsetAsync(d_ws, 0, WS_ZERO_BYTES, stream);
    Params p{};
    for (int i = 0; i < 19; ++i) p.in[i] = (const float*)d_in[i];
    p.out = (float*)d_out; p.ws = (unsigned char*)d_ws;
    void* args[] = {&p};
    hipError_t e = hipLaunchCooperativeKernel((const void*)mk_fwd, dim3(grid_blocks), dim3(NTHR), args, LDS_BYTES, stream);
    if (e != hipSuccess) fprintf(stderr, "cooperative launch failed: %s (grid %d)\n", hipGetErrorString(e), grid_blocks);
}
```

```cpp
#include <hip/hip_runtime.h>
#include <hip/hip_cooperative_groups.h>
#include <cstdio>
#include <cstdint>
namespace cg = cooperative_groups;
__device__ __forceinline__ int fresh_tid() { int t = threadIdx.x; asm volatile("" : "+v"(t)); return t; }
namespace pg8 {
#define PG8_LAS __attribute__((address_space(3)))
typedef unsigned short bf16_t;
typedef short bf16x8 __attribute__((ext_vector_type(8)));
typedef float f32x4 __attribute__((ext_vector_type(4)));
typedef unsigned u32x4 __attribute__((ext_vector_type(4)));
constexpr int BM = 256, BK = 64, HALF = 128, HTB = HALF * BK * 2  , STAGE_BYTES = 8 * HTB, NXCD = 8, WGM = 8;

__host__ __device__ __forceinline__ int lds_byte(int r, int c) { const int st = (r >> 4) * 2 + (c >> 5), rr = r & 15, cc = c & 31, ob = rr * 64 + cc * 2; return st * 1024 + (ob ^ (((ob >> 9) & 1) << 5)); }
__host__ __device__ __forceinline__ void stage_rc(int b, int& R, int& C) { const int st = b / 1024, sb = b % 1024, swz = sb ^ (((sb >> 9) & 1) << 5); R = (st >> 1) * 16 + swz / 64; C = (st & 1) * 32 + (swz % 64) / 2; }
__host__ __device__ __forceinline__ int perm32(int rho) { const int n = rho >> 4, i = rho & 15; return 8 * (i >> 2) + 4 * n + (i & 3); }

struct Unit { int pm, pn; };
struct Gemm { const bf16_t* A; const bf16_t* Bt; int M, N, K; };

struct StaticOrder {
    int nM, nN, nwg, G, c;
    __host__ __device__ void init(int M, int N, int G_, int c_) { nM = M / BM; nN = N / BM; nwg = nM * nN; G = G_; c = c_; }
    __host__ __device__ bool next(int i, Unit& u) const {
        const long L = (long)i * G + c; if (L >= nwg) return false;
        int wgid = (int)L; { const int q = nwg / NXCD, r = nwg % NXCD, xcd = wgid % NXCD, off = wgid / NXCD; wgid = (xcd < r ? xcd * (q + 1) : r * (q + 1) + (xcd - r) * q) + off; }
        const int nig = WGM * nN, gid = wgid / nig, fm = gid * WGM, gsz = (nM - fm) < WGM ? (nM - fm) : WGM;
        u.pm = fm + ((wgid % nig) % gsz); u.pn = (wgid % nig) / gsz; return true;
    }
    __device__ __forceinline__ void a_ready(const Unit&) const {}
    __device__ __forceinline__ void done(const Unit&) const {}
};

__device__ __forceinline__ unsigned cvt_pk_bf16(float lo, float hi) { unsigned r; asm volatile("v_cvt_pk_bf16_f32 %0, %1, %2" : "=v"(r) : "v"(lo), "v"(hi)); return r; }
struct EpiBf16 {
    static constexpr bool PERM = true, AFTER_DRAIN = false;
    bf16_t* O; int ldc; int split_cols; size_t split_stride;
    __device__ __forceinline__ void operator()(const f32x4 (&acc)[2][2][4][2], const Unit& u, int wr, int wc, int fr, int fq) const {
        const int row0 = u.pm * BM + wr * 64 + fr; int colt = u.pn * BM; bf16_t* base = O;
        if (split_cols) { const int t = colt / split_cols; base += (size_t)t * split_stride; colt -= t * split_cols; }
        const int col0 = colt + wc * 32 + 8 * fq;
#pragma unroll
        for (int ai = 0; ai < 2; ++ai)
#pragma unroll
            for (int m = 0; m < 4; ++m) { bf16_t* rowp = base + (size_t)(row0 + ai * HALF + m * 16) * ldc + col0;
#pragma unroll
                for (int bj = 0; bj < 2; ++bj) { const f32x4 v0 = acc[ai][bj][m][0], v1 = acc[ai][bj][m][1];
                    u32x4 w; w.x = cvt_pk_bf16(v0[0], v0[1]); w.y = cvt_pk_bf16(v0[2], v0[3]); w.z = cvt_pk_bf16(v1[0], v1[1]); w.w = cvt_pk_bf16(v1[2], v1[3]);
                    *(u32x4*)(rowp + bj * HALF) = w; } }
    }
};
struct EpiResF32 {
    static constexpr bool PERM = false, AFTER_DRAIN = false;
    const float* base; float* out; int ldc;
    __device__ __forceinline__ void operator()(const f32x4 (&acc)[2][2][4][2], const Unit& u, int wr, int wc, int fr, int fq) const {
        const int col0 = u.pn * BM + wc * 32 + 4 * fq;
#pragma unroll
        for (int ai = 0; ai < 2; ++ai)
#pragma unroll
            for (int m = 0; m < 4; ++m) { const size_t off = (size_t)(u.pm * BM + ai * HALF + wr * 64 + m * 16 + fr) * ldc + col0;
#pragma unroll
                for (int bj = 0; bj < 2; ++bj)
#pragma unroll
                    for (int n = 0; n < 2; ++n) { const f32x4 bs = *(const f32x4*)(base + off + bj * HALF + n * 16); *(f32x4*)(out + off + bj * HALF + n * 16) = bs + acc[ai][bj][m][n]; } }
    }
};
struct EpiQKV {
    static constexpr bool PERM = true, AFTER_DRAIN = false;
    bf16_t* QKV; size_t buf_elems; const float* rope; const float *gqm, *gkm, *gqd, *gkd; float* kmean; float qscale;
    __device__ __forceinline__ void operator()(const f32x4 (&acc)[2][2][4][2], const Unit& u, int wr, int wc, int fr, int fq) const {
        const int type = u.pn >> 1;
        bf16_t* base = QKV + (size_t)type * buf_elems + (size_t)(u.pm * BM + wr * 64 + fr) * 512 + (u.pn & 1) * 256 + wc * 64 + 8 * fq;
        if (type == 2 || type == 5) {
#pragma unroll
            for (int ai = 0; ai < 2; ++ai)
#pragma unroll
                for (int m = 0; m < 4; ++m) { bf16_t* rowp = base + (size_t)(ai * HALF + m * 16) * 512;
#pragma unroll
                    for (int bj = 0; bj < 2; ++bj) { const f32x4 v0 = acc[ai][bj][m][0], v1 = acc[ai][bj][m][1];
                        u32x4 w; w.x = cvt_pk_bf16(v0[0], v0[1]); w.y = cvt_pk_bf16(v0[2], v0[3]); w.z = cvt_pk_bf16(v1[0], v1[1]); w.w = cvt_pk_bf16(v1[2], v1[3]);
                        *(u32x4*)(rowp + bj * 32) = w; } }
            return;
        }
        const float* g = type == 0 ? gqm : type == 1 ? gkm : type == 3 ? gqd + (wc & 1) * 64 : gkd + (wc & 1) * 64;
        const f32x4 g1a = *(const f32x4*)(g + 8 * fq), g1b = *(const f32x4*)(g + 8 * fq + 4), g2a = *(const f32x4*)(g + 32 + 8 * fq), g2b = *(const f32x4*)(g + 32 + 8 * fq + 4);
        const float sc = (type == 0 || type == 3) ? qscale : 1.0f;
        f32x4 ks1a = {0.f, 0.f, 0.f, 0.f}, ks1b = ks1a, ks2a = ks1a, ks2b = ks1a;
#pragma unroll
        for (int ai = 0; ai < 2; ++ai)
#pragma unroll
            for (int m = 0; m < 4; ++m) {
                const int rloc = ai * HALF + m * 16; const int pos = (u.pm * BM + wr * 64 + fr + rloc) & 2047;
                const f32x4 x1a = acc[ai][0][m][0], x1b = acc[ai][0][m][1], x2a = acc[ai][1][m][0], x2b = acc[ai][1][m][1];
                f32x4 q = x1a * x1a + x1b * x1b + x2a * x2a + x2b * x2b; float ss = (q[0] + q[1]) + (q[2] + q[3]);
                ss += __shfl_xor(ss, 16); ss += __shfl_xor(ss, 32);
                const float rs = __builtin_amdgcn_rsqf(ss * (1.0f / 64.0f) + 1e-6f);
                const float* cp = rope + pos * 32 + 8 * fq; const f32x4 ca = *(const f32x4*)cp, cb = *(const f32x4*)(cp + 4), sa = *(const f32x4*)(cp + 65536), sb = *(const f32x4*)(cp + 65536 + 4);
                const f32x4 y1a = x1a * rs * g1a, y1b = x1b * rs * g1b, y2a = x2a * rs * g2a, y2b = x2b * rs * g2b;
                const f32x4 o1a = (y1a * ca - y2a * sa) * sc, o1b = (y1b * cb - y2b * sb) * sc, o2a = (y2a * ca + y1a * sa) * sc, o2b = (y2b * cb + y1b * sb) * sc;
                if (type == 1) { ks1a += o1a; ks1b += o1b; ks2a += o2a; ks2b += o2b; }
                bf16_t* rowp = base + (size_t)rloc * 512;
                u32x4 w1, w2; w1.x = cvt_pk_bf16(o1a[0], o1a[1]); w1.y = cvt_pk_bf16(o1a[2], o1a[3]); w1.z = cvt_pk_bf16(o1b[0], o1b[1]); w1.w = cvt_pk_bf16(o1b[2], o1b[3]);
                w2.x = cvt_pk_bf16(o2a[0], o2a[1]); w2.y = cvt_pk_bf16(o2a[2], o2a[3]); w2.z = cvt_pk_bf16(o2b[0], o2b[1]); w2.w = cvt_pk_bf16(o2b[2], o2b[3]);
                *(u32x4*)rowp = w1; *(u32x4*)(rowp + 32) = w2;
            }
        if (type == 1) {
            float kv[16] = {ks1a[0], ks1a[1], ks1a[2], ks1a[3], ks1b[0], ks1b[1], ks1b[2], ks1b[3], ks2a[0], ks2a[1], ks2a[2], ks2a[3], ks2b[0], ks2b[1], ks2b[2], ks2b[3]};
#pragma unroll
            for (int j = 0; j < 16; ++j) { float v = kv[j]; v += __shfl_xor(v, 1); v += __shfl_xor(v, 2); v += __shfl_xor(v, 4); v += __shfl_xor(v, 8); kv[j] = v; }
            if (fr == 0) { float* km = kmean + (((size_t)(u.pm >> 3) * 8 + (u.pn & 1) * 4 + wc) * 8 + (u.pm & 7)) * 64 + 8 * fq;
#pragma unroll
                for (int j = 0; j < 8; ++j) { atomicAdd(km + j, kv[j] * (1.0f / 256.0f)); atomicAdd(km + 32 + j, kv[8 + j] * (1.0f / 256.0f)); } }
        }
    }
};
struct EpiPQ {
    static constexpr bool PERM = true, AFTER_DRAIN = false;
    bf16_t* O;
    __device__ __forceinline__ void operator()(const f32x4 (&acc)[2][2][4][2], const Unit& u, int wr, int wc, int fr, int fq) const {
        const int s = wc * 2 + (fq >> 1), hi = fq & 1;
#pragma unroll
        for (int ai = 0; ai < 2; ++ai)
#pragma unroll
            for (int m = 0; m < 4; ++m) { const int R = u.pm * BM + ai * HALF + wr * 64 + m * 16 + fr, tb = R >> 5, r = R & 31;
#pragma unroll
                for (int bj = 0; bj < 2; ++bj) { const int hp = u.pn * 2 + bj; const f32x4 v0 = acc[ai][bj][m][0], v1 = acc[ai][bj][m][1];
                    u32x4 w; w.x = cvt_pk_bf16(v0[0], v0[1]); w.y = cvt_pk_bf16(v0[2], v0[3]); w.z = cvt_pk_bf16(v1[0], v1[1]); w.w = cvt_pk_bf16(v1[2], v1[3]);
                    *(u32x4*)(O + ((((size_t)tb * 16 + hp) * 8 + s) * 64 + hi * 32 + r) * 8) = w; } }
    }
};
template <class Epi, class Sched, bool ALIGN_EPI = false, bool SP2 = false>
__device__ __forceinline__ void gemm_phase(PG8_LAS unsigned char* lds, const Gemm g, const Sched& S, const Epi& E) {
    const int tid = fresh_tid(), wid = __builtin_amdgcn_readfirstlane(tid >> 6), lane = tid & 63, wr = wid >> 2, wc = wid & 3, fr = lane & 15, fq = lane >> 4;
    const int K = g.K, nt = K / BK;
    unsigned voffA[2], voffB[2];
#pragma unroll
    for (int i = 0; i < 2; ++i) { int R, C; stage_rc(tid * 16 + i * 8192, R, C); const int Rb = Epi::PERM ? ((R & ~31) + perm32(R & 31)) : R;
        voffA[i] = (unsigned)(R * K + C) * 2u; voffB[i] = (unsigned)(Rb * K + C) * 2u; }
    const size_t kstep = (size_t)(BK * 2);
    const size_t hstep = (size_t)HALF * K * 2;
    const size_t tstep = 2 * hstep;
    const unsigned ldsw = (unsigned)wid * 1024u;
    const int aoff = lds_byte(wr * 64 + fr, fq * 8), boff = lds_byte(wc * 32 + fr, fq * 8);
#define PG8_SA(b, h) (((b) * 2 + (h)) * HTB)
#define PG8_SB(b, h) ((4 + (b) * 2 + (h)) * HTB)
#define PG8_STAGE(bufoff, gbase, voff) do { _Pragma("unroll") for (int _i = 0; _i < 2; ++_i) \
        __builtin_amdgcn_global_load_lds((const unsigned*)((const char*)(gbase) + (voff)[_i]), (PG8_LAS unsigned*)(lds + (bufoff) + ldsw + _i * 8192), 16, 0, 0); } while (0)
#define PG8_LDA(dst, b, h) do { _Pragma("unroll") for (int m = 0; m < 4; ++m) _Pragma("unroll") for (int k = 0; k < 2; ++k) dst[m][k] = *(const PG8_LAS bf16x8*)(lds + PG8_SA(b, h) + aoff + m * 2048 + k * 1024); } while (0)
#define PG8_LDB(dst, b, h) do { _Pragma("unroll") for (int n = 0; n < 2; ++n) _Pragma("unroll") for (int k = 0; k < 2; ++k) dst[n][k] = *(const PG8_LAS bf16x8*)(lds + PG8_SB(b, h) + boff + n * 2048 + k * 1024); } while (0)
#define PG8_MMA(ai, bj, At, Bt) do { __builtin_amdgcn_s_setprio(1); _Pragma("unroll") for (int m = 0; m < 4; ++m) _Pragma("unroll") for (int n = 0; n < 2; ++n) _Pragma("unroll") for (int k = 0; k < 2; ++k) \
        acc[ai][bj][m][n] = __builtin_amdgcn_mfma_f32_16x16x32_bf16(Bt[n][k], At[m][k], acc[ai][bj][m][n], 0, 0, 0); __builtin_amdgcn_s_setprio(0); } while (0)
#define PG8_WAIT_V(n) asm volatile("s_waitcnt vmcnt(" #n ")" ::: "memory")
#define PG8_WAIT_L(n) asm volatile("s_waitcnt lgkmcnt(" #n ")" ::: "memory")
#define PG8_BAR __builtin_amdgcn_s_barrier()
#define PG8_SCHED __builtin_amdgcn_sched_barrier(0)
    Unit cur, nxt; int ui = 0;
    if (!S.next(0, cur)) return;
    f32x4 acc[2][2][4][2];
#pragma unroll
    for (int a = 0; a < 2; ++a)
#pragma unroll
        for (int b = 0; b < 2; ++b)
#pragma unroll
            for (int m = 0; m < 4; ++m)
#pragma unroll
                for (int n = 0; n < 2; ++n) acc[a][b][m][n] = (f32x4){0.f, 0.f, 0.f, 0.f};
    bf16x8 At[4][2], B0[2][2], B1[2][2];
    const char* cA = (const char*)g.A + (size_t)cur.pm * tstep; const char* cB = (const char*)g.Bt + (size_t)cur.pn * tstep;
    S.a_ready(cur);
    if constexpr (SP2) {
        PG8_STAGE(PG8_SB(0, 0), cB, voffB); PG8_STAGE(PG8_SB(0, 1), cB + hstep, voffB); PG8_STAGE(PG8_SA(0, 0), cA, voffA); PG8_STAGE(PG8_SA(0, 1), cA + hstep, voffA);
        if (wr == 1) PG8_BAR;
        PG8_WAIT_V(2); PG8_BAR;
        PG8_STAGE(PG8_SB(1, 0), cB + kstep, voffB); PG8_STAGE(PG8_SA(1, 0), cA + kstep, voffA); PG8_STAGE(PG8_SB(1, 1), cB + hstep + kstep, voffB);
        PG8_WAIT_V(6); PG8_BAR;
    } else {
        PG8_STAGE(PG8_SB(0, 0), cB, voffB); PG8_STAGE(PG8_SA(0, 0), cA, voffA); PG8_STAGE(PG8_SB(0, 1), cB + hstep, voffB); PG8_STAGE(PG8_SA(0, 1), cA + hstep, voffA);
        if (wr == 1) PG8_BAR;
        PG8_WAIT_V(4); PG8_BAR;
        PG8_STAGE(PG8_SB(1, 0), cB + kstep, voffB); PG8_STAGE(PG8_SA(1, 0), cA + kstep, voffA); PG8_STAGE(PG8_SB(1, 1), cB + hstep + kstep, voffB);
        PG8_WAIT_V(6); PG8_BAR;
    }
    for (;;) {
        const bool has_next = S.next(ui + 1, nxt);
        const char* nA = has_next ? (const char*)g.A + (size_t)nxt.pm * tstep : cA; const char* nB = has_next ? (const char*)g.Bt + (size_t)nxt.pn * tstep : cB;
        for (int t = 0; t < nt; t += 2) {
            const bool last = (t == nt - 2);
            const char* a1 = cA + (size_t)(t + 1) * kstep;
            const char* a2 = last ? nA : cA + (size_t)(t + 2) * kstep; const char* b2 = last ? nB : cB + (size_t)(t + 2) * kstep;
            const char* a3 = a2 + kstep; const char* b3 = b2 + kstep;
            if (last && has_next) S.a_ready(nxt);
            if constexpr (SP2) {
            PG8_LDB(B0, 0, 0); PG8_LDB(B1, 0, 1); PG8_SCHED; PG8_LDA(At, 0, 0); PG8_STAGE(PG8_SA(1, 1), a1 + hstep, voffA);
            PG8_WAIT_V(8); PG8_WAIT_L(0); PG8_BAR; PG8_MMA(0, 0, At, B0); PG8_MMA(0, 1, At, B1); PG8_BAR; PG8_SCHED;
            PG8_LDA(At, 0, 1); PG8_STAGE(PG8_SB(0, 0), b2, voffB); PG8_STAGE(PG8_SB(0, 1), b2 + hstep, voffB); PG8_STAGE(PG8_SA(0, 0), a2, voffA);
            PG8_WAIT_V(8); PG8_WAIT_L(0); PG8_BAR; PG8_MMA(1, 0, At, B0); PG8_MMA(1, 1, At, B1); PG8_BAR; PG8_SCHED;
            PG8_LDB(B0, 1, 0); PG8_LDB(B1, 1, 1); PG8_SCHED; PG8_LDA(At, 1, 0); PG8_STAGE(PG8_SA(0, 1), a2 + hstep, voffA);
            PG8_WAIT_V(8); PG8_WAIT_L(0); PG8_BAR; PG8_MMA(0, 0, At, B0); PG8_MMA(0, 1, At, B1); PG8_BAR; PG8_SCHED;
            PG8_LDA(At, 1, 1); PG8_STAGE(PG8_SB(1, 0), b3, voffB); PG8_STAGE(PG8_SB(1, 1), b3 + hstep, voffB); PG8_STAGE(PG8_SA(1, 0), a3, voffA);
            PG8_WAIT_V(8); PG8_WAIT_L(0); PG8_BAR; PG8_MMA(1, 0, At, B0); PG8_MMA(1, 1, At, B1); PG8_BAR; PG8_SCHED;
            } else {
            PG8_LDB(B0, 0, 0); PG8_SCHED; PG8_LDA(At, 0, 0); PG8_STAGE(PG8_SA(1, 1), a1 + hstep, voffA);
            PG8_WAIT_L(8); PG8_BAR; PG8_WAIT_L(0); PG8_MMA(0, 0, At, B0); PG8_BAR; PG8_SCHED;
            PG8_LDB(B1, 0, 1); PG8_STAGE(PG8_SB(0, 0), b2, voffB);
            PG8_BAR; PG8_WAIT_L(0); PG8_MMA(0, 1, At, B1); PG8_BAR;
            PG8_LDA(At, 0, 1); PG8_STAGE(PG8_SA(0, 0), a2, voffA);
            PG8_BAR; PG8_WAIT_L(0); PG8_MMA(1, 0, At, B0); PG8_BAR; PG8_SCHED;
            PG8_STAGE(PG8_SB(0, 1), b2 + hstep, voffB);
            PG8_WAIT_V(6); PG8_BAR; PG8_MMA(1, 1, At, B1); PG8_BAR;
            PG8_LDB(B0, 1, 0); PG8_SCHED; PG8_LDA(At, 1, 0); PG8_STAGE(PG8_SA(0, 1), a2 + hstep, voffA);
            PG8_WAIT_L(8); PG8_BAR; PG8_WAIT_L(0); PG8_MMA(0, 0, At, B0); PG8_BAR; PG8_SCHED;
            PG8_LDB(B1, 1, 1); PG8_STAGE(PG8_SB(1, 0), b3, voffB);
            PG8_BAR; PG8_WAIT_L(0); PG8_MMA(0, 1, At, B1); PG8_BAR;
            PG8_LDA(At, 1, 1); PG8_STAGE(PG8_SA(1, 0), a3, voffA);
            PG8_BAR; PG8_WAIT_L(0); PG8_MMA(1, 0, At, B0); PG8_BAR; PG8_SCHED;
            PG8_STAGE(PG8_SB(1, 1), b3 + hstep, voffB);
            PG8_WAIT_V(6); PG8_BAR; PG8_MMA(1, 1, At, B1); PG8_BAR;
            }
        }
        if constexpr (ALIGN_EPI) { if (wr == 0) PG8_BAR; }
        if constexpr (!Epi::AFTER_DRAIN) { E(acc, cur, wr, wc, fr, fq); S.done(cur); }
        if (!has_next) break;
#pragma unroll
        for (int a = 0; a < 2; ++a)
#pragma unroll
            for (int b = 0; b < 2; ++b)
#pragma unroll
                for (int m = 0; m < 4; ++m)
#pragma unroll
                    for (int n = 0; n < 2; ++n) acc[a][b][m][n] = (f32x4){0.f, 0.f, 0.f, 0.f};
        cur = nxt; cA = nA; cB = nB; ++ui;
        if constexpr (ALIGN_EPI) { if (wr == 1) PG8_BAR; }
    }
    PG8_WAIT_V(0);
    if constexpr (!ALIGN_EPI) { if (wr == 0) PG8_BAR; }
    PG8_BAR;
    if constexpr (Epi::AFTER_DRAIN) { E.fused(acc, cur, wr, wc, fr, fq, lds, wid, lane); S.done(cur); }
#undef PG8_SA
#undef PG8_SB
#undef PG8_STAGE
#undef PG8_LDA
#undef PG8_LDB
#undef PG8_MMA
#undef PG8_WAIT_V
#undef PG8_WAIT_L
#undef PG8_BAR
#undef PG8_SCHED
}
}
#include <hip/hip_bf16.h>
#include <cmath>
namespace attn_body {
using bf16=__hip_bfloat16;
using bf16x8=__attribute__((ext_vector_type(8)))short;
using s16x4=__attribute__((ext_vector_type(4)))short;
using f32x16=__attribute__((ext_vector_type(16)))float;
using u32x4=__attribute__((ext_vector_type(4)))unsigned;
constexpr int SEQ=2048,D=64,DM=512,PO=1024;
constexpr int NW=8,QBLK=32,QB=QBLK*NW,KVBLK=64,NQB=SEQ/QB;
constexpr int ATTN_UNIT_ROWS=QB;
__device__ __forceinline__ int crow(int r,int hi){return (r&3)+8*(r>>2)+4*hi;}
#define SBAR() __builtin_amdgcn_sched_barrier(0)
__device__ __forceinline__ void cmask(f32x16&p0,f32x16&p1,int jb,int qrel,int hi){
  const float NEG=-INFINITY; int kb=64*jb+4*hi;
  #pragma unroll
  for(int r=0;r<16;++r){int kv=kb+(r&3)+8*(r>>2); if(kv>qrel)p0[r]=NEG; if(kv+32>qrel)p1[r]=NEG;}
}

__device__ __forceinline__ void bmask(f32x16&p0,f32x16&p1,unsigned on){
  if(!on){
    #pragma unroll
    for(int r=0;r<16;++r){p0[r]=-INFINITY;p1[r]=-INFINITY;} }
}
constexpr int NSLOT=3, SLOTB=8192;
constexpr int LDS_K=0, LDS_V=NSLOT*SLOTB, LDS_WS=2*NSLOT*SLOTB, LDS_OST=LDS_WS+NW*64*4, LDS_BYTES=LDS_OST+NW*4096;
constexpr float C2=0.125f*1.4426950408889634f;
__device__ __forceinline__ void glds16(const void*gsrc,unsigned lds_dst){unsigned keep;
  asm volatile("s_mov_b32 %0, m0\n\ts_mov_b32 m0, %2\n\ts_nop 0\n\tglobal_load_lds_dwordx4 %1, off\n\ts_mov_b32 m0, %0":"=&s"(keep):"v"(gsrc),"s"(lds_dst):"memory");}
__device__ __forceinline__ float max3f(float a,float b,float c){float r;asm("v_max3_f32 %0, %1, %2, %3":"=v"(r):"v"(a),"v"(b),"v"(c));return r;}
__device__ __forceinline__ float max2f(float a,float b){float r;asm("v_max_f32_e32 %0, %1, %2":"=v"(r):"v"(a),"v"(b));return r;}
__device__ __forceinline__ float fadd_s(float a,float b){float r;asm("v_add_f32_e32 %0, %1, %2":"=v"(r):"v"(a),"v"(b));return r;}
__device__ __forceinline__ float fsub_s(float a,float b){float r;asm("v_sub_f32_e32 %0, %1, %2":"=v"(r):"v"(a),"v"(b));return r;}
typedef float f32x2_t __attribute__((ext_vector_type(2))); typedef __bf16 bf16x2_t __attribute__((ext_vector_type(2)));
__device__ __forceinline__ unsigned cvtpk_s(float lo,float hi){f32x2_t v={lo,hi};bf16x2_t b=__builtin_convertvector(v,bf16x2_t);return __builtin_bit_cast(unsigned,b);}
#define WAIT_BAR(N) asm volatile("s_waitcnt vmcnt(" #N ") lgkmcnt(0)\n\ts_barrier":::"memory")

__device__ __forceinline__ void qkt(f32x16&p0,f32x16&p1,const char*Kslot,const bf16x8*qr,int r32,int hi){
  const char*kb=Kslot+hi*1024+r32*16;
  #pragma unroll
  for(int d0=0;d0<4;++d0){
    const bf16x8 b0=*reinterpret_cast<const bf16x8*>(kb+d0*2048);
    const bf16x8 b1=*reinterpret_cast<const bf16x8*>(kb+d0*2048+512);
    if(d0==0){p0=__builtin_amdgcn_mfma_f32_32x32x16_bf16(b0,qr[0],f32x16{},0,0,0);p1=__builtin_amdgcn_mfma_f32_32x32x16_bf16(b1,qr[0],f32x16{},0,0,0);}
    else{p0=__builtin_amdgcn_mfma_f32_32x32x16_bf16(b0,qr[d0],p0,0,0,0);p1=__builtin_amdgcn_mfma_f32_32x32x16_bf16(b1,qr[d0],p1,0,0,0);}}
}
typedef __attribute__((address_space(3))) const char* lds_cptr;
typedef short v4i16_t __attribute__((ext_vector_type(4)));
__device__ __forceinline__ void kload8(bf16x8*kf,lds_cptr kp){
  kf[0]=*(const __attribute__((address_space(3))) bf16x8*)(kp);      kf[1]=*(const __attribute__((address_space(3))) bf16x8*)(kp+512);
  kf[2]=*(const __attribute__((address_space(3))) bf16x8*)(kp+2048); kf[3]=*(const __attribute__((address_space(3))) bf16x8*)(kp+2560);
  kf[4]=*(const __attribute__((address_space(3))) bf16x8*)(kp+4096); kf[5]=*(const __attribute__((address_space(3))) bf16x8*)(kp+4608);
  kf[6]=*(const __attribute__((address_space(3))) bf16x8*)(kp+6144); kf[7]=*(const __attribute__((address_space(3))) bf16x8*)(kp+6656);
}
__device__ __forceinline__ void kload2(bf16x8*kf,lds_cptr kp,int j){ kf[2*j]=*(const __attribute__((address_space(3))) bf16x8*)(kp+j*2048); kf[2*j+1]=*(const __attribute__((address_space(3))) bf16x8*)(kp+j*2048+512); }
__device__ __forceinline__ s16x4 vtr(lds_cptr p){ return __builtin_bit_cast(s16x4,__builtin_amdgcn_ds_read_tr16_b64_v4i16((__attribute__((address_space(3))) v4i16_t*)p)); }
__device__ __forceinline__ float rowmax(const f32x16&p0,const f32x16&p1){
  float a=max3f(p0[0],p0[1],p1[0]),b=max3f(p0[2],p0[3],p1[1]);a=max3f(a,p1[2],p1[3]);
  #pragma unroll
  for(int r=4;r<16;r+=4){a=max3f(a,p0[r],p0[r+1]);b=max3f(b,p0[r+2],p0[r+3]);a=max3f(a,p1[r],p1[r+1]);b=max3f(b,p1[r+2],p1[r+3]);}
  const float m=max2f(a,b);
  auto rr=__builtin_amdgcn_permlane32_swap(__float_as_uint(m),__float_as_uint(m),false,false);
  return max2f(__uint_as_float(rr[0]),__uint_as_float(rr[1]));
}
__device__ __forceinline__ void pv(f32x16*o,int vb,bf16x8 pa0,bf16x8 pa1,bf16x8 pa2,bf16x8 pa3){
  #pragma unroll
  for(int d0=0;d0<2;++d0){s16x4 lo[4],hi[4];
    #pragma unroll
    for(int ks=0;ks<4;++ks){
      asm volatile("ds_read_b64_tr_b16 %0,%1 offset:%c2":"=&v"(lo[ks]):"v"(vb),"i"(d0*4096+ks*1024):"memory");
      asm volatile("ds_read_b64_tr_b16 %0,%1 offset:%c2":"=&v"(hi[ks]):"v"(vb),"i"(d0*4096+ks*1024+512):"memory");}
    asm volatile("s_waitcnt lgkmcnt(0)":::"memory");SBAR();
    #define PK(k) (bf16x8){lo[k][0],lo[k][1],lo[k][2],lo[k][3],hi[k][0],hi[k][1],hi[k][2],hi[k][3]}
    o[d0]=__builtin_amdgcn_mfma_f32_32x32x16_bf16(pa0,PK(0),o[d0],0,0,0);
    o[d0]=__builtin_amdgcn_mfma_f32_32x32x16_bf16(pa1,PK(1),o[d0],0,0,0);
    o[d0]=__builtin_amdgcn_mfma_f32_32x32x16_bf16(pa2,PK(2),o[d0],0,0,0);
    o[d0]=__builtin_amdgcn_mfma_f32_32x32x16_bf16(pa3,PK(3),o[d0],0,0,0);
    #undef PK
  }
}

#ifndef ATTN_STORE16
#define ATTN_STORE16(p,v) (*(u32x4*)(p)=(v))
#endif
template<int THRL,bool MOBA> __device__ __forceinline__ void attn_unit(int qb,const bf16*Qu,const bf16*__restrict__ Kh,const bf16*__restrict__ Vh,bf16*Ou,const float*__restrict__ km,const float*__restrict__ gm,char*shm){
  const int tid=fresh_tid(),lane=tid&63,r32=lane&31,hi=lane>>5; const int wid=__builtin_amdgcn_readfirstlane(tid>>6);
  const int q0=qb*QB;
  const bf16*Qw=Qu+(long)(wid*QBLK)*DM;
  const unsigned lds0=(unsigned)(uintptr_t)shm;
  float*wsf=(float*)(shm+LDS_WS)+wid*64;
  const bf16*ksrc=Kh+(long)lane*DM+wid*8;
  const bf16*vsrc=Vh+(long)(16*(wid&3)+(lane>>2))*DM+(wid>>2)*32+(lane&3)*8;
  const unsigned kdst=lds0+LDS_K+wid*1024, vdst=lds0+LDS_V+wid*1024;
  #define DMA_K(t,slot) glds16(ksrc+(long)(t)*KVBLK*DM,(unsigned)__builtin_amdgcn_readfirstlane(kdst+(slot)))
  #define DMA_V(t,slot) glds16(vsrc+(long)(t)*KVBLK*DM,(unsigned)__builtin_amdgcn_readfirstlane(vdst+(slot)))
  const int vb0=(int)(lds0+LDS_V)+((lane>>4)&1)*32+(lane&3)*8+(4*hi+((lane&15)>>2))*64;
  const char*Kbase=shm+LDS_K; bf16x8 kf[8];
  const lds_cptr shm3=(lds_cptr)shm; const lds_cptr kp0=shm3+LDS_K+hi*1024+r32*16; const lds_cptr vp0=shm3+LDS_V+((lane>>4)&1)*32+(lane&3)*8+(4*hi+((lane&15)>>2))*64;
  const int NT=(q0+QB)/KVBLK;
  DMA_K(0,0);DMA_V(0,0);DMA_K(1,SLOTB);
  bf16x8 qr[4];
  #pragma unroll
  for(int d0=0;d0<4;++d0)qr[d0]=*reinterpret_cast<const bf16x8*>(&Qw[(long)r32*DM+d0*16+hi*8]);
  unsigned selm=0u;
  if(MOBA){ float g[8];
    #pragma unroll
    for(int n=0;n<8;++n){ float s_=0.f; if(n<qb){
      #pragma unroll
      for(int d0=0;d0<4;++d0){ const float4 ka=*reinterpret_cast<const float4*>(km+n*64+d0*16+hi*8), kb2=*reinterpret_cast<const float4*>(km+n*64+d0*16+hi*8+4);
        const float kv[8]={ka.x,ka.y,ka.z,ka.w,kb2.x,kb2.y,kb2.z,kb2.w};
        #pragma unroll
        for(int j=0;j<8;++j)s_+=__uint_as_float(((unsigned)(unsigned short)qr[d0][j])<<16)*kv[j]; }
      s_+=__shfl_xor(s_,32); } g[n]=s_; asm volatile("":"+v"(s_)::"memory"); SBAR(); }
    #pragma unroll
    for(int r=0;r<3;++r){ float best=-3.0e38f; int bi=-1;
      #pragma unroll
      for(int n=0;n<8;++n) if(n<qb&&!((selm>>n)&1u)&&g[n]>best){best=g[n];bi=n;}
      if(bi>=0)selm|=1u<<bi; } }
  float l_reg=0.f;f32x16 o[2];o[0]=f32x16{};o[1]=f32x16{};
  const int qrel=wid*QBLK+r32;
  #define CMASK(P0,P1,t) do{int jb_=(t)-(NT-4); if(jb_>=0)cmask(P0,P1,jb_,qrel,hi); else if(MOBA) bmask(P0,P1,(selm>>((t)>>2))&1u);}while(0)
  #define START(P0,P1) do{ _Pragma("unroll") for(int r=0;r<16;++r)P0[r]=__builtin_amdgcn_exp2f(P0[r]); }while(0)
  #define RESC() do{}while(0)
  f32x16 pA0,pA1,pB0,pB1;
  int sl_prev=0,sl_cur=0,sl_next=SLOTB;
  #define ROT() do{sl_prev=sl_cur;sl_cur=sl_next;sl_next=(sl_next==(NSLOT-1)*SLOTB)?0:sl_next+SLOTB;}while(0)
  DMA_K(2,2*SLOTB);
  WAIT_BAR(3);
  qkt(pA0,pA1,Kbase,qr,r32,hi);asm volatile("s_nop 15\n\ts_nop 7":"+v"(pA0),"+v"(pA1));CMASK(pA0,pA1,0);
  START(pA0,pA1);
  _Pragma("unroll") for(int r=0;r<16;++r)pA1[r]=__builtin_amdgcn_exp2f(pA1[r]);
  WAIT_BAR(0);
  DMA_K(3,0);DMA_V(1,SLOTB);
  ROT();
  kload8(kf,kp0+sl_cur);
  WAIT_BAR(2);
  s16x4 vlo[8],vhi[8]; u32x4 pw0,pw1,pw2,pw3;
  #define PKW(P,B) cvtpk_s(P[B],P[B+1])
  #define PAF(k) __builtin_bit_cast(bf16x8,pw##k)
  #define VFR(i) (bf16x8){vlo[i][0],vlo[i][1],vlo[i][2],vlo[i][3],vhi[i][0],vhi[i][1],vhi[i][2],vhi[i][3]}
  #define PIN(x) asm volatile("":"+v"(x))
  #define MX3(a,b,c) __builtin_fmaxf(__builtin_fmaxf((a),(b)),(c))
  #define GAPA(MF,A0,A1,A2,A3,W0,W1,PW) do{ MF; sacc+=A0; sacc+=A1; sacc+=A2; sacc+=A3; PIN(sacc); W0; W1; PIN(PW); SBAR(); }while(0)
  #define EX(v) __builtin_amdgcn_exp2f(v)
  #define GAPB(MF,X,B) do{ MF; X[B]=EX(X[B]); X[B+1]=EX(X[B+1]); X[B+2]=EX(X[B+2]); X[B+3]=EX(X[B+3]); PIN(X); SBAR(); }while(0)
  #define VRD(i) do{ vlo[i]=vtr(vp_+(((i)>>2)*4096+((i)&3)*1024)); vhi[i]=vtr(vp_+(((i)>>2)*4096+((i)&3)*1024+512)); }while(0)
  #define KRD(G,j) do{ if(G){ kload2(kf,kp0+sl_next,j); SBAR(); } }while(0)
  #define STEP(C0,C1,P0,P1,t,GK,GV,GL) do{ SBAR(); \
    const lds_cptr vp_=vp0+sl_prev; \
    VRD(0); SBAR(); float sacc=(P0[0]+P0[1]); \
    GAPA(C0=__builtin_amdgcn_mfma_f32_32x32x16_bf16(kf[0],qr[0],f32x16{},0,0,0), P0[2],P0[3],P0[4],P0[5],     pw0[0]=PKW(P0,0), pw0[1]=PKW(P0,2), pw0); \
    VRD(4); SBAR(); GAPA(C1=__builtin_amdgcn_mfma_f32_32x32x16_bf16(kf[1],qr[0],f32x16{},0,0,0), P0[6],P0[7],P0[8],P0[9],     pw0[2]=PKW(P0,4), pw0[3]=PKW(P0,6), pw0); \
    VRD(1); SBAR(); GAPA(C0=__builtin_amdgcn_mfma_f32_32x32x16_bf16(kf[2],qr[1],C0,0,0,0),   P0[10],P0[11],P0[12],P0[13], pw1[0]=PKW(P0,8), pw1[1]=PKW(P0,10), pw1); \
    VRD(5); SBAR(); GAPA(C1=__builtin_amdgcn_mfma_f32_32x32x16_bf16(kf[3],qr[1],C1,0,0,0),   P0[14],P0[15],P1[0],P1[1],   pw1[2]=PKW(P0,12),pw1[3]=PKW(P0,14), pw1); \
    VRD(2); SBAR(); GAPA(C0=__builtin_amdgcn_mfma_f32_32x32x16_bf16(kf[4],qr[2],C0,0,0,0),   P1[2],P1[3],P1[4],P1[5],     pw2[0]=PKW(P1,0), pw2[1]=PKW(P1,2), pw2); \
    VRD(6); SBAR(); GAPA(C1=__builtin_amdgcn_mfma_f32_32x32x16_bf16(kf[5],qr[2],C1,0,0,0),   P1[6],P1[7],P1[8],P1[9],     pw2[2]=PKW(P1,4), pw2[3]=PKW(P1,6), pw2); \
    VRD(3); SBAR(); GAPA(C0=__builtin_amdgcn_mfma_f32_32x32x16_bf16(kf[6],qr[3],C0,0,0,0),   P1[10],P1[11],P1[12],P1[13], pw3[0]=PKW(P1,8), pw3[1]=PKW(P1,10), pw3); \
    VRD(7); SBAR(); GAPA(C1=__builtin_amdgcn_mfma_f32_32x32x16_bf16(kf[7],qr[3],C1,0,0,0),   P1[14],P1[15],0.f,0.f,       pw3[2]=PKW(P1,12),pw3[3]=PKW(P1,14), pw3); \
    l_reg+=sacc; \
    if(GK){DMA_K((t)+3,sl_cur);} if(GV){DMA_V((t)+1,sl_next);} \
    CMASK(C0,C1,t); \
    SBAR(); \
    GAPB(o[0]=__builtin_amdgcn_mfma_f32_32x32x16_bf16(PAF(0),VFR(0),o[0],0,0,0), C0,0); \
    GAPB(o[1]=__builtin_amdgcn_mfma_f32_32x32x16_bf16(PAF(0),VFR(4),o[1],0,0,0), C0,4); \
    KRD(GL,0); GAPB(o[0]=__builtin_amdgcn_mfma_f32_32x32x16_bf16(PAF(1),VFR(1),o[0],0,0,0), C0,8); \
    KRD(GL,1); GAPB(o[1]=__builtin_amdgcn_mfma_f32_32x32x16_bf16(PAF(1),VFR(5),o[1],0,0,0), C0,12); \
    KRD(GL,2); GAPB(o[0]=__builtin_amdgcn_mfma_f32_32x32x16_bf16(PAF(2),VFR(2),o[0],0,0,0), C1,0); \
    KRD(GL,3); GAPB(o[1]=__builtin_amdgcn_mfma_f32_32x32x16_bf16(PAF(2),VFR(6),o[1],0,0,0), C1,4); \
    GAPB(o[0]=__builtin_amdgcn_mfma_f32_32x32x16_bf16(PAF(3),VFR(3),o[0],0,0,0), C1,8); \
    GAPB(o[1]=__builtin_amdgcn_mfma_f32_32x32x16_bf16(PAF(3),VFR(7),o[1],0,0,0), C1,12); \
    }while(0)
  int t=1;
  #undef CMASK
  #define CMASK(P0,P1,t) do{ if(MOBA) bmask(P0,P1,(selm>>((t)>>2))&1u); }while(0)
  for(;t+5<NT;t+=2){
    STEP(pB0,pB1,pA0,pA1,t,true,true,true);     WAIT_BAR(2); RESC(); ROT();
    STEP(pA0,pA1,pB0,pB1,t+1,true,true,true);   WAIT_BAR(2); RESC(); ROT();
  }
  #undef CMASK
  #define CMASK(P0,P1,t) do{int jb_=(t)-(NT-4); if(jb_>=0)cmask(P0,P1,jb_,qrel,hi); else if(MOBA) bmask(P0,P1,(selm>>((t)>>2))&1u);}while(0)
  #define ENDW(tt) do{ if((tt)+3<NT){WAIT_BAR(2);} else if((tt)+2<NT){WAIT_BAR(1);} else {WAIT_BAR(0);} }while(0)
  for(;t+1<NT;t+=2){
    STEP(pB0,pB1,pA0,pA1,t,(t+3<NT),(t+1<NT),(t+1<NT));       ENDW(t);   RESC(); ROT();
    STEP(pA0,pA1,pB0,pB1,t+1,(t+4<NT),(t+2<NT),(t+2<NT));     ENDW(t+1); RESC(); ROT();
  }
  STEP(pB0,pB1,pA0,pA1,NT-1,false,false,false); RESC();
  { float sacc=pB0[0]+pB0[1]; _Pragma("unroll") for(int r=2;r<16;++r)sacc+=pB0[r]; _Pragma("unroll") for(int r=0;r<16;++r)sacc+=pB1[r]; l_reg+=sacc;
    pw0=(u32x4){PKW(pB0,0),PKW(pB0,2),PKW(pB0,4),PKW(pB0,6)};pw1=(u32x4){PKW(pB0,8),PKW(pB0,10),PKW(pB0,12),PKW(pB0,14)};pw2=(u32x4){PKW(pB1,0),PKW(pB1,2),PKW(pB1,4),PKW(pB1,6)};pw3=(u32x4){PKW(pB1,8),PKW(pB1,10),PKW(pB1,12),PKW(pB1,14)};
    SBAR(); pv(o,vb0+sl_cur,PAF(0),PAF(1),PAF(2),PAF(3)); }
  #undef PKW
  #undef PAF
  #undef VFR
  #undef PIN
  #undef MX3
  #undef GAPA
  #undef GAPB
  #undef EX
  #undef VRD
  #undef KRD
  #undef STEP
  #undef ENDW
  {auto rr=__builtin_amdgcn_permlane32_swap(__float_as_uint(l_reg),__float_as_uint(l_reg),false,false);l_reg=__uint_as_float(rr[0])+__uint_as_float(rr[1]);}
  if(hi==0)wsf[32+r32]=l_reg;asm volatile("s_waitcnt lgkmcnt(0)":::"memory");
  float rli[16];
  #pragma unroll
  for(int r=0;r<16;++r)rli[r]=__builtin_amdgcn_rcpf(wsf[32+crow(r,hi)]);
  bf16*Ow=Ou+(long)(wid*QBLK)*PO;
  { bf16*stg=(bf16*)(shm+LDS_OST)+wid*2048;
    #pragma unroll
    for(int r=0;r<16;++r){const int orow=crow(r,hi);
      #pragma unroll
      for(int d0=0;d0<2;++d0)stg[orow*64+d0*32+r32]=__float2bfloat16(o[d0][r]*rli[r]);}
    asm volatile("s_waitcnt lgkmcnt(0)":::"memory");
    #pragma unroll
    for(int i=0;i<4;++i){const int row=i*8+(lane>>3),ch=lane&7; u32x4 v=*(const u32x4*)(stg+row*64+ch*8);
      if(MOBA){ float f[8]; float ss=0.f;
        #pragma unroll
        for(int e=0;e<4;++e){ f[2*e]=__uint_as_float(v[e]<<16); f[2*e+1]=__uint_as_float(v[e]&0xffff0000u); ss+=f[2*e]*f[2*e]+f[2*e+1]*f[2*e+1]; }
        ss+=__shfl_xor(ss,1); ss+=__shfl_xor(ss,2); ss+=__shfl_xor(ss,4);
        const float rs=__builtin_amdgcn_rsqf(ss*(1.0f/64.0f)+1e-6f);
        const float4 g0=*reinterpret_cast<const float4*>(gm+ch*8), g1=*reinterpret_cast<const float4*>(gm+ch*8+4);
        v[0]=cvtpk_s(f[0]*rs*g0.x,f[1]*rs*g0.y); v[1]=cvtpk_s(f[2]*rs*g0.z,f[3]*rs*g0.w); v[2]=cvtpk_s(f[4]*rs*g1.x,f[5]*rs*g1.y); v[3]=cvtpk_s(f[6]*rs*g1.z,f[7]*rs*g1.w); }
      ATTN_STORE16(Ow+(long)row*PO+ch*8,v);} }
  asm volatile("s_waitcnt lgkmcnt(0)\n\ts_barrier":::"memory");
  #undef DMA_K
  #undef DMA_V
  #undef CMASK
  #undef START
  #undef RESC
  #undef ROT
}
constexpr int ATTN_LDS_BYTES=LDS_BYTES;
#undef SBAR
#undef WAIT_BAR
}
typedef unsigned short bf16;
constexpr int T = 65536, DM = 1024, SEQ = 2048, NB = 32;
constexpr size_t MiB = 1u << 20;
constexpr size_t WS_CTL = 0, WS_KMEAN = 1 * MiB, WS_ZERO_BYTES = 2 * MiB;
constexpr size_t WS_ROPE = 2 * MiB, WS_SCAL = 3 * MiB;
constexpr size_t WS_WIN = 4 * MiB, WS_WOUT = 10 * MiB, WS_WQ = 12 * MiB, WS_SUBK = 16 * MiB;
constexpr size_t WS_DOWN = 32 * MiB, WS_UP = 64 * MiB, WS_XN = 96 * MiB;
constexpr size_t WS_QKV = 224 * MiB, QKV_STRIDE = 64 * MiB;
constexpr size_t WS_PQ = 224 * MiB;
constexpr size_t WS_MIXED = 608 * MiB, WS_DO = 736 * MiB, WS_IDS = 864 * MiB, WS_GATES = 896 * MiB, WS_END = 928 * MiB;
constexpr size_t QKV_ELEMS = QKV_STRIDE / 2;
constexpr float QSCALE = 0.125f * 1.4426950408889634f;
constexpr float EPS = 1e-6f;

__device__ __forceinline__ unsigned f2bf(float f) { unsigned u = __float_as_uint(f); return (u + 0x7fffu + ((u >> 16) & 1u)) >> 16; }
__device__ __forceinline__ float bf2f(unsigned h) { return __uint_as_float(h << 16); }
__device__ __forceinline__ float wave_sum(float v) {
#pragma unroll
    for (int o = 1; o < 64; o <<= 1) v += __shfl_xor(v, o);
    return v;
}

#ifndef LAS
#define LAS __attribute__((address_space(3)))
#endif
#define GAS __attribute__((address_space(1)))
typedef GAS unsigned gu32;
#define XB_TMO      128
#define XB_XCNT(j)  (256  + 64 * (j))
#define XB_XSUB(j)  (1280 + 64 * (j))
#define XB_XGEN(j)  (2304 + 64 * (j))
#define XB_TOP      3328
#define XB_TOPGEN   3392
#define XCD_BAR_WORDS 3456
#define XB_SPIN_CAP (1u << 18)

__device__ __forceinline__ unsigned xb_ld(unsigned* p)              { return __hip_atomic_load(p, __ATOMIC_RELAXED, __HIP_MEMORY_SCOPE_AGENT); }
__device__ __forceinline__ unsigned xb_add(unsigned* p, unsigned v) { return __hip_atomic_fetch_add(p, v, __ATOMIC_RELAXED, __HIP_MEMORY_SCOPE_AGENT); }
__device__ __forceinline__ unsigned xb_xcc_id() { return (unsigned)__builtin_amdgcn_s_getreg((3 << 11) | 20) & 0xFu; }
#define XB_SPIN(cond, bar) do { unsigned _sp = 0; while (cond) { __builtin_amdgcn_s_sleep(1); \
    if ((++_sp & 255u) == 0u) { if (xb_ld(&(bar)[XB_TMO])) break; if (_sp > XB_SPIN_CAP) { atomicAdd(&(bar)[XB_TMO], 1u); break; } } } } while (0)

struct XcdBarrier {
    unsigned* bar; unsigned x;
    volatile LAS unsigned* st;
};

__device__ __forceinline__ XcdBarrier xcd_barrier_post(unsigned* bar, volatile LAS unsigned* st) {
    XcdBarrier b; b.bar = bar; b.x = xb_xcc_id(); b.st = st;
    if (threadIdx.x == 0) (void)xb_add(&bar[XB_XCNT(b.x)], 1u);
    return b;
}
__device__ __forceinline__ void xcd_barrier_complete(unsigned* bar, unsigned x, unsigned& nloc, unsigned& nx) {
    const unsigned G = gridDim.x * gridDim.y * gridDim.z;
    unsigned sum, cnt, mine, sp = 0u;
    for (;;) {
        sum = 0u; cnt = 0u; mine = 0u;
#pragma unroll
        for (unsigned j = 0; j < 16; ++j) { const unsigned c = xb_ld(&bar[XB_XCNT(j)]); sum += c; cnt += (c > 0u) ? 1u : 0u; mine = (j == x) ? c : mine; }
        if (sum == G) break;
        __builtin_amdgcn_s_sleep(1);
        if ((++sp & 255u) == 0u) { if (xb_ld(&bar[XB_TMO])) break; if (sp > XB_SPIN_CAP) { atomicAdd(&bar[XB_TMO], 1u); break; } }
    }
    nloc = mine > 0u ? mine : 1u; nx = cnt > 0u ? cnt : 1u;
}

__device__ __forceinline__ void xcd_barrier(const XcdBarrier& b) {
    asm volatile("s_waitcnt vmcnt(0)" ::: "memory");
    __syncthreads();
    if (threadIdx.x == 0) {
        unsigned* bar = b.bar;
        __builtin_amdgcn_s_waitcnt(0);
        unsigned nloc = b.st[0], nx = b.st[1];
        if (nloc == 0u) { xcd_barrier_complete(bar, b.x, nloc, nx); b.st[0] = nloc; b.st[1] = nx; }
        const unsigned old = xb_add(&bar[XB_XSUB(b.x)], 1u);
        const unsigned gen = old / nloc;
        if (old + 1u == (gen + 1u) * nloc) {
            __builtin_amdgcn_fence(__ATOMIC_RELEASE, "agent");
            asm volatile("s_waitcnt vmcnt(0)" ::: "memory");
            const unsigned og = xb_add(&bar[XB_TOP], 1u);
            const unsigned tg = og / nx;
            if (og + 1u == (tg + 1u) * nx) xb_add(&bar[XB_TOPGEN], 1u);
            else XB_SPIN(xb_ld(&bar[XB_TOPGEN]) == tg, bar);
            __builtin_amdgcn_fence(__ATOMIC_ACQUIRE, "agent");
            xb_add(&bar[XB_XGEN(b.x)], 1u);
            asm volatile("s_waitcnt vmcnt(0)" ::: "memory");
        } else {
            XB_SPIN(xb_ld(&bar[XB_XGEN(b.x)]) == gen, bar);
            __builtin_amdgcn_fence(__ATOMIC_ACQUIRE, "agent");
            asm volatile("s_waitcnt vmcnt(0)" ::: "memory");
        }
    }
    __syncthreads();
}
#ifndef LAS
#define LAS __attribute__((address_space(3)))
#endif
constexpr int NTHR = 512, NWAVE = 8;
constexpr int LDS_BYTES = 147456;

struct Params {
    const float* in[19]; float* out; unsigned char* ws;
};

template <bool HEADPERM> __device__ __forceinline__ void ph_transpose(const float* __restrict__ W, int K, int N, bf16* __restrict__ WT, float* tiles, int wg, int nwg, int tid) {
    float (*tile)[33] = (float (*)[33])(tiles + (tid >> 8) * (32 * 33));
    const int nt_n = N / 32, nitems = nt_n * (K / 32), tx = tid & 31, ty = (tid & 255) >> 5;
    for (int it0 = wg * 2; it0 < nitems; it0 += nwg * 2) {
        const int it = it0 + (tid >> 8); const bool act = it < nitems;
        const int n0 = (it % nt_n) * 32, k0 = (it / nt_n) * 32;
        if (act) for (int i = ty; i < 32; i += 8) tile[i][tx] = W[(size_t)(k0 + i) * N + n0 + tx];
        __syncthreads();
        if (act) for (int i = ty; i < 32; i += 8) { int nn = n0 + i; if (HEADPERM) nn = (nn & ~255) | (((nn >> 5) & 1) << 7) | (((nn >> 6) & 3) << 5) | (nn & 31);
            WT[(size_t)nn * K + k0 + tx] = (bf16)f2bf(tile[tx][i]); }
        __syncthreads();
    }
}
__device__ __forceinline__ void ph_convert(const float* __restrict__ src, bf16* __restrict__ dst, size_t n4, int wg, int nwg, int tid) {
    for (size_t i = (size_t)wg * NTHR + tid; i < n4; i += (size_t)nwg * NTHR) {
        const float4 v = ((const float4*)src)[i];
        uint2 o; o.x = f2bf(v.x) | (f2bf(v.y) << 16); o.y = f2bf(v.z) | (f2bf(v.w) << 16);
        ((uint2*)dst)[i] = o;
    }
}
__device__ __forceinline__ void ph_rope(float* __restrict__ rope, int wg, int nwg, int tid) {
    for (int i = wg * NTHR + tid; i < SEQ * 32; i += nwg * NTHR) {
        const int pos = i >> 5, j = i & 31;
        const float inv = 1.0f / exp2f((float)j * (13.287712379549449f / 32.0f));
        const float ang = (float)pos * inv;
        double rev = (double)ang * 0.15915494309189535; rev -= floor(rev);
        rope[i] = __builtin_amdgcn_cosf((float)rev); rope[SEQ * 32 + i] = __builtin_amdgcn_sinf((float)rev);
    }
}
__device__ __forceinline__ void ph_rmsnorm(const float* __restrict__ x, const float* __restrict__ g, bf16* __restrict__ out, int rows, int wg, int nwg, int tid) {
    const int lane = tid & 63, nw = nwg * NWAVE;
    for (int r = wg * NWAVE + (tid >> 6); r < rows; r += nw) {
        const float4* xr = (const float4*)(x + (size_t)r * DM) + lane;
        float4 v[4]; float s = 0.f;
#pragma unroll
        for (int j = 0; j < 4; ++j) { v[j] = xr[64 * j]; s += (v[j].x * v[j].x + v[j].y * v[j].y) + (v[j].z * v[j].z + v[j].w * v[j].w); }
        const float rs = rsqrtf(wave_sum(s) * (1.0f / DM) + EPS);
        uint2* o = (uint2*)(out + (size_t)r * DM) + lane;
#pragma unroll
        for (int j = 0; j < 4; ++j) { const float4 gg = ((const float4*)g)[lane + 64 * j];
            uint2 w; w.x = f2bf(v[j].x * rs * gg.x) | (f2bf(v[j].y * rs * gg.y) << 16); w.y = f2bf(v[j].z * rs * gg.z) | (f2bf(v[j].w * rs * gg.w) << 16);
            o[64 * j] = w; }
    }
}
__device__ __forceinline__ void ph_qk_post(bf16* __restrict__ qkv, const float* __restrict__ rope, const float* __restrict__ gqm, const float* __restrict__ gkm,
                                           const float* __restrict__ gqd, const float* __restrict__ gkd, float* __restrict__ kmean, int wg, int nwg, int tid) {
    const int lane = tid & 63, half = lane >> 5, j = lane & 31, wv = tid >> 6;
    for (int blk = wg; blk < T / 256; blk += nwg) {
        float ks[4][2];
#pragma unroll
        for (int a = 0; a < 4; ++a) { ks[a][0] = 0.f; ks[a][1] = 0.f; }
        for (int tt = wv; tt < 256; tt += NWAVE) {
            const int t = blk * 256 + tt, pos = t & (SEQ - 1);
            const float c = rope[pos * 32 + j], sn = rope[SEQ * 32 + pos * 32 + j];
#pragma unroll
            for (int it = 0; it < 16; ++it) {
                const int s = it * 2 + half, type = it >> 2, hs = s & 7;
                bf16* buf = qkv + (size_t)(type < 2 ? type : type + 1) * QKV_ELEMS + (size_t)t * 512 + hs * 64;
                const float x1 = bf2f(buf[j]), x2 = bf2f(buf[j + 32]);
                float ss = x1 * x1 + x2 * x2;
#pragma unroll
                for (int o = 1; o < 32; o <<= 1) ss += __shfl_xor(ss, o);
                const float rs = rsqrtf(ss * (1.0f / 64.0f) + EPS);
                const float* g = type == 0 ? gqm : type == 1 ? gkm : type == 2 ? gqd + (hs & 1) * 64 : gkd + (hs & 1) * 64;
                const float y1 = x1 * rs * g[j], y2 = x2 * rs * g[j + 32];
                float o1 = y1 * c - y2 * sn, o2 = y2 * c + y1 * sn;
                if (type == 0 || type == 2) { o1 *= QSCALE; o2 *= QSCALE; }
                if (type == 1) { ks[it - 4][0] += o1; ks[it - 4][1] += o2; }
                buf[j] = (bf16)f2bf(o1); buf[j + 32] = (bf16)f2bf(o2);
            }
        }
        const int b = blk >> 3, nb = blk & 7;
#pragma unroll
        for (int a = 0; a < 4; ++a) { const int h = a * 2 + half; float* km = kmean + (((size_t)b * 8 + h) * 8 + nb) * 64;
            atomicAdd(km + j, ks[a][0] * (1.0f / 256.0f)); atomicAdd(km + j + 32, ks[a][1] * (1.0f / 256.0f)); }
    }
}
__device__ __forceinline__ void ph_diff_combine(const bf16* __restrict__ dob, float lam, const float* __restrict__ gain_d, bf16* __restrict__ mixed, int wg, int nwg, int tid) {
    const int lane = tid & 63, nw = nwg * NWAVE;
    for (int w = wg * NWAVE + (tid >> 6); w < T * 4; w += nw) {
        const int t = w >> 2, h = w & 3; const bf16* p = dob + (size_t)t * 1024 + h * 256;
        const float da = bf2f(p[lane]) - lam * bf2f(p[128 + lane]), db = bf2f(p[64 + lane]) - lam * bf2f(p[192 + lane]);
        const float rs = rsqrtf(wave_sum(da * da + db * db) * (1.0f / 128.0f) + EPS) * 0.8f;
        bf16* o = mixed + (size_t)t * 1024 + 512 + h * 128;
        o[lane] = (bf16)f2bf(da * rs * gain_d[h * 128 + lane]); o[64 + lane] = (bf16)f2bf(db * rs * gain_d[h * 128 + 64 + lane]);
    }
}
typedef float rf32x16 __attribute__((ext_vector_type(16)));
typedef short rbf16x8 __attribute__((ext_vector_type(8)));
__device__ __forceinline__ unsigned umax_(unsigned a, unsigned b) { return a > b ? a : b; }
__device__ __forceinline__ unsigned umin_(unsigned a, unsigned b) { return a > b ? b : a; }
#define CE_D(x, y) { const unsigned mx_ = umax_(x, y), mn_ = umin_(x, y); x = mx_; y = mn_; }
__device__ __forceinline__ void sort16_desc(unsigned (&v)[16]) {
    CE_D(v[0], v[1]) CE_D(v[3], v[2]) CE_D(v[4], v[5]) CE_D(v[7], v[6]) CE_D(v[8], v[9]) CE_D(v[11], v[10]) CE_D(v[12], v[13]) CE_D(v[15], v[14])
    CE_D(v[0], v[2]) CE_D(v[1], v[3]) CE_D(v[6], v[4]) CE_D(v[7], v[5]) CE_D(v[8], v[10]) CE_D(v[9], v[11]) CE_D(v[14], v[12]) CE_D(v[15], v[13])
    CE_D(v[0], v[1]) CE_D(v[2], v[3]) CE_D(v[5], v[4]) CE_D(v[7], v[6]) CE_D(v[8], v[9]) CE_D(v[10], v[11]) CE_D(v[13], v[12]) CE_D(v[15], v[14])
    CE_D(v[0], v[4]) CE_D(v[1], v[5]) CE_D(v[2], v[6]) CE_D(v[3], v[7]) CE_D(v[12], v[8]) CE_D(v[13], v[9]) CE_D(v[14], v[10]) CE_D(v[15], v[11])
    CE_D(v[0], v[2]) CE_D(v[1], v[3]) CE_D(v[4], v[6]) CE_D(v[5], v[7]) CE_D(v[10], v[8]) CE_D(v[11], v[9]) CE_D(v[14], v[12]) CE_D(v[15], v[13])
    CE_D(v[0], v[1]) CE_D(v[2], v[3]) CE_D(v[4], v[5]) CE_D(v[6], v[7]) CE_D(v[9], v[8]) CE_D(v[11], v[10]) CE_D(v[13], v[12]) CE_D(v[15], v[14])
    CE_D(v[0], v[8]) CE_D(v[1], v[9]) CE_D(v[2], v[10]) CE_D(v[3], v[11]) CE_D(v[4], v[12]) CE_D(v[5], v[13]) CE_D(v[6], v[14]) CE_D(v[7], v[15])
    CE_D(v[0], v[4]) CE_D(v[1], v[5]) CE_D(v[2], v[6]) CE_D(v[3], v[7]) CE_D(v[8], v[12]) CE_D(v[9], v[13]) CE_D(v[10], v[14]) CE_D(v[11], v[15])
    CE_D(v[0], v[2]) CE_D(v[1], v[3]) CE_D(v[4], v[6]) CE_D(v[5], v[7]) CE_D(v[8], v[10]) CE_D(v[9], v[11]) CE_D(v[12], v[14]) CE_D(v[13], v[15])
    CE_D(v[0], v[1]) CE_D(v[2], v[3]) CE_D(v[4], v[5]) CE_D(v[6], v[7]) CE_D(v[8], v[9]) CE_D(v[10], v[11]) CE_D(v[12], v[13]) CE_D(v[14], v[15])
}
__device__ __forceinline__ void merge16_desc(unsigned (&a)[16], const unsigned (&b)[16]) {
    a[0] = umax_(a[0], b[15]); a[1] = umax_(a[1], b[14]); a[2] = umax_(a[2], b[13]); a[3] = umax_(a[3], b[12]); a[4] = umax_(a[4], b[11]); a[5] = umax_(a[5], b[10]); a[6] = umax_(a[6], b[9]); a[7] = umax_(a[7], b[8]); a[8] = umax_(a[8], b[7]); a[9] = umax_(a[9], b[6]); a[10] = umax_(a[10], b[5]); a[11] = umax_(a[11], b[4]); a[12] = umax_(a[12], b[3]); a[13] = umax_(a[13], b[2]); a[14] = umax_(a[14], b[1]); a[15] = umax_(a[15], b[0]);
    CE_D(a[0], a[8]) CE_D(a[1], a[9]) CE_D(a[2], a[10]) CE_D(a[3], a[11]) CE_D(a[4], a[12]) CE_D(a[5], a[13]) CE_D(a[6], a[14]) CE_D(a[7], a[15])
    CE_D(a[0], a[4]) CE_D(a[1], a[5]) CE_D(a[2], a[6]) CE_D(a[3], a[7]) CE_D(a[8], a[12]) CE_D(a[9], a[13]) CE_D(a[10], a[14]) CE_D(a[11], a[15])
    CE_D(a[0], a[2]) CE_D(a[1], a[3]) CE_D(a[4], a[6]) CE_D(a[5], a[7]) CE_D(a[8], a[10]) CE_D(a[9], a[11]) CE_D(a[12], a[14]) CE_D(a[13], a[15])
    CE_D(a[0], a[1]) CE_D(a[2], a[3]) CE_D(a[4], a[5]) CE_D(a[6], a[7]) CE_D(a[8], a[9]) CE_D(a[10], a[11]) CE_D(a[12], a[13]) CE_D(a[14], a[15])
}
__device__ __forceinline__ void top16_of_64(unsigned (&G)[4][16]) {
    sort16_desc(G[0]); sort16_desc(G[1]); sort16_desc(G[2]); sort16_desc(G[3]);
    merge16_desc(G[0], G[1]); merge16_desc(G[2], G[3]); merge16_desc(G[0], G[2]);
}
__device__ __forceinline__ void route_scores(unsigned (&Lp)[16], const rbf16x8 (&bq)[8], const LAS unsigned char* kfr, int lane, int hi) {
    unsigned G[4][16]; unsigned hmask = hi ? ~4u : ~0u; asm volatile("" : "+v"(hmask));
#pragma unroll
    for (int nb = 0; nb < 4; ++nb) {
        rf32x16 acc = rf32x16{};
#pragma unroll
        for (int s = 0; s < 8; ++s) { const rbf16x8 a = *(const LAS rbf16x8*)(kfr + (nb * 8 + s) * 1024 + lane * 16); acc = __builtin_amdgcn_mfma_f32_32x32x16_bf16(a, bq[s], acc, 0, 0, 0); }
#pragma unroll
        for (int i = 0; i < 16; ++i) { const float v = fmaxf(acc[i] + 16.0f, 0.0f); const int n = nb * 32 + (i & 3) + 8 * (i >> 2);
            G[nb][i] = ((__float_as_uint(v) & ~127u) | (unsigned)(127 - n)) & hmask; }
        asm volatile("" ::: "memory"); __builtin_amdgcn_sched_barrier(0);
    }
    top16_of_64(G);
    unsigned O[16];
#pragma unroll
    for (int i = 0; i < 16; ++i) { auto rr = __builtin_amdgcn_permlane32_swap(G[0][i], G[0][i], false, false); O[i] = hi ? rr[0] : rr[1]; }
    merge16_desc(G[0], O);
#pragma unroll
    for (int i = 0; i < 16; ++i) Lp[i] = G[0][i];
    asm volatile("" ::: "memory"); __builtin_amdgcn_sched_barrier(0);
}
__device__ __forceinline__ void route_loadq(rbf16x8 (&bq)[8], const bf16* __restrict__ PQ, int tb, int hp, int lane) {
    const bf16* qp = PQ + (((size_t)tb * 16 + hp) * 8 * 64 + lane) * 8;
#pragma unroll
    for (int s = 0; s < 8; ++s) bq[s] = *(const rbf16x8*)(qp + s * 512);
}
__device__ __forceinline__ void route_loadk(pg8::u32x4 (&kr)[8], const bf16* __restrict__ subk, int h, int tid) {
#pragma unroll
    for (int i = 0; i < 8; ++i) { const int e = i * NTHR + tid, f = e >> 6, l2 = e & 63;
        kr[i] = *(const pg8::u32x4*)(subk + ((size_t)(h * 2 + (f >> 5)) * 128 + ((f >> 3) & 3) * 32 + (l2 & 31)) * 128 + 16 * (f & 7) + 8 * (l2 >> 5)); }
}
__device__ __forceinline__ void ph_peer_route(const bf16* __restrict__ PQ, const bf16* __restrict__ subk, int* __restrict__ ids, float* __restrict__ gates, LAS unsigned char* lds3, int wg, int nwg, int tid) {
    const int lane = tid & 63, r = lane & 31, hi = lane >> 5, wv = tid >> 6;
    LAS unsigned* myl = (LAS unsigned*)(lds3 + 65536) + wv * 2048;
    for (int tb0 = wg * NWAVE; tb0 < T / 32; tb0 += nwg * NWAVE) {
        const int tb = tb0 + wv; const bool live = tb < T / 32; const int t = (live ? tb : 0) * 32 + r;
        rbf16x8 bqA[8], bqB[8];
        route_loadq(bqA, PQ, live ? tb : 0, 0, lane);
        for (int h = 0; h < 8; ++h) {
            __syncthreads();
            { pg8::u32x4 kr[8]; route_loadk(kr, subk, h, tid);
#pragma unroll
              for (int i = 0; i < 8; ++i) *(LAS pg8::u32x4*)(lds3 + (i * NTHR + tid) * 16) = kr[i]; }
            __syncthreads();
            unsigned L[2][16];
            route_loadq(bqB, PQ, live ? tb : 0, h * 2 + 1, lane);
            route_scores(L[0], bqA, lds3, lane, hi);
            if (h < 7) route_loadq(bqA, PQ, live ? tb : 0, h * 2 + 2, lane);
            route_scores(L[1], bqB, lds3 + 32768, lane, hi);
#pragma unroll
            for (int i = 0; i < 16; ++i) { myl[i * 64 + lane] = 127u - (L[0][i] & 127u); myl[(16 + i) * 64 + lane] = 127u - (L[1][i] & 127u); }
            float fa[16], fb[16];
#pragma unroll
            for (int i = 0; i < 16; ++i) { fa[i] = __uint_as_float(L[0][i] & ~127u); fb[i] = __uint_as_float(L[1][i] & ~127u); }
            unsigned C[4][16];
            C[0][0] = (__float_as_uint(fmaxf(fa[0] + fb[0] - 24.0f, 0.0f)) & ~255u) | 255u;
            C[0][1] = (__float_as_uint(fmaxf(fa[0] + fb[1] - 24.0f, 0.0f)) & ~255u) | 254u;
            C[0][2] = (__float_as_uint(fmaxf(fa[0] + fb[2] - 24.0f, 0.0f)) & ~255u) | 253u;
            C[0][3] = (__float_as_uint(fmaxf(fa[0] + fb[3] - 24.0f, 0.0f)) & ~255u) | 252u;
            C[0][4] = (__float_as_uint(fmaxf(fa[0] + fb[4] - 24.0f, 0.0f)) & ~255u) | 251u;
            C[0][5] = (__float_as_uint(fmaxf(fa[0] + fb[5] - 24.0f, 0.0f)) & ~255u) | 250u;
            C[0][6] = (__float_as_uint(fmaxf(fa[0] + fb[6] - 24.0f, 0.0f)) & ~255u) | 249u;
            C[0][7] = (__float_as_uint(fmaxf(fa[0] + fb[7] - 24.0f, 0.0f)) & ~255u) | 248u;
            C[0][8] = (__float_as_uint(fmaxf(fa[0] + fb[8] - 24.0f, 0.0f)) & ~255u) | 247u;
            C[0][9] = (__float_as_uint(fmaxf(fa[0] + fb[9] - 24.0f, 0.0f)) & ~255u) | 246u;
            C[0][10] = (__float_as_uint(fmaxf(fa[0] + fb[10] - 24.0f, 0.0f)) & ~255u) | 245u;
            C[0][11] = (__float_as_uint(fmaxf(fa[0] + fb[11] - 24.0f, 0.0f)) & ~255u) | 244u;
            C[0][12] = (__float_as_uint(fmaxf(fa[0] + fb[12] - 24.0f, 0.0f)) & ~255u) | 243u;
            C[0][13] = (__float_as_uint(fmaxf(fa[0] + fb[13] - 24.0f, 0.0f)) & ~255u) | 242u;
            C[0][14] = (__float_as_uint(fmaxf(fa[0] + fb[14] - 24.0f, 0.0f)) & ~255u) | 241u;
            C[0][15] = (__float_as_uint(fmaxf(fa[0] + fb[15] - 24.0f, 0.0f)) & ~255u) | 240u;
            C[1][0] = (__float_as_uint(fmaxf(fa[1] + fb[0] - 24.0f, 0.0f)) & ~255u) | 239u;
            C[1][1] = (__float_as_uint(fmaxf(fa[1] + fb[1] - 24.0f, 0.0f)) & ~255u) | 238u;
            C[1][2] = (__float_as_uint(fmaxf(fa[1] + fb[2] - 24.0f, 0.0f)) & ~255u) | 237u;
            C[1][3] = (__float_as_uint(fmaxf(fa[1] + fb[3] - 24.0f, 0.0f)) & ~255u) | 236u;
            C[1][4] = (__float_as_uint(fmaxf(fa[1] + fb[4] - 24.0f, 0.0f)) & ~255u) | 235u;
            C[1][5] = (__float_as_uint(fmaxf(fa[1] + fb[5] - 24.0f, 0.0f)) & ~255u) | 234u;
            C[1][6] = (__float_as_uint(fmaxf(fa[1] + fb[6] - 24.0f, 0.0f)) & ~255u) | 233u;
            C[1][7] = (__float_as_uint(fmaxf(fa[1] + fb[7] - 24.0f, 0.0f)) & ~255u) | 232u;
            C[1][8] = (__float_as_uint(fmaxf(fa[2] + fb[0] - 24.0f, 0.0f)) & ~255u) | 223u;
            C[1][9] = (__float_as_uint(fmaxf(fa[2] + fb[1] - 24.0f, 0.0f)) & ~255u) | 222u;
            C[1][10] = (__float_as_uint(fmaxf(fa[2] + fb[2] - 24.0f, 0.0f)) & ~255u) | 221u;
            C[1][11] = (__float_as_uint(fmaxf(fa[2] + fb[3] - 24.0f, 0.0f)) & ~255u) | 220u;
            C[1][12] = (__float_as_uint(fmaxf(fa[2] + fb[4] - 24.0f, 0.0f)) & ~255u) | 219u;
            C[1][13] = (__float_as_uint(fmaxf(fa[3] + fb[0] - 24.0f, 0.0f)) & ~255u) | 207u;
            C[1][14] = (__float_as_uint(fmaxf(fa[3] + fb[1] - 24.0f, 0.0f)) & ~255u) | 206u;
            C[1][15] = (__float_as_uint(fmaxf(fa[3] + fb[2] - 24.0f, 0.0f)) & ~255u) | 205u;
            C[2][0] = (__float_as_uint(fmaxf(fa[3] + fb[3] - 24.0f, 0.0f)) & ~255u) | 204u;
            C[2][1] = (__float_as_uint(fmaxf(fa[4] + fb[0] - 24.0f, 0.0f)) & ~255u) | 191u;
            C[2][2] = (__float_as_uint(fmaxf(fa[4] + fb[1] - 24.0f, 0.0f)) & ~255u) | 190u;
            C[2][3] = (__float_as_uint(fmaxf(fa[4] + fb[2] - 24.0f, 0.0f)) & ~255u) | 189u;
            C[2][4] = (__float_as_uint(fmaxf(fa[5] + fb[0] - 24.0f, 0.0f)) & ~255u) | 175u;
            C[2][5] = (__float_as_uint(fmaxf(fa[5] + fb[1] - 24.0f, 0.0f)) & ~255u) | 174u;
            C[2][6] = (__float_as_uint(fmaxf(fa[6] + fb[0] - 24.0f, 0.0f)) & ~255u) | 159u;
            C[2][7] = (__float_as_uint(fmaxf(fa[6] + fb[1] - 24.0f, 0.0f)) & ~255u) | 158u;
            C[2][8] = (__float_as_uint(fmaxf(fa[7] + fb[0] - 24.0f, 0.0f)) & ~255u) | 143u;
            C[2][9] = (__float_as_uint(fmaxf(fa[7] + fb[1] - 24.0f, 0.0f)) & ~255u) | 142u;
            C[2][10] = (__float_as_uint(fmaxf(fa[8] + fb[0] - 24.0f, 0.0f)) & ~255u) | 127u;
            C[2][11] = (__float_as_uint(fmaxf(fa[9] + fb[0] - 24.0f, 0.0f)) & ~255u) | 111u;
            C[2][12] = (__float_as_uint(fmaxf(fa[10] + fb[0] - 24.0f, 0.0f)) & ~255u) | 95u;
            C[2][13] = (__float_as_uint(fmaxf(fa[11] + fb[0] - 24.0f, 0.0f)) & ~255u) | 79u;
            C[2][14] = (__float_as_uint(fmaxf(fa[12] + fb[0] - 24.0f, 0.0f)) & ~255u) | 63u;
            C[2][15] = (__float_as_uint(fmaxf(fa[13] + fb[0] - 24.0f, 0.0f)) & ~255u) | 47u;
            C[3][0] = (__float_as_uint(fmaxf(fa[14] + fb[0] - 24.0f, 0.0f)) & ~255u) | 31u;
            C[3][1] = (__float_as_uint(fmaxf(fa[15] + fb[0] - 24.0f, 0.0f)) & ~255u) | 15u;
            C[3][2] = 0u;
            C[3][3] = 0u;
            C[3][4] = 0u;
            C[3][5] = 0u;
            C[3][6] = 0u;
            C[3][7] = 0u;
            C[3][8] = 0u;
            C[3][9] = 0u;
            C[3][10] = 0u;
            C[3][11] = 0u;
            C[3][12] = 0u;
            C[3][13] = 0u;
            C[3][14] = 0u;
            C[3][15] = 0u;
            top16_of_64(C);
            const float s0 = __uint_as_float(C[0][0] & ~255u);
            float ex[16]; float sum = 0.f; int eid[16];
#pragma unroll
            for (int k = 0; k < 16; ++k) { ex[k] = __expf(__uint_as_float(C[0][k] & ~255u) - s0); sum += ex[k];
                const unsigned code = 255u - (C[0][k] & 255u); const unsigned ia = myl[(code >> 4) * 64 + lane], ib = myl[(16 + (code & 15u)) * 64 + lane]; eid[k] = (int)(ia * 128u + ib); }
            const float inv = 1.0f / sum;
            if (live && hi == 0) { int4* dst = (int4*)(ids + (size_t)t * 128 + h * 16);
#pragma unroll
                for (int k = 0; k < 4; ++k) dst[k] = make_int4(eid[4 * k], eid[4 * k + 1], eid[4 * k + 2], eid[4 * k + 3]); }
            else if (live) { float4* dst = (float4*)(gates + (size_t)t * 128 + h * 16);
#pragma unroll
                for (int k = 0; k < 4; ++k) dst[k] = make_float4(ex[4 * k] * inv, ex[4 * k + 1] * inv, ex[4 * k + 2] * inv, ex[4 * k + 3] * inv); }
        }
    }
}
typedef __bf16 bf16x2_t __attribute__((ext_vector_type(2)));
__device__ __forceinline__ float dot2bf(unsigned a, unsigned b, float acc) { return __builtin_amdgcn_fdot2_f32_bf16(__builtin_bit_cast(bf16x2_t, a), __builtin_bit_cast(bf16x2_t, b), acc, false); }
__device__ __forceinline__ float dot8(const uint4 a, const uint4 b, float s) { s = dot2bf(a.x, b.x, s); s = dot2bf(a.y, b.y, s); s = dot2bf(a.z, b.z, s); s = dot2bf(a.w, b.w, s); return s; }
__device__ __forceinline__ float gelu_erf(float z) { return 0.5f * z * (1.0f + erff(z * 0.70710678118654752f)); }
constexpr float TSCALE = 32.0f, TINV = 1.0f / 32.0f;
typedef float f32x2g __attribute__((ext_vector_type(2)));
constexpr int GB = 4;
struct GBatch { uint4 d[GB]; uint4 u[GB]; float g[GB]; };
__device__ __forceinline__ void gb_load(GBatch& B, const int* __restrict__ idp, const float* __restrict__ gp, int e0, const unsigned char* __restrict__ down, const unsigned char* __restrict__ up, int lane) {
#pragma unroll
    for (int j = 0; j < GB; ++j) { const int id = __builtin_amdgcn_readfirstlane(idp[e0 + j]); B.g[j] = gp[e0 + j];
        B.d[j] = *(const uint4*)(down + (size_t)id * DM + lane * 16); B.u[j] = *(const uint4*)(up + (size_t)id * DM + lane * 16); }
}
__device__ __forceinline__ void unpack16(const uint4 v, f32x2g (&f)[8]) {
    f[0] = __builtin_amdgcn_cvt_pk_f32_fp8((int)v.x, false); f[1] = __builtin_amdgcn_cvt_pk_f32_fp8((int)v.x, true);
    f[2] = __builtin_amdgcn_cvt_pk_f32_fp8((int)v.y, false); f[3] = __builtin_amdgcn_cvt_pk_f32_fp8((int)v.y, true);
    f[4] = __builtin_amdgcn_cvt_pk_f32_fp8((int)v.z, false); f[5] = __builtin_amdgcn_cvt_pk_f32_fp8((int)v.z, true);
    f[6] = __builtin_amdgcn_cvt_pk_f32_fp8((int)v.w, false); f[7] = __builtin_amdgcn_cvt_pk_f32_fp8((int)v.w, true);
}
__device__ __forceinline__ void gb_compute(const GBatch& B, const f32x2g (&xf)[8], f32x2g (&acc)[8]) {
    float z[GB];
#pragma unroll
    for (int j = 0; j < GB; ++j) { f32x2g d[8]; unpack16(B.d[j], d); f32x2g s = xf[0] * d[0];
#pragma unroll
        for (int i = 1; i < 8; ++i) s = __builtin_elementwise_fma(xf[i], d[i], s);
        z[j] = s.x + s.y; }
#pragma unroll
    for (int o = 1; o < 64; o <<= 1) {
#pragma unroll
        for (int j = 0; j < GB; ++j) z[j] += __shfl_xor(z[j], o); }
#pragma unroll
    for (int j = 0; j < GB; ++j) { const float w = B.g[j] * gelu_erf(z[j] * TINV); f32x2g u[8]; unpack16(B.u[j], u); const f32x2g w2 = {w, w};
#pragma unroll
        for (int i = 0; i < 8; ++i) acc[i] = __builtin_elementwise_fma(u[i], w2, acc[i]); }
}
__device__ __forceinline__ void ph_peer_gather(const bf16* __restrict__ xn, const int* __restrict__ ids, const float* __restrict__ gates, const unsigned char* __restrict__ down, const unsigned char* __restrict__ up, const float* x1, float* outw, unsigned* ctr, int tid) {
    const int lane = tid & 63;
    int t; { unsigned v_ = 0; if (lane == 0) v_ = atomicAdd(ctr, 1u); t = (int)__builtin_amdgcn_readfirstlane(v_); }
    while (t < T) {
        unsigned vn_ = 0; if (lane == 0) vn_ = atomicAdd(ctr, 1u);
        const int* idp = ids + (size_t)t * 128; const float* gp = gates + (size_t)t * 128;
        GBatch B0, B1;
        gb_load(B0, idp, gp, 0, down, up, lane);
        f32x2g xf[8];
        { const uint4 xa = *(const uint4*)(xn + (size_t)t * DM + lane * 16), xb = *(const uint4*)(xn + (size_t)t * DM + lane * 16 + 8);
          const unsigned xw[8] = {xa.x, xa.y, xa.z, xa.w, xb.x, xb.y, xb.z, xb.w};
#pragma unroll
          for (int i = 0; i < 8; ++i) { xf[i].x = __uint_as_float(xw[i] << 16); xf[i].y = __uint_as_float(xw[i] & 0xffff0000u); } }
        f32x2g acc[8];
#pragma unroll
        for (int i = 0; i < 8; ++i) acc[i] = (f32x2g){0.f, 0.f};
        for (int e0 = 0; e0 < 128; e0 += 2 * GB) {
            gb_load(B1, idp, gp, e0 + GB, down, up, lane);
            gb_compute(B0, xf, acc);
            if (e0 + 2 * GB < 128) gb_load(B0, idp, gp, e0 + 2 * GB, down, up, lane);
            gb_compute(B1, xf, acc);
        }
        const float* xi = x1 + (size_t)t * DM + lane * 16; float* o = outw + (size_t)t * DM + lane * 16;
#pragma unroll
        for (int k = 0; k < 4; ++k) { float4 r = *(const float4*)(xi + 4 * k);
            r.x += acc[2 * k].x * TINV; r.y += acc[2 * k].y * TINV; r.z += acc[2 * k + 1].x * TINV; r.w += acc[2 * k + 1].y * TINV; *(float4*)(o + 4 * k) = r; }
        t = (int)__builtin_amdgcn_readfirstlane(vn_);
    }
}
__device__ __forceinline__ void ph_convert_fp8(const float* __restrict__ src, unsigned* __restrict__ dst, size_t n4, int wg, int nwg, int tid) {
    for (size_t i = (size_t)wg * NTHR + tid; i < n4; i += (size_t)nwg * NTHR) {
        const float4 v = ((const float4*)src)[i];
        int w = __builtin_amdgcn_cvt_pk_fp8_f32(v.x * TSCALE, v.y * TSCALE, 0, false); w = __builtin_amdgcn_cvt_pk_fp8_f32(v.z * TSCALE, v.w * TSCALE, w, true);
        dst[i] = (unsigned)w;
    }
}
#ifndef PROBE_PHASE
#define PROBE_PHASE -1
#endif
#ifndef PROBE_MULT
#define PROBE_MULT 4
#endif
#ifndef REP_ATTN
#define REP_ATTN 1
#endif
#ifndef REP_ROUTE
#define REP_ROUTE 1
#endif
#ifndef REP_GATHER
#define REP_GATHER 1
#endif
#ifndef REP_QKPOST
#define REP_QKPOST 1
#endif
__global__ void __launch_bounds__(NTHR, 2) mk_fwd(Params P) {
    extern __shared__ __attribute__((aligned(16))) unsigned char lds[];
    cg::grid_group grid = cg::this_grid();
    const int wg = blockIdx.x, nwg = gridDim.x;
#if PROBE_PHASE >= 0
    volatile unsigned* tsl = (volatile unsigned*)(lds + 147456 - 256);
#define STAMP(i) do { if (threadIdx.x == 0) tsl[i] = (unsigned)__builtin_amdgcn_s_memrealtime(); } while (0)
#else
#define STAMP(i) do {} while (0)
#endif
    STAMP(0);
    volatile LAS unsigned* bst = (volatile LAS unsigned*)((LAS unsigned char*)lds + LDS_BYTES - 512);
    if (threadIdx.x < 2) bst[threadIdx.x] = 0u;
    __syncthreads();
    XcdBarrier xbar = xcd_barrier_post((unsigned*)(P.ws + 4096), bst);
#define GRID_BAR() xcd_barrier(xbar)
    unsigned char* ws = P.ws; float* out = P.out;
    const float* x = P.in[0];
    bf16* WinT = (bf16*)(ws + WS_WIN); bf16* WoutT = (bf16*)(ws + WS_WOUT); bf16* WqT = (bf16*)(ws + WS_WQ); bf16* SUBK = (bf16*)(ws + WS_SUBK);
    unsigned char* DOWN = ws + WS_DOWN; unsigned char* UP = ws + WS_UP; bf16* XN = (bf16*)(ws + WS_XN); bf16* QKV = (bf16*)(ws + WS_QKV); bf16* PQ = (bf16*)(ws + WS_PQ);
    bf16* MIXED = (bf16*)(ws + WS_MIXED); bf16* DOB = (bf16*)(ws + WS_DO); int* IDS = (int*)(ws + WS_IDS); float* GATES = (float*)(ws + WS_GATES);
    float* ROPE = (float*)(ws + WS_ROPE); float* KMEAN = (float*)(ws + WS_KMEAN);

    ph_transpose<true>(P.in[2], 1024, 3072, WinT, (float*)lds, wg, nwg, fresh_tid());
    ph_transpose<false>(P.in[13], 1024, 1024, WoutT, (float*)lds, wg, nwg, fresh_tid());
    ph_transpose<false>(P.in[15], 1024, 2048, WqT, (float*)lds, wg, nwg, fresh_tid());
    ph_convert(P.in[16], SUBK, (size_t)16 * 128 * 128 / 4, wg, nwg, fresh_tid());
    ph_convert_fp8(P.in[17], (unsigned*)DOWN, (size_t)16384 * 1024 / 4, wg, nwg, fresh_tid());
    ph_convert_fp8(P.in[18], (unsigned*)UP, (size_t)16384 * 1024 / 4, wg, nwg, fresh_tid());
    ph_rope(ROPE, wg, nwg, fresh_tid());
    ph_rmsnorm(x, P.in[1], XN, T, wg, nwg, fresh_tid());
    float lam; { float a = 0.f, b = 0.f; for (int i = 0; i < 64; ++i) { a += P.in[7][i] * P.in[8][i]; b += P.in[9][i] * P.in[10][i]; } lam = expf(a) - expf(b) + 0.2f; }
    grid.sync();
    STAMP(1);
    { pg8::Gemm g{XN, WinT, T, 3072, 1024}; pg8::EpiQKV E{QKV, QKV_ELEMS, ROPE, P.in[3], P.in[4], P.in[5], P.in[6], KMEAN, QSCALE}; pg8::StaticOrder S; S.init(g.M, g.N, nwg, wg);
      pg8::gemm_phase<pg8::EpiQKV, pg8::StaticOrder, true, true>((PG8_LAS unsigned char*)lds, g, S, E); }
    GRID_BAR();
    STAMP(2);
    STAMP(3);
    for (int rep_ = 0; rep_ < REP_ATTN; ++rep_) { const float* gain_m = P.in[11];
      for (int combo = wg; combo < NB * 8; combo += nwg) {
        const int b = combo >> 3, hd = combo & 7; const size_t brow = (size_t)b * SEQ;
        for (int qb = 7; qb >= 0; --qb) { const size_t qrow = brow + (size_t)qb * 256;
            attn_body::attn_unit<8, true>(qb, (const attn_body::bf16*)(QKV + qrow * 512 + hd * 64), (const attn_body::bf16*)(QKV + QKV_ELEMS + brow * 512 + hd * 64),
                (const attn_body::bf16*)(QKV + 2 * QKV_ELEMS + brow * 512 + hd * 64), (attn_body::bf16*)(MIXED + qrow * 1024 + hd * 64), KMEAN + ((size_t)b * 8 + hd) * 512, gain_m + hd * 64, (char*)lds); }
      }
      for (int combo = wg; combo < NB * 16; combo += nwg) {
        const int b = combo >> 4, jj = combo & 15, h = jj >> 2, m = (jj >> 1) & 1, c = jj & 1; const size_t brow = (size_t)b * SEQ;
        for (int qb = 7; qb >= 0; --qb) { const size_t qrow = brow + (size_t)qb * 256;
            attn_body::attn_unit<8, false>(qb, (const attn_body::bf16*)(QKV + 3 * QKV_ELEMS + qrow * 512 + h * 128 + m * 64), (const attn_body::bf16*)(QKV + 4 * QKV_ELEMS + brow * 512 + h * 128 + m * 64),
                (const attn_body::bf16*)(QKV + 5 * QKV_ELEMS + brow * 512 + h * 128 + c * 64), (attn_body::bf16*)(DOB + qrow * 1024 + h * 256 + m * 128 + c * 64), nullptr, nullptr, (char*)lds); }
      } }
    GRID_BAR();
    STAMP(4);
    ph_diff_combine(DOB, lam, P.in[12], MIXED, wg, nwg, fresh_tid());
    GRID_BAR();
    STAMP(5);
    { pg8::Gemm g{MIXED, WoutT, T, 1024, 1024}; pg8::EpiResF32 E{x, out, 1024}; pg8::StaticOrder S; S.init(g.M, g.N, nwg, wg);
      pg8::gemm_phase<pg8::EpiResF32, pg8::StaticOrder, true, true>((PG8_LAS unsigned char*)lds, g, S, E); }
    GRID_BAR();
    STAMP(6);
    ph_rmsnorm(out, P.in[14], XN, T, wg, nwg, fresh_tid());
    GRID_BAR();
    STAMP(7);
    { pg8::Gemm g{XN, WqT, T, 2048, 1024}; pg8::EpiPQ E{PQ}; pg8::StaticOrder S; S.init(g.M, g.N, nwg, wg);
      pg8::gemm_phase<pg8::EpiPQ, pg8::StaticOrder, true, true>((PG8_LAS unsigned char*)lds, g, S, E); }
    GRID_BAR();
    STAMP(8);
    for (int rep_ = 0; rep_ < REP_ROUTE; ++rep_) ph_peer_route(PQ, SUBK, IDS, GATES, (LAS unsigned char*)lds, wg, nwg, fresh_tid());
    GRID_BAR();
    STAMP(9);
    for (int rep_ = 1; rep_ < REP_GATHER; ++rep_) ph_peer_gather(XN, IDS, GATES, DOWN, UP, out, (float*)(ws + WS_MIXED), (unsigned*)(ws + 65536 + 256 * rep_), fresh_tid());
    ph_peer_gather(XN, IDS, GATES, DOWN, UP, out, out, (unsigned*)(ws + 65536), fresh_tid());
    STAMP(10);
#if PROBE_PHASE >= 0
    if (blockIdx.x == 0 && threadIdx.x == 0) { const unsigned dt = (tsl[PROBE_PHASE + 1] - tsl[PROBE_PHASE]) * PROBE_MULT; const unsigned long long t0 = __builtin_amdgcn_s_memrealtime(); while ((unsigned)(__builtin_amdgcn_s_memrealtime() - t0) < dt) __builtin_amdgcn_s_sleep(8); }
#endif
}

extern "C" void kernel_launch(void* const* d_in, const int* in_sizes, int n_in, void* d_out, int out_size, void* d_ws, size_t ws_size, hipStream_t stream) {
    static int grid_blocks = 0;
    if (grid_blocks == 0) {
        if (n_in != 19 || in_sizes[0] != T * DM || out_size != T * DM || ws_size < WS_END) { fprintf(stderr, "kernel_launch: unexpected shapes (n_in %d in0 %d out %d ws %zu)\n", n_in, n_in > 0 ? in_sizes[0] : -1, out_size, ws_size); grid_blocks = -1; return; }
        int dev = 0, cus = 0, per_cu = 0;
        (void)hipGetDevice(&dev); (void)hipDeviceGetAttribute(&cus, hipDeviceAttributeMultiprocessorCount, dev);
        (void)hipFuncSetAttribute((const void*)mk_fwd, hipFuncAttributeMaxDynamicSharedMemorySize, LDS_BYTES);
        (void)hipOccupancyMaxActiveBlocksPerMultiprocessor(&per_cu, (const void*)mk_fwd, NTHR, LDS_BYTES);
        if (per_cu < 1 || cus < 1) { fprintf(stderr, "kernel_launch: occupancy query says %d blocks/CU on %d CUs\n", per_cu, cus); grid_blocks = -1; return; }
        if (per_cu > 1) per_cu = 1;
        grid_blocks = cus * per_cu;
    }
    if (grid_blocks < 0) return;
    (void)hipMemsetAsync(d_ws, 0, WS_ZERO_BYTES, stream);
    Params p{};
    for (int i = 0; i < 19; ++i) p.in[i] = (const float*)d_in[i];
    p.out = (float*)d_out; p.ws = (unsigned char*)d_ws;
    void* args[] = {&p};
    hipError_t e = hipLaunchCooperativeKernel((const void*)mk_fwd, dim3(grid_blocks), dim3(NTHR), args, LDS_BYTES, stream);
    if (e != hipSuccess) fprintf(stderr, "cooperative launch failed: %s (grid %d)\n", hipGetErrorString(e), grid_blocks);
}
```

```cpp
#include <hip/hip_runtime.h>
#include <hip/hip_cooperative_groups.h>
#include <cstdio>
#include <cstdint>
namespace cg = cooperative_groups;
__device__ __forceinline__ int fresh_tid() { int t = threadIdx.x; asm volatile("" : "+v"(t)); return t; }
namespace pg8 {
#define PG8_LAS __attribute__((address_space(3)))
typedef unsigned short bf16_t;
typedef short bf16x8 __attribute__((ext_vector_type(8)));
typedef float f32x4 __attribute__((ext_vector_type(4)));
typedef unsigned u32x4 __attribute__((ext_vector_type(4)));
constexpr int BM = 256, BK = 64, HALF = 128, HTB = HALF * BK * 2  , STAGE_BYTES = 8 * HTB, NXCD = 8, WGM = 8;

__host__ __device__ __forceinline__ int lds_byte(int r, int c) { const int st = (r >> 4) * 2 + (c >> 5), rr = r & 15, cc = c & 31, ob = rr * 64 + cc * 2; return st * 1024 + (ob ^ (((ob >> 9) & 1) << 5)); }
__host__ __device__ __forceinline__ void stage_rc(int b, int& R, int& C) { const int st = b / 1024, sb = b % 1024, swz = sb ^ (((sb >> 9) & 1) << 5); R = (st >> 1) * 16 + swz / 64; C = (st & 1) * 32 + (swz % 64) / 2; }
__host__ __device__ __forceinline__ int perm32(int rho) { const int n = rho >> 4, i = rho & 15; return 8 * (i >> 2) + 4 * n + (i & 3); }

struct Unit { int pm, pn; };
struct Gemm { const bf16_t* A; const bf16_t* Bt; int M, N, K; };

struct StaticOrder {
    int nM, nN, nwg, G, c;
    __host__ __device__ void init(int M, int N, int G_, int c_) { nM = M / BM; nN = N / BM; nwg = nM * nN; G = G_; c = c_; }
    __host__ __device__ bool next(int i, Unit& u) const {
        const long L = (long)i * G + c; if (L >= nwg) return false;
        int wgid = (int)L; { const int q = nwg / NXCD, r = nwg % NXCD, xcd = wgid % NXCD, off = wgid / NXCD; wgid = (xcd < r ? xcd * (q + 1) : r * (q + 1) + (xcd - r) * q) + off; }
        const int nig = WGM * nN, gid = wgid / nig, fm = gid * WGM, gsz = (nM - fm) < WGM ? (nM - fm) : WGM;
        u.pm = fm + ((wgid % nig) % gsz); u.pn = (wgid % nig) / gsz; return true;
    }
    __device__ __forceinline__ void a_ready(const Unit&) const {}
    __device__ __forceinline__ void done(const Unit&) const {}
};

__device__ __forceinline__ unsigned cvt_pk_bf16(float lo, float hi) { unsigned r; asm volatile("v_cvt_pk_bf16_f32 %0, %1, %2" : "=v"(r) : "v"(lo), "v"(hi)); return r; }
struct EpiBf16 {
    static constexpr bool PERM = true, AFTER_DRAIN = false;
    bf16_t* O; int ldc; int split_cols; size_t split_stride;
    __device__ __forceinline__ void operator()(const f32x4 (&acc)[2][2][4][2], const Unit& u, int wr, int wc, int fr, int fq) const {
        const int row0 = u.pm * BM + wr * 64 + fr; int colt = u.pn * BM; bf16_t* base = O;
        if (split_cols) { const int t = colt / split_cols; base += (size_t)t * split_stride; colt -= t * split_cols; }
        const int col0 = colt + wc * 32 + 8 * fq;
#pragma unroll
        for (int ai = 0; ai < 2; ++ai)
#pragma unroll
            for (int m = 0; m < 4; ++m) { bf16_t* rowp = base + (size_t)(row0 + ai * HALF + m * 16) * ldc + col0;
#pragma unroll
                for (int bj = 0; bj < 2; ++bj) { const f32x4 v0 = acc[ai][bj][m][0], v1 = acc[ai][bj][m][1];
                    u32x4 w; w.x = cvt_pk_bf16(v0[0], v0[1]); w.y = cvt_pk_bf16(v0[2], v0[3]); w.z = cvt_pk_bf16(v1[0], v1[1]); w.w = cvt_pk_bf16(v1[2], v1[3]);
                    *(u32x4*)(rowp + bj * HALF) = w; } }
    }
};
struct EpiResF32 {
    static constexpr bool PERM = false, AFTER_DRAIN = false;
    const float* base; float* out; int ldc;
    __device__ __forceinline__ void operator()(const f32x4 (&acc)[2][2][4][2], const Unit& u, int wr, int wc, int fr, int fq) const {
        const int col0 = u.pn * BM + wc * 32 + 4 * fq;
#pragma unroll
        for (int ai = 0; ai < 2; ++ai)
#pragma unroll
            for (int m = 0; m < 4; ++m) { const size_t off = (size_t)(u.pm * BM + ai * HALF + wr * 64 + m * 16 + fr) * ldc + col0;
#pragma unroll
                for (int bj = 0; bj < 2; ++bj)
#pragma unroll
                    for (int n = 0; n < 2; ++n) { const f32x4 bs = *(const f32x4*)(base + off + bj * HALF + n * 16); *(f32x4*)(out + off + bj * HALF + n * 16) = bs + acc[ai][bj][m][n]; } }
    }
};
struct EpiQKV {
    static constexpr bool PERM = true, AFTER_DRAIN = false;
    bf16_t* QKV; size_t buf_elems; const float* rope; const float *gqm, *gkm, *gqd, *gkd; float* kmean; float qscale;
    __device__ __forceinline__ void operator()(const f32x4 (&acc)[2][2][4][2], const Unit& u, int wr, int wc, int fr, int fq) const {
        const int type = u.pn >> 1;
        bf16_t* base = QKV + (size_t)type * buf_elems + (size_t)(u.pm * BM + wr * 64 + fr) * 512 + (u.pn & 1) * 256 + wc * 64 + 8 * fq;
        if (type == 2 || type == 5) {
#pragma unroll
            for (int ai = 0; ai < 2; ++ai)
#pragma unroll
                for (int m = 0; m < 4; ++m) { bf16_t* rowp = base + (size_t)(ai * HALF + m * 16) * 512;
#pragma unroll
                    for (int bj = 0; bj < 2; ++bj) { const f32x4 v0 = acc[ai][bj][m][0], v1 = acc[ai][bj][m][1];
                        u32x4 w; w.x = cvt_pk_bf16(v0[0], v0[1]); w.y = cvt_pk_bf16(v0[2], v0[3]); w.z = cvt_pk_bf16(v1[0], v1[1]); w.w = cvt_pk_bf16(v1[2], v1[3]);
                        *(u32x4*)(rowp + bj * 32) = w; } }
            return;
        }
        const float* g = type == 0 ? gqm : type == 1 ? gkm : type == 3 ? gqd + (wc & 1) * 64 : gkd + (wc & 1) * 64;
        const f32x4 g1a = *(const f32x4*)(g + 8 * fq), g1b = *(const f32x4*)(g + 8 * fq + 4), g2a = *(const f32x4*)(g + 32 + 8 * fq), g2b = *(const f32x4*)(g + 32 + 8 * fq + 4);
        const float sc = (type == 0 || type == 3) ? qscale : 1.0f;
        f32x4 ks1a = {0.f, 0.f, 0.f, 0.f}, ks1b = ks1a, ks2a = ks1a, ks2b = ks1a;
#pragma unroll
        for (int ai = 0; ai < 2; ++ai)
#pragma unroll
            for (int m = 0; m < 4; ++m) {
                const int rloc = ai * HALF + m * 16; const int pos = (u.pm * BM + wr * 64 + fr + rloc) & 2047;
                const f32x4 x1a = acc[ai][0][m][0], x1b = acc[ai][0][m][1], x2a = acc[ai][1][m][0], x2b = acc[ai][1][m][1];
                f32x4 q = x1a * x1a + x1b * x1b + x2a * x2a + x2b * x2b; float ss = (q[0] + q[1]) + (q[2] + q[3]);
                ss += __shfl_xor(ss, 16); ss += __shfl_xor(ss, 32);
                const float rs = __builtin_amdgcn_rsqf(ss * (1.0f / 64.0f) + 1e-6f);
                const float* cp = rope + pos * 32 + 8 * fq; const f32x4 ca = *(const f32x4*)cp, cb = *(const f32x4*)(cp + 4), sa = *(const f32x4*)(cp + 65536), sb = *(const f32x4*)(cp + 65536 + 4);
                const f32x4 y1a = x1a * rs * g1a, y1b = x1b * rs * g1b, y2a = x2a * rs * g2a, y2b = x2b * rs * g2b;
                const f32x4 o1a = (y1a * ca - y2a * sa) * sc, o1b = (y1b * cb - y2b * sb) * sc, o2a = (y2a * ca + y1a * sa) * sc, o2b = (y2b * cb + y1b * sb) * sc;
                if (type == 1) { ks1a += o1a; ks1b += o1b; ks2a += o2a; ks2b += o2b; }
                bf16_t* rowp = base + (size_t)rloc * 512;
                u32x4 w1, w2; w1.x = cvt_pk_bf16(o1a[0], o1a[1]); w1.y = cvt_pk_bf16(o1a[2], o1a[3]); w1.z = cvt_pk_bf16(o1b[0], o1b[1]); w1.w = cvt_pk_bf16(o1b[2], o1b[3]);
                w2.x = cvt_pk_bf16(o2a[0], o2a[1]); w2.y = cvt_pk_bf16(o2a[2], o2a[3]); w2.z = cvt_pk_bf16(o2b[0], o2b[1]); w2.w = cvt_pk_bf16(o2b[2], o2b[3]);
                *(u32x4*)rowp = w1; *(u32x4*)(rowp + 32) = w2;
            }
        if (type == 1) {
            float kv[16] = {ks1a[0], ks1a[1], ks1a[2], ks1a[3], ks1b[0], ks1b[1], ks1b[2], ks1b[3], ks2a[0], ks2a[1], ks2a[2], ks2a[3], ks2b[0], ks2b[1], ks2b[2], ks2b[3]};
#pragma unroll
            for (int j = 0; j < 16; ++j) { float v = kv[j]; v += __shfl_xor(v, 1); v += __shfl_xor(v, 2); v += __shfl_xor(v, 4); v += __shfl_xor(v, 8); kv[j] = v; }
            if (fr == 0) { float* km = kmean + (((size_t)(u.pm >> 3) * 8 + (u.pn & 1) * 4 + wc) * 8 + (u.pm & 7)) * 64 + 8 * fq;
#pragma unroll
                for (int j = 0; j < 8; ++j) { atomicAdd(km + j, kv[j] * (1.0f / 256.0f)); atomicAdd(km + 32 + j, kv[8 + j] * (1.0f / 256.0f)); } }
        }
    }
};
struct EpiPQ {
    static constexpr bool PERM = true, AFTER_DRAIN = false;
    bf16_t* O; const float* rs;
    __device__ __forceinline__ void operator()(const f32x4 (&acc)[2][2][4][2], const Unit& u, int wr, int wc, int fr, int fq) const {
        const int s = wc * 2 + (fq >> 1), hi = fq & 1;
#pragma unroll
        for (int ai = 0; ai < 2; ++ai)
#pragma unroll
            for (int m = 0; m < 4; ++m) { const int R = u.pm * BM + ai * HALF + wr * 64 + m * 16 + fr, tb = R >> 5, r = R & 31; const float rr = rs[R];
#pragma unroll
                for (int bj = 0; bj < 2; ++bj) { const int hp = u.pn * 2 + bj; const f32x4 v0 = acc[ai][bj][m][0] * rr, v1 = acc[ai][bj][m][1] * rr;
                    u32x4 w; w.x = cvt_pk_bf16(v0[0], v0[1]); w.y = cvt_pk_bf16(v0[2], v0[3]); w.z = cvt_pk_bf16(v1[0], v1[1]); w.w = cvt_pk_bf16(v1[2], v1[3]);
                    *(u32x4*)(O + ((((size_t)tb * 16 + hp) * 8 + s) * 64 + hi * 32 + r) * 8) = w; } }
    }
};
struct EpiRes2 {
    static constexpr bool PERM = true, AFTER_DRAIN = false;
    const float* base; float* out; bf16_t* xb; float* ss; int ldc;
    __device__ __forceinline__ void operator()(const f32x4 (&acc)[2][2][4][2], const Unit& u, int wr, int wc, int fr, int fq) const {
        const int col0 = u.pn * BM + wc * 32 + 8 * fq;
#pragma unroll
        for (int ai = 0; ai < 2; ++ai) { float keep = 0.f;
#pragma unroll
            for (int m = 0; m < 4; ++m) { const size_t off = (size_t)(u.pm * BM + ai * HALF + wr * 64 + m * 16 + fr) * ldc + col0; float s = 0.f;
#pragma unroll
                for (int bj = 0; bj < 2; ++bj) { const f32x4 b0 = *(const f32x4*)(base + off + bj * HALF), b1 = *(const f32x4*)(base + off + bj * HALF + 4);
                    const f32x4 o0 = b0 + acc[ai][bj][m][0], o1 = b1 + acc[ai][bj][m][1];
                    *(f32x4*)(out + off + bj * HALF) = o0; *(f32x4*)(out + off + bj * HALF + 4) = o1;
                    s += (o0[0] * o0[0] + o0[1] * o0[1]) + (o0[2] * o0[2] + o0[3] * o0[3]) + (o1[0] * o1[0] + o1[1] * o1[1]) + (o1[2] * o1[2] + o1[3] * o1[3]);
                    u32x4 w; w.x = cvt_pk_bf16(o0[0], o0[1]); w.y = cvt_pk_bf16(o0[2], o0[3]); w.z = cvt_pk_bf16(o1[0], o1[1]); w.w = cvt_pk_bf16(o1[2], o1[3]);
                    *(u32x4*)(xb + off + bj * HALF) = w; }
                s += __shfl_xor(s, 16); s += __shfl_xor(s, 32);
                if (fq == m) keep = s; }
            ss[(size_t)(u.pn * 4 + wc) * 65536 + u.pm * BM + ai * HALF + wr * 64 + fq * 16 + fr] = keep; }
    }
};
template <class Epi, class Sched, bool ALIGN_EPI = false, bool SP2 = false>
__device__ __forceinline__ void gemm_phase(PG8_LAS unsigned char* lds, const Gemm g, const Sched& S, const Epi& E) {
    const int tid = fresh_tid(), wid = __builtin_amdgcn_readfirstlane(tid >> 6), lane = tid & 63, wr = wid >> 2, wc = wid & 3, fr = lane & 15, fq = lane >> 4;
    const int K = g.K, nt = K / BK;
    unsigned voffA[2], voffB[2];
#pragma unroll
    for (int i = 0; i < 2; ++i) { int R, C; stage_rc(tid * 16 + i * 8192, R, C); const int Rb = Epi::PERM ? ((R & ~31) + perm32(R & 31)) : R;
        voffA[i] = (unsigned)(R * K + C) * 2u; voffB[i] = (unsigned)(Rb * K + C) * 2u; }
    const size_t kstep = (size_t)(BK * 2);
    const size_t hstep = (size_t)HALF * K * 2;
    const size_t tstep = 2 * hstep;
    const unsigned ldsw = (unsigned)wid * 1024u;
    const int aoff = lds_byte(wr * 64 + fr, fq * 8), boff = lds_byte(wc * 32 + fr, fq * 8);
#define PG8_SA(b, h) (((b) * 2 + (h)) * HTB)
#define PG8_SB(b, h) ((4 + (b) * 2 + (h)) * HTB)
#define PG8_STAGE(bufoff, gbase, voff) do { _Pragma("unroll") for (int _i = 0; _i < 2; ++_i) \
        __builtin_amdgcn_global_load_lds((const unsigned*)((const char*)(gbase) + (voff)[_i]), (PG8_LAS unsigned*)(lds + (bufoff) + ldsw + _i * 8192), 16, 0, 0); } while (0)
#define PG8_LDA(dst, b, h) do { _Pragma("unroll") for (int m = 0; m < 4; ++m) _Pragma("unroll") for (int k = 0; k < 2; ++k) dst[m][k] = *(const PG8_LAS bf16x8*)(lds + PG8_SA(b, h) + aoff + m * 2048 + k * 1024); } while (0)
#define PG8_LDB(dst, b, h) do { _Pragma("unroll") for (int n = 0; n < 2; ++n) _Pragma("unroll") for (int k = 0; k < 2; ++k) dst[n][k] = *(const PG8_LAS bf16x8*)(lds + PG8_SB(b, h) + boff + n * 2048 + k * 1024); } while (0)
#define PG8_MMA(ai, bj, At, Bt) do { __builtin_amdgcn_s_setprio(1); _Pragma("unroll") for (int m = 0; m < 4; ++m) _Pragma("unroll") for (int n = 0; n < 2; ++n) _Pragma("unroll") for (int k = 0; k < 2; ++k) \
        acc[ai][bj][m][n] = __builtin_amdgcn_mfma_f32_16x16x32_bf16(Bt[n][k], At[m][k], acc[ai][bj][m][n], 0, 0, 0); __builtin_amdgcn_s_setprio(0); } while (0)
#define PG8_WAIT_V(n) asm volatile("s_waitcnt vmcnt(" #n ")" ::: "memory")
#define PG8_WAIT_L(n) asm volatile("s_waitcnt lgkmcnt(" #n ")" ::: "memory")
#define PG8_BAR __builtin_amdgcn_s_barrier()
#define PG8_SCHED __builtin_amdgcn_sched_barrier(0)
    Unit cur, nxt; int ui = 0;
    if (!S.next(0, cur)) return;
    f32x4 acc[2][2][4][2];
#pragma unroll
    for (int a = 0; a < 2; ++a)
#pragma unroll
        for (int b = 0; b < 2; ++b)
#pragma unroll
            for (int m = 0; m < 4; ++m)
#pragma unroll
                for (int n = 0; n < 2; ++n) acc[a][b][m][n] = (f32x4){0.f, 0.f, 0.f, 0.f};
    bf16x8 At[4][2], B0[2][2], B1[2][2];
    const char* cA = (const char*)g.A + (size_t)cur.pm * tstep; const char* cB = (const char*)g.Bt + (size_t)cur.pn * tstep;
    S.a_ready(cur);
    if constexpr (SP2) {
        PG8_STAGE(PG8_SB(0, 0), cB, voffB); PG8_STAGE(PG8_SB(0, 1), cB + hstep, voffB); PG8_STAGE(PG8_SA(0, 0), cA, voffA); PG8_STAGE(PG8_SA(0, 1), cA + hstep, voffA);
        if (wr == 1) PG8_BAR;
        PG8_WAIT_V(2); PG8_BAR;
        PG8_STAGE(PG8_SB(1, 0), cB + kstep, voffB); PG8_STAGE(PG8_SA(1, 0), cA + kstep, voffA); PG8_STAGE(PG8_SB(1, 1), cB + hstep + kstep, voffB);
        PG8_WAIT_V(6); PG8_BAR;
    } else {
        PG8_STAGE(PG8_SB(0, 0), cB, voffB); PG8_STAGE(PG8_SA(0, 0), cA, voffA); PG8_STAGE(PG8_SB(0, 1), cB + hstep, voffB); PG8_STAGE(PG8_SA(0, 1), cA + hstep, voffA);
        if (wr == 1) PG8_BAR;
        PG8_WAIT_V(4); PG8_BAR;
        PG8_STAGE(PG8_SB(1, 0), cB + kstep, voffB); PG8_STAGE(PG8_SA(1, 0), cA + kstep, voffA); PG8_STAGE(PG8_SB(1, 1), cB + hstep + kstep, voffB);
        PG8_WAIT_V(6); PG8_BAR;
    }
    for (;;) {
        const bool has_next = S.next(ui + 1, nxt);
        const char* nA = has_next ? (const char*)g.A + (size_t)nxt.pm * tstep : cA; const char* nB = has_next ? (const char*)g.Bt + (size_t)nxt.pn * tstep : cB;
        for (int t = 0; t < nt; t += 2) {
            const bool last = (t == nt - 2);
            const char* a1 = cA + (size_t)(t + 1) * kstep;
            const char* a2 = last ? nA : cA + (size_t)(t + 2) * kstep; const char* b2 = last ? nB : cB + (size_t)(t + 2) * kstep;
            const char* a3 = a2 + kstep; const char* b3 = b2 + kstep;
            if (last && has_next) S.a_ready(nxt);
            if constexpr (SP2) {
            PG8_LDB(B0, 0, 0); PG8_LDB(B1, 0, 1); PG8_SCHED; PG8_LDA(At, 0, 0); PG8_STAGE(PG8_SA(1, 1), a1 + hstep, voffA);
            PG8_WAIT_V(8); PG8_WAIT_L(0); PG8_BAR; PG8_MMA(0, 0, At, B0); PG8_MMA(0, 1, At, B1); PG8_BAR; PG8_SCHED;
            PG8_LDA(At, 0, 1); PG8_STAGE(PG8_SB(0, 0), b2, voffB); PG8_STAGE(PG8_SB(0, 1), b2 + hstep, voffB); PG8_STAGE(PG8_SA(0, 0), a2, voffA);
            PG8_WAIT_V(8); PG8_WAIT_L(0); PG8_BAR; PG8_MMA(1, 0, At, B0); PG8_MMA(1, 1, At, B1); PG8_BAR; PG8_SCHED;
            PG8_LDB(B0, 1, 0); PG8_LDB(B1, 1, 1); PG8_SCHED; PG8_LDA(At, 1, 0); PG8_STAGE(PG8_SA(0, 1), a2 + hstep, voffA);
            PG8_WAIT_V(8); PG8_WAIT_L(0); PG8_BAR; PG8_MMA(0, 0, At, B0); PG8_MMA(0, 1, At, B1); PG8_BAR; PG8_SCHED;
            PG8_LDA(At, 1, 1); PG8_STAGE(PG8_SB(1, 0), b3, voffB); PG8_STAGE(PG8_SB(1, 1), b3 + hstep, voffB); PG8_STAGE(PG8_SA(1, 0), a3, voffA);
            PG8_WAIT_V(8); PG8_WAIT_L(0); PG8_BAR; PG8_MMA(1, 0, At, B0); PG8_MMA(1, 1, At, B1); PG8_BAR; PG8_SCHED;
            } else {
            PG8_LDB(B0, 0, 0); PG8_SCHED; PG8_LDA(At, 0, 0); PG8_STAGE(PG8_SA(1, 1), a1 + hstep, voffA);
            PG8_WAIT_L(8); PG8_BAR; PG8_WAIT_L(0); PG8_MMA(0, 0, At, B0); PG8_BAR; PG8_SCHED;
            PG8_LDB(B1, 0, 1); PG8_STAGE(PG8_SB(0, 0), b2, voffB);
            PG8_BAR; PG8_WAIT_L(0); PG8_MMA(0, 1, At, B1); PG8_BAR;
            PG8_LDA(At, 0, 1); PG8_STAGE(PG8_SA(0, 0), a2, voffA);
            PG8_BAR; PG8_WAIT_L(0); PG8_MMA(1, 0, At, B0); PG8_BAR; PG8_SCHED;
            PG8_STAGE(PG8_SB(0, 1), b2 + hstep, voffB);
            PG8_WAIT_V(6); PG8_BAR; PG8_MMA(1, 1, At, B1); PG8_BAR;
            PG8_LDB(B0, 1, 0); PG8_SCHED; PG8_LDA(At, 1, 0); PG8_STAGE(PG8_SA(0, 1), a2 + hstep, voffA);
            PG8_WAIT_L(8); PG8_BAR; PG8_WAIT_L(0); PG8_MMA(0, 0, At, B0); PG8_BAR; PG8_SCHED;
            PG8_LDB(B1, 1, 1); PG8_STAGE(PG8_SB(1, 0), b3, voffB);
            PG8_BAR; PG8_WAIT_L(0); PG8_MMA(0, 1, At, B1); PG8_BAR;
            PG8_LDA(At, 1, 1); PG8_STAGE(PG8_SA(1, 0), a3, voffA);
            PG8_BAR; PG8_WAIT_L(0); PG8_MMA(1, 0, At, B0); PG8_BAR; PG8_SCHED;
            PG8_STAGE(PG8_SB(1, 1), b3 + hstep, voffB);
            PG8_WAIT_V(6); PG8_BAR; PG8_MMA(1, 1, At, B1); PG8_BAR;
            }
        }
        if constexpr (ALIGN_EPI) { if (wr == 0) PG8_BAR; }
        if constexpr (!Epi::AFTER_DRAIN) { E(acc, cur, wr, wc, fr, fq); S.done(cur); }
        if (!has_next) break;
#pragma unroll
        for (int a = 0; a < 2; ++a)
#pragma unroll
            for (int b = 0; b < 2; ++b)
#pragma unroll
                for (int m = 0; m < 4; ++m)
#pragma unroll
                    for (int n = 0; n < 2; ++n) acc[a][b][m][n] = (f32x4){0.f, 0.f, 0.f, 0.f};
        cur = nxt; cA = nA; cB = nB; ++ui;
        if constexpr (ALIGN_EPI) { if (wr == 1) PG8_BAR; }
    }
    PG8_WAIT_V(0);
    if constexpr (!ALIGN_EPI) { if (wr == 0) PG8_BAR; }
    PG8_BAR;
    if constexpr (Epi::AFTER_DRAIN) { E.fused(acc, cur, wr, wc, fr, fq, lds, wid, lane); S.done(cur); }
#undef PG8_SA
#undef PG8_SB
#undef PG8_STAGE
#undef PG8_LDA
#undef PG8_LDB
#undef PG8_MMA
#undef PG8_WAIT_V
#undef PG8_WAIT_L
#undef PG8_BAR
#undef PG8_SCHED
}
}
#include <hip/hip_bf16.h>
#include <cmath>
namespace attn_body {
using bf16=__hip_bfloat16;
using bf16x8=__attribute__((ext_vector_type(8)))short;
using s16x4=__attribute__((ext_vector_type(4)))short;
using f32x16=__attribute__((ext_vector_type(16)))float;
using u32x4=__attribute__((ext_vector_type(4)))unsigned;
constexpr int SEQ=2048,D=64,DM=512,PO=1024;
constexpr int NW=8,QBLK=32,QB=QBLK*NW,KVBLK=64,NQB=SEQ/QB;
constexpr int ATTN_UNIT_ROWS=QB;
__device__ __forceinline__ int crow(int r,int hi){return (r&3)+8*(r>>2)+4*hi;}
#define SBAR() __builtin_amdgcn_sched_barrier(0)
__device__ __forceinline__ void cmask(f32x16&p0,f32x16&p1,int jb,int qrel,int hi){
  const float NEG=-INFINITY; int kb=64*jb+4*hi;
  #pragma unroll
  for(int r=0;r<16;++r){int kv=kb+(r&3)+8*(r>>2); if(kv>qrel)p0[r]=NEG; if(kv+32>qrel)p1[r]=NEG;}
}

__device__ __forceinline__ void bmask(f32x16&p0,f32x16&p1,unsigned on){
  if(!on){
    #pragma unroll
    for(int r=0;r<16;++r){p0[r]=-INFINITY;p1[r]=-INFINITY;} }
}
constexpr int NSLOT=3, SLOTB=8192;
constexpr int LDS_K=0, LDS_V=NSLOT*SLOTB, LDS_WS=2*NSLOT*SLOTB, LDS_OST=LDS_WS+NW*64*4, LDS_BYTES=LDS_OST+NW*4096;
constexpr float C2=0.125f*1.4426950408889634f;
__device__ __forceinline__ void glds16(const void*gsrc,unsigned lds_dst){unsigned keep;
  asm volatile("s_mov_b32 %0, m0\n\ts_mov_b32 m0, %2\n\ts_nop 0\n\tglobal_load_lds_dwordx4 %1, off\n\ts_mov_b32 m0, %0":"=&s"(keep):"v"(gsrc),"s"(lds_dst):"memory");}
__device__ __forceinline__ float max3f(float a,float b,float c){float r;asm("v_max3_f32 %0, %1, %2, %3":"=v"(r):"v"(a),"v"(b),"v"(c));return r;}
__device__ __forceinline__ float max2f(float a,float b){float r;asm("v_max_f32_e32 %0, %1, %2":"=v"(r):"v"(a),"v"(b));return r;}
__device__ __forceinline__ float fadd_s(float a,float b){float r;asm("v_add_f32_e32 %0, %1, %2":"=v"(r):"v"(a),"v"(b));return r;}
__device__ __forceinline__ float fsub_s(float a,float b){float r;asm("v_sub_f32_e32 %0, %1, %2":"=v"(r):"v"(a),"v"(b));return r;}
typedef float f32x2_t __attribute__((ext_vector_type(2))); typedef __bf16 bf16x2_t __attribute__((ext_vector_type(2)));
__device__ __forceinline__ unsigned cvtpk_s(float lo,float hi){f32x2_t v={lo,hi};bf16x2_t b=__builtin_convertvector(v,bf16x2_t);return __builtin_bit_cast(unsigned,b);}
#define WAIT_BAR(N) asm volatile("s_waitcnt vmcnt(" #N ") lgkmcnt(0)\n\ts_barrier":::"memory")

__device__ __forceinline__ void qkt(f32x16&p0,f32x16&p1,const char*Kslot,const bf16x8*qr,int r32,int hi){
  const char*kb=Kslot+hi*1024+r32*16;
  #pragma unroll
  for(int d0=0;d0<4;++d0){
    const bf16x8 b0=*reinterpret_cast<const bf16x8*>(kb+d0*2048);
    const bf16x8 b1=*reinterpret_cast<const bf16x8*>(kb+d0*2048+512);
    if(d0==0){p0=__builtin_amdgcn_mfma_f32_32x32x16_bf16(b0,qr[0],f32x16{},0,0,0);p1=__builtin_amdgcn_mfma_f32_32x32x16_bf16(b1,qr[0],f32x16{},0,0,0);}
    else{p0=__builtin_amdgcn_mfma_f32_32x32x16_bf16(b0,qr[d0],p0,0,0,0);p1=__builtin_amdgcn_mfma_f32_32x32x16_bf16(b1,qr[d0],p1,0,0,0);}}
}
typedef __attribute__((address_space(3))) const char* lds_cptr;
typedef short v4i16_t __attribute__((ext_vector_type(4)));
__device__ __forceinline__ void kload8(bf16x8*kf,lds_cptr kp){
  kf[0]=*(const __attribute__((address_space(3))) bf16x8*)(kp);      kf[1]=*(const __attribute__((address_space(3))) bf16x8*)(kp+512);
  kf[2]=*(const __attribute__((address_space(3))) bf16x8*)(kp+2048); kf[3]=*(const __attribute__((address_space(3))) bf16x8*)(kp+2560);
  kf[4]=*(const __attribute__((address_space(3))) bf16x8*)(kp+4096); kf[5]=*(const __attribute__((address_space(3))) bf16x8*)(kp+4608);
  kf[6]=*(const __attribute__((address_space(3))) bf16x8*)(kp+6144); kf[7]=*(const __attribute__((address_space(3))) bf16x8*)(kp+6656);
}
__device__ __forceinline__ void kload2(bf16x8*kf,lds_cptr kp,int j){ kf[2*j]=*(const __attribute__((address_space(3))) bf16x8*)(kp+j*2048); kf[2*j+1]=*(const __attribute__((address_space(3))) bf16x8*)(kp+j*2048+512); }
__device__ __forceinline__ s16x4 vtr(lds_cptr p){ return __builtin_bit_cast(s16x4,__builtin_amdgcn_ds_read_tr16_b64_v4i16((__attribute__((address_space(3))) v4i16_t*)p)); }
__device__ __forceinline__ float rowmax(const f32x16&p0,const f32x16&p1){
  float a=max3f(p0[0],p0[1],p1[0]),b=max3f(p0[2],p0[3],p1[1]);a=max3f(a,p1[2],p1[3]);
  #pragma unroll
  for(int r=4;r<16;r+=4){a=max3f(a,p0[r],p0[r+1]);b=max3f(b,p0[r+2],p0[r+3]);a=max3f(a,p1[r],p1[r+1]);b=max3f(b,p1[r+2],p1[r+3]);}
  const float m=max2f(a,b);
  auto rr=__builtin_amdgcn_permlane32_swap(__float_as_uint(m),__float_as_uint(m),false,false);
  return max2f(__uint_as_float(rr[0]),__uint_as_float(rr[1]));
}
__device__ __forceinline__ void pv(f32x16*o,int vb,bf16x8 pa0,bf16x8 pa1,bf16x8 pa2,bf16x8 pa3){
  #pragma unroll
  for(int d0=0;d0<2;++d0){s16x4 lo[4],hi[4];
    #pragma unroll
    for(int ks=0;ks<4;++ks){
      asm volatile("ds_read_b64_tr_b16 %0,%1 offset:%c2":"=&v"(lo[ks]):"v"(vb),"i"(d0*4096+ks*1024):"memory");
      asm volatile("ds_read_b64_tr_b16 %0,%1 offset:%c2":"=&v"(hi[ks]):"v"(vb),"i"(d0*4096+ks*1024+512):"memory");}
    asm volatile("s_waitcnt lgkmcnt(0)":::"memory");SBAR();
    #define PK(k) (bf16x8){lo[k][0],lo[k][1],lo[k][2],lo[k][3],hi[k][0],hi[k][1],hi[k][2],hi[k][3]}
    o[d0]=__builtin_amdgcn_mfma_f32_32x32x16_bf16(pa0,PK(0),o[d0],0,0,0);
    o[d0]=__builtin_amdgcn_mfma_f32_32x32x16_bf16(pa1,PK(1),o[d0],0,0,0);
    o[d0]=__builtin_amdgcn_mfma_f32_32x32x16_bf16(pa2,PK(2),o[d0],0,0,0);
    o[d0]=__builtin_amdgcn_mfma_f32_32x32x16_bf16(pa3,PK(3),o[d0],0,0,0);
    #undef PK
  }
}

#ifndef ATTN_STORE16
#define ATTN_STORE16(p,v) (*(u32x4*)(p)=(v))
#endif
template<int THRL,bool MOBA> __device__ __forceinline__ void attn_unit(int qb,const bf16*Qu,const bf16*__restrict__ Kh,const bf16*__restrict__ Vh,bf16*Ou,const float*__restrict__ km,const float*__restrict__ gm,char*shm){
  const int tid=fresh_tid(),lane=tid&63,r32=lane&31,hi=lane>>5; const int wid=__builtin_amdgcn_readfirstlane(tid>>6);
  const int q0=qb*QB;
  const bf16*Qw=Qu+(long)(wid*QBLK)*DM;
  const unsigned lds0=(unsigned)(uintptr_t)shm;
  float*wsf=(float*)(shm+LDS_WS)+wid*64;
  const bf16*ksrc=Kh+(long)lane*DM+wid*8;
  const bf16*vsrc=Vh+(long)(16*(wid&3)+(lane>>2))*DM+(wid>>2)*32+(lane&3)*8;
  const unsigned kdst=lds0+LDS_K+wid*1024, vdst=lds0+LDS_V+wid*1024;
  #define DMA_K(t,slot) glds16(ksrc+(long)(t)*KVBLK*DM,(unsigned)__builtin_amdgcn_readfirstlane(kdst+(slot)))
  #define DMA_V(t,slot) glds16(vsrc+(long)(t)*KVBLK*DM,(unsigned)__builtin_amdgcn_readfirstlane(vdst+(slot)))
  const int vb0=(int)(lds0+LDS_V)+((lane>>4)&1)*32+(lane&3)*8+(4*hi+((lane&15)>>2))*64;
  const char*Kbase=shm+LDS_K; bf16x8 kf[8];
  const lds_cptr shm3=(lds_cptr)shm; const lds_cptr kp0=shm3+LDS_K+hi*1024+r32*16; const lds_cptr vp0=shm3+LDS_V+((lane>>4)&1)*32+(lane&3)*8+(4*hi+((lane&15)>>2))*64;
  const int NT=(q0+QB)/KVBLK;
  DMA_K(0,0);DMA_V(0,0);DMA_K(1,SLOTB);
  bf16x8 qr[4];
  #pragma unroll
  for(int d0=0;d0<4;++d0)qr[d0]=*reinterpret_cast<const bf16x8*>(&Qw[(long)r32*DM+d0*16+hi*8]);
  unsigned selm=0u;
  if(MOBA){ float g[8];
    #pragma unroll
    for(int n=0;n<8;++n){ float s_=0.f; if(n<qb){
      #pragma unroll
      for(int d0=0;d0<4;++d0){ const float4 ka=*reinterpret_cast<const float4*>(km+n*64+d0*16+hi*8), kb2=*reinterpret_cast<const float4*>(km+n*64+d0*16+hi*8+4);
        const float kv[8]={ka.x,ka.y,ka.z,ka.w,kb2.x,kb2.y,kb2.z,kb2.w};
        #pragma unroll
        for(int j=0;j<8;++j)s_+=__uint_as_float(((unsigned)(unsigned short)qr[d0][j])<<16)*kv[j]; }
      s_+=__shfl_xor(s_,32); } g[n]=s_; asm volatile("":"+v"(s_)::"memory"); SBAR(); }
    #pragma unroll
    for(int r=0;r<3;++r){ float best=-3.0e38f; int bi=-1;
      #pragma unroll
      for(int n=0;n<8;++n) if(n<qb&&!((selm>>n)&1u)&&g[n]>best){best=g[n];bi=n;}
      if(bi>=0)selm|=1u<<bi; } }
  float l_reg=0.f;f32x16 o[2];o[0]=f32x16{};o[1]=f32x16{};
  const int qrel=wid*QBLK+r32;
  #define CMASK(P0,P1,t) do{int jb_=(t)-(NT-4); if(jb_>=0)cmask(P0,P1,jb_,qrel,hi); else if(MOBA) bmask(P0,P1,(selm>>((t)>>2))&1u);}while(0)
  #define START(P0,P1) do{ _Pragma("unroll") for(int r=0;r<16;++r)P0[r]=__builtin_amdgcn_exp2f(P0[r]); }while(0)
  #define RESC() do{}while(0)
  f32x16 pA0,pA1,pB0,pB1;
  int sl_prev=0,sl_cur=0,sl_next=SLOTB;
  #define ROT() do{sl_prev=sl_cur;sl_cur=sl_next;sl_next=(sl_next==(NSLOT-1)*SLOTB)?0:sl_next+SLOTB;}while(0)
  DMA_K(2,2*SLOTB);
  WAIT_BAR(3);
  qkt(pA0,pA1,Kbase,qr,r32,hi);asm volatile("s_nop 15\n\ts_nop 7":"+v"(pA0),"+v"(pA1));CMASK(pA0,pA1,0);
  START(pA0,pA1);
  _Pragma("unroll") for(int r=0;r<16;++r)pA1[r]=__builtin_amdgcn_exp2f(pA1[r]);
  WAIT_BAR(0);
  DMA_K(3,0);DMA_V(1,SLOTB);
  ROT();
  kload8(kf,kp0+sl_cur);
  WAIT_BAR(2);
  s16x4 vlo[8],vhi[8]; u32x4 pw0,pw1,pw2,pw3;
  #define PKW(P,B) cvtpk_s(P[B],P[B+1])
  #define PAF(k) __builtin_bit_cast(bf16x8,pw##k)
  #define VFR(i) (bf16x8){vlo[i][0],vlo[i][1],vlo[i][2],vlo[i][3],vhi[i][0],vhi[i][1],vhi[i][2],vhi[i][3]}
  #define PIN(x) asm volatile("":"+v"(x))
  #define MX3(a,b,c) __builtin_fmaxf(__builtin_fmaxf((a),(b)),(c))
  #define GAPA(MF,A0,A1,A2,A3,W0,W1,PW) do{ MF; sacc+=A0; sacc+=A1; sacc+=A2; sacc+=A3; PIN(sacc); W0; W1; PIN(PW); SBAR(); }while(0)
  #define EX(v) __builtin_amdgcn_exp2f(v)
  #define GAPB(MF,X,B) do{ MF; X[B]=EX(X[B]); X[B+1]=EX(X[B+1]); X[B+2]=EX(X[B+2]); X[B+3]=EX(X[B+3]); PIN(X); SBAR(); }while(0)
  #define VRD(i) do{ vlo[i]=vtr(vp_+(((i)>>2)*4096+((i)&3)*1024)); vhi[i]=vtr(vp_+(((i)>>2)*4096+((i)&3)*1024+512)); }while(0)
  #define KRD(G,j) do{ if(G){ kload2(kf,kp0+sl_next,j); SBAR(); } }while(0)
  #define STEP(C0,C1,P0,P1,t,GK,GV,GL) do{ SBAR(); \
    const lds_cptr vp_=vp0+sl_prev; \
    VRD(0); SBAR(); float sacc=(P0[0]+P0[1]); \
    GAPA(C0=__builtin_amdgcn_mfma_f32_32x32x16_bf16(kf[0],qr[0],f32x16{},0,0,0), P0[2],P0[3],P0[4],P0[5],     pw0[0]=PKW(P0,0), pw0[1]=PKW(P0,2), pw0); \
    VRD(4); SBAR(); GAPA(C1=__builtin_amdgcn_mfma_f32_32x32x16_bf16(kf[1],qr[0],f32x16{},0,0,0), P0[6],P0[7],P0[8],P0[9],     pw0[2]=PKW(P0,4), pw0[3]=PKW(P0,6), pw0); \
    VRD(1); SBAR(); GAPA(C0=__builtin_amdgcn_mfma_f32_32x32x16_bf16(kf[2],qr[1],C0,0,0,0),   P0[10],P0[11],P0[12],P0[13], pw1[0]=PKW(P0,8), pw1[1]=PKW(P0,10), pw1); \
    VRD(5); SBAR(); GAPA(C1=__builtin_amdgcn_mfma_f32_32x32x16_bf16(kf[3],qr[1],C1,0,0,0),   P0[14],P0[15],P1[0],P1[1],   pw1[2]=PKW(P0,12),pw1[3]=PKW(P0,14), pw1); \
    VRD(2); SBAR(); GAPA(C0=__builtin_amdgcn_mfma_f32_32x32x16_bf16(kf[4],qr[2],C0,0,0,0),   P1[2],P1[3],P1[4],P1[5],     pw2[0]=PKW(P1,0), pw2[1]=PKW(P1,2), pw2); \
    VRD(6); SBAR(); GAPA(C1=__builtin_amdgcn_mfma_f32_32x32x16_bf16(kf[5],qr[2],C1,0,0,0),   P1[6],P1[7],P1[8],P1[9],     pw2[2]=PKW(P1,4), pw2[3]=PKW(P1,6), pw2); \
    VRD(3); SBAR(); GAPA(C0=__builtin_amdgcn_mfma_f32_32x32x16_bf16(kf[6],qr[3],C0,0,0,0),   P1[10],P1[11],P1[12],P1[13], pw3[0]=PKW(P1,8), pw3[1]=PKW(P1,10), pw3); \
    VRD(7); SBAR(); GAPA(C1=__builtin_amdgcn_mfma_f32_32x32x16_bf16(kf[7],qr[3],C1,0,0,0),   P1[14],P1[15],0.f,0.f,       pw3[2]=PKW(P1,12),pw3[3]=PKW(P1,14), pw3); \
    l_reg+=sacc; \
    if(GK){DMA_K((t)+3,sl_cur);} if(GV){DMA_V((t)+1,sl_next);} \
    CMASK(C0,C1,t); \
    SBAR(); \
    GAPB(o[0]=__builtin_amdgcn_mfma_f32_32x32x16_bf16(PAF(0),VFR(0),o[0],0,0,0), C0,0); \
    GAPB(o[1]=__builtin_amdgcn_mfma_f32_32x32x16_bf16(PAF(0),VFR(4),o[1],0,0,0), C0,4); \
    KRD(GL,0); GAPB(o[0]=__builtin_amdgcn_mfma_f32_32x32x16_bf16(PAF(1),VFR(1),o[0],0,0,0), C0,8); \
    KRD(GL,1); GAPB(o[1]=__builtin_amdgcn_mfma_f32_32x32x16_bf16(PAF(1),VFR(5),o[1],0,0,0), C0,12); \
    KRD(GL,2); GAPB(o[0]=__builtin_amdgcn_mfma_f32_32x32x16_bf16(PAF(2),VFR(2),o[0],0,0,0), C1,0); \
    KRD(GL,3); GAPB(o[1]=__builtin_amdgcn_mfma_f32_32x32x16_bf16(PAF(2),VFR(6),o[1],0,0,0), C1,4); \
    GAPB(o[0]=__builtin_amdgcn_mfma_f32_32x32x16_bf16(PAF(3),VFR(3),o[0],0,0,0), C1,8); \
    GAPB(o[1]=__builtin_amdgcn_mfma_f32_32x32x16_bf16(PAF(3),VFR(7),o[1],0,0,0), C1,12); \
    }while(0)
  int t=1;
  #undef CMASK
  #define CMASK(P0,P1,t) do{ if(MOBA) bmask(P0,P1,(selm>>((t)>>2))&1u); }while(0)
  for(;t+5<NT;t+=2){
    STEP(pB0,pB1,pA0,pA1,t,true,true,true);     WAIT_BAR(2); RESC(); ROT();
    STEP(pA0,pA1,pB0,pB1,t+1,true,true,true);   WAIT_BAR(2); RESC(); ROT();
  }
  #undef CMASK
  #define CMASK(P0,P1,t) do{int jb_=(t)-(NT-4); if(jb_>=0)cmask(P0,P1,jb_,qrel,hi); else if(MOBA) bmask(P0,P1,(selm>>((t)>>2))&1u);}while(0)
  #define ENDW(tt) do{ if((tt)+3<NT){WAIT_BAR(2);} else if((tt)+2<NT){WAIT_BAR(1);} else {WAIT_BAR(0);} }while(0)
  for(;t+1<NT;t+=2){
    STEP(pB0,pB1,pA0,pA1,t,(t+3<NT),(t+1<NT),(t+1<NT));       ENDW(t);   RESC(); ROT();
    STEP(pA0,pA1,pB0,pB1,t+1,(t+4<NT),(t+2<NT),(t+2<NT));     ENDW(t+1); RESC(); ROT();
  }
  STEP(pB0,pB1,pA0,pA1,NT-1,false,false,false); RESC();
  { float sacc=pB0[0]+pB0[1]; _Pragma("unroll") for(int r=2;r<16;++r)sacc+=pB0[r]; _Pragma("unroll") for(int r=0;r<16;++r)sacc+=pB1[r]; l_reg+=sacc;
    pw0=(u32x4){PKW(pB0,0),PKW(pB0,2),PKW(pB0,4),PKW(pB0,6)};pw1=(u32x4){PKW(pB0,8),PKW(pB0,10),PKW(pB0,12),PKW(pB0,14)};pw2=(u32x4){PKW(pB1,0),PKW(pB1,2),PKW(pB1,4),PKW(pB1,6)};pw3=(u32x4){PKW(pB1,8),PKW(pB1,10),PKW(pB1,12),PKW(pB1,14)};
    SBAR(); pv(o,vb0+sl_cur,PAF(0),PAF(1),PAF(2),PAF(3)); }
  #undef PKW
  #undef PAF
  #undef VFR
  #undef PIN
  #undef MX3
  #undef GAPA
  #undef GAPB
  #undef EX
  #undef VRD
  #undef KRD
  #undef STEP
  #undef ENDW
  {auto rr=__builtin_amdgcn_permlane32_swap(__float_as_uint(l_reg),__float_as_uint(l_reg),false,false);l_reg=__uint_as_float(rr[0])+__uint_as_float(rr[1]);}
  if(hi==0)wsf[32+r32]=l_reg;asm volatile("s_waitcnt lgkmcnt(0)":::"memory");
  float rli[16];
  #pragma unroll
  for(int r=0;r<16;++r)rli[r]=__builtin_amdgcn_rcpf(wsf[32+crow(r,hi)]);
  bf16*Ow=Ou+(long)(wid*QBLK)*PO;
  { bf16*stg=(bf16*)(shm+LDS_OST)+wid*2048;
    #pragma unroll
    for(int r=0;r<16;++r){const int orow=crow(r,hi);
      #pragma unroll
      for(int d0=0;d0<2;++d0)stg[orow*64+d0*32+r32]=__float2bfloat16(o[d0][r]*rli[r]);}
    asm volatile("s_waitcnt lgkmcnt(0)":::"memory");
    #pragma unroll
    for(int i=0;i<4;++i){const int row=i*8+(lane>>3),ch=lane&7; u32x4 v=*(const u32x4*)(stg+row*64+ch*8);
      if(MOBA){ float f[8]; float ss=0.f;
        #pragma unroll
        for(int e=0;e<4;++e){ f[2*e]=__uint_as_float(v[e]<<16); f[2*e+1]=__uint_as_float(v[e]&0xffff0000u); ss+=f[2*e]*f[2*e]+f[2*e+1]*f[2*e+1]; }
        ss+=__shfl_xor(ss,1); ss+=__shfl_xor(ss,2); ss+=__shfl_xor(ss,4);
        const float rs=__builtin_amdgcn_rsqf(ss*(1.0f/64.0f)+1e-6f);
        const float4 g0=*reinterpret_cast<const float4*>(gm+ch*8), g1=*reinterpret_cast<const float4*>(gm+ch*8+4);
        v[0]=cvtpk_s(f[0]*rs*g0.x,f[1]*rs*g0.y); v[1]=cvtpk_s(f[2]*rs*g0.z,f[3]*rs*g0.w); v[2]=cvtpk_s(f[4]*rs*g1.x,f[5]*rs*g1.y); v[3]=cvtpk_s(f[6]*rs*g1.z,f[7]*rs*g1.w); }
      ATTN_STORE16(Ow+(long)row*PO+ch*8,v);} }
  asm volatile("s_waitcnt lgkmcnt(0)\n\ts_barrier":::"memory");
  #undef DMA_K
  #undef DMA_V
  #undef CMASK
  #undef START
  #undef RESC
  #undef ROT
}
constexpr int ATTN_LDS_BYTES=LDS_BYTES;
#undef SBAR
#undef WAIT_BAR
}
typedef unsigned short bf16;
constexpr int T = 65536, DM = 1024, SEQ = 2048, NB = 32;
constexpr size_t MiB = 1u << 20;
constexpr size_t WS_CTL = 0, WS_KMEAN = 1 * MiB, WS_ZERO_BYTES = 2 * MiB;
constexpr size_t WS_ROPE = 2 * MiB, WS_SCAL = 3 * MiB;
constexpr size_t WS_WIN = 4 * MiB, WS_WOUT = 10 * MiB, WS_WQ = 12 * MiB, WS_SUBK = 16 * MiB;
constexpr size_t WS_SS = 20 * MiB, WS_RS = 26 * MiB;
constexpr size_t WS_DOWN = 32 * MiB, WS_UP = 64 * MiB, WS_XN = 96 * MiB;
constexpr size_t WS_QKV = 224 * MiB, QKV_STRIDE = 64 * MiB;
constexpr size_t WS_PQ = 224 * MiB;
constexpr size_t WS_MIXED = 608 * MiB, WS_DO = 736 * MiB, WS_IDS = 864 * MiB, WS_GATES = 896 * MiB, WS_END = 928 * MiB;
constexpr size_t QKV_ELEMS = QKV_STRIDE / 2;
constexpr float QSCALE = 0.125f * 1.4426950408889634f;
constexpr float EPS = 1e-6f;

__device__ __forceinline__ unsigned f2bf(float f) { unsigned u = __float_as_uint(f); return (u + 0x7fffu + ((u >> 16) & 1u)) >> 16; }
__device__ __forceinline__ float bf2f(unsigned h) { return __uint_as_float(h << 16); }
__device__ __forceinline__ float wave_sum(float v) {
#pragma unroll
    for (int o = 1; o < 64; o <<= 1) v += __shfl_xor(v, o);
    return v;
}

#ifndef LAS
#define LAS __attribute__((address_space(3)))
#endif
#define GAS __attribute__((address_space(1)))
typedef GAS unsigned gu32;
#define XB_TMO      128
#define XB_XCNT(j)  (256  + 64 * (j))
#define XB_XSUB(j)  (1280 + 64 * (j))
#define XB_XGEN(j)  (2304 + 64 * (j))
#define XB_TOP      3328
#define XB_TOPGEN   3392
#define XCD_BAR_WORDS 3456
#define XB_SPIN_CAP (1u << 18)

__device__ __forceinline__ unsigned xb_ld(unsigned* p)              { return __hip_atomic_load(p, __ATOMIC_RELAXED, __HIP_MEMORY_SCOPE_AGENT); }
__device__ __forceinline__ unsigned xb_add(unsigned* p, unsigned v) { return __hip_atomic_fetch_add(p, v, __ATOMIC_RELAXED, __HIP_MEMORY_SCOPE_AGENT); }
__device__ __forceinline__ unsigned xb_xcc_id() { return (unsigned)__builtin_amdgcn_s_getreg((3 << 11) | 20) & 0xFu; }
#define XB_SPIN(cond, bar) do { unsigned _sp = 0; while (cond) { __builtin_amdgcn_s_sleep(1); \
    if ((++_sp & 255u) == 0u) { if (xb_ld(&(bar)[XB_TMO])) break; if (_sp > XB_SPIN_CAP) { atomicAdd(&(bar)[XB_TMO], 1u); break; } } } } while (0)

struct XcdBarrier {
    unsigned* bar; unsigned x;
    volatile LAS unsigned* st;
};

__device__ __forceinline__ XcdBarrier xcd_barrier_post(unsigned* bar, volatile LAS unsigned* st) {
    XcdBarrier b; b.bar = bar; b.x = xb_xcc_id(); b.st = st;
    if (threadIdx.x == 0) (void)xb_add(&bar[XB_XCNT(b.x)], 1u);
    return b;
}
__device__ __forceinline__ void xcd_barrier_complete(unsigned* bar, unsigned x, unsigned& nloc, unsigned& nx) {
    const unsigned G = gridDim.x * gridDim.y * gridDim.z;
    unsigned sum, cnt, mine, sp = 0u;
    for (;;) {
        sum = 0u; cnt = 0u; mine = 0u;
#pragma unroll
        for (unsigned j = 0; j < 16; ++j) { const unsigned c = xb_ld(&bar[XB_XCNT(j)]); sum += c; cnt += (c > 0u) ? 1u : 0u; mine = (j == x) ? c : mine; }
        if (sum == G) break;
        __builtin_amdgcn_s_sleep(1);
        if ((++sp & 255u) == 0u) { if (xb_ld(&bar[XB_TMO])) break; if (sp > XB_SPIN_CAP) { atomicAdd(&bar[XB_TMO], 1u); break; } }
    }
    nloc = mine > 0u ? mine : 1u; nx = cnt > 0u ? cnt : 1u;
}

__device__ __forceinline__ void xcd_barrier(const XcdBarrier& b) {
    asm volatile("s_waitcnt vmcnt(0)" ::: "memory");
    __syncthreads();
    if (threadIdx.x == 0) {
        unsigned* bar = b.bar;
        __builtin_amdgcn_s_waitcnt(0);
        unsigned nloc = b.st[0], nx = b.st[1];
        if (nloc == 0u) { xcd_barrier_complete(bar, b.x, nloc, nx); b.st[0] = nloc; b.st[1] = nx; }
        const unsigned old = xb_add(&bar[XB_XSUB(b.x)], 1u);
        const unsigned gen = old / nloc;
        if (old + 1u == (gen + 1u) * nloc) {
            __builtin_amdgcn_fence(__ATOMIC_RELEASE, "agent");
            asm volatile("s_waitcnt vmcnt(0)" ::: "memory");
            const unsigned og = xb_add(&bar[XB_TOP], 1u);
            const unsigned tg = og / nx;
            if (og + 1u == (tg + 1u) * nx) xb_add(&bar[XB_TOPGEN], 1u);
            else XB_SPIN(xb_ld(&bar[XB_TOPGEN]) == tg, bar);
            __builtin_amdgcn_fence(__ATOMIC_ACQUIRE, "agent");
            xb_add(&bar[XB_XGEN(b.x)], 1u);
            asm volatile("s_waitcnt vmcnt(0)" ::: "memory");
        } else {
            XB_SPIN(xb_ld(&bar[XB_XGEN(b.x)]) == gen, bar);
            __builtin_amdgcn_fence(__ATOMIC_ACQUIRE, "agent");
            asm volatile("s_waitcnt vmcnt(0)" ::: "memory");
        }
    }
    __syncthreads();
}
#ifndef LAS
#define LAS __attribute__((address_space(3)))
#endif
constexpr int NTHR = 512, NWAVE = 8;
constexpr int LDS_BYTES = 147456;

struct Params {
    const float* in[19]; float* out; unsigned char* ws;
};

template <bool HEADPERM> __device__ __forceinline__ void ph_transpose(const float* __restrict__ W, int K, int N, bf16* __restrict__ WT, float* tiles, int wg, int nwg, int tid, const float* __restrict__ kgain = nullptr) {
    float (*tile)[33] = (float (*)[33])(tiles + (tid >> 8) * (32 * 33));
    const int nt_n = N / 32, nitems = nt_n * (K / 32), tx = tid & 31, ty = (tid & 255) >> 5;
    for (int it0 = wg * 2; it0 < nitems; it0 += nwg * 2) {
        const int it = it0 + (tid >> 8); const bool act = it < nitems;
        const int n0 = (it % nt_n) * 32, k0 = (it / nt_n) * 32;
        if (act) for (int i = ty; i < 32; i += 8) tile[i][tx] = W[(size_t)(k0 + i) * N + n0 + tx];
        __syncthreads();
        if (act) for (int i = ty; i < 32; i += 8) { int nn = n0 + i; if (HEADPERM) nn = (nn & ~255) | (((nn >> 5) & 1) << 7) | (((nn >> 6) & 3) << 5) | (nn & 31);
            WT[(size_t)nn * K + k0 + tx] = (bf16)f2bf(tile[tx][i] * (kgain ? kgain[k0 + tx] : 1.0f)); }
        __syncthreads();
    }
}
__device__ __forceinline__ void ph_convert(const float* __restrict__ src, bf16* __restrict__ dst, size_t n4, int wg, int nwg, int tid) {
    for (size_t i = (size_t)wg * NTHR + tid; i < n4; i += (size_t)nwg * NTHR) {
        const float4 v = ((const float4*)src)[i];
        uint2 o; o.x = f2bf(v.x) | (f2bf(v.y) << 16); o.y = f2bf(v.z) | (f2bf(v.w) << 16);
        ((uint2*)dst)[i] = o;
    }
}
__device__ __forceinline__ void ph_rope(float* __restrict__ rope, int wg, int nwg, int tid) {
    for (int i = wg * NTHR + tid; i < SEQ * 32; i += nwg * NTHR) {
        const int pos = i >> 5, j = i & 31;
        const float inv = 1.0f / exp2f((float)j * (13.287712379549449f / 32.0f));
        const float ang = (float)pos * inv;
        double rev = (double)ang * 0.15915494309189535; rev -= floor(rev);
        rope[i] = __builtin_amdgcn_cosf((float)rev); rope[SEQ * 32 + i] = __builtin_amdgcn_sinf((float)rev);
    }
}
__device__ __forceinline__ void ph_rmsnorm(const float* __restrict__ x, const float* __restrict__ g, bf16* __restrict__ out, int rows, int wg, int nwg, int tid) {
    const int lane = tid & 63, nw = nwg * NWAVE;
    for (int r = wg * NWAVE + (tid >> 6); r < rows; r += nw) {
        const float4* xr = (const float4*)(x + (size_t)r * DM) + lane;
        float4 v[4]; float s = 0.f;
#pragma unroll
        for (int j = 0; j < 4; ++j) { v[j] = xr[64 * j]; s += (v[j].x * v[j].x + v[j].y * v[j].y) + (v[j].z * v[j].z + v[j].w * v[j].w); }
        const float rs = rsqrtf(wave_sum(s) * (1.0f / DM) + EPS);
        uint2* o = (uint2*)(out + (size_t)r * DM) + lane;
#pragma unroll
        for (int j = 0; j < 4; ++j) { const float4 gg = ((const float4*)g)[lane + 64 * j];
            uint2 w; w.x = f2bf(v[j].x * rs * gg.x) | (f2bf(v[j].y * rs * gg.y) << 16); w.y = f2bf(v[j].z * rs * gg.z) | (f2bf(v[j].w * rs * gg.w) << 16);
            o[64 * j] = w; }
    }
}
__device__ __forceinline__ void ph_qk_post(bf16* __restrict__ qkv, const float* __restrict__ rope, const float* __restrict__ gqm, const float* __restrict__ gkm,
                                           const float* __restrict__ gqd, const float* __restrict__ gkd, float* __restrict__ kmean, int wg, int nwg, int tid) {
    const int lane = tid & 63, half = lane >> 5, j = lane & 31, wv = tid >> 6;
    for (int blk = wg; blk < T / 256; blk += nwg) {
        float ks[4][2];
#pragma unroll
        for (int a = 0; a < 4; ++a) { ks[a][0] = 0.f; ks[a][1] = 0.f; }
        for (int tt = wv; tt < 256; tt += NWAVE) {
            const int t = blk * 256 + tt, pos = t & (SEQ - 1);
            const float c = rope[pos * 32 + j], sn = rope[SEQ * 32 + pos * 32 + j];
#pragma unroll
            for (int it = 0; it < 16; ++it) {
                const int s = it * 2 + half, type = it >> 2, hs = s & 7;
                bf16* buf = qkv + (size_t)(type < 2 ? type : type + 1) * QKV_ELEMS + (size_t)t * 512 + hs * 64;
                const float x1 = bf2f(buf[j]), x2 = bf2f(buf[j + 32]);
                float ss = x1 * x1 + x2 * x2;
#pragma unroll
                for (int o = 1; o < 32; o <<= 1) ss += __shfl_xor(ss, o);
                const float rs = rsqrtf(ss * (1.0f / 64.0f) + EPS);
                const float* g = type == 0 ? gqm : type == 1 ? gkm : type == 2 ? gqd + (hs & 1) * 64 : gkd + (hs & 1) * 64;
                const float y1 = x1 * rs * g[j], y2 = x2 * rs * g[j + 32];
                float o1 = y1 * c - y2 * sn, o2 = y2 * c + y1 * sn;
                if (type == 0 || type == 2) { o1 *= QSCALE; o2 *= QSCALE; }
                if (type == 1) { ks[it - 4][0] += o1; ks[it - 4][1] += o2; }
                buf[j] = (bf16)f2bf(o1); buf[j + 32] = (bf16)f2bf(o2);
            }
        }
        const int b = blk >> 3, nb = blk & 7;
#pragma unroll
        for (int a = 0; a < 4; ++a) { const int h = a * 2 + half; float* km = kmean + (((size_t)b * 8 + h) * 8 + nb) * 64;
            atomicAdd(km + j, ks[a][0] * (1.0f / 256.0f)); atomicAdd(km + j + 32, ks[a][1] * (1.0f / 256.0f)); }
    }
}
__device__ __forceinline__ void ph_diff_combine(const bf16* __restrict__ dob, float lam, const float* __restrict__ gain_d, bf16* __restrict__ mixed, int wg, int nwg, int tid) {
    const int lane = tid & 63, nw = nwg * NWAVE;
    for (int w = wg * NWAVE + (tid >> 6); w < T * 4; w += nw) {
        const int t = w >> 2, h = w & 3; const bf16* p = dob + (size_t)t * 1024 + h * 256;
        const float da = bf2f(p[lane]) - lam * bf2f(p[128 + lane]), db = bf2f(p[64 + lane]) - lam * bf2f(p[192 + lane]);
        const float rs = rsqrtf(wave_sum(da * da + db * db) * (1.0f / 128.0f) + EPS) * 0.8f;
        bf16* o = mixed + (size_t)t * 1024 + 512 + h * 128;
        o[lane] = (bf16)f2bf(da * rs * gain_d[h * 128 + lane]); o[64 + lane] = (bf16)f2bf(db * rs * gain_d[h * 128 + 64 + lane]);
    }
}
typedef float rf32x16 __attribute__((ext_vector_type(16)));
typedef short rbf16x8 __attribute__((ext_vector_type(8)));
__device__ __forceinline__ unsigned umax_(unsigned a, unsigned b) { return a > b ? a : b; }
__device__ __forceinline__ unsigned umin_(unsigned a, unsigned b) { return a > b ? b : a; }
#define CE_D(x, y) { const unsigned mx_ = umax_(x, y), mn_ = umin_(x, y); x = mx_; y = mn_; }
__device__ __forceinline__ void sort16_desc(unsigned (&v)[16]) {
    CE_D(v[0], v[1]) CE_D(v[3], v[2]) CE_D(v[4], v[5]) CE_D(v[7], v[6]) CE_D(v[8], v[9]) CE_D(v[11], v[10]) CE_D(v[12], v[13]) CE_D(v[15], v[14])
    CE_D(v[0], v[2]) CE_D(v[1], v[3]) CE_D(v[6], v[4]) CE_D(v[7], v[5]) CE_D(v[8], v[10]) CE_D(v[9], v[11]) CE_D(v[14], v[12]) CE_D(v[15], v[13])
    CE_D(v[0], v[1]) CE_D(v[2], v[3]) CE_D(v[5], v[4]) CE_D(v[7], v[6]) CE_D(v[8], v[9]) CE_D(v[10], v[11]) CE_D(v[13], v[12]) CE_D(v[15], v[14])
    CE_D(v[0], v[4]) CE_D(v[1], v[5]) CE_D(v[2], v[6]) CE_D(v[3], v[7]) CE_D(v[12], v[8]) CE_D(v[13], v[9]) CE_D(v[14], v[10]) CE_D(v[15], v[11])
    CE_D(v[0], v[2]) CE_D(v[1], v[3]) CE_D(v[4], v[6]) CE_D(v[5], v[7]) CE_D(v[10], v[8]) CE_D(v[11], v[9]) CE_D(v[14], v[12]) CE_D(v[15], v[13])
    CE_D(v[0], v[1]) CE_D(v[2], v[3]) CE_D(v[4], v[5]) CE_D(v[6], v[7]) CE_D(v[9], v[8]) CE_D(v[11], v[10]) CE_D(v[13], v[12]) CE_D(v[15], v[14])
    CE_D(v[0], v[8]) CE_D(v[1], v[9]) CE_D(v[2], v[10]) CE_D(v[3], v[11]) CE_D(v[4], v[12]) CE_D(v[5], v[13]) CE_D(v[6], v[14]) CE_D(v[7], v[15])
    CE_D(v[0], v[4]) CE_D(v[1], v[5]) CE_D(v[2], v[6]) CE_D(v[3], v[7]) CE_D(v[8], v[12]) CE_D(v[9], v[13]) CE_D(v[10], v[14]) CE_D(v[11], v[15])
    CE_D(v[0], v[2]) CE_D(v[1], v[3]) CE_D(v[4], v[6]) CE_D(v[5], v[7]) CE_D(v[8], v[10]) CE_D(v[9], v[11]) CE_D(v[12], v[14]) CE_D(v[13], v[15])
    CE_D(v[0], v[1]) CE_D(v[2], v[3]) CE_D(v[4], v[5]) CE_D(v[6], v[7]) CE_D(v[8], v[9]) CE_D(v[10], v[11]) CE_D(v[12], v[13]) CE_D(v[14], v[15])
}
__device__ __forceinline__ void merge16_desc(unsigned (&a)[16], const unsigned (&b)[16]) {
    a[0] = umax_(a[0], b[15]); a[1] = umax_(a[1], b[14]); a[2] = umax_(a[2], b[13]); a[3] = umax_(a[3], b[12]); a[4] = umax_(a[4], b[11]); a[5] = umax_(a[5], b[10]); a[6] = umax_(a[6], b[9]); a[7] = umax_(a[7], b[8]); a[8] = umax_(a[8], b[7]); a[9] = umax_(a[9], b[6]); a[10] = umax_(a[10], b[5]); a[11] = umax_(a[11], b[4]); a[12] = umax_(a[12], b[3]); a[13] = umax_(a[13], b[2]); a[14] = umax_(a[14], b[1]); a[15] = umax_(a[15], b[0]);
    CE_D(a[0], a[8]) CE_D(a[1], a[9]) CE_D(a[2], a[10]) CE_D(a[3], a[11]) CE_D(a[4], a[12]) CE_D(a[5], a[13]) CE_D(a[6], a[14]) CE_D(a[7], a[15])
    CE_D(a[0], a[4]) CE_D(a[1], a[5]) CE_D(a[2], a[6]) CE_D(a[3], a[7]) CE_D(a[8], a[12]) CE_D(a[9], a[13]) CE_D(a[10], a[14]) CE_D(a[11], a[15])
    CE_D(a[0], a[2]) CE_D(a[1], a[3]) CE_D(a[4], a[6]) CE_D(a[5], a[7]) CE_D(a[8], a[10]) CE_D(a[9], a[11]) CE_D(a[12], a[14]) CE_D(a[13], a[15])
    CE_D(a[0], a[1]) CE_D(a[2], a[3]) CE_D(a[4], a[5]) CE_D(a[6], a[7]) CE_D(a[8], a[9]) CE_D(a[10], a[11]) CE_D(a[12], a[13]) CE_D(a[14], a[15])
}
__device__ __forceinline__ void top16_of_64(unsigned (&G)[4][16]) {
    sort16_desc(G[0]); sort16_desc(G[1]); sort16_desc(G[2]); sort16_desc(G[3]);
    merge16_desc(G[0], G[1]); merge16_desc(G[2], G[3]); merge16_desc(G[0], G[2]);
}
__device__ __forceinline__ void route_scores(unsigned (&Lp)[16], const rbf16x8 (&bq)[8], const LAS unsigned char* kfr, int lane, int hi) {
    unsigned G[4][16]; unsigned hmask = hi ? ~4u : ~0u; asm volatile("" : "+v"(hmask));
#pragma unroll
    for (int nb = 0; nb < 4; ++nb) {
        rf32x16 acc = rf32x16{};
#pragma unroll
        for (int s = 0; s < 8; ++s) { const rbf16x8 a = *(const LAS rbf16x8*)(kfr + (nb * 8 + s) * 1024 + lane * 16); acc = __builtin_amdgcn_mfma_f32_32x32x16_bf16(a, bq[s], acc, 0, 0, 0); }
#pragma unroll
        for (int i = 0; i < 16; ++i) { const float v = fmaxf(acc[i] + 16.0f, 0.0f); const int n = nb * 32 + (i & 3) + 8 * (i >> 2);
            G[nb][i] = ((__float_as_uint(v) & ~127u) | (unsigned)(127 - n)) & hmask; }
        asm volatile("" ::: "memory"); __builtin_amdgcn_sched_barrier(0);
    }
    top16_of_64(G);
    unsigned O[16];
#pragma unroll
    for (int i = 0; i < 16; ++i) { auto rr = __builtin_amdgcn_permlane32_swap(G[0][i], G[0][i], false, false); O[i] = hi ? rr[0] : rr[1]; }
    merge16_desc(G[0], O);
#pragma unroll
    for (int i = 0; i < 16; ++i) Lp[i] = G[0][i];
    asm volatile("" ::: "memory"); __builtin_amdgcn_sched_barrier(0);
}
__device__ __forceinline__ void route_loadq(rbf16x8 (&bq)[8], const bf16* __restrict__ PQ, int tb, int hp, int lane) {
    const bf16* qp = PQ + (((size_t)tb * 16 + hp) * 8 * 64 + lane) * 8;
#pragma unroll
    for (int s = 0; s < 8; ++s) bq[s] = *(const rbf16x8*)(qp + s * 512);
}
__device__ __forceinline__ void route_loadk(pg8::u32x4 (&kr)[8], const bf16* __restrict__ subk, int h, int tid) {
#pragma unroll
    for (int i = 0; i < 8; ++i) { const int e = i * NTHR + tid, f = e >> 6, l2 = e & 63;
        kr[i] = *(const pg8::u32x4*)(subk + ((size_t)(h * 2 + (f >> 5)) * 128 + ((f >> 3) & 3) * 32 + (l2 & 31)) * 128 + 16 * (f & 7) + 8 * (l2 >> 5)); }
}
__device__ __forceinline__ void ph_peer_route(const bf16* __restrict__ PQ, const bf16* __restrict__ subk, int* __restrict__ ids, float* __restrict__ gates, LAS unsigned char* lds3, int wg, int nwg, int tid) {
    const int lane = tid & 63, r = lane & 31, hi = lane >> 5, wv = tid >> 6;
    LAS unsigned* myl = (LAS unsigned*)(lds3 + 65536) + wv * 2048;
    for (int tb0 = wg * NWAVE; tb0 < T / 32; tb0 += nwg * NWAVE) {
        const int tb = tb0 + wv; const bool live = tb < T / 32; const int t = (live ? tb : 0) * 32 + r;
        rbf16x8 bqA[8], bqB[8];
        route_loadq(bqA, PQ, live ? tb : 0, 0, lane);
        for (int h = 0; h < 8; ++h) {
            __syncthreads();
            { pg8::u32x4 kr[8]; route_loadk(kr, subk, h, tid);
#pragma unroll
              for (int i = 0; i < 8; ++i) *(LAS pg8::u32x4*)(lds3 + (i * NTHR + tid) * 16) = kr[i]; }
            __syncthreads();
            unsigned L[2][16];
            route_loadq(bqB, PQ, live ? tb : 0, h * 2 + 1, lane);
            route_scores(L[0], bqA, lds3, lane, hi);
            if (h < 7) route_loadq(bqA, PQ, live ? tb : 0, h * 2 + 2, lane);
            route_scores(L[1], bqB, lds3 + 32768, lane, hi);
#pragma unroll
            for (int i = 0; i < 16; ++i) { myl[i * 64 + lane] = 127u - (L[0][i] & 127u); myl[(16 + i) * 64 + lane] = 127u - (L[1][i] & 127u); }
            float fa[16], fb[16];
#pragma unroll
            for (int i = 0; i < 16; ++i) { fa[i] = __uint_as_float(L[0][i] & ~127u); fb[i] = __uint_as_float(L[1][i] & ~127u); }
            unsigned C[4][16];
            C[0][0] = (__float_as_uint(fmaxf(fa[0] + fb[0] - 24.0f, 0.0f)) & ~255u) | 255u;
            C[0][1] = (__float_as_uint(fmaxf(fa[0] + fb[1] - 24.0f, 0.0f)) & ~255u) | 254u;
            C[0][2] = (__float_as_uint(fmaxf(fa[0] + fb[2] - 24.0f, 0.0f)) & ~255u) | 253u;
            C[0][3] = (__float_as_uint(fmaxf(fa[0] + fb[3] - 24.0f, 0.0f)) & ~255u) | 252u;
            C[0][4] = (__float_as_uint(fmaxf(fa[0] + fb[4] - 24.0f, 0.0f)) & ~255u) | 251u;
            C[0][5] = (__float_as_uint(fmaxf(fa[0] + fb[5] - 24.0f, 0.0f)) & ~255u) | 250u;
            C[0][6] = (__float_as_uint(fmaxf(fa[0] + fb[6] - 24.0f, 0.0f)) & ~255u) | 249u;
            C[0][7] = (__float_as_uint(fmaxf(fa[0] + fb[7] - 24.0f, 0.0f)) & ~255u) | 248u;
            C[0][8] = (__float_as_uint(fmaxf(fa[0] + fb[8] - 24.0f, 0.0f)) & ~255u) | 247u;
            C[0][9] = (__float_as_uint(fmaxf(fa[0] + fb[9] - 24.0f, 0.0f)) & ~255u) | 246u;
            C[0][10] = (__float_as_uint(fmaxf(fa[0] + fb[10] - 24.0f, 0.0f)) & ~255u) | 245u;
            C[0][11] = (__float_as_uint(fmaxf(fa[0] + fb[11] - 24.0f, 0.0f)) & ~255u) | 244u;
            C[0][12] = (__float_as_uint(fmaxf(fa[0] + fb[12] - 24.0f, 0.0f)) & ~255u) | 243u;
            C[0][13] = (__float_as_uint(fmaxf(fa[0] + fb[13] - 24.0f, 0.0f)) & ~255u) | 242u;
            C[0][14] = (__float_as_uint(fmaxf(fa[0] + fb[14] - 24.0f, 0.0f)) & ~255u) | 241u;
            C[0][15] = (__float_as_uint(fmaxf(fa[0] + fb[15] - 24.0f, 0.0f)) & ~255u) | 240u;
            C[1][0] = (__float_as_uint(fmaxf(fa[1] + fb[0] - 24.0f, 0.0f)) & ~255u) | 239u;
            C[1][1] = (__float_as_uint(fmaxf(fa[1] + fb[1] - 24.0f, 0.0f)) & ~255u) | 238u;
            C[1][2] = (__float_as_uint(fmaxf(fa[1] + fb[2] - 24.0f, 0.0f)) & ~255u) | 237u;
            C[1][3] = (__float_as_uint(fmaxf(fa[1] + fb[3] - 24.0f, 0.0f)) & ~255u) | 236u;
            C[1][4] = (__float_as_uint(fmaxf(fa[1] + fb[4] - 24.0f, 0.0f)) & ~255u) | 235u;
            C[1][5] = (__float_as_uint(fmaxf(fa[1] + fb[5] - 24.0f, 0.0f)) & ~255u) | 234u;
            C[1][6] = (__float_as_uint(fmaxf(fa[1] + fb[6] - 24.0f, 0.0f)) & ~255u) | 233u;
            C[1][7] = (__float_as_uint(fmaxf(fa[1] + fb[7] - 24.0f, 0.0f)) & ~255u) | 232u;
            C[1][8] = (__float_as_uint(fmaxf(fa[2] + fb[0] - 24.0f, 0.0f)) & ~255u) | 223u;
            C[1][9] = (__float_as_uint(fmaxf(fa[2] + fb[1] - 24.0f, 0.0f)) & ~255u) | 222u;
            C[1][10] = (__float_as_uint(fmaxf(fa[2] + fb[2] - 24.0f, 0.0f)) & ~255u) | 221u;
            C[1][11] = (__float_as_uint(fmaxf(fa[2] + fb[3] - 24.0f, 0.0f)) & ~255u) | 220u;
            C[1][12] = (__float_as_uint(fmaxf(fa[2] + fb[4] - 24.0f, 0.0f)) & ~255u) | 219u;
            C[1][13] = (__float_as_uint(fmaxf(fa[3] + fb[0] - 24.0f, 0.0f)) & ~255u) | 207u;
            C[1][14] = (__float_as_uint(fmaxf(fa[3] + fb[1] - 24.0f, 0.0f)) & ~255u) | 206u;
            C[1][15] = (__float_as_uint(fmaxf(fa[3] + fb[2] - 24.0f, 0.0f)) & ~255u) | 205u;
            C[2][0] = (__float_as_uint(fmaxf(fa[3] + fb[3] - 24.0f, 0.0f)) & ~255u) | 204u;
            C[2][1] = (__float_as_uint(fmaxf(fa[4] + fb[0] - 24.0f, 0.0f)) & ~255u) | 191u;
            C[2][2] = (__float_as_uint(fmaxf(fa[4] + fb[1] - 24.0f, 0.0f)) & ~255u) | 190u;
            C[2][3] = (__float_as_uint(fmaxf(fa[4] + fb[2] - 24.0f, 0.0f)) & ~255u) | 189u;
            C[2][4] = (__float_as_uint(fmaxf(fa[5] + fb[0] - 24.0f, 0.0f)) & ~255u) | 175u;
            C[2][5] = (__float_as_uint(fmaxf(fa[5] + fb[1] - 24.0f, 0.0f)) & ~255u) | 174u;
            C[2][6] = (__float_as_uint(fmaxf(fa[6] + fb[0] - 24.0f, 0.0f)) & ~255u) | 159u;
            C[2][7] = (__float_as_uint(fmaxf(fa[6] + fb[1] - 24.0f, 0.0f)) & ~255u) | 158u;
            C[2][8] = (__float_as_uint(fmaxf(fa[7] + fb[0] - 24.0f, 0.0f)) & ~255u) | 143u;
            C[2][9] = (__float_as_uint(fmaxf(fa[7] + fb[1] - 24.0f, 0.0f)) & ~255u) | 142u;
            C[2][10] = (__float_as_uint(fmaxf(fa[8] + fb[0] - 24.0f, 0.0f)) & ~255u) | 127u;
            C[2][11] = (__float_as_uint(fmaxf(fa[9] + fb[0] - 24.0f, 0.0f)) & ~255u) | 111u;
            C[2][12] = (__float_as_uint(fmaxf(fa[10] + fb[0] - 24.0f, 0.0f)) & ~255u) | 95u;
            C[2][13] = (__float_as_uint(fmaxf(fa[11] + fb[0] - 24.0f, 0.0f)) & ~255u) | 79u;
            C[2][14] = (__float_as_uint(fmaxf(fa[12] + fb[0] - 24.0f, 0.0f)) & ~255u) | 63u;
            C[2][15] = (__float_as_uint(fmaxf(fa[13] + fb[0] - 24.0f, 0.0f)) & ~255u) | 47u;
            C[3][0] = (__float_as_uint(fmaxf(fa[14] + fb[0] - 24.0f, 0.0f)) & ~255u) | 31u;
            C[3][1] = (__float_as_uint(fmaxf(fa[15] + fb[0] - 24.0f, 0.0f)) & ~255u) | 15u;
            C[3][2] = 0u;
            C[3][3] = 0u;
            C[3][4] = 0u;
            C[3][5] = 0u;
            C[3][6] = 0u;
            C[3][7] = 0u;
            C[3][8] = 0u;
            C[3][9] = 0u;
            C[3][10] = 0u;
            C[3][11] = 0u;
            C[3][12] = 0u;
            C[3][13] = 0u;
            C[3][14] = 0u;
            C[3][15] = 0u;
            top16_of_64(C);
            const float s0 = __uint_as_float(C[0][0] & ~255u);
            float ex[16]; float sum = 0.f; int eid[16];
#pragma unroll
            for (int k = 0; k < 16; ++k) { ex[k] = __expf(__uint_as_float(C[0][k] & ~255u) - s0); sum += ex[k];
                const unsigned code = 255u - (C[0][k] & 255u); const unsigned ia = myl[(code >> 4) * 64 + lane], ib = myl[(16 + (code & 15u)) * 64 + lane]; eid[k] = (int)(ia * 128u + ib); }
            const float inv = 1.0f / sum;
            if (live && hi == 0) { int4* dst = (int4*)(ids + (size_t)t * 128 + h * 16);
#pragma unroll
                for (int k = 0; k < 4; ++k) dst[k] = make_int4(eid[4 * k], eid[4 * k + 1], eid[4 * k + 2], eid[4 * k + 3]); }
            else if (live) { float4* dst = (float4*)(gates + (size_t)t * 128 + h * 16);
#pragma unroll
                for (int k = 0; k < 4; ++k) dst[k] = make_float4(ex[4 * k] * inv, ex[4 * k + 1] * inv, ex[4 * k + 2] * inv, ex[4 * k + 3] * inv); }
        }
    }
}
typedef __bf16 bf16x2_t __attribute__((ext_vector_type(2)));
__device__ __forceinline__ float dot2bf(unsigned a, unsigned b, float acc) { return __builtin_amdgcn_fdot2_f32_bf16(__builtin_bit_cast(bf16x2_t, a), __builtin_bit_cast(bf16x2_t, b), acc, false); }
__device__ __forceinline__ float dot8(const uint4 a, const uint4 b, float s) { s = dot2bf(a.x, b.x, s); s = dot2bf(a.y, b.y, s); s = dot2bf(a.z, b.z, s); s = dot2bf(a.w, b.w, s); return s; }
__device__ __forceinline__ float gelu_erf(float z) { return 0.5f * z * (1.0f + erff(z * 0.70710678118654752f)); }
constexpr float TSCALE = 32.0f, TINV = 1.0f / 32.0f;
typedef float f32x2g __attribute__((ext_vector_type(2)));
constexpr int GB = 4;
struct GBatch { uint4 d[GB]; uint4 u[GB]; float g[GB]; };
__device__ __forceinline__ void gb_load(GBatch& B, const int* __restrict__ idp, const float* __restrict__ gp, int e0, const unsigned char* __restrict__ down, const unsigned char* __restrict__ up, int lane) {
#pragma unroll
    for (int j = 0; j < GB; ++j) { const int id = __builtin_amdgcn_readfirstlane(idp[e0 + j]); B.g[j] = gp[e0 + j];
        B.d[j] = *(const uint4*)(down + (size_t)id * DM + lane * 16); B.u[j] = *(const uint4*)(up + (size_t)id * DM + lane * 16); }
}
__device__ __forceinline__ void unpack16(const uint4 v, f32x2g (&f)[8]) {
    f[0] = __builtin_amdgcn_cvt_pk_f32_fp8((int)v.x, false); f[1] = __builtin_amdgcn_cvt_pk_f32_fp8((int)v.x, true);
    f[2] = __builtin_amdgcn_cvt_pk_f32_fp8((int)v.y, false); f[3] = __builtin_amdgcn_cvt_pk_f32_fp8((int)v.y, true);
    f[4] = __builtin_amdgcn_cvt_pk_f32_fp8((int)v.z, false); f[5] = __builtin_amdgcn_cvt_pk_f32_fp8((int)v.z, true);
    f[6] = __builtin_amdgcn_cvt_pk_f32_fp8((int)v.w, false); f[7] = __builtin_amdgcn_cvt_pk_f32_fp8((int)v.w, true);
}
__device__ __forceinline__ void gb_compute(const GBatch& B, const f32x2g (&xf)[8], f32x2g (&acc)[8], float zscale) {
    float z[GB];
#pragma unroll
    for (int j = 0; j < GB; ++j) { f32x2g d[8]; unpack16(B.d[j], d); f32x2g s = xf[0] * d[0];
#pragma unroll
        for (int i = 1; i < 8; ++i) s = __builtin_elementwise_fma(xf[i], d[i], s);
        z[j] = s.x + s.y; }
#pragma unroll
    for (int o = 1; o < 64; o <<= 1) {
#pragma unroll
        for (int j = 0; j < GB; ++j) z[j] += __shfl_xor(z[j], o); }
#pragma unroll
    for (int j = 0; j < GB; ++j) { const float w = B.g[j] * gelu_erf(z[j] * zscale); f32x2g u[8]; unpack16(B.u[j], u); const f32x2g w2 = {w, w};
#pragma unroll
        for (int i = 0; i < 8; ++i) acc[i] = __builtin_elementwise_fma(u[i], w2, acc[i]); }
}
__device__ __forceinline__ void ph_peer_gather(const bf16* __restrict__ xn, const int* __restrict__ ids, const float* __restrict__ gates, const unsigned char* __restrict__ down, const unsigned char* __restrict__ up, const float* x1, float* outw, unsigned* ctr, int tid, const float* __restrict__ rsv) {
    const int lane = tid & 63;
    int t; { unsigned v_ = 0; if (lane == 0) v_ = atomicAdd(ctr, 1u); t = (int)__builtin_amdgcn_readfirstlane(v_); }
    while (t < T) {
        unsigned vn_ = 0; if (lane == 0) vn_ = atomicAdd(ctr, 1u);
        const int* idp = ids + (size_t)t * 128; const float* gp = gates + (size_t)t * 128;
        GBatch B0, B1;
        gb_load(B0, idp, gp, 0, down, up, lane);
        f32x2g xf[8];
        { const uint4 xa = *(const uint4*)(xn + (size_t)t * DM + lane * 16), xb = *(const uint4*)(xn + (size_t)t * DM + lane * 16 + 8);
          const unsigned xw[8] = {xa.x, xa.y, xa.z, xa.w, xb.x, xb.y, xb.z, xb.w};
#pragma unroll
          for (int i = 0; i < 8; ++i) { xf[i].x = __uint_as_float(xw[i] << 16); xf[i].y = __uint_as_float(xw[i] & 0xffff0000u); } }
        const float zs = rsv[t] * TINV;
        f32x2g acc[8];
#pragma unroll
        for (int i = 0; i < 8; ++i) acc[i] = (f32x2g){0.f, 0.f};
        for (int e0 = 0; e0 < 128; e0 += 2 * GB) {
            gb_load(B1, idp, gp, e0 + GB, down, up, lane);
            gb_compute(B0, xf, acc, zs);
            if (e0 + 2 * GB < 128) gb_load(B0, idp, gp, e0 + 2 * GB, down, up, lane);
            gb_compute(B1, xf, acc, zs);
        }
        const float* xi = x1 + (size_t)t * DM + lane * 16; float* o = outw + (size_t)t * DM + lane * 16;
#pragma unroll
        for (int k = 0; k < 4; ++k) { float4 r = *(const float4*)(xi + 4 * k);
            r.x += acc[2 * k].x * TINV; r.y += acc[2 * k].y * TINV; r.z += acc[2 * k + 1].x * TINV; r.w += acc[2 * k + 1].y * TINV; *(float4*)(o + 4 * k) = r; }
        t = (int)__builtin_amdgcn_readfirstlane(vn_);
    }
}
__device__ __forceinline__ void ph_convert_fp8(const float* __restrict__ src, unsigned* __restrict__ dst, size_t n4, int wg, int nwg, int tid, const float* __restrict__ cgain = nullptr) {
    for (size_t i = (size_t)wg * NTHR + tid; i < n4; i += (size_t)nwg * NTHR) {
        float4 v = ((const float4*)src)[i];
        if (cgain) { const float4 g = ((const float4*)cgain)[i & 255]; v.x *= g.x; v.y *= g.y; v.z *= g.z; v.w *= g.w; }
        int w = __builtin_amdgcn_cvt_pk_fp8_f32(v.x * TSCALE, v.y * TSCALE, 0, false); w = __builtin_amdgcn_cvt_pk_fp8_f32(v.z * TSCALE, v.w * TSCALE, w, true);
        dst[i] = (unsigned)w;
    }
}

__device__ __forceinline__ void ph_rowrs(const float* __restrict__ ss, float* __restrict__ rs, int wg, int nwg, int tid) {
    for (int r = wg * NTHR + tid; r < T; r += nwg * NTHR) { float s = 0.f;
#pragma unroll
        for (int k = 0; k < 16; ++k) s += ss[(size_t)k * 65536 + r];
        rs[r] = rsqrtf(s * (1.0f / DM) + EPS); }
}
#ifndef PROBE_PHASE
#define PROBE_PHASE -1
#endif
#ifndef PROBE_MULT
#define PROBE_MULT 4
#endif
#ifndef REP_ATTN
#define REP_ATTN 1
#endif
#ifndef REP_ROUTE
#define REP_ROUTE 1
#endif
#ifndef REP_GATHER
#define REP_GATHER 1
#endif
#ifndef REP_QKPOST
#define REP_QKPOST 1
#endif
__global__ void __launch_bounds__(NTHR, 2) mk_fwd(Params P) {
    extern __shared__ __attribute__((aligned(16))) unsigned char lds[];
    cg::grid_group grid = cg::this_grid();
    const int wg = blockIdx.x, nwg = gridDim.x;
#if PROBE_PHASE >= 0
    volatile unsigned* tsl = (volatile unsigned*)(lds + 147456 - 256);
#define STAMP(i) do { if (threadIdx.x == 0) tsl[i] = (unsigned)__builtin_amdgcn_s_memrealtime(); } while (0)
#else
#define STAMP(i) do {} while (0)
#endif
    STAMP(0);
    volatile LAS unsigned* bst = (volatile LAS unsigned*)((LAS unsigned char*)lds + LDS_BYTES - 512);
    if (threadIdx.x < 2) bst[threadIdx.x] = 0u;
    __syncthreads();
    XcdBarrier xbar = xcd_barrier_post((unsigned*)(P.ws + 4096), bst);
#define GRID_BAR() xcd_barrier(xbar)
    unsigned char* ws = P.ws; float* out = P.out;
    const float* x = P.in[0];
    bf16* WinT = (bf16*)(ws + WS_WIN); bf16* WoutT = (bf16*)(ws + WS_WOUT); bf16* WqT = (bf16*)(ws + WS_WQ); bf16* SUBK = (bf16*)(ws + WS_SUBK);
    unsigned char* DOWN = ws + WS_DOWN; unsigned char* UP = ws + WS_UP; bf16* XN = (bf16*)(ws + WS_XN); bf16* QKV = (bf16*)(ws + WS_QKV); bf16* PQ = (bf16*)(ws + WS_PQ);
    bf16* MIXED = (bf16*)(ws + WS_MIXED); bf16* DOB = (bf16*)(ws + WS_DO); int* IDS = (int*)(ws + WS_IDS); float* GATES = (float*)(ws + WS_GATES);
    float* ROPE = (float*)(ws + WS_ROPE); float* KMEAN = (float*)(ws + WS_KMEAN);

    ph_transpose<true>(P.in[2], 1024, 3072, WinT, (float*)lds, wg, nwg, fresh_tid());
    ph_transpose<false>(P.in[13], 1024, 1024, WoutT, (float*)lds, wg, nwg, fresh_tid());
    ph_transpose<false>(P.in[15], 1024, 2048, WqT, (float*)lds, wg, nwg, fresh_tid(), P.in[14]);
    ph_convert(P.in[16], SUBK, (size_t)16 * 128 * 128 / 4, wg, nwg, fresh_tid());
    ph_convert_fp8(P.in[17], (unsigned*)DOWN, (size_t)16384 * 1024 / 4, wg, nwg, fresh_tid(), P.in[14]);
    ph_convert_fp8(P.in[18], (unsigned*)UP, (size_t)16384 * 1024 / 4, wg, nwg, fresh_tid());
    ph_rope(ROPE, wg, nwg, fresh_tid());
    ph_rmsnorm(x, P.in[1], XN, T, wg, nwg, fresh_tid());
    grid.sync();
    STAMP(1);
    { pg8::Gemm g{XN, WinT, T, 3072, 1024}; pg8::EpiQKV E{QKV, QKV_ELEMS, ROPE, P.in[3], P.in[4], P.in[5], P.in[6], KMEAN, QSCALE}; pg8::StaticOrder S; S.init(g.M, g.N, nwg, wg);
      pg8::gemm_phase<pg8::EpiQKV, pg8::StaticOrder, true, true>((PG8_LAS unsigned char*)lds, g, S, E); }
    GRID_BAR();
    STAMP(2);
    STAMP(3);
    for (int rep_ = 0; rep_ < REP_ATTN; ++rep_) { const float* gain_m = P.in[11];
      for (int combo = wg; combo < NB * 8; combo += nwg) {
        const int b = combo >> 3, hd = combo & 7; const size_t brow = (size_t)b * SEQ;
        for (int qb = 7; qb >= 0; --qb) { const size_t qrow = brow + (size_t)qb * 256;
            attn_body::attn_unit<8, true>(qb, (const attn_body::bf16*)(QKV + qrow * 512 + hd * 64), (const attn_body::bf16*)(QKV + QKV_ELEMS + brow * 512 + hd * 64),
                (const attn_body::bf16*)(QKV + 2 * QKV_ELEMS + brow * 512 + hd * 64), (attn_body::bf16*)(MIXED + qrow * 1024 + hd * 64), KMEAN + ((size_t)b * 8 + hd) * 512, gain_m + hd * 64, (char*)lds); }
      }
      float lam; { float a_ = 0.f, b_ = 0.f; for (int i = 0; i < 64; ++i) { a_ += P.in[7][i] * P.in[8][i]; b_ += P.in[9][i] * P.in[10][i]; } lam = expf(a_) - expf(b_) + 0.2f; }
      const float* gain_d = P.in[12];
      for (int cw = wg; cw < NB * 8; cw += nwg) {
        const int combo = cw >> 1, b = combo >> 2, h = combo & 3; const size_t brow = (size_t)b * SEQ;
        for (int qi = 0; qi < 4; ++qi) { const int qb = (cw & 1) ? (qi == 0 ? 7 : qi == 1 ? 4 : qi == 2 ? 3 : 0) : (qi == 0 ? 6 : qi == 1 ? 5 : qi == 2 ? 2 : 1);
          const size_t qrow = brow + (size_t)qb * 256;
          for (int sub = 0; sub < 4; ++sub) { const int m = sub >> 1, c = sub & 1;
            attn_body::attn_unit<8, false>(qb, (const attn_body::bf16*)(QKV + 3 * QKV_ELEMS + qrow * 512 + h * 128 + m * 64), (const attn_body::bf16*)(QKV + 4 * QKV_ELEMS + brow * 512 + h * 128 + m * 64),
                (const attn_body::bf16*)(QKV + 5 * QKV_ELEMS + brow * 512 + h * 128 + c * 64), (attn_body::bf16*)(DOB + qrow * 1024 + h * 256 + m * 128 + c * 64), nullptr, nullptr, (char*)lds); }
          asm volatile("s_waitcnt vmcnt(0)" ::: "memory");
          { const int tid_ = fresh_tid(), lane = tid_ & 63, wv = tid_ >> 6, sub16 = lane & 15, rq = lane >> 4;
#pragma unroll 2
            for (int it = 0; it < 8; ++it) { const size_t row = qrow + wv * 32 + it * 4 + rq; const bf16* p = DOB + row * 1024 + h * 256 + sub16 * 8;
              const uint4 a1 = *(const uint4*)p, a2 = *(const uint4*)(p + 128);
              const unsigned u1[4] = {a1.x, a1.y, a1.z, a1.w}, u2[4] = {a2.x, a2.y, a2.z, a2.w}; float d[8]; float ss = 0.f;
#pragma unroll
              for (int e = 0; e < 4; ++e) { d[2 * e] = __uint_as_float(u1[e] << 16) - lam * __uint_as_float(u2[e] << 16); d[2 * e + 1] = __uint_as_float(u1[e] & 0xffff0000u) - lam * __uint_as_float(u2[e] & 0xffff0000u);
                ss += d[2 * e] * d[2 * e] + d[2 * e + 1] * d[2 * e + 1]; }
              ss += __shfl_xor(ss, 1); ss += __shfl_xor(ss, 2); ss += __shfl_xor(ss, 4); ss += __shfl_xor(ss, 8);
              const float rs = rsqrtf(ss * (1.0f / 128.0f) + EPS) * 0.8f; const float4 g0 = *(const float4*)(gain_d + h * 128 + sub16 * 8), g1 = *(const float4*)(gain_d + h * 128 + sub16 * 8 + 4);
              uint4 o; o.x = f2bf(d[0] * rs * g0.x) | (f2bf(d[1] * rs * g0.y) << 16); o.y = f2bf(d[2] * rs * g0.z) | (f2bf(d[3] * rs * g0.w) << 16);
              o.z = f2bf(d[4] * rs * g1.x) | (f2bf(d[5] * rs * g1.y) << 16); o.w = f2bf(d[6] * rs * g1.z) | (f2bf(d[7] * rs * g1.w) << 16);
              *(uint4*)(MIXED + row * 1024 + 512 + h * 128 + sub16 * 8) = o; } }
        }
      } }
    GRID_BAR();
    STAMP(4);
    STAMP(5);
    { pg8::Gemm g{MIXED, WoutT, T, 1024, 1024}; pg8::EpiRes2 E{x, out, XN, (float*)(ws + WS_SS), 1024}; pg8::StaticOrder S; S.init(g.M, g.N, nwg, wg);
      pg8::gemm_phase<pg8::EpiRes2, pg8::StaticOrder, true, true>((PG8_LAS unsigned char*)lds, g, S, E); }
    GRID_BAR();
    STAMP(6);
    ph_rowrs((const float*)(ws + WS_SS), (float*)(ws + WS_RS), wg, nwg, fresh_tid());
    GRID_BAR();
    STAMP(7);
    { pg8::Gemm g{XN, WqT, T, 2048, 1024}; pg8::EpiPQ E{PQ, (const float*)(ws + WS_RS)}; pg8::StaticOrder S; S.init(g.M, g.N, nwg, wg);
      pg8::gemm_phase<pg8::EpiPQ, pg8::StaticOrder, true, true>((PG8_LAS unsigned char*)lds, g, S, E); }
    GRID_BAR();
    STAMP(8);
    for (int rep_ = 0; rep_ < REP_ROUTE; ++rep_) ph_peer_route(PQ, SUBK, IDS, GATES, (LAS unsigned char*)lds, wg, nwg, fresh_tid());
    GRID_BAR();
    STAMP(9);
    for (int rep_ = 1; rep_ < REP_GATHER; ++rep_) ph_peer_gather(XN, IDS, GATES, DOWN, UP, out, (float*)(ws + WS_MIXED), (unsigned*)(ws + 65536 + 256 * rep_), fresh_tid(), (const float*)(ws + WS_RS));
    ph_peer_gather(XN, IDS, GATES, DOWN, UP, out, out, (unsigned*)(ws + 65536), fresh_tid(), (const float*)(ws + WS_RS));
    STAMP(10);
#if PROBE_PHASE >= 0
    if (blockIdx.x == 0 && threadIdx.x == 0) { const unsigned dt = (tsl[PROBE_PHASE + 1] - tsl[PROBE_PHASE]) * PROBE_MULT; const unsigned long long t0 = __builtin_amdgcn_s_memrealtime(); while ((unsigned)(__builtin_amdgcn_s_memrealtime() - t0) < dt) __builtin_amdgcn_s_sleep(8); }
#endif
}

extern "C" void kernel_launch(void* const* d_in, const int* in_sizes, int n_in, void* d_out, int out_size, void* d_ws, size_t ws_size, hipStream_t stream) {
    static int grid_blocks = 0;
    if (grid_blocks == 0) {
        if (n_in != 19 || in_sizes[0] != T * DM || out_size != T * DM || ws_size < WS_END) { fprintf(stderr, "kernel_launch: unexpected shapes (n_in %d in0 %d out %d ws %zu)\n", n_in, n_in > 0 ? in_sizes[0] : -1, out_size, ws_size); grid_blocks = -1; return; }
        int dev = 0, cus = 0, per_cu = 0;
        (void)hipGetDevice(&dev); (void)hipDeviceGetAttribute(&cus, hipDeviceAttributeMultiprocessorCount, dev);
        (void)hipFuncSetAttribute((const void*)mk_fwd, hipFuncAttributeMaxDynamicSharedMemorySize, LDS_BYTES);
        (void)hipOccupancyMaxActiveBlocksPerMultiprocessor(&per_cu, (const void*)mk_fwd, NTHR, LDS_BYTES);
        if (per_cu < 1 || cus < 1) { fprintf(stderr, "kernel_launch: occupancy query says %d blocks/CU on %d CUs\n", per_cu, cus); grid_blocks = -1; return; }
        if (per_cu > 1) per_cu = 1;
        grid_blocks = cus * per_cu;
    }
    if (grid_blocks < 0) return;
    (void)hipMemsetAsync(d_ws, 0, WS_ZERO_BYTES, stream);
    Params p{};
    for (int i = 0; i < 19; ++i) p.in[i] = (const float*)d_in[i];
    p.out = (float*)d_out; p.ws = (unsigned char*)d_ws;
    void* args[] = {&p};
    hipError_t e = hipLaunchCooperativeKernel((const void*)mk_fwd, dim3(grid_blocks), dim3(NTHR), args, LDS_BYTES, stream);
    if (e != hipSuccess) fprintf(stderr, "cooperative launch failed: %s (grid %d)\n", hipGetErrorString(e), grid_blocks);
}
```

```cpp
#include <hip/hip_runtime.h>
#include <hip/hip_cooperative_groups.h>
#include <cstdio>
#include <cstdint>
namespace cg = cooperative_groups;
__device__ __forceinline__ int fresh_tid() { int t = threadIdx.x; asm volatile("" : "+v"(t)); return t; }
namespace pg8 {
#define PG8_LAS __attribute__((address_space(3)))
typedef unsigned short bf16_t;
typedef short bf16x8 __attribute__((ext_vector_type(8)));
typedef float f32x4 __attribute__((ext_vector_type(4)));
typedef unsigned u32x4 __attribute__((ext_vector_type(4)));
constexpr int BM = 256, BK = 64, HALF = 128, HTB = HALF * BK * 2  , STAGE_BYTES = 8 * HTB, NXCD = 8, WGM = 8;

__host__ __device__ __forceinline__ int lds_byte(int r, int c) { const int st = (r >> 4) * 2 + (c >> 5), rr = r & 15, cc = c & 31, ob = rr * 64 + cc * 2; return st * 1024 + (ob ^ (((ob >> 9) & 1) << 5)); }
__host__ __device__ __forceinline__ void stage_rc(int b, int& R, int& C) { const int st = b / 1024, sb = b % 1024, swz = sb ^ (((sb >> 9) & 1) << 5); R = (st >> 1) * 16 + swz / 64; C = (st & 1) * 32 + (swz % 64) / 2; }
__host__ __device__ __forceinline__ int perm32(int rho) { const int n = rho >> 4, i = rho & 15; return 8 * (i >> 2) + 4 * n + (i & 3); }

struct Unit { int pm, pn; };
struct Gemm { const bf16_t* A; const bf16_t* Bt; int M, N, K; };

struct StaticOrder {
    int nM, nN, nwg, G, c;
    __host__ __device__ void init(int M, int N, int G_, int c_) { nM = M / BM; nN = N / BM; nwg = nM * nN; G = G_; c = c_; }
    __host__ __device__ bool next(int i, Unit& u) const {
        const long L = (long)i * G + c; if (L >= nwg) return false;
        int wgid = (int)L; { const int q = nwg / NXCD, r = nwg % NXCD, xcd = wgid % NXCD, off = wgid / NXCD; wgid = (xcd < r ? xcd * (q + 1) : r * (q + 1) + (xcd - r) * q) + off; }
        const int nig = WGM * nN, gid = wgid / nig, fm = gid * WGM, gsz = (nM - fm) < WGM ? (nM - fm) : WGM;
        u.pm = fm + ((wgid % nig) % gsz); u.pn = (wgid % nig) / gsz; return true;
    }
    __device__ __forceinline__ void a_ready(const Unit&) const {}
    __device__ __forceinline__ void done(const Unit&) const {}
};

__device__ __forceinline__ unsigned cvt_pk_bf16(float lo, float hi) { unsigned r; asm volatile("v_cvt_pk_bf16_f32 %0, %1, %2" : "=v"(r) : "v"(lo), "v"(hi)); return r; }
struct EpiBf16 {
    static constexpr bool PERM = true, AFTER_DRAIN = false;
    bf16_t* O; int ldc; int split_cols; size_t split_stride;
    __device__ __forceinline__ void operator()(const f32x4 (&acc)[2][2][4][2], const Unit& u, int wr, int wc, int fr, int fq) const {
        const int row0 = u.pm * BM + wr * 64 + fr; int colt = u.pn * BM; bf16_t* base = O;
        if (split_cols) { const int t = colt / split_cols; base += (size_t)t * split_stride; colt -= t * split_cols; }
        const int col0 = colt + wc * 32 + 8 * fq;
#pragma unroll
        for (int ai = 0; ai < 2; ++ai)
#pragma unroll
            for (int m = 0; m < 4; ++m) { bf16_t* rowp = base + (size_t)(row0 + ai * HALF + m * 16) * ldc + col0;
#pragma unroll
                for (int bj = 0; bj < 2; ++bj) { const f32x4 v0 = acc[ai][bj][m][0], v1 = acc[ai][bj][m][1];
                    u32x4 w; w.x = cvt_pk_bf16(v0[0], v0[1]); w.y = cvt_pk_bf16(v0[2], v0[3]); w.z = cvt_pk_bf16(v1[0], v1[1]); w.w = cvt_pk_bf16(v1[2], v1[3]);
                    *(u32x4*)(rowp + bj * HALF) = w; } }
    }
};
struct EpiResF32 {
    static constexpr bool PERM = false, AFTER_DRAIN = false;
    const float* base; float* out; int ldc;
    __device__ __forceinline__ void operator()(const f32x4 (&acc)[2][2][4][2], const Unit& u, int wr, int wc, int fr, int fq) const {
        const int col0 = u.pn * BM + wc * 32 + 4 * fq;
#pragma unroll
        for (int ai = 0; ai < 2; ++ai)
#pragma unroll
            for (int m = 0; m < 4; ++m) { const size_t off = (size_t)(u.pm * BM + ai * HALF + wr * 64 + m * 16 + fr) * ldc + col0;
#pragma unroll
                for (int bj = 0; bj < 2; ++bj)
#pragma unroll
                    for (int n = 0; n < 2; ++n) { const f32x4 bs = *(const f32x4*)(base + off + bj * HALF + n * 16); *(f32x4*)(out + off + bj * HALF + n * 16) = bs + acc[ai][bj][m][n]; } }
    }
};
struct EpiQKV {
    static constexpr bool PERM = true, AFTER_DRAIN = false;
    bf16_t* QKV; size_t buf_elems; const float* rope; const float *gqm, *gkm, *gqd, *gkd; float* kmean; float qscale;
    __device__ __forceinline__ void operator()(const f32x4 (&acc)[2][2][4][2], const Unit& u, int wr, int wc, int fr, int fq) const {
        const int type = u.pn >> 1;
        bf16_t* base = QKV + (size_t)type * buf_elems + (size_t)(u.pm * BM + wr * 64 + fr) * 512 + (u.pn & 1) * 256 + wc * 64 + 8 * fq;
        if (type == 2 || type == 5) {
#pragma unroll
            for (int ai = 0; ai < 2; ++ai)
#pragma unroll
                for (int m = 0; m < 4; ++m) { bf16_t* rowp = base + (size_t)(ai * HALF + m * 16) * 512;
#pragma unroll
                    for (int bj = 0; bj < 2; ++bj) { const f32x4 v0 = acc[ai][bj][m][0], v1 = acc[ai][bj][m][1];
                        u32x4 w; w.x = cvt_pk_bf16(v0[0], v0[1]); w.y = cvt_pk_bf16(v0[2], v0[3]); w.z = cvt_pk_bf16(v1[0], v1[1]); w.w = cvt_pk_bf16(v1[2], v1[3]);
                        *(u32x4*)(rowp + bj * 32) = w; } }
            return;
        }
        const float* g = type == 0 ? gqm : type == 1 ? gkm : type == 3 ? gqd + (wc & 1) * 64 : gkd + (wc & 1) * 64;
        const f32x4 g1a = *(const f32x4*)(g + 8 * fq), g1b = *(const f32x4*)(g + 8 * fq + 4), g2a = *(const f32x4*)(g + 32 + 8 * fq), g2b = *(const f32x4*)(g + 32 + 8 * fq + 4);
        const float sc = (type == 0 || type == 3) ? qscale : 1.0f;
        f32x4 ks1a = {0.f, 0.f, 0.f, 0.f}, ks1b = ks1a, ks2a = ks1a, ks2b = ks1a;
#pragma unroll
        for (int ai = 0; ai < 2; ++ai)
#pragma unroll
            for (int m = 0; m < 4; ++m) {
                const int rloc = ai * HALF + m * 16; const int pos = (u.pm * BM + wr * 64 + fr + rloc) & 2047;
                const f32x4 x1a = acc[ai][0][m][0], x1b = acc[ai][0][m][1], x2a = acc[ai][1][m][0], x2b = acc[ai][1][m][1];
                f32x4 q = x1a * x1a + x1b * x1b + x2a * x2a + x2b * x2b; float ss = (q[0] + q[1]) + (q[2] + q[3]);
                ss += __shfl_xor(ss, 16); ss += __shfl_xor(ss, 32);
                const float rs = __builtin_amdgcn_rsqf(ss * (1.0f / 64.0f) + 1e-6f);
                const float* cp = rope + pos * 32 + 8 * fq; const f32x4 ca = *(const f32x4*)cp, cb = *(const f32x4*)(cp + 4), sa = *(const f32x4*)(cp + 65536), sb = *(const f32x4*)(cp + 65536 + 4);
                const f32x4 y1a = x1a * rs * g1a, y1b = x1b * rs * g1b, y2a = x2a * rs * g2a, y2b = x2b * rs * g2b;
                const f32x4 o1a = (y1a * ca - y2a * sa) * sc, o1b = (y1b * cb - y2b * sb) * sc, o2a = (y2a * ca + y1a * sa) * sc, o2b = (y2b * cb + y1b * sb) * sc;
                if (type == 1) { ks1a += o1a; ks1b += o1b; ks2a += o2a; ks2b += o2b; }
                bf16_t* rowp = base + (size_t)rloc * 512;
                u32x4 w1, w2; w1.x = cvt_pk_bf16(o1a[0], o1a[1]); w1.y = cvt_pk_bf16(o1a[2], o1a[3]); w1.z = cvt_pk_bf16(o1b[0], o1b[1]); w1.w = cvt_pk_bf16(o1b[2], o1b[3]);
                w2.x = cvt_pk_bf16(o2a[0], o2a[1]); w2.y = cvt_pk_bf16(o2a[2], o2a[3]); w2.z = cvt_pk_bf16(o2b[0], o2b[1]); w2.w = cvt_pk_bf16(o2b[2], o2b[3]);
                *(u32x4*)rowp = w1; *(u32x4*)(rowp + 32) = w2;
            }
        if (type == 1) {
            float kv[16] = {ks1a[0], ks1a[1], ks1a[2], ks1a[3], ks1b[0], ks1b[1], ks1b[2], ks1b[3], ks2a[0], ks2a[1], ks2a[2], ks2a[3], ks2b[0], ks2b[1], ks2b[2], ks2b[3]};
#pragma unroll
            for (int j = 0; j < 16; ++j) { float v = kv[j]; v += __shfl_xor(v, 1); v += __shfl_xor(v, 2); v += __shfl_xor(v, 4); v += __shfl_xor(v, 8); kv[j] = v; }
            if (fr == 0) { float* km = kmean + (((size_t)(u.pm >> 3) * 8 + (u.pn & 1) * 4 + wc) * 8 + (u.pm & 7)) * 64 + 8 * fq;
#pragma unroll
                for (int j = 0; j < 8; ++j) { atomicAdd(km + j, kv[j] * (1.0f / 256.0f)); atomicAdd(km + 32 + j, kv[8 + j] * (1.0f / 256.0f)); } }
        }
    }
};
struct EpiPQ {
    static constexpr bool PERM = true, AFTER_DRAIN = false;
    bf16_t* O; const float* rs;
    __device__ __forceinline__ void operator()(const f32x4 (&acc)[2][2][4][2], const Unit& u, int wr, int wc, int fr, int fq) const {
        const int s = wc * 2 + (fq >> 1), hi = fq & 1;
#pragma unroll
        for (int ai = 0; ai < 2; ++ai)
#pragma unroll
            for (int m = 0; m < 4; ++m) { const int R = u.pm * BM + ai * HALF + wr * 64 + m * 16 + fr, tb = R >> 5, r = R & 31; const float rr = rs[R];
#pragma unroll
                for (int bj = 0; bj < 2; ++bj) { const int hp = u.pn * 2 + bj; const f32x4 v0 = acc[ai][bj][m][0] * rr, v1 = acc[ai][bj][m][1] * rr;
                    u32x4 w; w.x = cvt_pk_bf16(v0[0], v0[1]); w.y = cvt_pk_bf16(v0[2], v0[3]); w.z = cvt_pk_bf16(v1[0], v1[1]); w.w = cvt_pk_bf16(v1[2], v1[3]);
                    *(u32x4*)(O + ((((size_t)tb * 16 + hp) * 8 + s) * 64 + hi * 32 + r) * 8) = w; } }
    }
};
struct EpiRes2 {
    static constexpr bool PERM = true, AFTER_DRAIN = false;
    const float* base; float* out; bf16_t* xb; float* ss; int ldc;
    __device__ __forceinline__ void operator()(const f32x4 (&acc)[2][2][4][2], const Unit& u, int wr, int wc, int fr, int fq) const {
        const int col0 = u.pn * BM + wc * 32 + 8 * fq;
#pragma unroll
        for (int ai = 0; ai < 2; ++ai) { float keep = 0.f;
#pragma unroll
            for (int m = 0; m < 4; ++m) { const size_t off = (size_t)(u.pm * BM + ai * HALF + wr * 64 + m * 16 + fr) * ldc + col0; float s = 0.f;
#pragma unroll
                for (int bj = 0; bj < 2; ++bj) { const f32x4 b0 = *(const f32x4*)(base + off + bj * HALF), b1 = *(const f32x4*)(base + off + bj * HALF + 4);
                    const f32x4 o0 = b0 + acc[ai][bj][m][0], o1 = b1 + acc[ai][bj][m][1];
                    *(f32x4*)(out + off + bj * HALF) = o0; *(f32x4*)(out + off + bj * HALF + 4) = o1;
                    s += (o0[0] * o0[0] + o0[1] * o0[1]) + (o0[2] * o0[2] + o0[3] * o0[3]) + (o1[0] * o1[0] + o1[1] * o1[1]) + (o1[2] * o1[2] + o1[3] * o1[3]);
                    u32x4 w; w.x = cvt_pk_bf16(o0[0], o0[1]); w.y = cvt_pk_bf16(o0[2], o0[3]); w.z = cvt_pk_bf16(o1[0], o1[1]); w.w = cvt_pk_bf16(o1[2], o1[3]);
                    *(u32x4*)(xb + off + bj * HALF) = w; }
                s += __shfl_xor(s, 16); s += __shfl_xor(s, 32);
                if (fq == m) keep = s; }
            ss[(size_t)(u.pn * 4 + wc) * 65536 + u.pm * BM + ai * HALF + wr * 64 + fq * 16 + fr] = keep; }
    }
};
template <class Epi, class Sched, bool ALIGN_EPI = false, bool SP2 = false>
__device__ __forceinline__ void gemm_phase(PG8_LAS unsigned char* lds, const Gemm g, const Sched& S, const Epi& E) {
    const int tid = fresh_tid(), wid = __builtin_amdgcn_readfirstlane(tid >> 6), lane = tid & 63, wr = wid >> 2, wc = wid & 3, fr = lane & 15, fq = lane >> 4;
    const int K = g.K, nt = K / BK;
    unsigned voffA[2], voffB[2];
#pragma unroll
    for (int i = 0; i < 2; ++i) { int R, C; stage_rc(tid * 16 + i * 8192, R, C); const int Rb = Epi::PERM ? ((R & ~31) + perm32(R & 31)) : R;
        voffA[i] = (unsigned)(R * K + C) * 2u; voffB[i] = (unsigned)(Rb * K + C) * 2u; }
    const size_t kstep = (size_t)(BK * 2);
    const size_t hstep = (size_t)HALF * K * 2;
    const size_t tstep = 2 * hstep;
    const unsigned ldsw = (unsigned)wid * 1024u;
    const int aoff = lds_byte(wr * 64 + fr, fq * 8), boff = lds_byte(wc * 32 + fr, fq * 8);
#define PG8_SA(b, h) (((b) * 2 + (h)) * HTB)
#define PG8_SB(b, h) ((4 + (b) * 2 + (h)) * HTB)
#define PG8_STAGE(bufoff, gbase, voff) do { _Pragma("unroll") for (int _i = 0; _i < 2; ++_i) \
        __builtin_amdgcn_global_load_lds((const unsigned*)((const char*)(gbase) + (voff)[_i]), (PG8_LAS unsigned*)(lds + (bufoff) + ldsw + _i * 8192), 16, 0, 0); } while (0)
#define PG8_LDA(dst, b, h) do { _Pragma("unroll") for (int m = 0; m < 4; ++m) _Pragma("unroll") for (int k = 0; k < 2; ++k) dst[m][k] = *(const PG8_LAS bf16x8*)(lds + PG8_SA(b, h) + aoff + m * 2048 + k * 1024); } while (0)
#define PG8_LDB(dst, b, h) do { _Pragma("unroll") for (int n = 0; n < 2; ++n) _Pragma("unroll") for (int k = 0; k < 2; ++k) dst[n][k] = *(const PG8_LAS bf16x8*)(lds + PG8_SB(b, h) + boff + n * 2048 + k * 1024); } while (0)
#define PG8_MMA(ai, bj, At, Bt) do { __builtin_amdgcn_s_setprio(1); _Pragma("unroll") for (int m = 0; m < 4; ++m) _Pragma("unroll") for (int n = 0; n < 2; ++n) _Pragma("unroll") for (int k = 0; k < 2; ++k) \
        acc[ai][bj][m][n] = __builtin_amdgcn_mfma_f32_16x16x32_bf16(Bt[n][k], At[m][k], acc[ai][bj][m][n], 0, 0, 0); __builtin_amdgcn_s_setprio(0); } while (0)
#define PG8_WAIT_V(n) asm volatile("s_waitcnt vmcnt(" #n ")" ::: "memory")
#define PG8_WAIT_L(n) asm volatile("s_waitcnt lgkmcnt(" #n ")" ::: "memory")
#define PG8_BAR __builtin_amdgcn_s_barrier()
#define PG8_SCHED __builtin_amdgcn_sched_barrier(0)
    Unit cur, nxt; int ui = 0;
    if (!S.next(0, cur)) return;
    f32x4 acc[2][2][4][2];
#pragma unroll
    for (int a = 0; a < 2; ++a)
#pragma unroll
        for (int b = 0; b < 2; ++b)
#pragma unroll
            for (int m = 0; m < 4; ++m)
#pragma unroll
                for (int n = 0; n < 2; ++n) acc[a][b][m][n] = (f32x4){0.f, 0.f, 0.f, 0.f};
    bf16x8 At[4][2], B0[2][2], B1[2][2];
    const char* cA = (const char*)g.A + (size_t)cur.pm * tstep; const char* cB = (const char*)g.Bt + (size_t)cur.pn * tstep;
    S.a_ready(cur);
    if constexpr (SP2) {
        PG8_STAGE(PG8_SB(0, 0), cB, voffB); PG8_STAGE(PG8_SB(0, 1), cB + hstep, voffB); PG8_STAGE(PG8_SA(0, 0), cA, voffA); PG8_STAGE(PG8_SA(0, 1), cA + hstep, voffA);
        if (wr == 1) PG8_BAR;
        PG8_WAIT_V(2); PG8_BAR;
        PG8_STAGE(PG8_SB(1, 0), cB + kstep, voffB); PG8_STAGE(PG8_SA(1, 0), cA + kstep, voffA); PG8_STAGE(PG8_SB(1, 1), cB + hstep + kstep, voffB);
        PG8_WAIT_V(6); PG8_BAR;
    } else {
        PG8_STAGE(PG8_SB(0, 0), cB, voffB); PG8_STAGE(PG8_SA(0, 0), cA, voffA); PG8_STAGE(PG8_SB(0, 1), cB + hstep, voffB); PG8_STAGE(PG8_SA(0, 1), cA + hstep, voffA);
        if (wr == 1) PG8_BAR;
        PG8_WAIT_V(4); PG8_BAR;
        PG8_STAGE(PG8_SB(1, 0), cB + kstep, voffB); PG8_STAGE(PG8_SA(1, 0), cA + kstep, voffA); PG8_STAGE(PG8_SB(1, 1), cB + hstep + kstep, voffB);
        PG8_WAIT_V(6); PG8_BAR;
    }
    for (;;) {
        const bool has_next = S.next(ui + 1, nxt);
        const char* nA = has_next ? (const char*)g.A + (size_t)nxt.pm * tstep : cA; const char* nB = has_next ? (const char*)g.Bt + (size_t)nxt.pn * tstep : cB;
        for (int t = 0; t < nt; t += 2) {
            const bool last = (t == nt - 2);
            const char* a1 = cA + (size_t)(t + 1) * kstep;
            const char* a2 = last ? nA : cA + (size_t)(t + 2) * kstep; const char* b2 = last ? nB : cB + (size_t)(t + 2) * kstep;
            const char* a3 = a2 + kstep; const char* b3 = b2 + kstep;
            if (last && has_next) S.a_ready(nxt);
            if constexpr (SP2) {
            PG8_LDB(B0, 0, 0); PG8_LDB(B1, 0, 1); PG8_SCHED; PG8_LDA(At, 0, 0); PG8_STAGE(PG8_SA(1, 1), a1 + hstep, voffA);
            PG8_WAIT_V(8); PG8_WAIT_L(0); PG8_BAR; PG8_MMA(0, 0, At, B0); PG8_MMA(0, 1, At, B1); PG8_BAR; PG8_SCHED;
            PG8_LDA(At, 0, 1); PG8_STAGE(PG8_SB(0, 0), b2, voffB); PG8_STAGE(PG8_SB(0, 1), b2 + hstep, voffB); PG8_STAGE(PG8_SA(0, 0), a2, voffA);
            PG8_WAIT_V(8); PG8_WAIT_L(0); PG8_BAR; PG8_MMA(1, 0, At, B0); PG8_MMA(1, 1, At, B1); PG8_BAR; PG8_SCHED;
            PG8_LDB(B0, 1, 0); PG8_LDB(B1, 1, 1); PG8_SCHED; PG8_LDA(At, 1, 0); PG8_STAGE(PG8_SA(0, 1), a2 + hstep, voffA);
            PG8_WAIT_V(8); PG8_WAIT_L(0); PG8_BAR; PG8_MMA(0, 0, At, B0); PG8_MMA(0, 1, At, B1); PG8_BAR; PG8_SCHED;
            PG8_LDA(At, 1, 1); PG8_STAGE(PG8_SB(1, 0), b3, voffB); PG8_STAGE(PG8_SB(1, 1), b3 + hstep, voffB); PG8_STAGE(PG8_SA(1, 0), a3, voffA);
            PG8_WAIT_V(8); PG8_WAIT_L(0); PG8_BAR; PG8_MMA(1, 0, At, B0); PG8_MMA(1, 1, At, B1); PG8_BAR; PG8_SCHED;
            } else {
            PG8_LDB(B0, 0, 0); PG8_SCHED; PG8_LDA(At, 0, 0); PG8_STAGE(PG8_SA(1, 1), a1 + hstep, voffA);
            PG8_WAIT_L(8); PG8_BAR; PG8_WAIT_L(0); PG8_MMA(0, 0, At, B0); PG8_BAR; PG8_SCHED;
            PG8_LDB(B1, 0, 1); PG8_STAGE(PG8_SB(0, 0), b2, voffB);
            PG8_BAR; PG8_WAIT_L(0); PG8_MMA(0, 1, At, B1); PG8_BAR;
            PG8_LDA(At, 0, 1); PG8_STAGE(PG8_SA(0, 0), a2, voffA);
            PG8_BAR; PG8_WAIT_L(0); PG8_MMA(1, 0, At, B0); PG8_BAR; PG8_SCHED;
            PG8_STAGE(PG8_SB(0, 1), b2 + hstep, voffB);
            PG8_WAIT_V(6); PG8_BAR; PG8_MMA(1, 1, At, B1); PG8_BAR;
            PG8_LDB(B0, 1, 0); PG8_SCHED; PG8_LDA(At, 1, 0); PG8_STAGE(PG8_SA(0, 1), a2 + hstep, voffA);
            PG8_WAIT_L(8); PG8_BAR; PG8_WAIT_L(0); PG8_MMA(0, 0, At, B0); PG8_BAR; PG8_SCHED;
            PG8_LDB(B1, 1, 1); PG8_STAGE(PG8_SB(1, 0), b3, voffB);
            PG8_BAR; PG8_WAIT_L(0); PG8_MMA(0, 1, At, B1); PG8_BAR;
            PG8_LDA(At, 1, 1); PG8_STAGE(PG8_SA(1, 0), a3, voffA);
            PG8_BAR; PG8_WAIT_L(0); PG8_MMA(1, 0, At, B0); PG8_BAR; PG8_SCHED;
            PG8_STAGE(PG8_SB(1, 1), b3 + hstep, voffB);
            PG8_WAIT_V(6); PG8_BAR; PG8_MMA(1, 1, At, B1); PG8_BAR;
            }
        }
        if constexpr (ALIGN_EPI) { if (wr == 0) PG8_BAR; }
        if constexpr (!Epi::AFTER_DRAIN) { E(acc, cur, wr, wc, fr, fq); S.done(cur); }
        if (!has_next) break;
#pragma unroll
        for (int a = 0; a < 2; ++a)
#pragma unroll
            for (int b = 0; b < 2; ++b)
#pragma unroll
                for (int m = 0; m < 4; ++m)
#pragma unroll
                    for (int n = 0; n < 2; ++n) acc[a][b][m][n] = (f32x4){0.f, 0.f, 0.f, 0.f};
        cur = nxt; cA = nA; cB = nB; ++ui;
        if constexpr (ALIGN_EPI) { if (wr == 1) PG8_BAR; }
    }
    PG8_WAIT_V(0);
    if constexpr (!ALIGN_EPI) { if (wr == 0) PG8_BAR; }
    PG8_BAR;
    if constexpr (Epi::AFTER_DRAIN) { E.fused(acc, cur, wr, wc, fr, fq, lds, wid, lane); S.done(cur); }
#undef PG8_SA
#undef PG8_SB
#undef PG8_STAGE
#undef PG8_LDA
#undef PG8_LDB
#undef PG8_MMA
#undef PG8_WAIT_V
#undef PG8_WAIT_L
#undef PG8_BAR
#undef PG8_SCHED
}
}
#include <hip/hip_bf16.h>
#include <cmath>
namespace attn_body {
using bf16=__hip_bfloat16;
using bf16x8=__attribute__((ext_vector_type(8)))short;
using s16x4=__attribute__((ext_vector_type(4)))short;
using f32x16=__attribute__((ext_vector_type(16)))float;
using u32x4=__attribute__((ext_vector_type(4)))unsigned;
constexpr int SEQ=2048,D=64,DM=512,PO=1024;
constexpr int NW=8,QBLK=32,QB=QBLK*NW,KVBLK=64,NQB=SEQ/QB;
constexpr int ATTN_UNIT_ROWS=QB;
__device__ __forceinline__ int crow(int r,int hi){return (r&3)+8*(r>>2)+4*hi;}
#define SBAR() __builtin_amdgcn_sched_barrier(0)
__device__ __forceinline__ void cmask(f32x16&p0,f32x16&p1,int jb,int qrel,int hi){
  const float NEG=-INFINITY; int kb=64*jb+4*hi;
  #pragma unroll
  for(int r=0;r<16;++r){int kv=kb+(r&3)+8*(r>>2); if(kv>qrel)p0[r]=NEG; if(kv+32>qrel)p1[r]=NEG;}
}

__device__ __forceinline__ void bmask(f32x16&p0,f32x16&p1,unsigned on){
  if(!on){
    #pragma unroll
    for(int r=0;r<16;++r){p0[r]=-INFINITY;p1[r]=-INFINITY;} }
}
constexpr int NSLOT=3, SLOTB=8192;
constexpr int LDS_K=0, LDS_V=NSLOT*SLOTB, LDS_WS=2*NSLOT*SLOTB, LDS_OST=LDS_WS+NW*64*4, LDS_BYTES=LDS_OST+NW*4096;
constexpr float C2=0.125f*1.4426950408889634f;
__device__ __forceinline__ void glds16(const void*gsrc,unsigned lds_dst){unsigned keep;
  asm volatile("s_mov_b32 %0, m0\n\ts_mov_b32 m0, %2\n\ts_nop 0\n\tglobal_load_lds_dwordx4 %1, off\n\ts_mov_b32 m0, %0":"=&s"(keep):"v"(gsrc),"s"(lds_dst):"memory");}
__device__ __forceinline__ float max3f(float a,float b,float c){float r;asm("v_max3_f32 %0, %1, %2, %3":"=v"(r):"v"(a),"v"(b),"v"(c));return r;}
__device__ __forceinline__ float max2f(float a,float b){float r;asm("v_max_f32_e32 %0, %1, %2":"=v"(r):"v"(a),"v"(b));return r;}
__device__ __forceinline__ float fadd_s(float a,float b){float r;asm("v_add_f32_e32 %0, %1, %2":"=v"(r):"v"(a),"v"(b));return r;}
__device__ __forceinline__ float fsub_s(float a,float b){float r;asm("v_sub_f32_e32 %0, %1, %2":"=v"(r):"v"(a),"v"(b));return r;}
typedef float f32x2_t __attribute__((ext_vector_type(2))); typedef __bf16 bf16x2_t __attribute__((ext_vector_type(2)));
__device__ __forceinline__ unsigned cvtpk_s(float lo,float hi){f32x2_t v={lo,hi};bf16x2_t b=__builtin_convertvector(v,bf16x2_t);return __builtin_bit_cast(unsigned,b);}
#define WAIT_BAR(N) asm volatile("s_waitcnt vmcnt(" #N ") lgkmcnt(0)\n\ts_barrier":::"memory")

__device__ __forceinline__ void qkt(f32x16&p0,f32x16&p1,const char*Kslot,const bf16x8*qr,int r32,int hi){
  const char*kb=Kslot+hi*1024+r32*16;
  #pragma unroll
  for(int d0=0;d0<4;++d0){
    const bf16x8 b0=*reinterpret_cast<const bf16x8*>(kb+d0*2048);
    const bf16x8 b1=*reinterpret_cast<const bf16x8*>(kb+d0*2048+512);
    if(d0==0){p0=__builtin_amdgcn_mfma_f32_32x32x16_bf16(b0,qr[0],f32x16{},0,0,0);p1=__builtin_amdgcn_mfma_f32_32x32x16_bf16(b1,qr[0],f32x16{},0,0,0);}
    else{p0=__builtin_amdgcn_mfma_f32_32x32x16_bf16(b0,qr[d0],p0,0,0,0);p1=__builtin_amdgcn_mfma_f32_32x32x16_bf16(b1,qr[d0],p1,0,0,0);}}
}
typedef __attribute__((address_space(3))) const char* lds_cptr;
typedef short v4i16_t __attribute__((ext_vector_type(4)));
__device__ __forceinline__ void kload8(bf16x8*kf,lds_cptr kp){
  kf[0]=*(const __attribute__((address_space(3))) bf16x8*)(kp);      kf[1]=*(const __attribute__((address_space(3))) bf16x8*)(kp+512);
  kf[2]=*(const __attribute__((address_space(3))) bf16x8*)(kp+2048); kf[3]=*(const __attribute__((address_space(3))) bf16x8*)(kp+2560);
  kf[4]=*(const __attribute__((address_space(3))) bf16x8*)(kp+4096); kf[5]=*(const __attribute__((address_space(3))) bf16x8*)(kp+4608);
  kf[6]=*(const __attribute__((address_space(3))) bf16x8*)(kp+6144); kf[7]=*(const __attribute__((address_space(3))) bf16x8*)(kp+6656);
}
__device__ __forceinline__ void kload2(bf16x8*kf,lds_cptr kp,int j){ kf[2*j]=*(const __attribute__((address_space(3))) bf16x8*)(kp+j*2048); kf[2*j+1]=*(const __attribute__((address_space(3))) bf16x8*)(kp+j*2048+512); }
__device__ __forceinline__ s16x4 vtr(lds_cptr p){ return __builtin_bit_cast(s16x4,__builtin_amdgcn_ds_read_tr16_b64_v4i16((__attribute__((address_space(3))) v4i16_t*)p)); }
__device__ __forceinline__ float rowmax(const f32x16&p0,const f32x16&p1){
  float a=max3f(p0[0],p0[1],p1[0]),b=max3f(p0[2],p0[3],p1[1]);a=max3f(a,p1[2],p1[3]);
  #pragma unroll
  for(int r=4;r<16;r+=4){a=max3f(a,p0[r],p0[r+1]);b=max3f(b,p0[r+2],p0[r+3]);a=max3f(a,p1[r],p1[r+1]);b=max3f(b,p1[r+2],p1[r+3]);}
  const float m=max2f(a,b);
  auto rr=__builtin_amdgcn_permlane32_swap(__float_as_uint(m),__float_as_uint(m),false,false);
  return max2f(__uint_as_float(rr[0]),__uint_as_float(rr[1]));
}
__device__ __forceinline__ void pv(f32x16*o,int vb,bf16x8 pa0,bf16x8 pa1,bf16x8 pa2,bf16x8 pa3){
  #pragma unroll
  for(int d0=0;d0<2;++d0){s16x4 lo[4],hi[4];
    #pragma unroll
    for(int ks=0;ks<4;++ks){
      asm volatile("ds_read_b64_tr_b16 %0,%1 offset:%c2":"=&v"(lo[ks]):"v"(vb),"i"(d0*4096+ks*1024):"memory");
      asm volatile("ds_read_b64_tr_b16 %0,%1 offset:%c2":"=&v"(hi[ks]):"v"(vb),"i"(d0*4096+ks*1024+512):"memory");}
    asm volatile("s_waitcnt lgkmcnt(0)":::"memory");SBAR();
    #define PK(k) (bf16x8){lo[k][0],lo[k][1],lo[k][2],lo[k][3],hi[k][0],hi[k][1],hi[k][2],hi[k][3]}
    o[d0]=__builtin_amdgcn_mfma_f32_32x32x16_bf16(pa0,PK(0),o[d0],0,0,0);
    o[d0]=__builtin_amdgcn_mfma_f32_32x32x16_bf16(pa1,PK(1),o[d0],0,0,0);
    o[d0]=__builtin_amdgcn_mfma_f32_32x32x16_bf16(pa2,PK(2),o[d0],0,0,0);
    o[d0]=__builtin_amdgcn_mfma_f32_32x32x16_bf16(pa3,PK(3),o[d0],0,0,0);
    #undef PK
  }
}

#ifndef ATTN_STORE16
#define ATTN_STORE16(p,v) (*(u32x4*)(p)=(v))
#endif
template<int THRL,bool MOBA> __device__ __forceinline__ void attn_unit(int qb,const bf16*Qu,const bf16*__restrict__ Kh,const bf16*__restrict__ Vh,bf16*Ou,const float*__restrict__ km,const float*__restrict__ gm,char*shm){
  const int tid=fresh_tid(),lane=tid&63,r32=lane&31,hi=lane>>5; const int wid=__builtin_amdgcn_readfirstlane(tid>>6);
  const int q0=qb*QB;
  const bf16*Qw=Qu+(long)(wid*QBLK)*DM;
  const unsigned lds0=(unsigned)(uintptr_t)shm;
  float*wsf=(float*)(shm+LDS_WS)+wid*64;
  const bf16*ksrc=Kh+(long)lane*DM+wid*8;
  const bf16*vsrc=Vh+(long)(16*(wid&3)+(lane>>2))*DM+(wid>>2)*32+(lane&3)*8;
  const unsigned kdst=lds0+LDS_K+wid*1024, vdst=lds0+LDS_V+wid*1024;
  #define DMA_K(t,slot) glds16(ksrc+(long)(t)*KVBLK*DM,(unsigned)__builtin_amdgcn_readfirstlane(kdst+(slot)))
  #define DMA_V(t,slot) glds16(vsrc+(long)(t)*KVBLK*DM,(unsigned)__builtin_amdgcn_readfirstlane(vdst+(slot)))
  const int vb0=(int)(lds0+LDS_V)+((lane>>4)&1)*32+(lane&3)*8+(4*hi+((lane&15)>>2))*64;
  const char*Kbase=shm+LDS_K; bf16x8 kf[8];
  const lds_cptr shm3=(lds_cptr)shm; const lds_cptr kp0=shm3+LDS_K+hi*1024+r32*16; const lds_cptr vp0=shm3+LDS_V+((lane>>4)&1)*32+(lane&3)*8+(4*hi+((lane&15)>>2))*64;
  const int NT=(q0+QB)/KVBLK;
  DMA_K(0,0);DMA_V(0,0);DMA_K(1,SLOTB);
  bf16x8 qr[4];
  #pragma unroll
  for(int d0=0;d0<4;++d0)qr[d0]=*reinterpret_cast<const bf16x8*>(&Qw[(long)r32*DM+d0*16+hi*8]);
  unsigned selm=0u;
  if(MOBA){ float g[8];
    #pragma unroll
    for(int n=0;n<8;++n){ float s_=0.f; if(n<qb){
      #pragma unroll
      for(int d0=0;d0<4;++d0){ const float4 ka=*reinterpret_cast<const float4*>(km+n*64+d0*16+hi*8), kb2=*reinterpret_cast<const float4*>(km+n*64+d0*16+hi*8+4);
        const float kv[8]={ka.x,ka.y,ka.z,ka.w,kb2.x,kb2.y,kb2.z,kb2.w};
        #pragma unroll
        for(int j=0;j<8;++j)s_+=__uint_as_float(((unsigned)(unsigned short)qr[d0][j])<<16)*kv[j]; }
      s_+=__shfl_xor(s_,32); } g[n]=s_; asm volatile("":"+v"(s_)::"memory"); SBAR(); }
    #pragma unroll
    for(int r=0;r<3;++r){ float best=-3.0e38f; int bi=-1;
      #pragma unroll
      for(int n=0;n<8;++n) if(n<qb&&!((selm>>n)&1u)&&g[n]>best){best=g[n];bi=n;}
      if(bi>=0)selm|=1u<<bi; } }
  float l_reg=0.f;f32x16 o[2];o[0]=f32x16{};o[1]=f32x16{};
  const int qrel=wid*QBLK+r32;
  #define CMASK(P0,P1,t) do{int jb_=(t)-(NT-4); if(jb_>=0)cmask(P0,P1,jb_,qrel,hi); else if(MOBA) bmask(P0,P1,(selm>>((t)>>2))&1u);}while(0)
  #define START(P0,P1) do{ _Pragma("unroll") for(int r=0;r<16;++r)P0[r]=__builtin_amdgcn_exp2f(P0[r]); }while(0)
  #define RESC() do{}while(0)
  f32x16 pA0,pA1,pB0,pB1;
  int sl_prev=0,sl_cur=0,sl_next=SLOTB;
  #define ROT() do{sl_prev=sl_cur;sl_cur=sl_next;sl_next=(sl_next==(NSLOT-1)*SLOTB)?0:sl_next+SLOTB;}while(0)
  DMA_K(2,2*SLOTB);
  WAIT_BAR(3);
  qkt(pA0,pA1,Kbase,qr,r32,hi);asm volatile("s_nop 15\n\ts_nop 7":"+v"(pA0),"+v"(pA1));CMASK(pA0,pA1,0);
  START(pA0,pA1);
  _Pragma("unroll") for(int r=0;r<16;++r)pA1[r]=__builtin_amdgcn_exp2f(pA1[r]);
  WAIT_BAR(0);
  DMA_K(3,0);DMA_V(1,SLOTB);
  ROT();
  kload8(kf,kp0+sl_cur);
  WAIT_BAR(2);
  s16x4 vlo[8],vhi[8]; u32x4 pw0,pw1,pw2,pw3;
  #define PKW(P,B) cvtpk_s(P[B],P[B+1])
  #define PAF(k) __builtin_bit_cast(bf16x8,pw##k)
  #define VFR(i) (bf16x8){vlo[i][0],vlo[i][1],vlo[i][2],vlo[i][3],vhi[i][0],vhi[i][1],vhi[i][2],vhi[i][3]}
  #define PIN(x) asm volatile("":"+v"(x))
  #define MX3(a,b,c) __builtin_fmaxf(__builtin_fmaxf((a),(b)),(c))
  #define GAPA(MF,A0,A1,A2,A3,W0,W1,PW) do{ MF; sacc+=A0; sacc+=A1; sacc+=A2; sacc+=A3; PIN(sacc); W0; W1; PIN(PW); SBAR(); }while(0)
  #define EX(v) __builtin_amdgcn_exp2f(v)
  #define GAPB(MF,X,B) do{ MF; X[B]=EX(X[B]); X[B+1]=EX(X[B+1]); X[B+2]=EX(X[B+2]); X[B+3]=EX(X[B+3]); PIN(X); SBAR(); }while(0)
  #define VRD(i) do{ vlo[i]=vtr(vp_+(((i)>>2)*4096+((i)&3)*1024)); vhi[i]=vtr(vp_+(((i)>>2)*4096+((i)&3)*1024+512)); }while(0)
  #define KRD(G,j) do{ if(G){ kload2(kf,kp0+sl_next,j); SBAR(); } }while(0)
  #define STEP(C0,C1,P0,P1,t,GK,GV,GL) do{ SBAR(); \
    const lds_cptr vp_=vp0+sl_prev; \
    VRD(0); SBAR(); float sacc=(P0[0]+P0[1]); \
    GAPA(C0=__builtin_amdgcn_mfma_f32_32x32x16_bf16(kf[0],qr[0],f32x16{},0,0,0), P0[2],P0[3],P0[4],P0[5],     pw0[0]=PKW(P0,0), pw0[1]=PKW(P0,2), pw0); \
    VRD(4); SBAR(); GAPA(C1=__builtin_amdgcn_mfma_f32_32x32x16_bf16(kf[1],qr[0],f32x16{},0,0,0), P0[6],P0[7],P0[8],P0[9],     pw0[2]=PKW(P0,4), pw0[3]=PKW(P0,6), pw0); \
    VRD(1); SBAR(); GAPA(C0=__builtin_amdgcn_mfma_f32_32x32x16_bf16(kf[2],qr[1],C0,0,0,0),   P0[10],P0[11],P0[12],P0[13], pw1[0]=PKW(P0,8), pw1[1]=PKW(P0,10), pw1); \
    VRD(5); SBAR(); GAPA(C1=__builtin_amdgcn_mfma_f32_32x32x16_bf16(kf[3],qr[1],C1,0,0,0),   P0[14],P0[15],P1[0],P1[1],   pw1[2]=PKW(P0,12),pw1[3]=PKW(P0,14), pw1); \
    VRD(2); SBAR(); GAPA(C0=__builtin_amdgcn_mfma_f32_32x32x16_bf16(kf[4],qr[2],C0,0,0,0),   P1[2],P1[3],P1[4],P1[5],     pw2[0]=PKW(P1,0), pw2[1]=PKW(P1,2), pw2); \
    VRD(6); SBAR(); GAPA(C1=__builtin_amdgcn_mfma_f32_32x32x16_bf16(kf[5],qr[2],C1,0,0,0),   P1[6],P1[7],P1[8],P1[9],     pw2[2]=PKW(P1,4), pw2[3]=PKW(P1,6), pw2); \
    VRD(3); SBAR(); GAPA(C0=__builtin_amdgcn_mfma_f32_32x32x16_bf16(kf[6],qr[3],C0,0,0,0),   P1[10],P1[11],P1[12],P1[13], pw3[0]=PKW(P1,8), pw3[1]=PKW(P1,10), pw3); \
    VRD(7); SBAR(); GAPA(C1=__builtin_amdgcn_mfma_f32_32x32x16_bf16(kf[7],qr[3],C1,0,0,0),   P1[14],P1[15],0.f,0.f,       pw3[2]=PKW(P1,12),pw3[3]=PKW(P1,14), pw3); \
    l_reg+=sacc; \
    if(GK){DMA_K((t)+3,sl_cur);} if(GV){DMA_V((t)+1,sl_next);} \
    CMASK(C0,C1,t); \
    SBAR(); \
    GAPB(o[0]=__builtin_amdgcn_mfma_f32_32x32x16_bf16(PAF(0),VFR(0),o[0],0,0,0), C0,0); \
    GAPB(o[1]=__builtin_amdgcn_mfma_f32_32x32x16_bf16(PAF(0),VFR(4),o[1],0,0,0), C0,4); \
    KRD(GL,0); GAPB(o[0]=__builtin_amdgcn_mfma_f32_32x32x16_bf16(PAF(1),VFR(1),o[0],0,0,0), C0,8); \
    KRD(GL,1); GAPB(o[1]=__builtin_amdgcn_mfma_f32_32x32x16_bf16(PAF(1),VFR(5),o[1],0,0,0), C0,12); \
    KRD(GL,2); GAPB(o[0]=__builtin_amdgcn_mfma_f32_32x32x16_bf16(PAF(2),VFR(2),o[0],0,0,0), C1,0); \
    KRD(GL,3); GAPB(o[1]=__builtin_amdgcn_mfma_f32_32x32x16_bf16(PAF(2),VFR(6),o[1],0,0,0), C1,4); \
    GAPB(o[0]=__builtin_amdgcn_mfma_f32_32x32x16_bf16(PAF(3),VFR(3),o[0],0,0,0), C1,8); \
    GAPB(o[1]=__builtin_amdgcn_mfma_f32_32x32x16_bf16(PAF(3),VFR(7),o[1],0,0,0), C1,12); \
    }while(0)
  int t=1;
  #undef CMASK
  #define CMASK(P0,P1,t) do{ if(MOBA) bmask(P0,P1,(selm>>((t)>>2))&1u); }while(0)
  for(;t+5<NT;t+=2){
    STEP(pB0,pB1,pA0,pA1,t,true,true,true);     WAIT_BAR(2); RESC(); ROT();
    STEP(pA0,pA1,pB0,pB1,t+1,true,true,true);   WAIT_BAR(2); RESC(); ROT();
  }
  #undef CMASK
  #define CMASK(P0,P1,t) do{int jb_=(t)-(NT-4); if(jb_>=0)cmask(P0,P1,jb_,qrel,hi); else if(MOBA) bmask(P0,P1,(selm>>((t)>>2))&1u);}while(0)
  #define ENDW(tt) do{ if((tt)+3<NT){WAIT_BAR(2);} else if((tt)+2<NT){WAIT_BAR(1);} else {WAIT_BAR(0);} }while(0)
  for(;t+1<NT;t+=2){
    STEP(pB0,pB1,pA0,pA1,t,(t+3<NT),(t+1<NT),(t+1<NT));       ENDW(t);   RESC(); ROT();
    STEP(pA0,pA1,pB0,pB1,t+1,(t+4<NT),(t+2<NT),(t+2<NT));     ENDW(t+1); RESC(); ROT();
  }
  STEP(pB0,pB1,pA0,pA1,NT-1,false,false,false); RESC();
  { float sacc=pB0[0]+pB0[1]; _Pragma("unroll") for(int r=2;r<16;++r)sacc+=pB0[r]; _Pragma("unroll") for(int r=0;r<16;++r)sacc+=pB1[r]; l_reg+=sacc;
    pw0=(u32x4){PKW(pB0,0),PKW(pB0,2),PKW(pB0,4),PKW(pB0,6)};pw1=(u32x4){PKW(pB0,8),PKW(pB0,10),PKW(pB0,12),PKW(pB0,14)};pw2=(u32x4){PKW(pB1,0),PKW(pB1,2),PKW(pB1,4),PKW(pB1,6)};pw3=(u32x4){PKW(pB1,8),PKW(pB1,10),PKW(pB1,12),PKW(pB1,14)};
    SBAR(); pv(o,vb0+sl_cur,PAF(0),PAF(1),PAF(2),PAF(3)); }
  #undef PKW
  #undef PAF
  #undef VFR
  #undef PIN
  #undef MX3
  #undef GAPA
  #undef GAPB
  #undef EX
  #undef VRD
  #undef KRD
  #undef STEP
  #undef ENDW
  {auto rr=__builtin_amdgcn_permlane32_swap(__float_as_uint(l_reg),__float_as_uint(l_reg),false,false);l_reg=__uint_as_float(rr[0])+__uint_as_float(rr[1]);}
  if(hi==0)wsf[32+r32]=l_reg;asm volatile("s_waitcnt lgkmcnt(0)":::"memory");
  float rli[16];
  #pragma unroll
  for(int r=0;r<16;++r)rli[r]=__builtin_amdgcn_rcpf(wsf[32+crow(r,hi)]);
  bf16*Ow=Ou+(long)(wid*QBLK)*PO;
  { bf16*stg=(bf16*)(shm+LDS_OST)+wid*2048;
    #pragma unroll
    for(int r=0;r<16;++r){const int orow=crow(r,hi);
      #pragma unroll
      for(int d0=0;d0<2;++d0)stg[orow*64+d0*32+r32]=__float2bfloat16(o[d0][r]*rli[r]);}
    asm volatile("s_waitcnt lgkmcnt(0)":::"memory");
    #pragma unroll
    for(int i=0;i<4;++i){const int row=i*8+(lane>>3),ch=lane&7; u32x4 v=*(const u32x4*)(stg+row*64+ch*8);
      if(MOBA){ float f[8]; float ss=0.f;
        #pragma unroll
        for(int e=0;e<4;++e){ f[2*e]=__uint_as_float(v[e]<<16); f[2*e+1]=__uint_as_float(v[e]&0xffff0000u); ss+=f[2*e]*f[2*e]+f[2*e+1]*f[2*e+1]; }
        ss+=__shfl_xor(ss,1); ss+=__shfl_xor(ss,2); ss+=__shfl_xor(ss,4);
        const float rs=__builtin_amdgcn_rsqf(ss*(1.0f/64.0f)+1e-6f);
        const float4 g0=*reinterpret_cast<const float4*>(gm+ch*8), g1=*reinterpret_cast<const float4*>(gm+ch*8+4);
        v[0]=cvtpk_s(f[0]*rs*g0.x,f[1]*rs*g0.y); v[1]=cvtpk_s(f[2]*rs*g0.z,f[3]*rs*g0.w); v[2]=cvtpk_s(f[4]*rs*g1.x,f[5]*rs*g1.y); v[3]=cvtpk_s(f[6]*rs*g1.z,f[7]*rs*g1.w); }
      ATTN_STORE16(Ow+(long)row*PO+ch*8,v);} }
  asm volatile("s_waitcnt lgkmcnt(0)\n\ts_barrier":::"memory");
  #undef DMA_K
  #undef DMA_V
  #undef CMASK
  #undef START
  #undef RESC
  #undef ROT
}
constexpr int ATTN_LDS_BYTES=LDS_BYTES;
#undef SBAR
#undef WAIT_BAR
}
typedef unsigned short bf16;
constexpr int T = 65536, DM = 1024, SEQ = 2048, NB = 32;
constexpr size_t MiB = 1u << 20;
constexpr size_t WS_CTL = 0, WS_KMEAN = 1 * MiB, WS_ZERO_BYTES = 2 * MiB;
constexpr size_t WS_ROPE = 2 * MiB, WS_SCAL = 3 * MiB;
constexpr size_t WS_WIN = 4 * MiB, WS_WOUT = 10 * MiB, WS_WQ = 12 * MiB, WS_SUBK = 16 * MiB;
constexpr size_t WS_SS = 20 * MiB, WS_RS = 26 * MiB;
constexpr size_t WS_DOWN = 32 * MiB, WS_UP = 64 * MiB, WS_XN = 96 * MiB;
constexpr size_t WS_QKV = 224 * MiB, QKV_STRIDE = 64 * MiB;
constexpr size_t WS_PQ = 224 * MiB;
constexpr size_t WS_MIXED = 608 * MiB, WS_DO = 736 * MiB, WS_IDS = 864 * MiB, WS_GATES = 896 * MiB, WS_END = 928 * MiB;
constexpr size_t QKV_ELEMS = QKV_STRIDE / 2;
constexpr float QSCALE = 0.125f * 1.4426950408889634f;
constexpr float EPS = 1e-6f;

__device__ __forceinline__ unsigned f2bf(float f) { unsigned u = __float_as_uint(f); return (u + 0x7fffu + ((u >> 16) & 1u)) >> 16; }
__device__ __forceinline__ float bf2f(unsigned h) { return __uint_as_float(h << 16); }
__device__ __forceinline__ float wave_sum(float v) {
#pragma unroll
    for (int o = 1; o < 64; o <<= 1) v += __shfl_xor(v, o);
    return v;
}

#ifndef LAS
#define LAS __attribute__((address_space(3)))
#endif
#define GAS __attribute__((address_space(1)))
typedef GAS unsigned gu32;
#define XB_TMO      128
#define XB_XCNT(j)  (256  + 64 * (j))
#define XB_XSUB(j)  (1280 + 64 * (j))
#define XB_XGEN(j)  (2304 + 64 * (j))
#define XB_TOP      3328
#define XB_TOPGEN   3392
#define XCD_BAR_WORDS 3456
#define XB_SPIN_CAP (1u << 18)

__device__ __forceinline__ unsigned xb_ld(unsigned* p)              { return __hip_atomic_load(p, __ATOMIC_RELAXED, __HIP_MEMORY_SCOPE_AGENT); }
__device__ __forceinline__ unsigned xb_add(unsigned* p, unsigned v) { return __hip_atomic_fetch_add(p, v, __ATOMIC_RELAXED, __HIP_MEMORY_SCOPE_AGENT); }
__device__ __forceinline__ unsigned xb_xcc_id() { return (unsigned)__builtin_amdgcn_s_getreg((3 << 11) | 20) & 0xFu; }
#define XB_SPIN(cond, bar) do { unsigned _sp = 0; while (cond) { __builtin_amdgcn_s_sleep(1); \
    if ((++_sp & 255u) == 0u) { if (xb_ld(&(bar)[XB_TMO])) break; if (_sp > XB_SPIN_CAP) { atomicAdd(&(bar)[XB_TMO], 1u); break; } } } } while (0)

struct XcdBarrier {
    unsigned* bar; unsigned x;
    volatile LAS unsigned* st;
};

__device__ __forceinline__ XcdBarrier xcd_barrier_post(unsigned* bar, volatile LAS unsigned* st) {
    XcdBarrier b; b.bar = bar; b.x = xb_xcc_id(); b.st = st;
    if (threadIdx.x == 0) (void)xb_add(&bar[XB_XCNT(b.x)], 1u);
    return b;
}
__device__ __forceinline__ void xcd_barrier_complete(unsigned* bar, unsigned x, unsigned& nloc, unsigned& nx) {
    const unsigned G = gridDim.x * gridDim.y * gridDim.z;
    unsigned sum, cnt, mine, sp = 0u;
    for (;;) {
        sum = 0u; cnt = 0u; mine = 0u;
#pragma unroll
        for (unsigned j = 0; j < 16; ++j) { const unsigned c = xb_ld(&bar[XB_XCNT(j)]); sum += c; cnt += (c > 0u) ? 1u : 0u; mine = (j == x) ? c : mine; }
        if (sum == G) break;
        __builtin_amdgcn_s_sleep(1);
        if ((++sp & 255u) == 0u) { if (xb_ld(&bar[XB_TMO])) break; if (sp > XB_SPIN_CAP) { atomicAdd(&bar[XB_TMO], 1u); break; } }
    }
    nloc = mine > 0u ? mine : 1u; nx = cnt > 0u ? cnt : 1u;
}

__device__ __forceinline__ void xcd_barrier(const XcdBarrier& b) {
    asm volatile("s_waitcnt vmcnt(0)" ::: "memory");
    __syncthreads();
    if (threadIdx.x == 0) {
        unsigned* bar = b.bar;
        __builtin_amdgcn_s_waitcnt(0);
        unsigned nloc = b.st[0], nx = b.st[1];
        if (nloc == 0u) { xcd_barrier_complete(bar, b.x, nloc, nx); b.st[0] = nloc; b.st[1] = nx; }
        const unsigned old = xb_add(&bar[XB_XSUB(b.x)], 1u);
        const unsigned gen = old / nloc;
        if (old + 1u == (gen + 1u) * nloc) {
            __builtin_amdgcn_fence(__ATOMIC_RELEASE, "agent");
            asm volatile("s_waitcnt vmcnt(0)" ::: "memory");
            const unsigned og = xb_add(&bar[XB_TOP], 1u);
            const unsigned tg = og / nx;
            if (og + 1u == (tg + 1u) * nx) xb_add(&bar[XB_TOPGEN], 1u);
            else XB_SPIN(xb_ld(&bar[XB_TOPGEN]) == tg, bar);
            __builtin_amdgcn_fence(__ATOMIC_ACQUIRE, "agent");
            xb_add(&bar[XB_XGEN(b.x)], 1u);
            asm volatile("s_waitcnt vmcnt(0)" ::: "memory");
        } else {
            XB_SPIN(xb_ld(&bar[XB_XGEN(b.x)]) == gen, bar);
            __builtin_amdgcn_fence(__ATOMIC_ACQUIRE, "agent");
            asm volatile("s_waitcnt vmcnt(0)" ::: "memory");
        }
    }
    __syncthreads();
}
#ifndef LAS
#define LAS __attribute__((address_space(3)))
#endif
constexpr int NTHR = 512, NWAVE = 8;
constexpr int LDS_BYTES = 147456;

struct Params {
    const float* in[19]; float* out; unsigned char* ws;
};

template <bool HEADPERM> __device__ __forceinline__ void ph_transpose(const float* __restrict__ W, int K, int N, bf16* __restrict__ WT, float* tiles, int wg, int nwg, int tid, const float* __restrict__ kgain = nullptr) {
    float (*tile)[33] = (float (*)[33])(tiles + (tid >> 8) * (32 * 33));
    const int nt_n = N / 32, nitems = nt_n * (K / 32), tx = tid & 31, ty = (tid & 255) >> 5;
    for (int it0 = wg * 2; it0 < nitems; it0 += nwg * 2) {
        const int it = it0 + (tid >> 8); const bool act = it < nitems;
        const int n0 = (it % nt_n) * 32, k0 = (it / nt_n) * 32;
        if (act) for (int i = ty; i < 32; i += 8) tile[i][tx] = W[(size_t)(k0 + i) * N + n0 + tx];
        __syncthreads();
        if (act) for (int i = ty; i < 32; i += 8) { int nn = n0 + i; if (HEADPERM) nn = (nn & ~255) | (((nn >> 5) & 1) << 7) | (((nn >> 6) & 3) << 5) | (nn & 31);
            WT[(size_t)nn * K + k0 + tx] = (bf16)f2bf(tile[tx][i] * (kgain ? kgain[k0 + tx] : 1.0f)); }
        __syncthreads();
    }
}
__device__ __forceinline__ void ph_convert(const float* __restrict__ src, bf16* __restrict__ dst, size_t n4, int wg, int nwg, int tid) {
    for (size_t i = (size_t)wg * NTHR + tid; i < n4; i += (size_t)nwg * NTHR) {
        const float4 v = ((const float4*)src)[i];
        uint2 o; o.x = f2bf(v.x) | (f2bf(v.y) << 16); o.y = f2bf(v.z) | (f2bf(v.w) << 16);
        ((uint2*)dst)[i] = o;
    }
}
__device__ __forceinline__ void ph_rope(float* __restrict__ rope, int wg, int nwg, int tid) {
    for (int i = wg * NTHR + tid; i < SEQ * 32; i += nwg * NTHR) {
        const int pos = i >> 5, j = i & 31;
        const float inv = 1.0f / exp2f((float)j * (13.287712379549449f / 32.0f));
        const float ang = (float)pos * inv;
        double rev = (double)ang * 0.15915494309189535; rev -= floor(rev);
        rope[i] = __builtin_amdgcn_cosf((float)rev); rope[SEQ * 32 + i] = __builtin_amdgcn_sinf((float)rev);
    }
}
__device__ __forceinline__ void ph_rmsnorm(const float* __restrict__ x, const float* __restrict__ g, bf16* __restrict__ out, int rows, int wg, int nwg, int tid) {
    const int lane = tid & 63, nw = nwg * NWAVE;
    for (int r = wg * NWAVE + (tid >> 6); r < rows; r += nw) {
        const float4* xr = (const float4*)(x + (size_t)r * DM) + lane;
        float4 v[4]; float s = 0.f;
#pragma unroll
        for (int j = 0; j < 4; ++j) { v[j] = xr[64 * j]; s += (v[j].x * v[j].x + v[j].y * v[j].y) + (v[j].z * v[j].z + v[j].w * v[j].w); }
        const float rs = rsqrtf(wave_sum(s) * (1.0f / DM) + EPS);
        uint2* o = (uint2*)(out + (size_t)r * DM) + lane;
#pragma unroll
        for (int j = 0; j < 4; ++j) { const float4 gg = ((const float4*)g)[lane + 64 * j];
            uint2 w; w.x = f2bf(v[j].x * rs * gg.x) | (f2bf(v[j].y * rs * gg.y) << 16); w.y = f2bf(v[j].z * rs * gg.z) | (f2bf(v[j].w * rs * gg.w) << 16);
            o[64 * j] = w; }
    }
}
__device__ __forceinline__ void ph_qk_post(bf16* __restrict__ qkv, const float* __restrict__ rope, const float* __restrict__ gqm, const float* __restrict__ gkm,
                                           const float* __restrict__ gqd, const float* __restrict__ gkd, float* __restrict__ kmean, int wg, int nwg, int tid) {
    const int lane = tid & 63, half = lane >> 5, j = lane & 31, wv = tid >> 6;
    for (int blk = wg; blk < T / 256; blk += nwg) {
        float ks[4][2];
#pragma unroll
        for (int a = 0; a < 4; ++a) { ks[a][0] = 0.f; ks[a][1] = 0.f; }
        for (int tt = wv; tt < 256; tt += NWAVE) {
            const int t = blk * 256 + tt, pos = t & (SEQ - 1);
            const float c = rope[pos * 32 + j], sn = rope[SEQ * 32 + pos * 32 + j];
#pragma unroll
            for (int it = 0; it < 16; ++it) {
                const int s = it * 2 + half, type = it >> 2, hs = s & 7;
                bf16* buf = qkv + (size_t)(type < 2 ? type : type + 1) * QKV_ELEMS + (size_t)t * 512 + hs * 64;
                const float x1 = bf2f(buf[j]), x2 = bf2f(buf[j + 32]);
                float ss = x1 * x1 + x2 * x2;
#pragma unroll
                for (int o = 1; o < 32; o <<= 1) ss += __shfl_xor(ss, o);
                const float rs = rsqrtf(ss * (1.0f / 64.0f) + EPS);
                const float* g = type == 0 ? gqm : type == 1 ? gkm : type == 2 ? gqd + (hs & 1) * 64 : gkd + (hs & 1) * 64;
                const float y1 = x1 * rs * g[j], y2 = x2 * rs * g[j + 32];
                float o1 = y1 * c - y2 * sn, o2 = y2 * c + y1 * sn;
                if (type == 0 || type == 2) { o1 *= QSCALE; o2 *= QSCALE; }
                if (type == 1) { ks[it - 4][0] += o1; ks[it - 4][1] += o2; }
                buf[j] = (bf16)f2bf(o1); buf[j + 32] = (bf16)f2bf(o2);
            }
        }
        const int b = blk >> 3, nb = blk & 7;
#pragma unroll
        for (int a = 0; a < 4; ++a) { const int h = a * 2 + half; float* km = kmean + (((size_t)b * 8 + h) * 8 + nb) * 64;
            atomicAdd(km + j, ks[a][0] * (1.0f / 256.0f)); atomicAdd(km + j + 32, ks[a][1] * (1.0f / 256.0f)); }
    }
}
__device__ __forceinline__ void ph_diff_combine(const bf16* __restrict__ dob, float lam, const float* __restrict__ gain_d, bf16* __restrict__ mixed, int wg, int nwg, int tid) {
    const int lane = tid & 63, nw = nwg * NWAVE;
    for (int w = wg * NWAVE + (tid >> 6); w < T * 4; w += nw) {
        const int t = w >> 2, h = w & 3; const bf16* p = dob + (size_t)t * 1024 + h * 256;
        const float da = bf2f(p[lane]) - lam * bf2f(p[128 + lane]), db = bf2f(p[64 + lane]) - lam * bf2f(p[192 + lane]);
        const float rs = rsqrtf(wave_sum(da * da + db * db) * (1.0f / 128.0f) + EPS) * 0.8f;
        bf16* o = mixed + (size_t)t * 1024 + 512 + h * 128;
        o[lane] = (bf16)f2bf(da * rs * gain_d[h * 128 + lane]); o[64 + lane] = (bf16)f2bf(db * rs * gain_d[h * 128 + 64 + lane]);
    }
}
typedef float rf32x16 __attribute__((ext_vector_type(16)));
typedef short rbf16x8 __attribute__((ext_vector_type(8)));
__device__ __forceinline__ unsigned umax_(unsigned a, unsigned b) { return a > b ? a : b; }
__device__ __forceinline__ unsigned umin_(unsigned a, unsigned b) { return a > b ? b : a; }
#define CE_D(x, y) { const unsigned mx_ = umax_(x, y), mn_ = umin_(x, y); x = mx_; y = mn_; }
__device__ __forceinline__ void sort16_desc(unsigned (&v)[16]) {
    CE_D(v[0], v[1]) CE_D(v[3], v[2]) CE_D(v[4], v[5]) CE_D(v[7], v[6]) CE_D(v[8], v[9]) CE_D(v[11], v[10]) CE_D(v[12], v[13]) CE_D(v[15], v[14])
    CE_D(v[0], v[2]) CE_D(v[1], v[3]) CE_D(v[6], v[4]) CE_D(v[7], v[5]) CE_D(v[8], v[10]) CE_D(v[9], v[11]) CE_D(v[14], v[12]) CE_D(v[15], v[13])
    CE_D(v[0], v[1]) CE_D(v[2], v[3]) CE_D(v[5], v[4]) CE_D(v[7], v[6]) CE_D(v[8], v[9]) CE_D(v[10], v[11]) CE_D(v[13], v[12]) CE_D(v[15], v[14])
    CE_D(v[0], v[4]) CE_D(v[1], v[5]) CE_D(v[2], v[6]) CE_D(v[3], v[7]) CE_D(v[12], v[8]) CE_D(v[13], v[9]) CE_D(v[14], v[10]) CE_D(v[15], v[11])
    CE_D(v[0], v[2]) CE_D(v[1], v[3]) CE_D(v[4], v[6]) CE_D(v[5], v[7]) CE_D(v[10], v[8]) CE_D(v[11], v[9]) CE_D(v[14], v[12]) CE_D(v[15], v[13])
    CE_D(v[0], v[1]) CE_D(v[2], v[3]) CE_D(v[4], v[5]) CE_D(v[6], v[7]) CE_D(v[9], v[8]) CE_D(v[11], v[10]) CE_D(v[13], v[12]) CE_D(v[15], v[14])
    CE_D(v[0], v[8]) CE_D(v[1], v[9]) CE_D(v[2], v[10]) CE_D(v[3], v[11]) CE_D(v[4], v[12]) CE_D(v[5], v[13]) CE_D(v[6], v[14]) CE_D(v[7], v[15])
    CE_D(v[0], v[4]) CE_D(v[1], v[5]) CE_D(v[2], v[6]) CE_D(v[3], v[7]) CE_D(v[8], v[12]) CE_D(v[9], v[13]) CE_D(v[10], v[14]) CE_D(v[11], v[15])
    CE_D(v[0], v[2]) CE_D(v[1], v[3]) CE_D(v[4], v[6]) CE_D(v[5], v[7]) CE_D(v[8], v[10]) CE_D(v[9], v[11]) CE_D(v[12], v[14]) CE_D(v[13], v[15])
    CE_D(v[0], v[1]) CE_D(v[2], v[3]) CE_D(v[4], v[5]) CE_D(v[6], v[7]) CE_D(v[8], v[9]) CE_D(v[10], v[11]) CE_D(v[12], v[13]) CE_D(v[14], v[15])
}
__device__ __forceinline__ void merge16_desc(unsigned (&a)[16], const unsigned (&b)[16]) {
    a[0] = umax_(a[0], b[15]); a[1] = umax_(a[1], b[14]); a[2] = umax_(a[2], b[13]); a[3] = umax_(a[3], b[12]); a[4] = umax_(a[4], b[11]); a[5] = umax_(a[5], b[10]); a[6] = umax_(a[6], b[9]); a[7] = umax_(a[7], b[8]); a[8] = umax_(a[8], b[7]); a[9] = umax_(a[9], b[6]); a[10] = umax_(a[10], b[5]); a[11] = umax_(a[11], b[4]); a[12] = umax_(a[12], b[3]); a[13] = umax_(a[13], b[2]); a[14] = umax_(a[14], b[1]); a[15] = umax_(a[15], b[0]);
    CE_D(a[0], a[8]) CE_D(a[1], a[9]) CE_D(a[2], a[10]) CE_D(a[3], a[11]) CE_D(a[4], a[12]) CE_D(a[5], a[13]) CE_D(a[6], a[14]) CE_D(a[7], a[15])
    CE_D(a[0], a[4]) CE_D(a[1], a[5]) CE_D(a[2], a[6]) CE_D(a[3], a[7]) CE_D(a[8], a[12]) CE_D(a[9], a[13]) CE_D(a[10], a[14]) CE_D(a[11], a[15])
    CE_D(a[0], a[2]) CE_D(a[1], a[3]) CE_D(a[4], a[6]) CE_D(a[5], a[7]) CE_D(a[8], a[10]) CE_D(a[9], a[11]) CE_D(a[12], a[14]) CE_D(a[13], a[15])
    CE_D(a[0], a[1]) CE_D(a[2], a[3]) CE_D(a[4], a[5]) CE_D(a[6], a[7]) CE_D(a[8], a[9]) CE_D(a[10], a[11]) CE_D(a[12], a[13]) CE_D(a[14], a[15])
}
__device__ __forceinline__ void top16_of_64(unsigned (&G)[4][16]) {
    sort16_desc(G[0]); sort16_desc(G[1]); sort16_desc(G[2]); sort16_desc(G[3]);
    merge16_desc(G[0], G[1]); merge16_desc(G[2], G[3]); merge16_desc(G[0], G[2]);
}
__device__ __forceinline__ void route_scores(unsigned (&Lp)[16], const rbf16x8 (&bq)[8], const LAS unsigned char* kfr, int lane, int hi) {
    unsigned G[4][16]; unsigned hmask = hi ? ~4u : ~0u; asm volatile("" : "+v"(hmask));
#pragma unroll
    for (int nb = 0; nb < 4; ++nb) {
        rf32x16 acc = rf32x16{};
#pragma unroll
        for (int s = 0; s < 8; ++s) { const rbf16x8 a = *(const LAS rbf16x8*)(kfr + (nb * 8 + s) * 1024 + lane * 16); acc = __builtin_amdgcn_mfma_f32_32x32x16_bf16(a, bq[s], acc, 0, 0, 0); }
#pragma unroll
        for (int i = 0; i < 16; ++i) { const float v = fmaxf(acc[i] + 16.0f, 0.0f); const int n = nb * 32 + (i & 3) + 8 * (i >> 2);
            G[nb][i] = ((__float_as_uint(v) & ~127u) | (unsigned)(127 - n)) & hmask; }
        asm volatile("" ::: "memory"); __builtin_amdgcn_sched_barrier(0);
    }
    top16_of_64(G);
    unsigned O[16];
#pragma unroll
    for (int i = 0; i < 16; ++i) { auto rr = __builtin_amdgcn_permlane32_swap(G[0][i], G[0][i], false, false); O[i] = hi ? rr[0] : rr[1]; }
    merge16_desc(G[0], O);
#pragma unroll
    for (int i = 0; i < 16; ++i) Lp[i] = G[0][i];
    asm volatile("" ::: "memory"); __builtin_amdgcn_sched_barrier(0);
}
__device__ __forceinline__ void route_loadq(rbf16x8 (&bq)[8], const bf16* __restrict__ PQ, int tb, int hp, int lane) {
    const bf16* qp = PQ + (((size_t)tb * 16 + hp) * 8 * 64 + lane) * 8;
#pragma unroll
    for (int s = 0; s < 8; ++s) bq[s] = *(const rbf16x8*)(qp + s * 512);
}
__device__ __forceinline__ void route_loadk(pg8::u32x4 (&kr)[8], const bf16* __restrict__ subk, int h, int tid) {
#pragma unroll
    for (int i = 0; i < 8; ++i) { const int e = i * NTHR + tid, f = e >> 6, l2 = e & 63;
        kr[i] = *(const pg8::u32x4*)(subk + ((size_t)(h * 2 + (f >> 5)) * 128 + ((f >> 3) & 3) * 32 + (l2 & 31)) * 128 + 16 * (f & 7) + 8 * (l2 >> 5)); }
}
__device__ __forceinline__ void ph_peer_route(const bf16* __restrict__ PQ, const bf16* __restrict__ subk, int* __restrict__ ids, float* __restrict__ gates, LAS unsigned char* lds3, int wg, int nwg, int tid) {
    const int lane = tid & 63, r = lane & 31, hi = lane >> 5, wv = tid >> 6;
    LAS unsigned* myl = (LAS unsigned*)(lds3 + 65536) + wv * 2048;
    for (int tb0 = wg * NWAVE; tb0 < T / 32; tb0 += nwg * NWAVE) {
        const int tb = tb0 + wv; const bool live = tb < T / 32; const int t = (live ? tb : 0) * 32 + r;
        rbf16x8 bqA[8], bqB[8];
        route_loadq(bqA, PQ, live ? tb : 0, 0, lane);
        for (int h = 0; h < 8; ++h) {
            __syncthreads();
            { pg8::u32x4 kr[8]; route_loadk(kr, subk, h, tid);
#pragma unroll
              for (int i = 0; i < 8; ++i) *(LAS pg8::u32x4*)(lds3 + (i * NTHR + tid) * 16) = kr[i]; }
            __syncthreads();
            unsigned L[2][16];
            route_loadq(bqB, PQ, live ? tb : 0, h * 2 + 1, lane);
            route_scores(L[0], bqA, lds3, lane, hi);
            if (h < 7) route_loadq(bqA, PQ, live ? tb : 0, h * 2 + 2, lane);
            route_scores(L[1], bqB, lds3 + 32768, lane, hi);
#pragma unroll
            for (int i = 0; i < 16; ++i) { myl[i * 64 + lane] = 127u - (L[0][i] & 127u); myl[(16 + i) * 64 + lane] = 127u - (L[1][i] & 127u); }
            float fa[16], fb[16];
#pragma unroll
            for (int i = 0; i < 16; ++i) { fa[i] = __uint_as_float(L[0][i] & ~127u); fb[i] = __uint_as_float(L[1][i] & ~127u); }
            unsigned C[4][16];
            C[0][0] = (__float_as_uint(fmaxf(fa[0] + fb[0] - 24.0f, 0.0f)) & ~255u) | 255u;
            C[0][1] = (__float_as_uint(fmaxf(fa[0] + fb[1] - 24.0f, 0.0f)) & ~255u) | 254u;
            C[0][2] = (__float_as_uint(fmaxf(fa[0] + fb[2] - 24.0f, 0.0f)) & ~255u) | 253u;
            C[0][3] = (__float_as_uint(fmaxf(fa[0] + fb[3] - 24.0f, 0.0f)) & ~255u) | 252u;
            C[0][4] = (__float_as_uint(fmaxf(fa[0] + fb[4] - 24.0f, 0.0f)) & ~255u) | 251u;
            C[0][5] = (__float_as_uint(fmaxf(fa[0] + fb[5] - 24.0f, 0.0f)) & ~255u) | 250u;
            C[0][6] = (__float_as_uint(fmaxf(fa[0] + fb[6] - 24.0f, 0.0f)) & ~255u) | 249u;
            C[0][7] = (__float_as_uint(fmaxf(fa[0] + fb[7] - 24.0f, 0.0f)) & ~255u) | 248u;
            C[0][8] = (__float_as_uint(fmaxf(fa[0] + fb[8] - 24.0f, 0.0f)) & ~255u) | 247u;
            C[0][9] = (__float_as_uint(fmaxf(fa[0] + fb[9] - 24.0f, 0.0f)) & ~255u) | 246u;
            C[0][10] = (__float_as_uint(fmaxf(fa[0] + fb[10] - 24.0f, 0.0f)) & ~255u) | 245u;
            C[0][11] = (__float_as_uint(fmaxf(fa[0] + fb[11] - 24.0f, 0.0f)) & ~255u) | 244u;
            C[0][12] = (__float_as_uint(fmaxf(fa[0] + fb[12] - 24.0f, 0.0f)) & ~255u) | 243u;
            C[0][13] = (__float_as_uint(fmaxf(fa[0] + fb[13] - 24.0f, 0.0f)) & ~255u) | 242u;
            C[0][14] = (__float_as_uint(fmaxf(fa[0] + fb[14] - 24.0f, 0.0f)) & ~255u) | 241u;
            C[0][15] = (__float_as_uint(fmaxf(fa[0] + fb[15] - 24.0f, 0.0f)) & ~255u) | 240u;
            C[1][0] = (__float_as_uint(fmaxf(fa[1] + fb[0] - 24.0f, 0.0f)) & ~255u) | 239u;
            C[1][1] = (__float_as_uint(fmaxf(fa[1] + fb[1] - 24.0f, 0.0f)) & ~255u) | 238u;
            C[1][2] = (__float_as_uint(fmaxf(fa[1] + fb[2] - 24.0f, 0.0f)) & ~255u) | 237u;
            C[1][3] = (__float_as_uint(fmaxf(fa[1] + fb[3] - 24.0f, 0.0f)) & ~255u) | 236u;
            C[1][4] = (__float_as_uint(fmaxf(fa[1] + fb[4] - 24.0f, 0.0f)) & ~255u) | 235u;
            C[1][5] = (__float_as_uint(fmaxf(fa[1] + fb[5] - 24.0f, 0.0f)) & ~255u) | 234u;
            C[1][6] = (__float_as_uint(fmaxf(fa[1] + fb[6] - 24.0f, 0.0f)) & ~255u) | 233u;
            C[1][7] = (__float_as_uint(fmaxf(fa[1] + fb[7] - 24.0f, 0.0f)) & ~255u) | 232u;
            C[1][8] = (__float_as_uint(fmaxf(fa[2] + fb[0] - 24.0f, 0.0f)) & ~255u) | 223u;
            C[1][9] = (__float_as_uint(fmaxf(fa[2] + fb[1] - 24.0f, 0.0f)) & ~255u) | 222u;
            C[1][10] = (__float_as_uint(fmaxf(fa[2] + fb[2] - 24.0f, 0.0f)) & ~255u) | 221u;
            C[1][11] = (__float_as_uint(fmaxf(fa[2] + fb[3] - 24.0f, 0.0f)) & ~255u) | 220u;
            C[1][12] = (__float_as_uint(fmaxf(fa[2] + fb[4] - 24.0f, 0.0f)) & ~255u) | 219u;
            C[1][13] = (__float_as_uint(fmaxf(fa[3] + fb[0] - 24.0f, 0.0f)) & ~255u) | 207u;
            C[1][14] = (__float_as_uint(fmaxf(fa[3] + fb[1] - 24.0f, 0.0f)) & ~255u) | 206u;
            C[1][15] = (__float_as_uint(fmaxf(fa[3] + fb[2] - 24.0f, 0.0f)) & ~255u) | 205u;
            C[2][0] = (__float_as_uint(fmaxf(fa[3] + fb[3] - 24.0f, 0.0f)) & ~255u) | 204u;
            C[2][1] = (__float_as_uint(fmaxf(fa[4] + fb[0] - 24.0f, 0.0f)) & ~255u) | 191u;
            C[2][2] = (__float_as_uint(fmaxf(fa[4] + fb[1] - 24.0f, 0.0f)) & ~255u) | 190u;
            C[2][3] = (__float_as_uint(fmaxf(fa[4] + fb[2] - 24.0f, 0.0f)) & ~255u) | 189u;
            C[2][4] = (__float_as_uint(fmaxf(fa[5] + fb[0] - 24.0f, 0.0f)) & ~255u) | 175u;
            C[2][5] = (__float_as_uint(fmaxf(fa[5] + fb[1] - 24.0f, 0.0f)) & ~255u) | 174u;
            C[2][6] = (__float_as_uint(fmaxf(fa[6] + fb[0] - 24.0f, 0.0f)) & ~255u) | 159u;
            C[2][7] = (__float_as_uint(fmaxf(fa[6] + fb[1] - 24.0f, 0.0f)) & ~255u) | 158u;
            C[2][8] = (__float_as_uint(fmaxf(fa[7] + fb[0] - 24.0f, 0.0f)) & ~255u) | 143u;
            C[2][9] = (__float_as_uint(fmaxf(fa[7] + fb[1] - 24.0f, 0.0f)) & ~255u) | 142u;
            C[2][10] = (__float_as_uint(fmaxf(fa[8] + fb[0] - 24.0f, 0.0f)) & ~255u) | 127u;
            C[2][11] = (__float_as_uint(fmaxf(fa[9] + fb[0] - 24.0f, 0.0f)) & ~255u) | 111u;
            C[2][12] = (__float_as_uint(fmaxf(fa[10] + fb[0] - 24.0f, 0.0f)) & ~255u) | 95u;
            C[2][13] = (__float_as_uint(fmaxf(fa[11] + fb[0] - 24.0f, 0.0f)) & ~255u) | 79u;
            C[2][14] = (__float_as_uint(fmaxf(fa[12] + fb[0] - 24.0f, 0.0f)) & ~255u) | 63u;
            C[2][15] = (__float_as_uint(fmaxf(fa[13] + fb[0] - 24.0f, 0.0f)) & ~255u) | 47u;
            C[3][0] = (__float_as_uint(fmaxf(fa[14] + fb[0] - 24.0f, 0.0f)) & ~255u) | 31u;
            C[3][1] = (__float_as_uint(fmaxf(fa[15] + fb[0] - 24.0f, 0.0f)) & ~255u) | 15u;
            C[3][2] = 0u;
            C[3][3] = 0u;
            C[3][4] = 0u;
            C[3][5] = 0u;
            C[3][6] = 0u;
            C[3][7] = 0u;
            C[3][8] = 0u;
            C[3][9] = 0u;
            C[3][10] = 0u;
            C[3][11] = 0u;
            C[3][12] = 0u;
            C[3][13] = 0u;
            C[3][14] = 0u;
            C[3][15] = 0u;
            top16_of_64(C);
            const float s0 = __uint_as_float(C[0][0] & ~255u);
            float ex[16]; float sum = 0.f; int eid[16];
#pragma unroll
            for (int k = 0; k < 16; ++k) { ex[k] = __expf(__uint_as_float(C[0][k] & ~255u) - s0); sum += ex[k];
                const unsigned code = 255u - (C[0][k] & 255u); const unsigned ia = myl[(code >> 4) * 64 + lane], ib = myl[(16 + (code & 15u)) * 64 + lane]; eid[k] = (int)(ia * 128u + ib); }
            const float inv = 1.0f / sum;
            if (live && hi == 0) { int4* dst = (int4*)(ids + (size_t)t * 128 + h * 16);
#pragma unroll
                for (int k = 0; k < 4; ++k) dst[k] = make_int4(eid[4 * k], eid[4 * k + 1], eid[4 * k + 2], eid[4 * k + 3]); }
            else if (live) { float4* dst = (float4*)(gates + (size_t)t * 128 + h * 16);
#pragma unroll
                for (int k = 0; k < 4; ++k) dst[k] = make_float4(ex[4 * k] * inv, ex[4 * k + 1] * inv, ex[4 * k + 2] * inv, ex[4 * k + 3] * inv); }
        }
    }
}
typedef __bf16 bf16x2_t __attribute__((ext_vector_type(2)));
__device__ __forceinline__ float dot2bf(unsigned a, unsigned b, float acc) { return __builtin_amdgcn_fdot2_f32_bf16(__builtin_bit_cast(bf16x2_t, a), __builtin_bit_cast(bf16x2_t, b), acc, false); }
__device__ __forceinline__ float dot8(const uint4 a, const uint4 b, float s) { s = dot2bf(a.x, b.x, s); s = dot2bf(a.y, b.y, s); s = dot2bf(a.z, b.z, s); s = dot2bf(a.w, b.w, s); return s; }
__device__ __forceinline__ float gelu_erf(float z) { return 0.5f * z * (1.0f + erff(z * 0.70710678118654752f)); }
constexpr float TSCALE = 32.0f, TINV = 1.0f / 32.0f;
typedef float f32x2g __attribute__((ext_vector_type(2)));
constexpr int GB = 4;
struct GBatch { uint4 d[GB]; uint4 u[GB]; float g[GB]; };
__device__ __forceinline__ void gb_load(GBatch& B, const int* __restrict__ idp, const float* __restrict__ gp, int e0, const unsigned char* __restrict__ down, const unsigned char* __restrict__ up, int lane) {
#pragma unroll
    for (int j = 0; j < GB; ++j) { const int id = __builtin_amdgcn_readfirstlane(idp[e0 + j]); B.g[j] = gp[e0 + j];
        B.d[j] = *(const uint4*)(down + (size_t)id * DM + lane * 16); B.u[j] = *(const uint4*)(up + (size_t)id * DM + lane * 16); }
}
__device__ __forceinline__ void unpack16(const uint4 v, f32x2g (&f)[8]) {
    f[0] = __builtin_amdgcn_cvt_pk_f32_fp8((int)v.x, false); f[1] = __builtin_amdgcn_cvt_pk_f32_fp8((int)v.x, true);
    f[2] = __builtin_amdgcn_cvt_pk_f32_fp8((int)v.y, false); f[3] = __builtin_amdgcn_cvt_pk_f32_fp8((int)v.y, true);
    f[4] = __builtin_amdgcn_cvt_pk_f32_fp8((int)v.z, false); f[5] = __builtin_amdgcn_cvt_pk_f32_fp8((int)v.z, true);
    f[6] = __builtin_amdgcn_cvt_pk_f32_fp8((int)v.w, false); f[7] = __builtin_amdgcn_cvt_pk_f32_fp8((int)v.w, true);
}
__device__ __forceinline__ void gb_compute(const GBatch& B, const f32x2g (&xf)[8], f32x2g (&acc)[8], float zscale) {
    float z[GB];
#pragma unroll
    for (int j = 0; j < GB; ++j) { f32x2g d[8]; unpack16(B.d[j], d); f32x2g s = xf[0] * d[0];
#pragma unroll
        for (int i = 1; i < 8; ++i) s = __builtin_elementwise_fma(xf[i], d[i], s);
        z[j] = s.x + s.y; }
#pragma unroll
    for (int o = 1; o < 64; o <<= 1) {
#pragma unroll
        for (int j = 0; j < GB; ++j) z[j] += __shfl_xor(z[j], o); }
#pragma unroll
    for (int j = 0; j < GB; ++j) { const float w = B.g[j] * gelu_erf(z[j] * zscale); f32x2g u[8]; unpack16(B.u[j], u); const f32x2g w2 = {w, w};
#pragma unroll
        for (int i = 0; i < 8; ++i) acc[i] = __builtin_elementwise_fma(u[i], w2, acc[i]); }
}
__device__ __forceinline__ void ph_peer_gather(const bf16* __restrict__ xn, const int* __restrict__ ids, const float* __restrict__ gates, const unsigned char* __restrict__ down, const unsigned char* __restrict__ up, const float* x1, float* outw, unsigned* ctr, int tid, const float* __restrict__ rsv) {
    const int lane = tid & 63;
    int t; { unsigned v_ = 0; if (lane == 0) v_ = atomicAdd(ctr, 1u); t = (int)__builtin_amdgcn_readfirstlane(v_); }
    while (t < T) {
        unsigned vn_ = 0; if (lane == 0) vn_ = atomicAdd(ctr, 1u);
        const int* idp = ids + (size_t)t * 128; const float* gp = gates + (size_t)t * 128;
        GBatch B0, B1, B2;
        gb_load(B0, idp, gp, 0, down, up, lane); gb_load(B1, idp, gp, GB, down, up, lane);
        f32x2g xf[8];
        { const uint4 xa = *(const uint4*)(xn + (size_t)t * DM + lane * 16), xb = *(const uint4*)(xn + (size_t)t * DM + lane * 16 + 8);
          const unsigned xw[8] = {xa.x, xa.y, xa.z, xa.w, xb.x, xb.y, xb.z, xb.w};
#pragma unroll
          for (int i = 0; i < 8; ++i) { xf[i].x = __uint_as_float(xw[i] << 16); xf[i].y = __uint_as_float(xw[i] & 0xffff0000u); } }
        const float zs = rsv[t] * TINV;
        f32x2g acc[8];
#pragma unroll
        for (int i = 0; i < 8; ++i) acc[i] = (f32x2g){0.f, 0.f};
        for (int e0 = 0; e0 + 3 * GB <= 128 - 2 * GB + GB; e0 += 3 * GB) {
            gb_load(B2, idp, gp, e0 + 2 * GB, down, up, lane);
            gb_compute(B0, xf, acc, zs);
            gb_load(B0, idp, gp, e0 + 3 * GB, down, up, lane);
            gb_compute(B1, xf, acc, zs);
            gb_load(B1, idp, gp, e0 + 4 * GB, down, up, lane);
            gb_compute(B2, xf, acc, zs);
        }
        gb_compute(B0, xf, acc, zs); gb_compute(B1, xf, acc, zs);
        const float* xi = x1 + (size_t)t * DM + lane * 16; float* o = outw + (size_t)t * DM + lane * 16;
#pragma unroll
        for (int k = 0; k < 4; ++k) { float4 r = *(const float4*)(xi + 4 * k);
            r.x += acc[2 * k].x * TINV; r.y += acc[2 * k].y * TINV; r.z += acc[2 * k + 1].x * TINV; r.w += acc[2 * k + 1].y * TINV; *(float4*)(o + 4 * k) = r; }
        t = (int)__builtin_amdgcn_readfirstlane(vn_);
    }
}
__device__ __forceinline__ void ph_convert_fp8(const float* __restrict__ src, unsigned* __restrict__ dst, size_t n4, int wg, int nwg, int tid, const float* __restrict__ cgain = nullptr) {
    for (size_t i = (size_t)wg * NTHR + tid; i < n4; i += (size_t)nwg * NTHR) {
        float4 v = ((const float4*)src)[i];
        if (cgain) { const float4 g = ((const float4*)cgain)[i & 255]; v.x *= g.x; v.y *= g.y; v.z *= g.z; v.w *= g.w; }
        int w = __builtin_amdgcn_cvt_pk_fp8_f32(v.x * TSCALE, v.y * TSCALE, 0, false); w = __builtin_amdgcn_cvt_pk_fp8_f32(v.z * TSCALE, v.w * TSCALE, w, true);
        dst[i] = (unsigned)w;
    }
}

__device__ __forceinline__ void ph_rowrs(const float* __restrict__ ss, float* __restrict__ rs, int wg, int nwg, int tid) {
    for (int r = wg * NTHR + tid; r < T; r += nwg * NTHR) { float s = 0.f;
#pragma unroll
        for (int k = 0; k < 16; ++k) s += ss[(size_t)k * 65536 + r];
        rs[r] = rsqrtf(s * (1.0f / DM) + EPS); }
}
#ifndef PROBE_PHASE
#define PROBE_PHASE -1
#endif
#ifndef PROBE_MULT
#define PROBE_MULT 4
#endif
#ifndef REP_ATTN
#define REP_ATTN 1
#endif
#ifndef REP_ROUTE
#define REP_ROUTE 1
#endif
#ifndef REP_GATHER
#define REP_GATHER 1
#endif
#ifndef REP_QKPOST
#define REP_QKPOST 1
#endif
__global__ void __launch_bounds__(NTHR, 2) mk_fwd(Params P) {
    extern __shared__ __attribute__((aligned(16))) unsigned char lds[];
    cg::grid_group grid = cg::this_grid();
    const int wg = blockIdx.x, nwg = gridDim.x;
#if PROBE_PHASE >= 0
    volatile unsigned* tsl = (volatile unsigned*)(lds + 147456 - 256);
#define STAMP(i) do { if (threadIdx.x == 0) tsl[i] = (unsigned)__builtin_amdgcn_s_memrealtime(); } while (0)
#else
#define STAMP(i) do {} while (0)
#endif
    STAMP(0);
    volatile LAS unsigned* bst = (volatile LAS unsigned*)((LAS unsigned char*)lds + LDS_BYTES - 512);
    if (threadIdx.x < 2) bst[threadIdx.x] = 0u;
    __syncthreads();
    XcdBarrier xbar = xcd_barrier_post((unsigned*)(P.ws + 4096), bst);
#define GRID_BAR() xcd_barrier(xbar)
    unsigned char* ws = P.ws; float* out = P.out;
    const float* x = P.in[0];
    bf16* WinT = (bf16*)(ws + WS_WIN); bf16* WoutT = (bf16*)(ws + WS_WOUT); bf16* WqT = (bf16*)(ws + WS_WQ); bf16* SUBK = (bf16*)(ws + WS_SUBK);
    unsigned char* DOWN = ws + WS_DOWN; unsigned char* UP = ws + WS_UP; bf16* XN = (bf16*)(ws + WS_XN); bf16* QKV = (bf16*)(ws + WS_QKV); bf16* PQ = (bf16*)(ws + WS_PQ);
    bf16* MIXED = (bf16*)(ws + WS_MIXED); bf16* DOB = (bf16*)(ws + WS_DO); int* IDS = (int*)(ws + WS_IDS); float* GATES = (float*)(ws + WS_GATES);
    float* ROPE = (float*)(ws + WS_ROPE); float* KMEAN = (float*)(ws + WS_KMEAN);

    ph_transpose<true>(P.in[2], 1024, 3072, WinT, (float*)lds, wg, nwg, fresh_tid());
    ph_transpose<false>(P.in[13], 1024, 1024, WoutT, (float*)lds, wg, nwg, fresh_tid());
    ph_transpose<false>(P.in[15], 1024, 2048, WqT, (float*)lds, wg, nwg, fresh_tid(), P.in[14]);
    ph_convert(P.in[16], SUBK, (size_t)16 * 128 * 128 / 4, wg, nwg, fresh_tid());
    ph_convert_fp8(P.in[17], (unsigned*)DOWN, (size_t)16384 * 1024 / 4, wg, nwg, fresh_tid(), P.in[14]);
    ph_convert_fp8(P.in[18], (unsigned*)UP, (size_t)16384 * 1024 / 4, wg, nwg, fresh_tid());
    ph_rope(ROPE, wg, nwg, fresh_tid());
    ph_rmsnorm(x, P.in[1], XN, T, wg, nwg, fresh_tid());
    GRID_BAR();
    STAMP(1);
    { pg8::Gemm g{XN, WinT, T, 3072, 1024}; pg8::EpiQKV E{QKV, QKV_ELEMS, ROPE, P.in[3], P.in[4], P.in[5], P.in[6], KMEAN, QSCALE}; pg8::StaticOrder S; S.init(g.M, g.N, nwg, wg);
      pg8::gemm_phase<pg8::EpiQKV, pg8::StaticOrder, true, true>((PG8_LAS unsigned char*)lds, g, S, E); }
    GRID_BAR();
    STAMP(2);
    STAMP(3);
    for (int rep_ = 0; rep_ < REP_ATTN; ++rep_) { const float* gain_m = P.in[11];
      for (int combo = wg; combo < NB * 8; combo += nwg) {
        const int b = combo >> 3, hd = combo & 7; const size_t brow = (size_t)b * SEQ;
        for (int qb = 7; qb >= 0; --qb) { const size_t qrow = brow + (size_t)qb * 256;
            attn_body::attn_unit<8, true>(qb, (const attn_body::bf16*)(QKV + qrow * 512 + hd * 64), (const attn_body::bf16*)(QKV + QKV_ELEMS + brow * 512 + hd * 64),
                (const attn_body::bf16*)(QKV + 2 * QKV_ELEMS + brow * 512 + hd * 64), (attn_body::bf16*)(MIXED + qrow * 1024 + hd * 64), KMEAN + ((size_t)b * 8 + hd) * 512, gain_m + hd * 64, (char*)lds); }
      }
      float lam; { float a_ = 0.f, b_ = 0.f; for (int i = 0; i < 64; ++i) { a_ += P.in[7][i] * P.in[8][i]; b_ += P.in[9][i] * P.in[10][i]; } lam = expf(a_) - expf(b_) + 0.2f; }
      const float* gain_d = P.in[12];
      for (int cw = wg; cw < NB * 8; cw += nwg) {
        const int combo = cw >> 1, b = combo >> 2, h = combo & 3; const size_t brow = (size_t)b * SEQ;
        for (int qi = 0; qi < 4; ++qi) { const int qb = (cw & 1) ? (qi == 0 ? 7 : qi == 1 ? 4 : qi == 2 ? 3 : 0) : (qi == 0 ? 6 : qi == 1 ? 5 : qi == 2 ? 2 : 1);
          const size_t qrow = brow + (size_t)qb * 256;
          for (int sub = 0; sub < 4; ++sub) { const int m = sub >> 1, c = sub & 1;
            attn_body::attn_unit<8, false>(qb, (const attn_body::bf16*)(QKV + 3 * QKV_ELEMS + qrow * 512 + h * 128 + m * 64), (const attn_body::bf16*)(QKV + 4 * QKV_ELEMS + brow * 512 + h * 128 + m * 64),
                (const attn_body::bf16*)(QKV + 5 * QKV_ELEMS + brow * 512 + h * 128 + c * 64), (attn_body::bf16*)(DOB + qrow * 1024 + h * 256 + m * 128 + c * 64), nullptr, nullptr, (char*)lds); }
          asm volatile("s_waitcnt vmcnt(0)" ::: "memory");
          { const int tid_ = fresh_tid(), lane = tid_ & 63, wv = tid_ >> 6, sub16 = lane & 15, rq = lane >> 4;
#pragma unroll 2
            for (int it = 0; it < 8; ++it) { const size_t row = qrow + wv * 32 + it * 4 + rq; const bf16* p = DOB + row * 1024 + h * 256 + sub16 * 8;
              const uint4 a1 = *(const uint4*)p, a2 = *(const uint4*)(p + 128);
              const unsigned u1[4] = {a1.x, a1.y, a1.z, a1.w}, u2[4] = {a2.x, a2.y, a2.z, a2.w}; float d[8]; float ss = 0.f;
#pragma unroll
              for (int e = 0; e < 4; ++e) { d[2 * e] = __uint_as_float(u1[e] << 16) - lam * __uint_as_float(u2[e] << 16); d[2 * e + 1] = __uint_as_float(u1[e] & 0xffff0000u) - lam * __uint_as_float(u2[e] & 0xffff0000u);
                ss += d[2 * e] * d[2 * e] + d[2 * e + 1] * d[2 * e + 1]; }
              ss += __shfl_xor(ss, 1); ss += __shfl_xor(ss, 2); ss += __shfl_xor(ss, 4); ss += __shfl_xor(ss, 8);
              const float rs = rsqrtf(ss * (1.0f / 128.0f) + EPS) * 0.8f; const float4 g0 = *(const float4*)(gain_d + h * 128 + sub16 * 8), g1 = *(const float4*)(gain_d + h * 128 + sub16 * 8 + 4);
              uint4 o; o.x = f2bf(d[0] * rs * g0.x) | (f2bf(d[1] * rs * g0.y) << 16); o.y = f2bf(d[2] * rs * g0.z) | (f2bf(d[3] * rs * g0.w) << 16);
              o.z = f2bf(d[4] * rs * g1.x) | (f2bf(d[5] * rs * g1.y) << 16); o.w = f2bf(d[6] * rs * g1.z) | (f2bf(d[7] * rs * g1.w) << 16);
              *(uint4*)(MIXED + row * 1024 + 512 + h * 128 + sub16 * 8) = o; } }
        }
      } }
    GRID_BAR();
    STAMP(4);
    STAMP(5);
    { pg8::Gemm g{MIXED, WoutT, T, 1024, 1024}; pg8::EpiRes2 E{x, out, XN, (float*)(ws + WS_SS), 1024}; pg8::StaticOrder S; S.init(g.M, g.N, nwg, wg);
      pg8::gemm_phase<pg8::EpiRes2, pg8::StaticOrder, true, true>((PG8_LAS unsigned char*)lds, g, S, E); }
    GRID_BAR();
    STAMP(6);
    ph_rowrs((const float*)(ws + WS_SS), (float*)(ws + WS_RS), wg, nwg, fresh_tid());
    GRID_BAR();
    STAMP(7);
    { pg8::Gemm g{XN, WqT, T, 2048, 1024}; pg8::EpiPQ E{PQ, (const float*)(ws + WS_RS)}; pg8::StaticOrder S; S.init(g.M, g.N, nwg, wg);
      pg8::gemm_phase<pg8::EpiPQ, pg8::StaticOrder, true, true>((PG8_LAS unsigned char*)lds, g, S, E); }
    GRID_BAR();
    STAMP(8);
    for (int rep_ = 0; rep_ < REP_ROUTE; ++rep_) ph_peer_route(PQ, SUBK, IDS, GATES, (LAS unsigned char*)lds, wg, nwg, fresh_tid());
    GRID_BAR();
    STAMP(9);
    for (int rep_ = 1; rep_ < REP_GATHER; ++rep_) ph_peer_gather(XN, IDS, GATES, DOWN, UP, out, (float*)(ws + WS_MIXED), (unsigned*)(ws + 65536 + 256 * rep_), fresh_tid(), (const float*)(ws + WS_RS));
    ph_peer_gather(XN, IDS, GATES, DOWN, UP, out, out, (unsigned*)(ws + 65536), fresh_tid(), (const float*)(ws + WS_RS));
    STAMP(10);
    grid.sync();
#if PROBE_PHASE >= 0
    if (blockIdx.x == 0 && threadIdx.x == 0) { const unsigned dt = (tsl[PROBE_PHASE + 1] - tsl[PROBE_PHASE]) * PROBE_MULT; const unsigned long long t0 = __builtin_amdgcn_s_memrealtime(); while ((unsigned)(__builtin_amdgcn_s_memrealtime() - t0) < dt) __builtin_amdgcn_s_sleep(8); }
#endif
}

extern "C" void kernel_launch(void* const* d_in, const int* in_sizes, int n_in, void* d_out, int out_size, void* d_ws, size_t ws_size, hipStream_t stream) {
    static int grid_blocks = 0;
    if (grid_blocks == 0) {
        if (n_in != 19 || in_sizes[0] != T * DM || out_size != T * DM || ws_size < WS_END) { fprintf(stderr, "kernel_launch: unexpected shapes (n_in %d in0 %d out %d ws %zu)\n", n_in, n_in > 0 ? in_sizes[0] : -1, out_size, ws_size); grid_blocks = -1; return; }
        int dev = 0, cus = 0, per_cu = 0;
        (void)hipGetDevice(&dev); (void)hipDeviceGetAttribute(&cus, hipDeviceAttributeMultiprocessorCount, dev);
        (void)hipFuncSetAttribute((const void*)mk_fwd, hipFuncAttributeMaxDynamicSharedMemorySize, LDS_BYTES);
        (void)hipOccupancyMaxActiveBlocksPerMultiprocessor(&per_cu, (const void*)mk_fwd, NTHR, LDS_BYTES);
        if (per_cu < 1 || cus < 1) { fprintf(stderr, "kernel_launch: occupancy query says %d blocks/CU on %d CUs\n", per_cu, cus); grid_blocks = -1; return; }
        if (per_cu > 1) per_cu = 1;
        grid_blocks = cus * per_cu;
    }
    if (grid_blocks < 0) return;
    (void)hipMemsetAsync(d_ws, 0, WS_ZERO_BYTES, stream);
    Params p{};
    for (int i = 0; i < 19; ++i) p.in[i] = (const float*)d_in[i];
    p.out = (float*)d_out; p.ws = (unsigned char*)d_ws;
    void* args[] = {&p};
    hipError_t e = hipLaunchCooperativeKernel((const void*)mk_fwd, dim3(grid_blocks), dim3(NTHR), args, LDS_BYTES, stream);
    if (e != hipSuccess) fprintf(stderr, "cooperative launch failed: %s (grid %d)\n", hipGetErrorString(e), grid_blocks);
}
```

```cpp
#include <hip/hip_runtime.h>
#include <hip/hip_cooperative_groups.h>
#include <cstdio>
#include <cstdint>
namespace cg = cooperative_groups;
__device__ __forceinline__ int fresh_tid() { int t = threadIdx.x; asm volatile("" : "+v"(t)); return t; }
namespace pg8 {
#define PG8_LAS __attribute__((address_space(3)))
typedef unsigned short bf16_t;
typedef short bf16x8 __attribute__((ext_vector_type(8)));
typedef float f32x4 __attribute__((ext_vector_type(4)));
typedef unsigned u32x4 __attribute__((ext_vector_type(4)));
constexpr int BM = 256, BK = 64, HALF = 128, HTB = HALF * BK * 2  , STAGE_BYTES = 8 * HTB, NXCD = 8, WGM = 8;

__host__ __device__ __forceinline__ int lds_byte(int r, int c) { const int st = (r >> 4) * 2 + (c >> 5), rr = r & 15, cc = c & 31, ob = rr * 64 + cc * 2; return st * 1024 + (ob ^ (((ob >> 9) & 1) << 5)); }
__host__ __device__ __forceinline__ void stage_rc(int b, int& R, int& C) { const int st = b / 1024, sb = b % 1024, swz = sb ^ (((sb >> 9) & 1) << 5); R = (st >> 1) * 16 + swz / 64; C = (st & 1) * 32 + (swz % 64) / 2; }
__host__ __device__ __forceinline__ int perm32(int rho) { const int n = rho >> 4, i = rho & 15; return 8 * (i >> 2) + 4 * n + (i & 3); }

struct Unit { int pm, pn; };
struct Gemm { const bf16_t* A; const bf16_t* Bt; int M, N, K; };

struct StaticOrder {
    int nM, nN, nwg, G, c;
    __host__ __device__ void init(int M, int N, int G_, int c_) { nM = M / BM; nN = N / BM; nwg = nM * nN; G = G_; c = c_; }
    __host__ __device__ bool next(int i, Unit& u) const {
        const long L = (long)i * G + c; if (L >= nwg) return false;
        int wgid = (int)L; { const int q = nwg / NXCD, r = nwg % NXCD, xcd = wgid % NXCD, off = wgid / NXCD; wgid = (xcd < r ? xcd * (q + 1) : r * (q + 1) + (xcd - r) * q) + off; }
        const int nig = WGM * nN, gid = wgid / nig, fm = gid * WGM, gsz = (nM - fm) < WGM ? (nM - fm) : WGM;
        u.pm = fm + ((wgid % nig) % gsz); u.pn = (wgid % nig) / gsz; return true;
    }
    __device__ __forceinline__ void a_ready(const Unit&) const {}
    __device__ __forceinline__ void done(const Unit&) const {}
};

__device__ __forceinline__ unsigned cvt_pk_bf16(float lo, float hi) { unsigned r; asm volatile("v_cvt_pk_bf16_f32 %0, %1, %2" : "=v"(r) : "v"(lo), "v"(hi)); return r; }
struct EpiBf16 {
    static constexpr bool PERM = true, AFTER_DRAIN = false;
    bf16_t* O; int ldc; int split_cols; size_t split_stride;
    __device__ __forceinline__ void operator()(const f32x4 (&acc)[2][2][4][2], const Unit& u, int wr, int wc, int fr, int fq) const {
        const int row0 = u.pm * BM + wr * 64 + fr; int colt = u.pn * BM; bf16_t* base = O;
        if (split_cols) { const int t = colt / split_cols; base += (size_t)t * split_stride; colt -= t * split_cols; }
        const int col0 = colt + wc * 32 + 8 * fq;
#pragma unroll
        for (int ai = 0; ai < 2; ++ai)
#pragma unroll
            for (int m = 0; m < 4; ++m) { bf16_t* rowp = base + (size_t)(row0 + ai * HALF + m * 16) * ldc + col0;
#pragma unroll
                for (int bj = 0; bj < 2; ++bj) { const f32x4 v0 = acc[ai][bj][m][0], v1 = acc[ai][bj][m][1];
                    u32x4 w; w.x = cvt_pk_bf16(v0[0], v0[1]); w.y = cvt_pk_bf16(v0[2], v0[3]); w.z = cvt_pk_bf16(v1[0], v1[1]); w.w = cvt_pk_bf16(v1[2], v1[3]);
                    *(u32x4*)(rowp + bj * HALF) = w; } }
    }
};
struct EpiResF32 {
    static constexpr bool PERM = false, AFTER_DRAIN = false;
    const float* base; float* out; int ldc;
    __device__ __forceinline__ void operator()(const f32x4 (&acc)[2][2][4][2], const Unit& u, int wr, int wc, int fr, int fq) const {
        const int col0 = u.pn * BM + wc * 32 + 4 * fq;
#pragma unroll
        for (int ai = 0; ai < 2; ++ai)
#pragma unroll
            for (int m = 0; m < 4; ++m) { const size_t off = (size_t)(u.pm * BM + ai * HALF + wr * 64 + m * 16 + fr) * ldc + col0;
#pragma unroll
                for (int bj = 0; bj < 2; ++bj)
#pragma unroll
                    for (int n = 0; n < 2; ++n) { const f32x4 bs = *(const f32x4*)(base + off + bj * HALF + n * 16); *(f32x4*)(out + off + bj * HALF + n * 16) = bs + acc[ai][bj][m][n]; } }
    }
};
struct EpiQKV {
    static constexpr bool PERM = true, AFTER_DRAIN = false;
    bf16_t* QKV; size_t buf_elems; const float* rope; const float *gqm, *gkm, *gqd, *gkd; float* kmean; float qscale;
    __device__ __forceinline__ void operator()(const f32x4 (&acc)[2][2][4][2], const Unit& u, int wr, int wc, int fr, int fq) const {
        const int type = u.pn >> 1;
        bf16_t* base = QKV + (size_t)type * buf_elems + (size_t)(u.pm * BM + wr * 64 + fr) * 512 + (u.pn & 1) * 256 + wc * 64 + 8 * fq;
        if (type == 2 || type == 5) {
#pragma unroll
            for (int ai = 0; ai < 2; ++ai)
#pragma unroll
                for (int m = 0; m < 4; ++m) { bf16_t* rowp = base + (size_t)(ai * HALF + m * 16) * 512;
#pragma unroll
                    for (int bj = 0; bj < 2; ++bj) { const f32x4 v0 = acc[ai][bj][m][0], v1 = acc[ai][bj][m][1];
                        u32x4 w; w.x = cvt_pk_bf16(v0[0], v0[1]); w.y = cvt_pk_bf16(v0[2], v0[3]); w.z = cvt_pk_bf16(v1[0], v1[1]); w.w = cvt_pk_bf16(v1[2], v1[3]);
                        *(u32x4*)(rowp + bj * 32) = w; } }
            return;
        }
        const float* g = type == 0 ? gqm : type == 1 ? gkm : type == 3 ? gqd + (wc & 1) * 64 : gkd + (wc & 1) * 64;
        const f32x4 g1a = *(const f32x4*)(g + 8 * fq), g1b = *(const f32x4*)(g + 8 * fq + 4), g2a = *(const f32x4*)(g + 32 + 8 * fq), g2b = *(const f32x4*)(g + 32 + 8 * fq + 4);
        const float sc = (type == 0 || type == 3) ? qscale : 1.0f;
        f32x4 ks1a = {0.f, 0.f, 0.f, 0.f}, ks1b = ks1a, ks2a = ks1a, ks2b = ks1a;
#pragma unroll
        for (int ai = 0; ai < 2; ++ai)
#pragma unroll
            for (int m = 0; m < 4; ++m) {
                const int rloc = ai * HALF + m * 16; const int pos = (u.pm * BM + wr * 64 + fr + rloc) & 2047;
                const f32x4 x1a = acc[ai][0][m][0], x1b = acc[ai][0][m][1], x2a = acc[ai][1][m][0], x2b = acc[ai][1][m][1];
                f32x4 q = x1a * x1a + x1b * x1b + x2a * x2a + x2b * x2b; float ss = (q[0] + q[1]) + (q[2] + q[3]);
                ss += __shfl_xor(ss, 16); ss += __shfl_xor(ss, 32);
                const float rs = __builtin_amdgcn_rsqf(ss * (1.0f / 64.0f) + 1e-6f);
                const float* cp = rope + pos * 32 + 8 * fq; const f32x4 ca = *(const f32x4*)cp, cb = *(const f32x4*)(cp + 4), sa = *(const f32x4*)(cp + 65536), sb = *(const f32x4*)(cp + 65536 + 4);
                const f32x4 y1a = x1a * rs * g1a, y1b = x1b * rs * g1b, y2a = x2a * rs * g2a, y2b = x2b * rs * g2b;
                const f32x4 o1a = (y1a * ca - y2a * sa) * sc, o1b = (y1b * cb - y2b * sb) * sc, o2a = (y2a * ca + y1a * sa) * sc, o2b = (y2b * cb + y1b * sb) * sc;
                if (type == 1) { ks1a += o1a; ks1b += o1b; ks2a += o2a; ks2b += o2b; }
                bf16_t* rowp = base + (size_t)rloc * 512;
                u32x4 w1, w2; w1.x = cvt_pk_bf16(o1a[0], o1a[1]); w1.y = cvt_pk_bf16(o1a[2], o1a[3]); w1.z = cvt_pk_bf16(o1b[0], o1b[1]); w1.w = cvt_pk_bf16(o1b[2], o1b[3]);
                w2.x = cvt_pk_bf16(o2a[0], o2a[1]); w2.y = cvt_pk_bf16(o2a[2], o2a[3]); w2.z = cvt_pk_bf16(o2b[0], o2b[1]); w2.w = cvt_pk_bf16(o2b[2], o2b[3]);
                *(u32x4*)rowp = w1; *(u32x4*)(rowp + 32) = w2;
            }
        if (type == 1) {
            float kv[16] = {ks1a[0], ks1a[1], ks1a[2], ks1a[3], ks1b[0], ks1b[1], ks1b[2], ks1b[3], ks2a[0], ks2a[1], ks2a[2], ks2a[3], ks2b[0], ks2b[1], ks2b[2], ks2b[3]};
#pragma unroll
            for (int j = 0; j < 16; ++j) { float v = kv[j]; v += __shfl_xor(v, 1); v += __shfl_xor(v, 2); v += __shfl_xor(v, 4); v += __shfl_xor(v, 8); kv[j] = v; }
            if (fr == 0) { float* km = kmean + (((size_t)(u.pm >> 3) * 8 + (u.pn & 1) * 4 + wc) * 8 + (u.pm & 7)) * 64 + 8 * fq;
#pragma unroll
                for (int j = 0; j < 8; ++j) { atomicAdd(km + j, kv[j] * (1.0f / 256.0f)); atomicAdd(km + 32 + j, kv[8 + j] * (1.0f / 256.0f)); } }
        }
    }
};
struct EpiPQ {
    static constexpr bool PERM = true, AFTER_DRAIN = false;
    bf16_t* O; const float* rs;
    __device__ __forceinline__ void operator()(const f32x4 (&acc)[2][2][4][2], const Unit& u, int wr, int wc, int fr, int fq) const {
        const int s = wc * 2 + (fq >> 1), hi = fq & 1;
#pragma unroll
        for (int ai = 0; ai < 2; ++ai)
#pragma unroll
            for (int m = 0; m < 4; ++m) { const int R = u.pm * BM + ai * HALF + wr * 64 + m * 16 + fr, tb = R >> 5, r = R & 31; const float rr = rs[R];
#pragma unroll
                for (int bj = 0; bj < 2; ++bj) { const int hp = u.pn * 2 + bj; const f32x4 v0 = acc[ai][bj][m][0] * rr, v1 = acc[ai][bj][m][1] * rr;
                    u32x4 w; w.x = cvt_pk_bf16(v0[0], v0[1]); w.y = cvt_pk_bf16(v0[2], v0[3]); w.z = cvt_pk_bf16(v1[0], v1[1]); w.w = cvt_pk_bf16(v1[2], v1[3]);
                    *(u32x4*)(O + ((((size_t)tb * 16 + hp) * 8 + s) * 64 + hi * 32 + r) * 8) = w; } }
    }
};
struct EpiRes2 {
    static constexpr bool PERM = true, AFTER_DRAIN = false;
    const float* base; float* out; bf16_t* xb; float* ss; int ldc;
    __device__ __forceinline__ void operator()(const f32x4 (&acc)[2][2][4][2], const Unit& u, int wr, int wc, int fr, int fq) const {
        const int col0 = u.pn * BM + wc * 32 + 8 * fq;
#pragma unroll
        for (int ai = 0; ai < 2; ++ai) { float keep = 0.f;
#pragma unroll
            for (int m = 0; m < 4; ++m) { const size_t off = (size_t)(u.pm * BM + ai * HALF + wr * 64 + m * 16 + fr) * ldc + col0; float s = 0.f;
#pragma unroll
                for (int bj = 0; bj < 2; ++bj) { const f32x4 b0 = *(const f32x4*)(base + off + bj * HALF), b1 = *(const f32x4*)(base + off + bj * HALF + 4);
                    const f32x4 o0 = b0 + acc[ai][bj][m][0], o1 = b1 + acc[ai][bj][m][1];
                    *(f32x4*)(out + off + bj * HALF) = o0; *(f32x4*)(out + off + bj * HALF + 4) = o1;
                    s += (o0[0] * o0[0] + o0[1] * o0[1]) + (o0[2] * o0[2] + o0[3] * o0[3]) + (o1[0] * o1[0] + o1[1] * o1[1]) + (o1[2] * o1[2] + o1[3] * o1[3]);
                    u32x4 w; w.x = cvt_pk_bf16(o0[0], o0[1]); w.y = cvt_pk_bf16(o0[2], o0[3]); w.z = cvt_pk_bf16(o1[0], o1[1]); w.w = cvt_pk_bf16(o1[2], o1[3]);
                    *(u32x4*)(xb + off + bj * HALF) = w; }
                s += __shfl_xor(s, 16); s += __shfl_xor(s, 32);
                if (fq == m) keep = s; }
            ss[(size_t)(u.pn * 4 + wc) * 65536 + u.pm * BM + ai * HALF + wr * 64 + fq * 16 + fr] = keep; }
    }
};
template <class Epi, class Sched, bool ALIGN_EPI = false, bool SP2 = false>
__device__ __forceinline__ void gemm_phase(PG8_LAS unsigned char* lds, const Gemm g, const Sched& S, const Epi& E) {
    const int tid = fresh_tid(), wid = __builtin_amdgcn_readfirstlane(tid >> 6), lane = tid & 63, wr = wid >> 2, wc = wid & 3, fr = lane & 15, fq = lane >> 4;
    const int K = g.K, nt = K / BK;
    unsigned voffA[2], voffB[2];
#pragma unroll
    for (int i = 0; i < 2; ++i) { int R, C; stage_rc(tid * 16 + i * 8192, R, C); const int Rb = Epi::PERM ? ((R & ~31) + perm32(R & 31)) : R;
        voffA[i] = (unsigned)(R * K + C) * 2u; voffB[i] = (unsigned)(Rb * K + C) * 2u; }
    const size_t kstep = (size_t)(BK * 2);
    const size_t hstep = (size_t)HALF * K * 2;
    const size_t tstep = 2 * hstep;
    const unsigned ldsw = (unsigned)wid * 1024u;
    const int aoff = lds_byte(wr * 64 + fr, fq * 8), boff = lds_byte(wc * 32 + fr, fq * 8);
#define PG8_SA(b, h) (((b) * 2 + (h)) * HTB)
#define PG8_SB(b, h) ((4 + (b) * 2 + (h)) * HTB)
#define PG8_STAGE(bufoff, gbase, voff) do { _Pragma("unroll") for (int _i = 0; _i < 2; ++_i) \
        __builtin_amdgcn_global_load_lds((const unsigned*)((const char*)(gbase) + (voff)[_i]), (PG8_LAS unsigned*)(lds + (bufoff) + ldsw + _i * 8192), 16, 0, 0); } while (0)
#define PG8_LDA(dst, b, h) do { _Pragma("unroll") for (int m = 0; m < 4; ++m) _Pragma("unroll") for (int k = 0; k < 2; ++k) dst[m][k] = *(const PG8_LAS bf16x8*)(lds + PG8_SA(b, h) + aoff + m * 2048 + k * 1024); } while (0)
#define PG8_LDB(dst, b, h) do { _Pragma("unroll") for (int n = 0; n < 2; ++n) _Pragma("unroll") for (int k = 0; k < 2; ++k) dst[n][k] = *(const PG8_LAS bf16x8*)(lds + PG8_SB(b, h) + boff + n * 2048 + k * 1024); } while (0)
#define PG8_MMA(ai, bj, At, Bt) do { __builtin_amdgcn_s_setprio(1); _Pragma("unroll") for (int m = 0; m < 4; ++m) _Pragma("unroll") for (int n = 0; n < 2; ++n) _Pragma("unroll") for (int k = 0; k < 2; ++k) \
        acc[ai][bj][m][n] = __builtin_amdgcn_mfma_f32_16x16x32_bf16(Bt[n][k], At[m][k], acc[ai][bj][m][n], 0, 0, 0); __builtin_amdgcn_s_setprio(0); } while (0)
#define PG8_WAIT_V(n) asm volatile("s_waitcnt vmcnt(" #n ")" ::: "memory")
#define PG8_WAIT_L(n) asm volatile("s_waitcnt lgkmcnt(" #n ")" ::: "memory")
#define PG8_BAR __builtin_amdgcn_s_barrier()
#define PG8_SCHED __builtin_amdgcn_sched_barrier(0)
    Unit cur, nxt; int ui = 0;
    if (!S.next(0, cur)) return;
    f32x4 acc[2][2][4][2];
#pragma unroll
    for (int a = 0; a < 2; ++a)
#pragma unroll
        for (int b = 0; b < 2; ++b)
#pragma unroll
            for (int m = 0; m < 4; ++m)
#pragma unroll
                for (int n = 0; n < 2; ++n) acc[a][b][m][n] = (f32x4){0.f, 0.f, 0.f, 0.f};
    bf16x8 At[4][2], B0[2][2], B1[2][2];
    const char* cA = (const char*)g.A + (size_t)cur.pm * tstep; const char* cB = (const char*)g.Bt + (size_t)cur.pn * tstep;
    S.a_ready(cur);
    if constexpr (SP2) {
        PG8_STAGE(PG8_SB(0, 0), cB, voffB); PG8_STAGE(PG8_SB(0, 1), cB + hstep, voffB); PG8_STAGE(PG8_SA(0, 0), cA, voffA); PG8_STAGE(PG8_SA(0, 1), cA + hstep, voffA);
        if (wr == 1) PG8_BAR;
        PG8_WAIT_V(2); PG8_BAR;
        PG8_STAGE(PG8_SB(1, 0), cB + kstep, voffB); PG8_STAGE(PG8_SA(1, 0), cA + kstep, voffA); PG8_STAGE(PG8_SB(1, 1), cB + hstep + kstep, voffB);
        PG8_WAIT_V(6); PG8_BAR;
    } else {
        PG8_STAGE(PG8_SB(0, 0), cB, voffB); PG8_STAGE(PG8_SA(0, 0), cA, voffA); PG8_STAGE(PG8_SB(0, 1), cB + hstep, voffB); PG8_STAGE(PG8_SA(0, 1), cA + hstep, voffA);
        if (wr == 1) PG8_BAR;
        PG8_WAIT_V(4); PG8_BAR;
        PG8_STAGE(PG8_SB(1, 0), cB + kstep, voffB); PG8_STAGE(PG8_SA(1, 0), cA + kstep, voffA); PG8_STAGE(PG8_SB(1, 1), cB + hstep + kstep, voffB);
        PG8_WAIT_V(6); PG8_BAR;
    }
    for (;;) {
        const bool has_next = S.next(ui + 1, nxt);
        const char* nA = has_next ? (const char*)g.A + (size_t)nxt.pm * tstep : cA; const char* nB = has_next ? (const char*)g.Bt + (size_t)nxt.pn * tstep : cB;
        for (int t = 0; t < nt; t += 2) {
            const bool last = (t == nt - 2);
            const char* a1 = cA + (size_t)(t + 1) * kstep;
            const char* a2 = last ? nA : cA + (size_t)(t + 2) * kstep; const char* b2 = last ? nB : cB + (size_t)(t + 2) * kstep;
            const char* a3 = a2 + kstep; const char* b3 = b2 + kstep;
            if (last && has_next) S.a_ready(nxt);
            if constexpr (SP2) {
            PG8_LDB(B0, 0, 0); PG8_LDB(B1, 0, 1); PG8_SCHED; PG8_LDA(At, 0, 0); PG8_STAGE(PG8_SA(1, 1), a1 + hstep, voffA);
            PG8_WAIT_V(8); PG8_WAIT_L(0); PG8_BAR; PG8_MMA(0, 0, At, B0); PG8_MMA(0, 1, At, B1); PG8_BAR; PG8_SCHED;
            PG8_LDA(At, 0, 1); PG8_STAGE(PG8_SB(0, 0), b2, voffB); PG8_STAGE(PG8_SB(0, 1), b2 + hstep, voffB); PG8_STAGE(PG8_SA(0, 0), a2, voffA);
            PG8_WAIT_V(8); PG8_WAIT_L(0); PG8_BAR; PG8_MMA(1, 0, At, B0); PG8_MMA(1, 1, At, B1); PG8_BAR; PG8_SCHED;
            PG8_LDB(B0, 1, 0); PG8_LDB(B1, 1, 1); PG8_SCHED; PG8_LDA(At, 1, 0); PG8_STAGE(PG8_SA(0, 1), a2 + hstep, voffA);
            PG8_WAIT_V(8); PG8_WAIT_L(0); PG8_BAR; PG8_MMA(0, 0, At, B0); PG8_MMA(0, 1, At, B1); PG8_BAR; PG8_SCHED;
            PG8_LDA(At, 1, 1); PG8_STAGE(PG8_SB(1, 0), b3, voffB); PG8_STAGE(PG8_SB(1, 1), b3 + hstep, voffB); PG8_STAGE(PG8_SA(1, 0), a3, voffA);
            PG8_WAIT_V(8); PG8_WAIT_L(0); PG8_BAR; PG8_MMA(1, 0, At, B0); PG8_MMA(1, 1, At, B1); PG8_BAR; PG8_SCHED;
            } else {
            PG8_LDB(B0, 0, 0); PG8_SCHED; PG8_LDA(At, 0, 0); PG8_STAGE(PG8_SA(1, 1), a1 + hstep, voffA);
            PG8_WAIT_L(8); PG8_BAR; PG8_WAIT_L(0); PG8_MMA(0, 0, At, B0); PG8_BAR; PG8_SCHED;
            PG8_LDB(B1, 0, 1); PG8_STAGE(PG8_SB(0, 0), b2, voffB);
            PG8_BAR; PG8_WAIT_L(0); PG8_MMA(0, 1, At, B1); PG8_BAR;
            PG8_LDA(At, 0, 1); PG8_STAGE(PG8_SA(0, 0), a2, voffA);
            PG8_BAR; PG8_WAIT_L(0); PG8_MMA(1, 0, At, B0); PG8_BAR; PG8_SCHED;
            PG8_STAGE(PG8_SB(0, 1), b2 + hstep, voffB);
            PG8_WAIT_V(6); PG8_BAR; PG8_MMA(1, 1, At, B1); PG8_BAR;
            PG8_LDB(B0, 1, 0); PG8_SCHED; PG8_LDA(At, 1, 0); PG8_STAGE(PG8_SA(0, 1), a2 + hstep, voffA);
            PG8_WAIT_L(8); PG8_BAR; PG8_WAIT_L(0); PG8_MMA(0, 0, At, B0); PG8_BAR; PG8_SCHED;
            PG8_LDB(B1, 1, 1); PG8_STAGE(PG8_SB(1, 0), b3, voffB);
            PG8_BAR; PG8_WAIT_L(0); PG8_MMA(0, 1, At, B1); PG8_BAR;
            PG8_LDA(At, 1, 1); PG8_STAGE(PG8_SA(1, 0), a3, voffA);
            PG8_BAR; PG8_WAIT_L(0); PG8_MMA(1, 0, At, B0); PG8_BAR; PG8_SCHED;
            PG8_STAGE(PG8_SB(1, 1), b3 + hstep, voffB);
            PG8_WAIT_V(6); PG8_BAR; PG8_MMA(1, 1, At, B1); PG8_BAR;
            }
        }
        if constexpr (ALIGN_EPI) { if (wr == 0) PG8_BAR; }
        if constexpr (!Epi::AFTER_DRAIN) { E(acc, cur, wr, wc, fr, fq); S.done(cur); }
        if (!has_next) break;
#pragma unroll
        for (int a = 0; a < 2; ++a)
#pragma unroll
            for (int b = 0; b < 2; ++b)
#pragma unroll
                for (int m = 0; m < 4; ++m)
#pragma unroll
                    for (int n = 0; n < 2; ++n) acc[a][b][m][n] = (f32x4){0.f, 0.f, 0.f, 0.f};
        cur = nxt; cA = nA; cB = nB; ++ui;
        if constexpr (ALIGN_EPI) { if (wr == 1) PG8_BAR; }
    }
    PG8_WAIT_V(0);
    if constexpr (!ALIGN_EPI) { if (wr == 0) PG8_BAR; }
    PG8_BAR;
    if constexpr (Epi::AFTER_DRAIN) { E.fused(acc, cur, wr, wc, fr, fq, lds, wid, lane); S.done(cur); }
#undef PG8_SA
#undef PG8_SB
#undef PG8_STAGE
#undef PG8_LDA
#undef PG8_LDB
#undef PG8_MMA
#undef PG8_WAIT_V
#undef PG8_WAIT_L
#undef PG8_BAR
#undef PG8_SCHED
}
}
#include <hip/hip_bf16.h>
#include <cmath>
namespace attn_body {
using bf16=__hip_bfloat16;
using bf16x8=__attribute__((ext_vector_type(8)))short;
using s16x4=__attribute__((ext_vector_type(4)))short;
using f32x16=__attribute__((ext_vector_type(16)))float;
using u32x4=__attribute__((ext_vector_type(4)))unsigned;
constexpr int SEQ=2048,D=64,DM=512,PO=1024;
constexpr int NW=8,QBLK=32,QB=QBLK*NW,KVBLK=64,NQB=SEQ/QB;
constexpr int ATTN_UNIT_ROWS=QB;
__device__ __forceinline__ int crow(int r,int hi){return (r&3)+8*(r>>2)+4*hi;}
#define SBAR() __builtin_amdgcn_sched_barrier(0)
__device__ __forceinline__ void cmask(f32x16&p0,f32x16&p1,int jb,int qrel,int hi){
  const float NEG=-INFINITY; int kb=64*jb+4*hi;
  #pragma unroll
  for(int r=0;r<16;++r){int kv=kb+(r&3)+8*(r>>2); if(kv>qrel)p0[r]=NEG; if(kv+32>qrel)p1[r]=NEG;}
}

__device__ __forceinline__ void bmask(f32x16&p0,f32x16&p1,unsigned on){
  if(!on){
    #pragma unroll
    for(int r=0;r<16;++r){p0[r]=-INFINITY;p1[r]=-INFINITY;} }
}
constexpr int NSLOT=3, SLOTB=8192;
constexpr int LDS_K=0, LDS_V=NSLOT*SLOTB, LDS_WS=2*NSLOT*SLOTB, LDS_OST=LDS_WS+NW*64*4, LDS_BYTES=LDS_OST+NW*4096;
constexpr float C2=0.125f*1.4426950408889634f;
__device__ __forceinline__ void glds16(const void*gsrc,unsigned lds_dst){unsigned keep;
  asm volatile("s_mov_b32 %0, m0\n\ts_mov_b32 m0, %2\n\ts_nop 0\n\tglobal_load_lds_dwordx4 %1, off\n\ts_mov_b32 m0, %0":"=&s"(keep):"v"(gsrc),"s"(lds_dst):"memory");}
__device__ __forceinline__ float max3f(float a,float b,float c){float r;asm("v_max3_f32 %0, %1, %2, %3":"=v"(r):"v"(a),"v"(b),"v"(c));return r;}
__device__ __forceinline__ float max2f(float a,float b){float r;asm("v_max_f32_e32 %0, %1, %2":"=v"(r):"v"(a),"v"(b));return r;}
__device__ __forceinline__ float fadd_s(float a,float b){float r;asm("v_add_f32_e32 %0, %1, %2":"=v"(r):"v"(a),"v"(b));return r;}
__device__ __forceinline__ float fsub_s(float a,float b){float r;asm("v_sub_f32_e32 %0, %1, %2":"=v"(r):"v"(a),"v"(b));return r;}
typedef float f32x2_t __attribute__((ext_vector_type(2))); typedef __bf16 bf16x2_t __attribute__((ext_vector_type(2)));
__device__ __forceinline__ unsigned cvtpk_s(float lo,float hi){f32x2_t v={lo,hi};bf16x2_t b=__builtin_convertvector(v,bf16x2_t);return __builtin_bit_cast(unsigned,b);}
#define WAIT_BAR(N) asm volatile("s_waitcnt vmcnt(" #N ") lgkmcnt(0)\n\ts_barrier":::"memory")

__device__ __forceinline__ void qkt(f32x16&p0,f32x16&p1,const char*Kslot,const bf16x8*qr,int r32,int hi){
  const char*kb=Kslot+hi*1024+r32*16;
  #pragma unroll
  for(int d0=0;d0<4;++d0){
    const bf16x8 b0=*reinterpret_cast<const bf16x8*>(kb+d0*2048);
    const bf16x8 b1=*reinterpret_cast<const bf16x8*>(kb+d0*2048+512);
    if(d0==0){p0=__builtin_amdgcn_mfma_f32_32x32x16_bf16(b0,qr[0],f32x16{},0,0,0);p1=__builtin_amdgcn_mfma_f32_32x32x16_bf16(b1,qr[0],f32x16{},0,0,0);}
    else{p0=__builtin_amdgcn_mfma_f32_32x32x16_bf16(b0,qr[d0],p0,0,0,0);p1=__builtin_amdgcn_mfma_f32_32x32x16_bf16(b1,qr[d0],p1,0,0,0);}}
}
typedef __attribute__((address_space(3))) const char* lds_cptr;
typedef short v4i16_t __attribute__((ext_vector_type(4)));
__device__ __forceinline__ void kload8(bf16x8*kf,lds_cptr kp){
  kf[0]=*(const __attribute__((address_space(3))) bf16x8*)(kp);      kf[1]=*(const __attribute__((address_space(3))) bf16x8*)(kp+512);
  kf[2]=*(const __attribute__((address_space(3))) bf16x8*)(kp+2048); kf[3]=*(const __attribute__((address_space(3))) bf16x8*)(kp+2560);
  kf[4]=*(const __attribute__((address_space(3))) bf16x8*)(kp+4096); kf[5]=*(const __attribute__((address_space(3))) bf16x8*)(kp+4608);
  kf[6]=*(const __attribute__((address_space(3))) bf16x8*)(kp+6144); kf[7]=*(const __attribute__((address_space(3))) bf16x8*)(kp+6656);
}
__device__ __forceinline__ void kload2(bf16x8*kf,lds_cptr kp,int j){ kf[2*j]=*(const __attribute__((address_space(3))) bf16x8*)(kp+j*2048); kf[2*j+1]=*(const __attribute__((address_space(3))) bf16x8*)(kp+j*2048+512); }
__device__ __forceinline__ s16x4 vtr(lds_cptr p){ return __builtin_bit_cast(s16x4,__builtin_amdgcn_ds_read_tr16_b64_v4i16((__attribute__((address_space(3))) v4i16_t*)p)); }
__device__ __forceinline__ float rowmax(const f32x16&p0,const f32x16&p1){
  float a=max3f(p0[0],p0[1],p1[0]),b=max3f(p0[2],p0[3],p1[1]);a=max3f(a,p1[2],p1[3]);
  #pragma unroll
  for(int r=4;r<16;r+=4){a=max3f(a,p0[r],p0[r+1]);b=max3f(b,p0[r+2],p0[r+3]);a=max3f(a,p1[r],p1[r+1]);b=max3f(b,p1[r+2],p1[r+3]);}
  const float m=max2f(a,b);
  auto rr=__builtin_amdgcn_permlane32_swap(__float_as_uint(m),__float_as_uint(m),false,false);
  return max2f(__uint_as_float(rr[0]),__uint_as_float(rr[1]));
}
__device__ __forceinline__ void pv(f32x16*o,int vb,bf16x8 pa0,bf16x8 pa1,bf16x8 pa2,bf16x8 pa3){
  #pragma unroll
  for(int d0=0;d0<2;++d0){s16x4 lo[4],hi[4];
    #pragma unroll
    for(int ks=0;ks<4;++ks){
      asm volatile("ds_read_b64_tr_b16 %0,%1 offset:%c2":"=&v"(lo[ks]):"v"(vb),"i"(d0*4096+ks*1024):"memory");
      asm volatile("ds_read_b64_tr_b16 %0,%1 offset:%c2":"=&v"(hi[ks]):"v"(vb),"i"(d0*4096+ks*1024+512):"memory");}
    asm volatile("s_waitcnt lgkmcnt(0)":::"memory");SBAR();
    #define PK(k) (bf16x8){lo[k][0],lo[k][1],lo[k][2],lo[k][3],hi[k][0],hi[k][1],hi[k][2],hi[k][3]}
    o[d0]=__builtin_amdgcn_mfma_f32_32x32x16_bf16(pa0,PK(0),o[d0],0,0,0);
    o[d0]=__builtin_amdgcn_mfma_f32_32x32x16_bf16(pa1,PK(1),o[d0],0,0,0);
    o[d0]=__builtin_amdgcn_mfma_f32_32x32x16_bf16(pa2,PK(2),o[d0],0,0,0);
    o[d0]=__builtin_amdgcn_mfma_f32_32x32x16_bf16(pa3,PK(3),o[d0],0,0,0);
    #undef PK
  }
}

#ifndef ATTN_STORE16
#define ATTN_STORE16(p,v) (*(u32x4*)(p)=(v))
#endif
template<int THRL,bool MOBA> __device__ __forceinline__ void attn_unit(int qb,const bf16*Qu,const bf16*__restrict__ Kh,const bf16*__restrict__ Vh,bf16*Ou,const float*__restrict__ km,const float*__restrict__ gm,char*shm){
  const int tid=fresh_tid(),lane=tid&63,r32=lane&31,hi=lane>>5; const int wid=__builtin_amdgcn_readfirstlane(tid>>6);
  const int q0=qb*QB;
  const bf16*Qw=Qu+(long)(wid*QBLK)*DM;
  const unsigned lds0=(unsigned)(uintptr_t)shm;
  float*wsf=(float*)(shm+LDS_WS)+wid*64;
  const bf16*ksrc=Kh+(long)lane*DM+wid*8;
  const bf16*vsrc=Vh+(long)(16*(wid&3)+(lane>>2))*DM+(wid>>2)*32+(lane&3)*8;
  const unsigned kdst=lds0+LDS_K+wid*1024, vdst=lds0+LDS_V+wid*1024;
  #define DMA_K(t,slot) glds16(ksrc+(long)(t)*KVBLK*DM,(unsigned)__builtin_amdgcn_readfirstlane(kdst+(slot)))
  #define DMA_V(t,slot) glds16(vsrc+(long)(t)*KVBLK*DM,(unsigned)__builtin_amdgcn_readfirstlane(vdst+(slot)))
  const int vb0=(int)(lds0+LDS_V)+((lane>>4)&1)*32+(lane&3)*8+(4*hi+((lane&15)>>2))*64;
  const char*Kbase=shm+LDS_K; bf16x8 kf[8];
  const lds_cptr shm3=(lds_cptr)shm; const lds_cptr kp0=shm3+LDS_K+hi*1024+r32*16; const lds_cptr vp0=shm3+LDS_V+((lane>>4)&1)*32+(lane&3)*8+(4*hi+((lane&15)>>2))*64;
  const int NT=(q0+QB)/KVBLK;
  DMA_K(0,0);DMA_V(0,0);DMA_K(1,SLOTB);
  bf16x8 qr[4];
  #pragma unroll
  for(int d0=0;d0<4;++d0)qr[d0]=*reinterpret_cast<const bf16x8*>(&Qw[(long)r32*DM+d0*16+hi*8]);
  unsigned selm=0u;
  if(MOBA){ float g[8];
    #pragma unroll
    for(int n=0;n<8;++n){ float s_=0.f; if(n<qb){
      #pragma unroll
      for(int d0=0;d0<4;++d0){ const float4 ka=*reinterpret_cast<const float4*>(km+n*64+d0*16+hi*8), kb2=*reinterpret_cast<const float4*>(km+n*64+d0*16+hi*8+4);
        const float kv[8]={ka.x,ka.y,ka.z,ka.w,kb2.x,kb2.y,kb2.z,kb2.w};
        #pragma unroll
        for(int j=0;j<8;++j)s_+=__uint_as_float(((unsigned)(unsigned short)qr[d0][j])<<16)*kv[j]; }
      s_+=__shfl_xor(s_,32); } g[n]=s_; asm volatile("":"+v"(s_)::"memory"); SBAR(); }
    #pragma unroll
    for(int r=0;r<3;++r){ float best=-3.0e38f; int bi=-1;
      #pragma unroll
      for(int n=0;n<8;++n) if(n<qb&&!((selm>>n)&1u)&&g[n]>best){best=g[n];bi=n;}
      if(bi>=0)selm|=1u<<bi; } }
  float l_reg=0.f;f32x16 o[2];o[0]=f32x16{};o[1]=f32x16{};
  const int qrel=wid*QBLK+r32;
  #define CMASK(P0,P1,t) do{int jb_=(t)-(NT-4); if(jb_>=0)cmask(P0,P1,jb_,qrel,hi); else if(MOBA) bmask(P0,P1,(selm>>((t)>>2))&1u);}while(0)
  #define START(P0,P1) do{ _Pragma("unroll") for(int r=0;r<16;++r)P0[r]=__builtin_amdgcn_exp2f(P0[r]); }while(0)
  #define RESC() do{}while(0)
  f32x16 pA0,pA1,pB0,pB1;
  int sl_prev=0,sl_cur=0,sl_next=SLOTB;
  #define ROT() do{sl_prev=sl_cur;sl_cur=sl_next;sl_next=(sl_next==(NSLOT-1)*SLOTB)?0:sl_next+SLOTB;}while(0)
  DMA_K(2,2*SLOTB);
  WAIT_BAR(3);
  qkt(pA0,pA1,Kbase,qr,r32,hi);asm volatile("s_nop 15\n\ts_nop 7":"+v"(pA0),"+v"(pA1));CMASK(pA0,pA1,0);
  START(pA0,pA1);
  _Pragma("unroll") for(int r=0;r<16;++r)pA1[r]=__builtin_amdgcn_exp2f(pA1[r]);
  WAIT_BAR(0);
  DMA_K(3,0);DMA_V(1,SLOTB);
  ROT();
  kload8(kf,kp0+sl_cur);
  WAIT_BAR(2);
  s16x4 vlo[8],vhi[8]; u32x4 pw0,pw1,pw2,pw3;
  #define PKW(P,B) cvtpk_s(P[B],P[B+1])
  #define PAF(k) __builtin_bit_cast(bf16x8,pw##k)
  #define VFR(i) (bf16x8){vlo[i][0],vlo[i][1],vlo[i][2],vlo[i][3],vhi[i][0],vhi[i][1],vhi[i][2],vhi[i][3]}
  #define PIN(x) asm volatile("":"+v"(x))
  #define MX3(a,b,c) __builtin_fmaxf(__builtin_fmaxf((a),(b)),(c))
  #define GAPA(MF,A0,A1,A2,A3,W0,W1,PW) do{ MF; sacc+=A0; sacc+=A1; sacc+=A2; sacc+=A3; PIN(sacc); W0; W1; PIN(PW); SBAR(); }while(0)
  #define EX(v) __builtin_amdgcn_exp2f(v)
  #define GAPB(MF,X,B) do{ MF; X[B]=EX(X[B]); X[B+1]=EX(X[B+1]); X[B+2]=EX(X[B+2]); X[B+3]=EX(X[B+3]); PIN(X); SBAR(); }while(0)
  #define VRD(i) do{ vlo[i]=vtr(vp_+(((i)>>2)*4096+((i)&3)*1024)); vhi[i]=vtr(vp_+(((i)>>2)*4096+((i)&3)*1024+512)); }while(0)
  #define KRD(G,j) do{ if(G){ kload2(kf,kp0+sl_next,j); SBAR(); } }while(0)
  #define STEP(C0,C1,P0,P1,t,GK,GV,GL) do{ SBAR(); \
    const lds_cptr vp_=vp0+sl_prev; \
    VRD(0); SBAR(); float sacc=(P0[0]+P0[1]); \
    GAPA(C0=__builtin_amdgcn_mfma_f32_32x32x16_bf16(kf[0],qr[0],f32x16{},0,0,0), P0[2],P0[3],P0[4],P0[5],     pw0[0]=PKW(P0,0), pw0[1]=PKW(P0,2), pw0); \
    VRD(4); SBAR(); GAPA(C1=__builtin_amdgcn_mfma_f32_32x32x16_bf16(kf[1],qr[0],f32x16{},0,0,0), P0[6],P0[7],P0[8],P0[9],     pw0[2]=PKW(P0,4), pw0[3]=PKW(P0,6), pw0); \
    VRD(1); SBAR(); GAPA(C0=__builtin_amdgcn_mfma_f32_32x32x16_bf16(kf[2],qr[1],C0,0,0,0),   P0[10],P0[11],P0[12],P0[13], pw1[0]=PKW(P0,8), pw1[1]=PKW(P0,10), pw1); \
    VRD(5); SBAR(); GAPA(C1=__builtin_amdgcn_mfma_f32_32x32x16_bf16(kf[3],qr[1],C1,0,0,0),   P0[14],P0[15],P1[0],P1[1],   pw1[2]=PKW(P0,12),pw1[3]=PKW(P0,14), pw1); \
    VRD(2); SBAR(); GAPA(C0=__builtin_amdgcn_mfma_f32_32x32x16_bf16(kf[4],qr[2],C0,0,0,0),   P1[2],P1[3],P1[4],P1[5],     pw2[0]=PKW(P1,0), pw2[1]=PKW(P1,2), pw2); \
    VRD(6); SBAR(); GAPA(C1=__builtin_amdgcn_mfma_f32_32x32x16_bf16(kf[5],qr[2],C1,0,0,0),   P1[6],P1[7],P1[8],P1[9],     pw2[2]=PKW(P1,4), pw2[3]=PKW(P1,6), pw2); \
    VRD(3); SBAR(); GAPA(C0=__builtin_amdgcn_mfma_f32_32x32x16_bf16(kf[6],qr[3],C0,0,0,0),   P1[10],P1[11],P1[12],P1[13], pw3[0]=PKW(P1,8), pw3[1]=PKW(P1,10), pw3); \
    VRD(7); SBAR(); GAPA(C1=__builtin_amdgcn_mfma_f32_32x32x16_bf16(kf[7],qr[3],C1,0,0,0),   P1[14],P1[15],0.f,0.f,       pw3[2]=PKW(P1,12),pw3[3]=PKW(P1,14), pw3); \
    l_reg+=sacc; \
    if(GK){DMA_K((t)+3,sl_cur);} if(GV){DMA_V((t)+1,sl_next);} \
    CMASK(C0,C1,t); \
    SBAR(); \
    GAPB(o[0]=__builtin_amdgcn_mfma_f32_32x32x16_bf16(PAF(0),VFR(0),o[0],0,0,0), C0,0); \
    GAPB(o[1]=__builtin_amdgcn_mfma_f32_32x32x16_bf16(PAF(0),VFR(4),o[1],0,0,0), C0,4); \
    KRD(GL,0); GAPB(o[0]=__builtin_amdgcn_mfma_f32_32x32x16_bf16(PAF(1),VFR(1),o[0],0,0,0), C0,8); \
    KRD(GL,1); GAPB(o[1]=__builtin_amdgcn_mfma_f32_32x32x16_bf16(PAF(1),VFR(5),o[1],0,0,0), C0,12); \
    KRD(GL,2); GAPB(o[0]=__builtin_amdgcn_mfma_f32_32x32x16_bf16(PAF(2),VFR(2),o[0],0,0,0), C1,0); \
    KRD(GL,3); GAPB(o[1]=__builtin_amdgcn_mfma_f32_32x32x16_bf16(PAF(2),VFR(6),o[1],0,0,0), C1,4); \
    GAPB(o[0]=__builtin_amdgcn_mfma_f32_32x32x16_bf16(PAF(3),VFR(3),o[0],0,0,0), C1,8); \
    GAPB(o[1]=__builtin_amdgcn_mfma_f32_32x32x16_bf16(PAF(3),VFR(7),o[1],0,0,0), C1,12); \
    }while(0)
  int t=1;
  #undef CMASK
  #define CMASK(P0,P1,t) do{ if(MOBA) bmask(P0,P1,(selm>>((t)>>2))&1u); }while(0)
  for(;t+5<NT;t+=2){
    STEP(pB0,pB1,pA0,pA1,t,true,true,true);     WAIT_BAR(2); RESC(); ROT();
    STEP(pA0,pA1,pB0,pB1,t+1,true,true,true);   WAIT_BAR(2); RESC(); ROT();
  }
  #undef CMASK
  #define CMASK(P0,P1,t) do{int jb_=(t)-(NT-4); if(jb_>=0)cmask(P0,P1,jb_,qrel,hi); else if(MOBA) bmask(P0,P1,(selm>>((t)>>2))&1u);}while(0)
  #define ENDW(tt) do{ if((tt)+3<NT){WAIT_BAR(2);} else if((tt)+2<NT){WAIT_BAR(1);} else {WAIT_BAR(0);} }while(0)
  for(;t+1<NT;t+=2){
    STEP(pB0,pB1,pA0,pA1,t,(t+3<NT),(t+1<NT),(t+1<NT));       ENDW(t);   RESC(); ROT();
    STEP(pA0,pA1,pB0,pB1,t+1,(t+4<NT),(t+2<NT),(t+2<NT));     ENDW(t+1); RESC(); ROT();
  }
  STEP(pB0,pB1,pA0,pA1,NT-1,false,false,false); RESC();
  { float sacc=pB0[0]+pB0[1]; _Pragma("unroll") for(int r=2;r<16;++r)sacc+=pB0[r]; _Pragma("unroll") for(int r=0;r<16;++r)sacc+=pB1[r]; l_reg+=sacc;
    pw0=(u32x4){PKW(pB0,0),PKW(pB0,2),PKW(pB0,4),PKW(pB0,6)};pw1=(u32x4){PKW(pB0,8),PKW(pB0,10),PKW(pB0,12),PKW(pB0,14)};pw2=(u32x4){PKW(pB1,0),PKW(pB1,2),PKW(pB1,4),PKW(pB1,6)};pw3=(u32x4){PKW(pB1,8),PKW(pB1,10),PKW(pB1,12),PKW(pB1,14)};
    SBAR(); pv(o,vb0+sl_cur,PAF(0),PAF(1),PAF(2),PAF(3)); }
  #undef PKW
  #undef PAF
  #undef VFR
  #undef PIN
  #undef MX3
  #undef GAPA
  #undef GAPB
  #undef EX
  #undef VRD
  #undef KRD
  #undef STEP
  #undef ENDW
  {auto rr=__builtin_amdgcn_permlane32_swap(__float_as_uint(l_reg),__float_as_uint(l_reg),false,false);l_reg=__uint_as_float(rr[0])+__uint_as_float(rr[1]);}
  if(hi==0)wsf[32+r32]=l_reg;asm volatile("s_waitcnt lgkmcnt(0)":::"memory");
  float rli[16];
  #pragma unroll
  for(int r=0;r<16;++r)rli[r]=__builtin_amdgcn_rcpf(wsf[32+crow(r,hi)]);
  bf16*Ow=Ou+(long)(wid*QBLK)*PO;
  { bf16*stg=(bf16*)(shm+LDS_OST)+wid*2048;
    #pragma unroll
    for(int r=0;r<16;++r){const int orow=crow(r,hi);
      #pragma unroll
      for(int d0=0;d0<2;++d0)stg[orow*64+d0*32+r32]=__float2bfloat16(o[d0][r]*rli[r]);}
    asm volatile("s_waitcnt lgkmcnt(0)":::"memory");
    #pragma unroll
    for(int i=0;i<4;++i){const int row=i*8+(lane>>3),ch=lane&7; u32x4 v=*(const u32x4*)(stg+row*64+ch*8);
      if(MOBA){ float f[8]; float ss=0.f;
        #pragma unroll
        for(int e=0;e<4;++e){ f[2*e]=__uint_as_float(v[e]<<16); f[2*e+1]=__uint_as_float(v[e]&0xffff0000u); ss+=f[2*e]*f[2*e]+f[2*e+1]*f[2*e+1]; }
        ss+=__shfl_xor(ss,1); ss+=__shfl_xor(ss,2); ss+=__shfl_xor(ss,4);
        const float rs=__builtin_amdgcn_rsqf(ss*(1.0f/64.0f)+1e-6f);
        const float4 g0=*reinterpret_cast<const float4*>(gm+ch*8), g1=*reinterpret_cast<const float4*>(gm+ch*8+4);
        v[0]=cvtpk_s(f[0]*rs*g0.x,f[1]*rs*g0.y); v[1]=cvtpk_s(f[2]*rs*g0.z,f[3]*rs*g0.w); v[2]=cvtpk_s(f[4]*rs*g1.x,f[5]*rs*g1.y); v[3]=cvtpk_s(f[6]*rs*g1.z,f[7]*rs*g1.w); }
      ATTN_STORE16(Ow+(long)row*PO+ch*8,v);} }
  asm volatile("s_waitcnt lgkmcnt(0)\n\ts_barrier":::"memory");
  #undef DMA_K
  #undef DMA_V
  #undef CMASK
  #undef START
  #undef RESC
  #undef ROT
}
constexpr int ATTN_LDS_BYTES=LDS_BYTES;
#undef SBAR
#undef WAIT_BAR
}
typedef unsigned short bf16;
constexpr int T = 65536, DM = 1024, SEQ = 2048, NB = 32;
constexpr size_t MiB = 1u << 20;
constexpr size_t WS_CTL = 0, WS_KMEAN = 1 * MiB, WS_ZERO_BYTES = 2 * MiB;
constexpr size_t WS_ROPE = 2 * MiB, WS_SCAL = 3 * MiB;
constexpr size_t WS_WIN = 4 * MiB, WS_WOUT = 10 * MiB, WS_WQ = 12 * MiB, WS_SUBK = 16 * MiB;
constexpr size_t WS_SS = 20 * MiB, WS_RS = 26 * MiB;
constexpr size_t WS_DOWN = 32 * MiB, WS_UP = 64 * MiB, WS_XN = 96 * MiB;
constexpr size_t WS_QKV = 224 * MiB, QKV_STRIDE = 64 * MiB;
constexpr size_t WS_PQ = 224 * MiB;
constexpr size_t WS_MIXED = 608 * MiB, WS_DO = 736 * MiB, WS_IDS = 864 * MiB, WS_GATES = 896 * MiB, WS_END = 928 * MiB;
constexpr size_t QKV_ELEMS = QKV_STRIDE / 2;
constexpr float QSCALE = 0.125f * 1.4426950408889634f;
constexpr float EPS = 1e-6f;

__device__ __forceinline__ unsigned f2bf(float f) { unsigned u = __float_as_uint(f); return (u + 0x7fffu + ((u >> 16) & 1u)) >> 16; }
__device__ __forceinline__ float bf2f(unsigned h) { return __uint_as_float(h << 16); }
__device__ __forceinline__ float wave_sum(float v) {
#pragma unroll
    for (int o = 1; o < 64; o <<= 1) v += __shfl_xor(v, o);
    return v;
}

#ifndef LAS
#define LAS __attribute__((address_space(3)))
#endif
#define GAS __attribute__((address_space(1)))
typedef GAS unsigned gu32;
#define XB_TMO      128
#define XB_XCNT(j)  (256  + 64 * (j))
#define XB_XSUB(j)  (1280 + 64 * (j))
#define XB_XGEN(j)  (2304 + 64 * (j))
#define XB_TOP      3328
#define XB_TOPGEN   3392
#define XCD_BAR_WORDS 3456
#define XB_SPIN_CAP (1u << 18)

__device__ __forceinline__ unsigned xb_ld(unsigned* p)              { return __hip_atomic_load(p, __ATOMIC_RELAXED, __HIP_MEMORY_SCOPE_AGENT); }
__device__ __forceinline__ unsigned xb_add(unsigned* p, unsigned v) { return __hip_atomic_fetch_add(p, v, __ATOMIC_RELAXED, __HIP_MEMORY_SCOPE_AGENT); }
__device__ __forceinline__ unsigned xb_xcc_id() { return (unsigned)__builtin_amdgcn_s_getreg((3 << 11) | 20) & 0xFu; }
#define XB_SPIN(cond, bar) do { unsigned _sp = 0; while (cond) { __builtin_amdgcn_s_sleep(1); \
    if ((++_sp & 255u) == 0u) { if (xb_ld(&(bar)[XB_TMO])) break; if (_sp > XB_SPIN_CAP) { atomicAdd(&(bar)[XB_TMO], 1u); break; } } } } while (0)

struct XcdBarrier {
    unsigned* bar; unsigned x;
    volatile LAS unsigned* st;
};

__device__ __forceinline__ XcdBarrier xcd_barrier_post(unsigned* bar, volatile LAS unsigned* st) {
    XcdBarrier b; b.bar = bar; b.x = xb_xcc_id(); b.st = st;
    if (threadIdx.x == 0) (void)xb_add(&bar[XB_XCNT(b.x)], 1u);
    return b;
}
__device__ __forceinline__ void xcd_barrier_complete(unsigned* bar, unsigned x, unsigned& nloc, unsigned& nx) {
    const unsigned G = gridDim.x * gridDim.y * gridDim.z;
    unsigned sum, cnt, mine, sp = 0u;
    for (;;) {
        sum = 0u; cnt = 0u; mine = 0u;
#pragma unroll
        for (unsigned j = 0; j < 16; ++j) { const unsigned c = xb_ld(&bar[XB_XCNT(j)]); sum += c; cnt += (c > 0u) ? 1u : 0u; mine = (j == x) ? c : mine; }
        if (sum == G) break;
        __builtin_amdgcn_s_sleep(1);
        if ((++sp & 255u) == 0u) { if (xb_ld(&bar[XB_TMO])) break; if (sp > XB_SPIN_CAP) { atomicAdd(&bar[XB_TMO], 1u); break; } }
    }
    nloc = mine > 0u ? mine : 1u; nx = cnt > 0u ? cnt : 1u;
}

__device__ __forceinline__ void xcd_barrier(const XcdBarrier& b) {
    asm volatile("s_waitcnt vmcnt(0)" ::: "memory");
    __syncthreads();
    if (threadIdx.x == 0) {
        unsigned* bar = b.bar;
        __builtin_amdgcn_s_waitcnt(0);
        unsigned nloc = b.st[0], nx = b.st[1];
        if (nloc == 0u) { xcd_barrier_complete(bar, b.x, nloc, nx); b.st[0] = nloc; b.st[1] = nx; }
        const unsigned old = xb_add(&bar[XB_XSUB(b.x)], 1u);
        const unsigned gen = old / nloc;
        if (old + 1u == (gen + 1u) * nloc) {
            __builtin_amdgcn_fence(__ATOMIC_RELEASE, "agent");
            asm volatile("s_waitcnt vmcnt(0)" ::: "memory");
            const unsigned og = xb_add(&bar[XB_TOP], 1u);
            const unsigned tg = og / nx;
            if (og + 1u == (tg + 1u) * nx) xb_add(&bar[XB_TOPGEN], 1u);
            else XB_SPIN(xb_ld(&bar[XB_TOPGEN]) == tg, bar);
            __builtin_amdgcn_fence(__ATOMIC_ACQUIRE, "agent");
            xb_add(&bar[XB_XGEN(b.x)], 1u);
            asm volatile("s_waitcnt vmcnt(0)" ::: "memory");
        } else {
            XB_SPIN(xb_ld(&bar[XB_XGEN(b.x)]) == gen, bar);
            __builtin_amdgcn_fence(__ATOMIC_ACQUIRE, "agent");
            asm volatile("s_waitcnt vmcnt(0)" ::: "memory");
        }
    }
    __syncthreads();
}
#ifndef LAS
#define LAS __attribute__((address_space(3)))
#endif
constexpr int NTHR = 512, NWAVE = 8;
constexpr int LDS_BYTES = 147456;

struct Params {
    const float* in[19]; float* out; unsigned char* ws;
};

template <bool HEADPERM> __device__ __forceinline__ void ph_transpose(const float* __restrict__ W, int K, int N, bf16* __restrict__ WT, float* tiles, int wg, int nwg, int tid, const float* __restrict__ kgain = nullptr) {
    float (*tile)[33] = (float (*)[33])(tiles + (tid >> 8) * (32 * 33));
    const int nt_n = N / 32, nitems = nt_n * (K / 32), tx = tid & 31, ty = (tid & 255) >> 5;
    for (int it0 = wg * 2; it0 < nitems; it0 += nwg * 2) {
        const int it = it0 + (tid >> 8); const bool act = it < nitems;
        const int n0 = (it % nt_n) * 32, k0 = (it / nt_n) * 32;
        if (act) for (int i = ty; i < 32; i += 8) tile[i][tx] = W[(size_t)(k0 + i) * N + n0 + tx];
        __syncthreads();
        if (act) for (int i = ty; i < 32; i += 8) { int nn = n0 + i; if (HEADPERM) nn = (nn & ~255) | (((nn >> 5) & 1) << 7) | (((nn >> 6) & 3) << 5) | (nn & 31);
            WT[(size_t)nn * K + k0 + tx] = (bf16)f2bf(tile[tx][i] * (kgain ? kgain[k0 + tx] : 1.0f)); }
        __syncthreads();
    }
}
__device__ __forceinline__ void ph_convert(const float* __restrict__ src, bf16* __restrict__ dst, size_t n4, int wg, int nwg, int tid) {
    for (size_t i = (size_t)wg * NTHR + tid; i < n4; i += (size_t)nwg * NTHR) {
        const float4 v = ((const float4*)src)[i];
        uint2 o; o.x = f2bf(v.x) | (f2bf(v.y) << 16); o.y = f2bf(v.z) | (f2bf(v.w) << 16);
        ((uint2*)dst)[i] = o;
    }
}
__device__ __forceinline__ void ph_rope(float* __restrict__ rope, int wg, int nwg, int tid) {
    for (int i = wg * NTHR + tid; i < SEQ * 32; i += nwg * NTHR) {
        const int pos = i >> 5, j = i & 31;
        const float inv = 1.0f / exp2f((float)j * (13.287712379549449f / 32.0f));
        const float ang = (float)pos * inv;
        double rev = (double)ang * 0.15915494309189535; rev -= floor(rev);
        rope[i] = __builtin_amdgcn_cosf((float)rev); rope[SEQ * 32 + i] = __builtin_amdgcn_sinf((float)rev);
    }
}
__device__ __forceinline__ void ph_rmsnorm(const float* __restrict__ x, const float* __restrict__ g, bf16* __restrict__ out, int rows, int wg, int nwg, int tid) {
    const int lane = tid & 63, nw = nwg * NWAVE;
    for (int r = wg * NWAVE + (tid >> 6); r < rows; r += nw) {
        const float4* xr = (const float4*)(x + (size_t)r * DM) + lane;
        float4 v[4]; float s = 0.f;
#pragma unroll
        for (int j = 0; j < 4; ++j) { v[j] = xr[64 * j]; s += (v[j].x * v[j].x + v[j].y * v[j].y) + (v[j].z * v[j].z + v[j].w * v[j].w); }
        const float rs = rsqrtf(wave_sum(s) * (1.0f / DM) + EPS);
        uint2* o = (uint2*)(out + (size_t)r * DM) + lane;
#pragma unroll
        for (int j = 0; j < 4; ++j) { const float4 gg = ((const float4*)g)[lane + 64 * j];
            uint2 w; w.x = f2bf(v[j].x * rs * gg.x) | (f2bf(v[j].y * rs * gg.y) << 16); w.y = f2bf(v[j].z * rs * gg.z) | (f2bf(v[j].w * rs * gg.w) << 16);
            o[64 * j] = w; }
    }
}
__device__ __forceinline__ void ph_qk_post(bf16* __restrict__ qkv, const float* __restrict__ rope, const float* __restrict__ gqm, const float* __restrict__ gkm,
                                           const float* __restrict__ gqd, const float* __restrict__ gkd, float* __restrict__ kmean, int wg, int nwg, int tid) {
    const int lane = tid & 63, half = lane >> 5, j = lane & 31, wv = tid >> 6;
    for (int blk = wg; blk < T / 256; blk += nwg) {
        float ks[4][2];
#pragma unroll
        for (int a = 0; a < 4; ++a) { ks[a][0] = 0.f; ks[a][1] = 0.f; }
        for (int tt = wv; tt < 256; tt += NWAVE) {
            const int t = blk * 256 + tt, pos = t & (SEQ - 1);
            const float c = rope[pos * 32 + j], sn = rope[SEQ * 32 + pos * 32 + j];
#pragma unroll
            for (int it = 0; it < 16; ++it) {
                const int s = it * 2 + half, type = it >> 2, hs = s & 7;
                bf16* buf = qkv + (size_t)(type < 2 ? type : type + 1) * QKV_ELEMS + (size_t)t * 512 + hs * 64;
                const float x1 = bf2f(buf[j]), x2 = bf2f(buf[j + 32]);
                float ss = x1 * x1 + x2 * x2;
#pragma unroll
                for (int o = 1; o < 32; o <<= 1) ss += __shfl_xor(ss, o);
                const float rs = rsqrtf(ss * (1.0f / 64.0f) + EPS);
                const float* g = type == 0 ? gqm : type == 1 ? gkm : type == 2 ? gqd + (hs & 1) * 64 : gkd + (hs & 1) * 64;
                const float y1 = x1 * rs * g[j], y2 = x2 * rs * g[j + 32];
                float o1 = y1 * c - y2 * sn, o2 = y2 * c + y1 * sn;
                if (type == 0 || type == 2) { o1 *= QSCALE; o2 *= QSCALE; }
                if (type == 1) { ks[it - 4][0] += o1; ks[it - 4][1] += o2; }
                buf[j] = (bf16)f2bf(o1); buf[j + 32] = (bf16)f2bf(o2);
            }
        }
        const int b = blk >> 3, nb = blk & 7;
#pragma unroll
        for (int a = 0; a < 4; ++a) { const int h = a * 2 + half; float* km = kmean + (((size_t)b * 8 + h) * 8 + nb) * 64;
            atomicAdd(km + j, ks[a][0] * (1.0f / 256.0f)); atomicAdd(km + j + 32, ks[a][1] * (1.0f / 256.0f)); }
    }
}
__device__ __forceinline__ void ph_diff_combine(const bf16* __restrict__ dob, float lam, const float* __restrict__ gain_d, bf16* __restrict__ mixed, int wg, int nwg, int tid) {
    const int lane = tid & 63, nw = nwg * NWAVE;
    for (int w = wg * NWAVE + (tid >> 6); w < T * 4; w += nw) {
        const int t = w >> 2, h = w & 3; const bf16* p = dob + (size_t)t * 1024 + h * 256;
        const float da = bf2f(p[lane]) - lam * bf2f(p[128 + lane]), db = bf2f(p[64 + lane]) - lam * bf2f(p[192 + lane]);
        const float rs = rsqrtf(wave_sum(da * da + db * db) * (1.0f / 128.0f) + EPS) * 0.8f;
        bf16* o = mixed + (size_t)t * 1024 + 512 + h * 128;
        o[lane] = (bf16)f2bf(da * rs * gain_d[h * 128 + lane]); o[64 + lane] = (bf16)f2bf(db * rs * gain_d[h * 128 + 64 + lane]);
    }
}
typedef float rf32x16 __attribute__((ext_vector_type(16)));
typedef short rbf16x8 __attribute__((ext_vector_type(8)));
__device__ __forceinline__ unsigned umax_(unsigned a, unsigned b) { return a > b ? a : b; }
__device__ __forceinline__ unsigned umin_(unsigned a, unsigned b) { return a > b ? b : a; }
#define CE_D(x, y) { const unsigned mx_ = umax_(x, y), mn_ = umin_(x, y); x = mx_; y = mn_; }
__device__ __forceinline__ void sort16_desc(unsigned (&v)[16]) {
    CE_D(v[0], v[1]) CE_D(v[3], v[2]) CE_D(v[4], v[5]) CE_D(v[7], v[6]) CE_D(v[8], v[9]) CE_D(v[11], v[10]) CE_D(v[12], v[13]) CE_D(v[15], v[14])
    CE_D(v[0], v[2]) CE_D(v[1], v[3]) CE_D(v[6], v[4]) CE_D(v[7], v[5]) CE_D(v[8], v[10]) CE_D(v[9], v[11]) CE_D(v[14], v[12]) CE_D(v[15], v[13])
    CE_D(v[0], v[1]) CE_D(v[2], v[3]) CE_D(v[5], v[4]) CE_D(v[7], v[6]) CE_D(v[8], v[9]) CE_D(v[10], v[11]) CE_D(v[13], v[12]) CE_D(v[15], v[14])
    CE_D(v[0], v[4]) CE_D(v[1], v[5]) CE_D(v[2], v[6]) CE_D(v[3], v[7]) CE_D(v[12], v[8]) CE_D(v[13], v[9]) CE_D(v[14], v[10]) CE_D(v[15], v[11])
    CE_D(v[0], v[2]) CE_D(v[1], v[3]) CE_D(v[4], v[6]) CE_D(v[5], v[7]) CE_D(v[10], v[8]) CE_D(v[11], v[9]) CE_D(v[14], v[12]) CE_D(v[15], v[13])
    CE_D(v[0], v[1]) CE_D(v[2], v[3]) CE_D(v[4], v[5]) CE_D(v[6], v[7]) CE_D(v[9], v[8]) CE_D(v[11], v[10]) CE_D(v[13], v[12]) CE_D(v[15], v[14])
    CE_D(v[0], v[8]) CE_D(v[1], v[9]) CE_D(v[2], v[10]) CE_D(v[3], v[11]) CE_D(v[4], v[12]) CE_D(v[5], v[13]) CE_D(v[6], v[14]) CE_D(v[7], v[15])
    CE_D(v[0], v[4]) CE_D(v[1], v[5]) CE_D(v[2], v[6]) CE_D(v[3], v[7]) CE_D(v[8], v[12]) CE_D(v[9], v[13]) CE_D(v[10], v[14]) CE_D(v[11], v[15])
    CE_D(v[0], v[2]) CE_D(v[1], v[3]) CE_D(v[4], v[6]) CE_D(v[5], v[7]) CE_D(v[8], v[10]) CE_D(v[9], v[11]) CE_D(v[12], v[14]) CE_D(v[13], v[15])
    CE_D(v[0], v[1]) CE_D(v[2], v[3]) CE_D(v[4], v[5]) CE_D(v[6], v[7]) CE_D(v[8], v[9]) CE_D(v[10], v[11]) CE_D(v[12], v[13]) CE_D(v[14], v[15])
}
__device__ __forceinline__ void merge16_desc(unsigned (&a)[16], const unsigned (&b)[16]) {
    a[0] = umax_(a[0], b[15]); a[1] = umax_(a[1], b[14]); a[2] = umax_(a[2], b[13]); a[3] = umax_(a[3], b[12]); a[4] = umax_(a[4], b[11]); a[5] = umax_(a[5], b[10]); a[6] = umax_(a[6], b[9]); a[7] = umax_(a[7], b[8]); a[8] = umax_(a[8], b[7]); a[9] = umax_(a[9], b[6]); a[10] = umax_(a[10], b[5]); a[11] = umax_(a[11], b[4]); a[12] = umax_(a[12], b[3]); a[13] = umax_(a[13], b[2]); a[14] = umax_(a[14], b[1]); a[15] = umax_(a[15], b[0]);
    CE_D(a[0], a[8]) CE_D(a[1], a[9]) CE_D(a[2], a[10]) CE_D(a[3], a[11]) CE_D(a[4], a[12]) CE_D(a[5], a[13]) CE_D(a[6], a[14]) CE_D(a[7], a[15])
    CE_D(a[0], a[4]) CE_D(a[1], a[5]) CE_D(a[2], a[6]) CE_D(a[3], a[7]) CE_D(a[8], a[12]) CE_D(a[9], a[13]) CE_D(a[10], a[14]) CE_D(a[11], a[15])
    CE_D(a[0], a[2]) CE_D(a[1], a[3]) CE_D(a[4], a[6]) CE_D(a[5], a[7]) CE_D(a[8], a[10]) CE_D(a[9], a[11]) CE_D(a[12], a[14]) CE_D(a[13], a[15])
    CE_D(a[0], a[1]) CE_D(a[2], a[3]) CE_D(a[4], a[5]) CE_D(a[6], a[7]) CE_D(a[8], a[9]) CE_D(a[10], a[11]) CE_D(a[12], a[13]) CE_D(a[14], a[15])
}
__device__ __forceinline__ void top16_of_64(unsigned (&G)[4][16]) {
    sort16_desc(G[0]); sort16_desc(G[1]); sort16_desc(G[2]); sort16_desc(G[3]);
    merge16_desc(G[0], G[1]); merge16_desc(G[2], G[3]); merge16_desc(G[0], G[2]);
}
__device__ __forceinline__ void route_scores(unsigned (&Lp)[16], const rbf16x8 (&bq)[8], const LAS unsigned char* kfr, int lane, int hi) {
    unsigned G[4][16]; unsigned hmask = hi ? ~4u : ~0u; asm volatile("" : "+v"(hmask));
#pragma unroll
    for (int nb = 0; nb < 4; ++nb) {
        rf32x16 acc = rf32x16{};
#pragma unroll
        for (int s = 0; s < 8; ++s) { const rbf16x8 a = *(const LAS rbf16x8*)(kfr + (nb * 8 + s) * 1024 + lane * 16); acc = __builtin_amdgcn_mfma_f32_32x32x16_bf16(a, bq[s], acc, 0, 0, 0); }
#pragma unroll
        for (int i = 0; i < 16; ++i) { const float v = fmaxf(acc[i] + 16.0f, 0.0f); const int n = nb * 32 + (i & 3) + 8 * (i >> 2);
            G[nb][i] = ((__float_as_uint(v) & ~127u) | (unsigned)(127 - n)) & hmask; }
        asm volatile("" ::: "memory"); __builtin_amdgcn_sched_barrier(0);
    }
    top16_of_64(G);
    unsigned O[16];
#pragma unroll
    for (int i = 0; i < 16; ++i) { auto rr = __builtin_amdgcn_permlane32_swap(G[0][i], G[0][i], false, false); O[i] = hi ? rr[0] : rr[1]; }
    merge16_desc(G[0], O);
#pragma unroll
    for (int i = 0; i < 16; ++i) Lp[i] = G[0][i];
    asm volatile("" ::: "memory"); __builtin_amdgcn_sched_barrier(0);
}
__device__ __forceinline__ void route_loadq(rbf16x8 (&bq)[8], const bf16* __restrict__ PQ, int tb, int hp, int lane) {
    const bf16* qp = PQ + (((size_t)tb * 16 + hp) * 8 * 64 + lane) * 8;
#pragma unroll
    for (int s = 0; s < 8; ++s) bq[s] = *(const rbf16x8*)(qp + s * 512);
}
__device__ __forceinline__ void route_loadk(pg8::u32x4 (&kr)[8], const bf16* __restrict__ subk, int h, int tid) {
#pragma unroll
    for (int i = 0; i < 8; ++i) { const int e = i * NTHR + tid, f = e >> 6, l2 = e & 63;
        kr[i] = *(const pg8::u32x4*)(subk + ((size_t)(h * 2 + (f >> 5)) * 128 + ((f >> 3) & 3) * 32 + (l2 & 31)) * 128 + 16 * (f & 7) + 8 * (l2 >> 5)); }
}
__device__ __forceinline__ void ph_peer_route(const bf16* __restrict__ PQ, const bf16* __restrict__ subk, int* __restrict__ ids, float* __restrict__ gates, LAS unsigned char* lds3, int wg, int nwg, int tid) {
    const int lane = tid & 63, r = lane & 31, hi = lane >> 5, wv = tid >> 6;
    LAS unsigned* myl = (LAS unsigned*)(lds3 + 65536) + wv * 2048;
    for (int tb0 = wg * NWAVE; tb0 < T / 32; tb0 += nwg * NWAVE) {
        const int tb = tb0 + wv; const bool live = tb < T / 32; const int t = (live ? tb : 0) * 32 + r;
        rbf16x8 bqA[8], bqB[8];
        route_loadq(bqA, PQ, live ? tb : 0, 0, lane);
        for (int h = 0; h < 8; ++h) {
            __syncthreads();
            { pg8::u32x4 kr[8]; route_loadk(kr, subk, h, tid);
#pragma unroll
              for (int i = 0; i < 8; ++i) *(LAS pg8::u32x4*)(lds3 + (i * NTHR + tid) * 16) = kr[i]; }
            __syncthreads();
            unsigned L[2][16];
            route_loadq(bqB, PQ, live ? tb : 0, h * 2 + 1, lane);
            route_scores(L[0], bqA, lds3, lane, hi);
            if (h < 7) route_loadq(bqA, PQ, live ? tb : 0, h * 2 + 2, lane);
            route_scores(L[1], bqB, lds3 + 32768, lane, hi);
#pragma unroll
            for (int i = 0; i < 16; ++i) { myl[i * 64 + lane] = 127u - (L[0][i] & 127u); myl[(16 + i) * 64 + lane] = 127u - (L[1][i] & 127u); }
            float fa[16], fb[16];
#pragma unroll
            for (int i = 0; i < 16; ++i) { fa[i] = __uint_as_float(L[0][i] & ~127u); fb[i] = __uint_as_float(L[1][i] & ~127u); }
            unsigned C[4][16];
            C[0][0] = (__float_as_uint(fmaxf(fa[0] + fb[0] - 24.0f, 0.0f)) & ~255u) | 255u;
            C[0][1] = (__float_as_uint(fmaxf(fa[0] + fb[1] - 24.0f, 0.0f)) & ~255u) | 254u;
            C[0][2] = (__float_as_uint(fmaxf(fa[0] + fb[2] - 24.0f, 0.0f)) & ~255u) | 253u;
            C[0][3] = (__float_as_uint(fmaxf(fa[0] + fb[3] - 24.0f, 0.0f)) & ~255u) | 252u;
            C[0][4] = (__float_as_uint(fmaxf(fa[0] + fb[4] - 24.0f, 0.0f)) & ~255u) | 251u;
            C[0][5] = (__float_as_uint(fmaxf(fa[0] + fb[5] - 24.0f, 0.0f)) & ~255u) | 250u;
            C[0][6] = (__float_as_uint(fmaxf(fa[0] + fb[6] - 24.0f, 0.0f)) & ~255u) | 249u;
            C[0][7] = (__float_as_uint(fmaxf(fa[0] + fb[7] - 24.0f, 0.0f)) & ~255u) | 248u;
            C[0][8] = (__float_as_uint(fmaxf(fa[0] + fb[8] - 24.0f, 0.0f)) & ~255u) | 247u;
            C[0][9] = (__float_as_uint(fmaxf(fa[0] + fb[9] - 24.0f, 0.0f)) & ~255u) | 246u;
            C[0][10] = (__float_as_uint(fmaxf(fa[0] + fb[10] - 24.0f, 0.0f)) & ~255u) | 245u;
            C[0][11] = (__float_as_uint(fmaxf(fa[0] + fb[11] - 24.0f, 0.0f)) & ~255u) | 244u;
            C[0][12] = (__float_as_uint(fmaxf(fa[0] + fb[12] - 24.0f, 0.0f)) & ~255u) | 243u;
            C[0][13] = (__float_as_uint(fmaxf(fa[0] + fb[13] - 24.0f, 0.0f)) & ~255u) | 242u;
            C[0][14] = (__float_as_uint(fmaxf(fa[0] + fb[14] - 24.0f, 0.0f)) & ~255u) | 241u;
            C[0][15] = (__float_as_uint(fmaxf(fa[0] + fb[15] - 24.0f, 0.0f)) & ~255u) | 240u;
            C[1][0] = (__float_as_uint(fmaxf(fa[1] + fb[0] - 24.0f, 0.0f)) & ~255u) | 239u;
            C[1][1] = (__float_as_uint(fmaxf(fa[1] + fb[1] - 24.0f, 0.0f)) & ~255u) | 238u;
            C[1][2] = (__float_as_uint(fmaxf(fa[1] + fb[2] - 24.0f, 0.0f)) & ~255u) | 237u;
            C[1][3] = (__float_as_uint(fmaxf(fa[1] + fb[3] - 24.0f, 0.0f)) & ~255u) | 236u;
            C[1][4] = (__float_as_uint(fmaxf(fa[1] + fb[4] - 24.0f, 0.0f)) & ~255u) | 235u;
            C[1][5] = (__float_as_uint(fmaxf(fa[1] + fb[5] - 24.0f, 0.0f)) & ~255u) | 234u;
            C[1][6] = (__float_as_uint(fmaxf(fa[1] + fb[6] - 24.0f, 0.0f)) & ~255u) | 233u;
            C[1][7] = (__float_as_uint(fmaxf(fa[1] + fb[7] - 24.0f, 0.0f)) & ~255u) | 232u;
            C[1][8] = (__float_as_uint(fmaxf(fa[2] + fb[0] - 24.0f, 0.0f)) & ~255u) | 223u;
            C[1][9] = (__float_as_uint(fmaxf(fa[2] + fb[1] - 24.0f, 0.0f)) & ~255u) | 222u;
            C[1][10] = (__float_as_uint(fmaxf(fa[2] + fb[2] - 24.0f, 0.0f)) & ~255u) | 221u;
            C[1][11] = (__float_as_uint(fmaxf(fa[2] + fb[3] - 24.0f, 0.0f)) & ~255u) | 220u;
            C[1][12] = (__float_as_uint(fmaxf(fa[2] + fb[4] - 24.0f, 0.0f)) & ~255u) | 219u;
            C[1][13] = (__float_as_uint(fmaxf(fa[3] + fb[0] - 24.0f, 0.0f)) & ~255u) | 207u;
            C[1][14] = (__float_as_uint(fmaxf(fa[3] + fb[1] - 24.0f, 0.0f)) & ~255u) | 206u;
            C[1][15] = (__float_as_uint(fmaxf(fa[3] + fb[2] - 24.0f, 0.0f)) & ~255u) | 205u;
            C[2][0] = (__float_as_uint(fmaxf(fa[3] + fb[3] - 24.0f, 0.0f)) & ~255u) | 204u;
            C[2][1] = (__float_as_uint(fmaxf(fa[4] + fb[0] - 24.0f, 0.0f)) & ~255u) | 191u;
            C[2][2] = (__float_as_uint(fmaxf(fa[4] + fb[1] - 24.0f, 0.0f)) & ~255u) | 190u;
            C[2][3] = (__float_as_uint(fmaxf(fa[4] + fb[2] - 24.0f, 0.0f)) & ~255u) | 189u;
            C[2][4] = (__float_as_uint(fmaxf(fa[5] + fb[0] - 24.0f, 0.0f)) & ~255u) | 175u;
            C[2][5] = (__float_as_uint(fmaxf(fa[5] + fb[1] - 24.0f, 0.0f)) & ~255u) | 174u;
            C[2][6] = (__float_as_uint(fmaxf(fa[6] + fb[0] - 24.0f, 0.0f)) & ~255u) | 159u;
            C[2][7] = (__float_as_uint(fmaxf(fa[6] + fb[1] - 24.0f, 0.0f)) & ~255u) | 158u;
            C[2][8] = (__float_as_uint(fmaxf(fa[7] + fb[0] - 24.0f, 0.0f)) & ~255u) | 143u;
            C[2][9] = (__float_as_uint(fmaxf(fa[7] + fb[1] - 24.0f, 0.0f)) & ~255u) | 142u;
            C[2][10] = (__float_as_uint(fmaxf(fa[8] + fb[0] - 24.0f, 0.0f)) & ~255u) | 127u;
            C[2][11] = (__float_as_uint(fmaxf(fa[9] + fb[0] - 24.0f, 0.0f)) & ~255u) | 111u;
            C[2][12] = (__float_as_uint(fmaxf(fa[10] + fb[0] - 24.0f, 0.0f)) & ~255u) | 95u;
            C[2][13] = (__float_as_uint(fmaxf(fa[11] + fb[0] - 24.0f, 0.0f)) & ~255u) | 79u;
            C[2][14] = (__float_as_uint(fmaxf(fa[12] + fb[0] - 24.0f, 0.0f)) & ~255u) | 63u;
            C[2][15] = (__float_as_uint(fmaxf(fa[13] + fb[0] - 24.0f, 0.0f)) & ~255u) | 47u;
            C[3][0] = (__float_as_uint(fmaxf(fa[14] + fb[0] - 24.0f, 0.0f)) & ~255u) | 31u;
            C[3][1] = (__float_as_uint(fmaxf(fa[15] + fb[0] - 24.0f, 0.0f)) & ~255u) | 15u;
            C[3][2] = 0u;
            C[3][3] = 0u;
            C[3][4] = 0u;
            C[3][5] = 0u;
            C[3][6] = 0u;
            C[3][7] = 0u;
            C[3][8] = 0u;
            C[3][9] = 0u;
            C[3][10] = 0u;
            C[3][11] = 0u;
            C[3][12] = 0u;
            C[3][13] = 0u;
            C[3][14] = 0u;
            C[3][15] = 0u;
            top16_of_64(C);
            const float s0 = __uint_as_float(C[0][0] & ~255u);
            float ex[16]; float sum = 0.f; int eid[16];
#pragma unroll
            for (int k = 0; k < 16; ++k) { ex[k] = __expf(__uint_as_float(C[0][k] & ~255u) - s0); sum += ex[k];
                const unsigned code = 255u - (C[0][k] & 255u); const unsigned ia = myl[(code >> 4) * 64 + lane], ib = myl[(16 + (code & 15u)) * 64 + lane]; eid[k] = (int)(ia * 128u + ib); }
            const float inv = 1.0f / sum;
            if (live && hi == 0) { int4* dst = (int4*)(ids + (size_t)t * 128 + h * 16);
#pragma unroll
                for (int k = 0; k < 4; ++k) dst[k] = make_int4(eid[4 * k], eid[4 * k + 1], eid[4 * k + 2], eid[4 * k + 3]); }
            else if (live) { float4* dst = (float4*)(gates + (size_t)t * 128 + h * 16);
#pragma unroll
                for (int k = 0; k < 4; ++k) dst[k] = make_float4(ex[4 * k] * inv, ex[4 * k + 1] * inv, ex[4 * k + 2] * inv, ex[4 * k + 3] * inv); }
        }
    }
}
typedef __bf16 bf16x2_t __attribute__((ext_vector_type(2)));
__device__ __forceinline__ float dot2bf(unsigned a, unsigned b, float acc) { return __builtin_amdgcn_fdot2_f32_bf16(__builtin_bit_cast(bf16x2_t, a), __builtin_bit_cast(bf16x2_t, b), acc, false); }
__device__ __forceinline__ float dot8(const uint4 a, const uint4 b, float s) { s = dot2bf(a.x, b.x, s); s = dot2bf(a.y, b.y, s); s = dot2bf(a.z, b.z, s); s = dot2bf(a.w, b.w, s); return s; }
__device__ __forceinline__ float gelu_erf(float z) { return 0.5f * z * (1.0f + erff(z * 0.70710678118654752f)); }
constexpr float TSCALE = 32.0f, TINV = 1.0f / 32.0f;
typedef float f32x2g __attribute__((ext_vector_type(2)));
#ifndef GATHER_STATIC
#define GATHER_STATIC 0
#endif
constexpr int GB = 4;
struct GBatch { uint4 d[GB]; uint4 u[GB]; float g[GB]; };
__device__ __forceinline__ void gb_load(GBatch& B, unsigned k0, unsigned k1, const float* __restrict__ gp, int e0, const unsigned char* __restrict__ down, const unsigned char* __restrict__ up, int lane) {
#pragma unroll
    for (int j = 0; j < GB; ++j) { const int el = e0 + j; const unsigned key = (unsigned)__builtin_amdgcn_readlane((int)((el & 1) ? k1 : k0), el >> 1);
        const int id = (int)(key >> 7); B.g[j] = gp[key & 127u];
        B.d[j] = *(const uint4*)(down + (size_t)id * DM + lane * 16); B.u[j] = *(const uint4*)(up + (size_t)id * DM + lane * 16); }
}
__device__ __forceinline__ void sort128(unsigned& k0, unsigned& k1, int lane) {
#pragma unroll
    for (int k = 2; k <= 128; k <<= 1)
#pragma unroll
        for (int j = k >> 1; j >= 1; j >>= 1) {
            if (j == 1) { const bool asc = ((2 * lane) & k) == 0; const unsigned lo = k0 < k1 ? k0 : k1, hi = k0 < k1 ? k1 : k0; k0 = asc ? lo : hi; k1 = asc ? hi : lo; }
            else { const int lj = j >> 1; const unsigned p0 = (unsigned)__shfl_xor((int)k0, lj), p1 = (unsigned)__shfl_xor((int)k1, lj);
                const bool asc = ((2 * lane) & k) == 0, lower = (lane & lj) == 0;
                const bool keepmin = asc == lower;
                k0 = keepmin ? (k0 < p0 ? k0 : p0) : (k0 < p0 ? p0 : k0); k1 = keepmin ? (k1 < p1 ? k1 : p1) : (k1 < p1 ? p1 : k1); }
        }
}
__device__ __forceinline__ void unpack16(const uint4 v, f32x2g (&f)[8]) {
    f[0] = __builtin_amdgcn_cvt_pk_f32_fp8((int)v.x, false); f[1] = __builtin_amdgcn_cvt_pk_f32_fp8((int)v.x, true);
    f[2] = __builtin_amdgcn_cvt_pk_f32_fp8((int)v.y, false); f[3] = __builtin_amdgcn_cvt_pk_f32_fp8((int)v.y, true);
    f[4] = __builtin_amdgcn_cvt_pk_f32_fp8((int)v.z, false); f[5] = __builtin_amdgcn_cvt_pk_f32_fp8((int)v.z, true);
    f[6] = __builtin_amdgcn_cvt_pk_f32_fp8((int)v.w, false); f[7] = __builtin_amdgcn_cvt_pk_f32_fp8((int)v.w, true);
}
__device__ __forceinline__ void gb_compute(const GBatch& B, const f32x2g (&xf)[8], f32x2g (&acc)[8], float zscale) {
    float z[GB];
#pragma unroll
    for (int j = 0; j < GB; ++j) { f32x2g d[8]; unpack16(B.d[j], d); f32x2g s = xf[0] * d[0];
#pragma unroll
        for (int i = 1; i < 8; ++i) s = __builtin_elementwise_fma(xf[i], d[i], s);
        z[j] = s.x + s.y; }
#pragma unroll
    for (int o = 1; o < 64; o <<= 1) {
#pragma unroll
        for (int j = 0; j < GB; ++j) z[j] += __shfl_xor(z[j], o); }
#pragma unroll
    for (int j = 0; j < GB; ++j) { const float w = B.g[j] * gelu_erf(z[j] * zscale); f32x2g u[8]; unpack16(B.u[j], u); const f32x2g w2 = {w, w};
#pragma unroll
        for (int i = 0; i < 8; ++i) acc[i] = __builtin_elementwise_fma(u[i], w2, acc[i]); }
}
__device__ __forceinline__ void ph_peer_gather(const bf16* __restrict__ xn, const int* __restrict__ ids, const float* __restrict__ gates, const unsigned char* __restrict__ down, const unsigned char* __restrict__ up, const float* x1, float* outw, unsigned* ctr, int tid, const float* __restrict__ rsv) {
    const int lane = tid & 63;
#if GATHER_STATIC
    const int nw_ = gridDim.x * NWAVE;
    for (int t = blockIdx.x * NWAVE + (tid >> 6); t < T; t += nw_) {
#else
    int t; { unsigned v_ = 0; if (lane == 0) v_ = atomicAdd(ctr, 1u); t = (int)__builtin_amdgcn_readfirstlane(v_); }
    while (t < T) {
        unsigned vn_ = 0; if (lane == 0) vn_ = atomicAdd(ctr, 1u);
#endif
        const int* idp = ids + (size_t)t * 128; const float* gp = gates + (size_t)t * 128;
        unsigned k0 = ((unsigned)idp[2 * lane] << 7) | (unsigned)(2 * lane), k1 = ((unsigned)idp[2 * lane + 1] << 7) | (unsigned)(2 * lane + 1);
        sort128(k0, k1, lane);
        GBatch B0, B1, B2;
        gb_load(B0, k0, k1, gp, 0, down, up, lane); gb_load(B1, k0, k1, gp, GB, down, up, lane);
        f32x2g xf[8];
        { const uint4 xa = *(const uint4*)(xn + (size_t)t * DM + lane * 16), xb = *(const uint4*)(xn + (size_t)t * DM + lane * 16 + 8);
          const unsigned xw[8] = {xa.x, xa.y, xa.z, xa.w, xb.x, xb.y, xb.z, xb.w};
#pragma unroll
          for (int i = 0; i < 8; ++i) { xf[i].x = __uint_as_float(xw[i] << 16); xf[i].y = __uint_as_float(xw[i] & 0xffff0000u); } }
        const float zs = rsv[t] * TINV;
        f32x2g acc[8];
#pragma unroll
        for (int i = 0; i < 8; ++i) acc[i] = (f32x2g){0.f, 0.f};
        for (int e0 = 0; e0 + 3 * GB <= 128 - GB; e0 += 3 * GB) {
            gb_load(B2, k0, k1, gp, e0 + 2 * GB, down, up, lane);
            gb_compute(B0, xf, acc, zs);
            gb_load(B0, k0, k1, gp, e0 + 3 * GB, down, up, lane);
            gb_compute(B1, xf, acc, zs);
            gb_load(B1, k0, k1, gp, e0 + 4 * GB, down, up, lane);
            gb_compute(B2, xf, acc, zs);
        }
        gb_compute(B0, xf, acc, zs); gb_compute(B1, xf, acc, zs);
        const float* xi = x1 + (size_t)t * DM + lane * 16; float* o = outw + (size_t)t * DM + lane * 16;
#pragma unroll
        for (int k = 0; k < 4; ++k) { float4 r = *(const float4*)(xi + 4 * k);
            r.x += acc[2 * k].x * TINV; r.y += acc[2 * k].y * TINV; r.z += acc[2 * k + 1].x * TINV; r.w += acc[2 * k + 1].y * TINV; *(float4*)(o + 4 * k) = r; }
#if !GATHER_STATIC
        t = (int)__builtin_amdgcn_readfirstlane(vn_);
#endif
    }
}
__device__ __forceinline__ void ph_convert_fp8(const float* __restrict__ src, unsigned* __restrict__ dst, size_t n4, int wg, int nwg, int tid, const float* __restrict__ cgain = nullptr) {
    for (size_t i = (size_t)wg * NTHR + tid; i < n4; i += (size_t)nwg * NTHR) {
        float4 v = ((const float4*)src)[i];
        if (cgain) { const float4 g = ((const float4*)cgain)[i & 255]; v.x *= g.x; v.y *= g.y; v.z *= g.z; v.w *= g.w; }
        int w = __builtin_amdgcn_cvt_pk_fp8_f32(v.x * TSCALE, v.y * TSCALE, 0, false); w = __builtin_amdgcn_cvt_pk_fp8_f32(v.z * TSCALE, v.w * TSCALE, w, true);
        dst[i] = (unsigned)w;
    }
}

__device__ __forceinline__ void ph_rowrs(const float* __restrict__ ss, float* __restrict__ rs, int wg, int nwg, int tid) {
    for (int r = wg * NTHR + tid; r < T; r += nwg * NTHR) { float s = 0.f;
#pragma unroll
        for (int k = 0; k < 16; ++k) s += ss[(size_t)k * 65536 + r];
        rs[r] = rsqrtf(s * (1.0f / DM) + EPS); }
}
#ifndef PROBE_PHASE
#define PROBE_PHASE -1
#endif
#ifndef PROBE_MULT
#define PROBE_MULT 4
#endif
#ifndef REP_ATTN
#define REP_ATTN 1
#endif
#ifndef REP_ROUTE
#define REP_ROUTE 1
#endif
#ifndef REP_GATHER
#define REP_GATHER 1
#endif
#ifndef REP_QKPOST
#define REP_QKPOST 1
#endif
__global__ void __launch_bounds__(NTHR, 2) mk_fwd(Params P) {
    extern __shared__ __attribute__((aligned(16))) unsigned char lds[];
    cg::grid_group grid = cg::this_grid();
    const int wg = blockIdx.x, nwg = gridDim.x;
#if PROBE_PHASE >= 0
    volatile unsigned* tsl = (volatile unsigned*)(lds + 147456 - 256);
#define STAMP(i) do { if (threadIdx.x == 0) tsl[i] = (unsigned)__builtin_amdgcn_s_memrealtime(); } while (0)
#else
#define STAMP(i) do {} while (0)
#endif
    STAMP(0);
    volatile LAS unsigned* bst = (volatile LAS unsigned*)((LAS unsigned char*)lds + LDS_BYTES - 512);
    if (threadIdx.x < 2) bst[threadIdx.x] = 0u;
    __syncthreads();
    XcdBarrier xbar = xcd_barrier_post((unsigned*)(P.ws + 4096), bst);
#define GRID_BAR() xcd_barrier(xbar)
    unsigned char* ws = P.ws; float* out = P.out;
    const float* x = P.in[0];
    bf16* WinT = (bf16*)(ws + WS_WIN); bf16* WoutT = (bf16*)(ws + WS_WOUT); bf16* WqT = (bf16*)(ws + WS_WQ); bf16* SUBK = (bf16*)(ws + WS_SUBK);
    unsigned char* DOWN = ws + WS_DOWN; unsigned char* UP = ws + WS_UP; bf16* XN = (bf16*)(ws + WS_XN); bf16* QKV = (bf16*)(ws + WS_QKV); bf16* PQ = (bf16*)(ws + WS_PQ);
    bf16* MIXED = (bf16*)(ws + WS_MIXED); bf16* DOB = (bf16*)(ws + WS_DO); int* IDS = (int*)(ws + WS_IDS); float* GATES = (float*)(ws + WS_GATES);
    float* ROPE = (float*)(ws + WS_ROPE); float* KMEAN = (float*)(ws + WS_KMEAN);

    ph_transpose<true>(P.in[2], 1024, 3072, WinT, (float*)lds, wg, nwg, fresh_tid());
    ph_transpose<false>(P.in[13], 1024, 1024, WoutT, (float*)lds, wg, nwg, fresh_tid());
    ph_transpose<false>(P.in[15], 1024, 2048, WqT, (float*)lds, wg, nwg, fresh_tid(), P.in[14]);
    ph_convert(P.in[16], SUBK, (size_t)16 * 128 * 128 / 4, wg, nwg, fresh_tid());
    ph_convert_fp8(P.in[17], (unsigned*)DOWN, (size_t)16384 * 1024 / 4, wg, nwg, fresh_tid(), P.in[14]);
    ph_convert_fp8(P.in[18], (unsigned*)UP, (size_t)16384 * 1024 / 4, wg, nwg, fresh_tid());
    ph_rope(ROPE, wg, nwg, fresh_tid());
    ph_rmsnorm(x, P.in[1], XN, T, wg, nwg, fresh_tid());
    GRID_BAR();
    STAMP(1);
    { pg8::Gemm g{XN, WinT, T, 3072, 1024}; pg8::EpiQKV E{QKV, QKV_ELEMS, ROPE, P.in[3], P.in[4], P.in[5], P.in[6], KMEAN, QSCALE}; pg8::StaticOrder S; S.init(g.M, g.N, nwg, wg);
      pg8::gemm_phase<pg8::EpiQKV, pg8::StaticOrder, true, true>((PG8_LAS unsigned char*)lds, g, S, E); }
    GRID_BAR();
    STAMP(2);
    STAMP(3);
    for (int rep_ = 0; rep_ < REP_ATTN; ++rep_) { const float* gain_m = P.in[11];
      for (int combo = wg; combo < NB * 8; combo += nwg) {
        const int b = combo >> 3, hd = combo & 7; const size_t brow = (size_t)b * SEQ;
        for (int qb = 7; qb >= 0; --qb) { const size_t qrow = brow + (size_t)qb * 256;
            attn_body::attn_unit<8, true>(qb, (const attn_body::bf16*)(QKV + qrow * 512 + hd * 64), (const attn_body::bf16*)(QKV + QKV_ELEMS + brow * 512 + hd * 64),
                (const attn_body::bf16*)(QKV + 2 * QKV_ELEMS + brow * 512 + hd * 64), (attn_body::bf16*)(MIXED + qrow * 1024 + hd * 64), KMEAN + ((size_t)b * 8 + hd) * 512, gain_m + hd * 64, (char*)lds); }
      }
      float lam; { float a_ = 0.f, b_ = 0.f; for (int i = 0; i < 64; ++i) { a_ += P.in[7][i] * P.in[8][i]; b_ += P.in[9][i] * P.in[10][i]; } lam = expf(a_) - expf(b_) + 0.2f; }
      const float* gain_d = P.in[12];
      for (int cw = wg; cw < NB * 8; cw += nwg) {
        const int combo = cw >> 1, b = combo >> 2, h = combo & 3; const size_t brow = (size_t)b * SEQ;
        for (int qi = 0; qi < 4; ++qi) { const int qb = (cw & 1) ? (qi == 0 ? 7 : qi == 1 ? 4 : qi == 2 ? 3 : 0) : (qi == 0 ? 6 : qi == 1 ? 5 : qi == 2 ? 2 : 1);
          const size_t qrow = brow + (size_t)qb * 256;
          for (int sub = 0; sub < 4; ++sub) { const int m = sub >> 1, c = sub & 1;
            attn_body::attn_unit<8, false>(qb, (const attn_body::bf16*)(QKV + 3 * QKV_ELEMS + qrow * 512 + h * 128 + m * 64), (const attn_body::bf16*)(QKV + 4 * QKV_ELEMS + brow * 512 + h * 128 + m * 64),
                (const attn_body::bf16*)(QKV + 5 * QKV_ELEMS + brow * 512 + h * 128 + c * 64), (attn_body::bf16*)(DOB + qrow * 1024 + h * 256 + m * 128 + c * 64), nullptr, nullptr, (char*)lds); }
          asm volatile("s_waitcnt vmcnt(0)" ::: "memory");
          { const int tid_ = fresh_tid(), lane = tid_ & 63, wv = tid_ >> 6, sub16 = lane & 15, rq = lane >> 4;
#pragma unroll 2
            for (int it = 0; it < 8; ++it) { const size_t row = qrow + wv * 32 + it * 4 + rq; const bf16* p = DOB + row * 1024 + h * 256 + sub16 * 8;
              const uint4 a1 = *(const uint4*)p, a2 = *(const uint4*)(p + 128);
              const unsigned u1[4] = {a1.x, a1.y, a1.z, a1.w}, u2[4] = {a2.x, a2.y, a2.z, a2.w}; float d[8]; float ss = 0.f;
#pragma unroll
              for (int e = 0; e < 4; ++e) { d[2 * e] = __uint_as_float(u1[e] << 16) - lam * __uint_as_float(u2[e] << 16); d[2 * e + 1] = __uint_as_float(u1[e] & 0xffff0000u) - lam * __uint_as_float(u2[e] & 0xffff0000u);
                ss += d[2 * e] * d[2 * e] + d[2 * e + 1] * d[2 * e + 1]; }
              ss += __shfl_xor(ss, 1); ss += __shfl_xor(ss, 2); ss += __shfl_xor(ss, 4); ss += __shfl_xor(ss, 8);
              const float rs = rsqrtf(ss * (1.0f / 128.0f) + EPS) * 0.8f; const float4 g0 = *(const float4*)(gain_d + h * 128 + sub16 * 8), g1 = *(const float4*)(gain_d + h * 128 + sub16 * 8 + 4);
              uint4 o; o.x = f2bf(d[0] * rs * g0.x) | (f2bf(d[1] * rs * g0.y) << 16); o.y = f2bf(d[2] * rs * g0.z) | (f2bf(d[3] * rs * g0.w) << 16);
              o.z = f2bf(d[4] * rs * g1.x) | (f2bf(d[5] * rs * g1.y) << 16); o.w = f2bf(d[6] * rs * g1.z) | (f2bf(d[7] * rs * g1.w) << 16);
              *(uint4*)(MIXED + row * 1024 + 512 + h * 128 + sub16 * 8) = o; } }
        }
      } }
    GRID_BAR();
    STAMP(4);
    STAMP(5);
    { pg8::Gemm g{MIXED, WoutT, T, 1024, 1024}; pg8::EpiRes2 E{x, out, XN, (float*)(ws + WS_SS), 1024}; pg8::StaticOrder S; S.init(g.M, g.N, nwg, wg);
      pg8::gemm_phase<pg8::EpiRes2, pg8::StaticOrder, true, true>((PG8_LAS unsigned char*)lds, g, S, E); }
    GRID_BAR();
    STAMP(6);
    ph_rowrs((const float*)(ws + WS_SS), (float*)(ws + WS_RS), wg, nwg, fresh_tid());
    GRID_BAR();
    STAMP(7);
    { pg8::Gemm g{XN, WqT, T, 2048, 1024}; pg8::EpiPQ E{PQ, (const float*)(ws + WS_RS)}; pg8::StaticOrder S; S.init(g.M, g.N, nwg, wg);
      pg8::gemm_phase<pg8::EpiPQ, pg8::StaticOrder, true, true>((PG8_LAS unsigned char*)lds, g, S, E); }
    GRID_BAR();
    STAMP(8);
    for (int rep_ = 0; rep_ < REP_ROUTE; ++rep_) ph_peer_route(PQ, SUBK, IDS, GATES, (LAS unsigned char*)lds, wg, nwg, fresh_tid());
    GRID_BAR();
    STAMP(9);
    for (int rep_ = 1; rep_ < REP_GATHER; ++rep_) ph_peer_gather(XN, IDS, GATES, DOWN, UP, out, (float*)(ws + WS_MIXED), (unsigned*)(ws + 65536 + 256 * rep_), fresh_tid(), (const float*)(ws + WS_RS));
    ph_peer_gather(XN, IDS, GATES, DOWN, UP, out, out, (unsigned*)(ws + 65536), fresh_tid(), (const float*)(ws + WS_RS));
    STAMP(10);
    grid.sync();
#if PROBE_PHASE >= 0
    if (blockIdx.x == 0 && threadIdx.x == 0) { const unsigned dt = (tsl[PROBE_PHASE + 1] - tsl[PROBE_PHASE]) * PROBE_MULT; const unsigned long long t0 = __builtin_amdgcn_s_memrealtime(); while ((unsigned)(__builtin_amdgcn_s_memrealtime() - t0) < dt) __builtin_amdgcn_s_sleep(8); }
#endif
}

extern "C" void kernel_launch(void* const* d_in, const int* in_sizes, int n_in, void* d_out, int out_size, void* d_ws, size_t ws_size, hipStream_t stream) {
    static int grid_blocks = 0;
    if (grid_blocks == 0) {
        if (n_in != 19 || in_sizes[0] != T * DM || out_size != T * DM || ws_size < WS_END) { fprintf(stderr, "kernel_launch: unexpected shapes (n_in %d in0 %d out %d ws %zu)\n", n_in, n_in > 0 ? in_sizes[0] : -1, out_size, ws_size); grid_blocks = -1; return; }
        int dev = 0, cus = 0, per_cu = 0;
        (void)hipGetDevice(&dev); (void)hipDeviceGetAttribute(&cus, hipDeviceAttributeMultiprocessorCount, dev);
        (void)hipFuncSetAttribute((const void*)mk_fwd, hipFuncAttributeMaxDynamicSharedMemorySize, LDS_BYTES);
        (void)hipOccupancyMaxActiveBlocksPerMultiprocessor(&per_cu, (const void*)mk_fwd, NTHR, LDS_BYTES);
        if (per_cu < 1 || cus < 1) { fprintf(stderr, "kernel_launch: occupancy query says %d blocks/CU on %d CUs\n", per_cu, cus); grid_blocks = -1; return; }
        if (per_cu > 1) per_cu = 1;
        grid_blocks = cus * per_cu;
    }
    if (grid_blocks < 0) return;
    (void)hipMemsetAsync(d_ws, 0, WS_ZERO_BYTES, stream);
    Params p{};
    for (int i = 0; i < 19; ++i) p.in[i] = (const float*)d_in[i];
    p.out = (float*)d_out; p.ws = (unsigned char*)d_ws;
    void* args[] = {&p};
    hipError_t e = hipLaunchCooperativeKernel((const void*)mk_fwd, dim3(grid_blocks), dim3(NTHR), args, LDS_BYTES, stream);
    if (e != hipSuccess) fprintf(stderr, "cooperative launch failed: %s (grid %d)\n", hipGetErrorString(e), grid_blocks);
}
```
